# Optimizing an MI355X kernel written in HIP

```python
import math
import jax, jax.numpy as jnp
from jax import lax
import numpy as np

D_MODEL = 1024
BATCH = 8
SEQ = 4096
DEPTH = 2

N_A_LAYERS = DEPTH // 2
N_B_LAYERS = DEPTH - N_A_LAYERS
N_EVEN = (DEPTH + 1) // 2
N_ODD = DEPTH // 2
CONV_WIDTH = 31
N_HEADS = 16
HEAD_DIM = D_MODEL // N_HEADS
DILATED_GROUPS = ((128, 1), (512, 4), (2048, 16))
N_GROUPS = len(DILATED_GROUPS)
Q_WIDTH = N_GROUPS * N_HEADS * HEAD_DIM
BLK = 128
N_BUCKETS = 32
MAX_DISTANCE = 2048
D_FF = 2752
N_EXPERTS = 8
TOP_K = 2
D_FF_EXPERT = 3584
EPS = 1e-6
NEG = -1e30

kernel_name = "yoco_conformer_dilated_moe_trunk"


def rmsnorm(x, g):
    xf = x.astype(jnp.float32)
    y = xf * lax.rsqrt(jnp.mean(xf * xf, axis=-1, keepdims=True) + EPS)
    return (y * g.astype(jnp.float32)).astype(x.dtype)


def layernorm(x, g, b):
    xf = x.astype(jnp.float32)
    mu = jnp.mean(xf, axis=-1, keepdims=True)
    var = jnp.mean(jnp.square(xf - mu), axis=-1, keepdims=True)
    y = (xf - mu) * lax.rsqrt(var + EPS)
    return (y * g.astype(jnp.float32) + b.astype(jnp.float32)).astype(x.dtype)


def swiglu(h, w_gate, w_up, w_down):
    return (jax.nn.silu(h @ w_gate) * (h @ w_up)) @ w_down


def t5_bucket(dist):
    n = np.asarray(dist)
    max_exact = N_BUCKETS // 2
    large = max_exact + (np.log(np.maximum(n, 1) / max_exact)
                         / np.log(MAX_DISTANCE / max_exact)
                         * (N_BUCKETS - max_exact)).astype(np.int32)
    large = np.minimum(large, N_BUCKETS - 1)
    return np.where(n < max_exact, n, large).astype(np.int32)


def make_band_bias(rel_bias, g):
    window, d = DILATED_GROUPS[g]
    span = window // d
    sub = BLK + np.arange(BLK)[:, None] - np.arange(2 * BLK)[None, :]
    in_band = (sub >= 0) & (sub <= span)
    bucket = t5_bucket(np.clip(sub, 0, span) * d)
    table_g = rel_bias[:, g * N_HEADS:(g + 1) * N_HEADS]
    bias = jnp.transpose(table_g[bucket], (2, 0, 1)).astype(jnp.float32)
    return jnp.where(jnp.asarray(in_band), bias, NEG)


def to_residue_layout(t, d):
    b, s = t.shape[0], t.shape[1]
    p = -(-s // (d * BLK)) * d * BLK
    t = jnp.pad(t, ((0, 0), (0, p - s)) + ((0, 0),) * (t.ndim - 2))
    t = t.reshape((b, p // d, d) + t.shape[2:])
    return jnp.swapaxes(t, 1, 2)


def from_residue_layout(t, s):
    b, d, l = t.shape[0], t.shape[1], t.shape[2]
    t = jnp.swapaxes(t, 1, 2)
    return t.reshape((b, l * d) + t.shape[3:])[:, :s]


def conv_module(x, norm_g, w_in, b_in, dw_w, dw_b, ln_g, ln_b, w_out, b_out):
    h = rmsnorm(x, norm_g)
    u = h @ w_in + b_in
    a, gate = jnp.split(u, 2, axis=-1)
    u = a * jax.nn.sigmoid(gate)
    u = lax.conv_general_dilated(u, dw_w[:, None, :], window_strides=(1,),
                                 padding=[(CONV_WIDTH - 1, 0)],
                                 dimension_numbers=('NWC', 'WIO', 'NWC'),
                                 feature_group_count=D_MODEL) + dw_b
    u = jax.nn.silu(layernorm(u, ln_g, ln_b))
    return u @ w_out + b_out


def shared_kv(x, kv_norm, w_kv, k_norm):
    b, s, _ = x.shape
    h = rmsnorm(x, kv_norm)
    kv = (h @ w_kv).reshape(b, s, 2, N_GROUPS, N_HEADS, HEAD_DIM)
    k = rmsnorm(kv[:, :, 0], k_norm[:, None, :])
    v = kv[:, :, 1]
    ks, vs = [], []
    for g, (_, d) in enumerate(DILATED_GROUPS):
        pad = ((0, 0), (0, 0), (BLK, 0), (0, 0), (0, 0))
        ks.append(jnp.pad(to_residue_layout(k[:, :, g], d), pad))
        vs.append(jnp.pad(to_residue_layout(v[:, :, g], d), pad))
    return ks, vs


def dilated_branch(q, k_res, v_res, band_bias, d):
    s = q.shape[1]
    q_res = to_residue_layout(q, d)
    b, _, l = q_res.shape[0], q_res.shape[1], q_res.shape[2]
    nb = l // BLK
    scale = HEAD_DIM ** -0.5

    def block(i):
        qb = lax.dynamic_slice_in_dim(q_res, i * BLK, BLK, axis=2).astype(jnp.float32)
        kb = lax.dynamic_slice_in_dim(k_res, i * BLK, 2 * BLK, axis=2).astype(jnp.float32)
        vb = lax.dynamic_slice_in_dim(v_res, i * BLK, 2 * BLK, axis=2).astype(jnp.float32)
        sc = jnp.einsum('brqhd,brkhd->brhqk', qb, kb) * scale + band_bias
        key_ok = (i * BLK - BLK + jnp.arange(2 * BLK)) >= 0
        sc = jnp.where(key_ok, sc, NEG)
        m = jnp.max(sc, axis=-1, keepdims=True)
        p = jnp.exp(sc - m)
        den = jnp.sum(p, axis=-1, keepdims=True)
        o = jnp.einsum('brhqk,brkhd->brqhd', p, vb) / jnp.swapaxes(den, 2, 3)
        lse = jnp.swapaxes((m + jnp.log(den))[..., 0], 2, 3)
        return o, lse

    o, lse = lax.map(block, jnp.arange(nb))
    o = jnp.moveaxis(o, 0, 2).reshape(b, d, l, N_HEADS, HEAD_DIM)
    lse = jnp.moveaxis(lse, 0, 2).reshape(b, d, l, N_HEADS)
    return from_residue_layout(o, s), from_residue_layout(lse, s)


def dilated_attention(x, norm_g, w_q, q_norm, w_o, ks, vs, band_biases):
    b, s, _ = x.shape
    h = rmsnorm(x, norm_g)
    q = (h @ w_q).reshape(b, s, N_GROUPS, N_HEADS, HEAD_DIM)
    q = rmsnorm(q, q_norm[:, None, :])
    outs, lses = [], []
    for g, (_, d) in enumerate(DILATED_GROUPS):
        o_g, lse_g = dilated_branch(q[:, :, g], ks[g], vs[g], band_biases[g], d)
        outs.append(o_g)
        lses.append(lse_g)
    wgt = jax.nn.softmax(jnp.stack(lses, axis=-1), axis=-1)
    o = jnp.einsum('bshg,bshgd->bshd', wgt, jnp.stack(outs, axis=3))
    return o.reshape(b, s, N_HEADS * HEAD_DIM).astype(x.dtype) @ w_o


def moe_ffn(x, norm_g, w_router, w_gate, w_up, w_down):
    h = rmsnorm(x, norm_g).reshape(-1, D_MODEL)
    logits = (h @ w_router).astype(jnp.float32)
    top_val, top_idx = lax.top_k(logits, TOP_K)
    gates = jax.nn.softmax(top_val, axis=-1)
    combine = jnp.sum(jax.nn.one_hot(top_idx, N_EXPERTS, dtype=jnp.float32)
                      * gates[..., None], axis=1)
    y = jnp.zeros(h.shape, jnp.float32)
    for e in range(N_EXPERTS):
        y = y + combine[:, e:e + 1] * swiglu(h, w_gate[e], w_up[e], w_down[e]).astype(jnp.float32)
    return y.astype(x.dtype).reshape(x.shape)


def setup_inputs(seed: int = 0) -> dict:
    key = jax.random.key(seed)
    ks = jax.random.split(key, 32)

    def nrm(k, shape, scale):
        return jax.random.normal(k, shape, jnp.float32) * scale

    def gain(k, shape):
        return 1.0 + 0.02 * jax.random.normal(k, shape, jnp.float32)

    D = D_MODEL
    return {
        "x": nrm(ks[0], (BATCH, SEQ, D), 1.0),
        "rel_bias": nrm(ks[1], (N_BUCKETS, N_GROUPS * N_HEADS), 0.5),
        "conv_norm": gain(ks[2], (N_A_LAYERS, D)),
        "conv_w_in": nrm(ks[3], (N_A_LAYERS, D, 2 * D), D ** -0.5),
        "conv_b_in": nrm(ks[4], (N_A_LAYERS, 2 * D), 0.02),
        "conv_dw_w": nrm(ks[5], (N_A_LAYERS, CONV_WIDTH, D), CONV_WIDTH ** -0.5),
        "conv_dw_b": nrm(ks[6], (N_A_LAYERS, D), 0.02),
        "conv_ln_g": gain(ks[7], (N_A_LAYERS, D)),
        "conv_ln_b": nrm(ks[8], (N_A_LAYERS, D), 0.02),
        "conv_w_out": nrm(ks[9], (N_A_LAYERS, D, D), D ** -0.5),
        "conv_b_out": nrm(ks[10], (N_A_LAYERS, D), 0.02),
        "kv_norm": gain(ks[11], (D,)),
        "w_kv": nrm(ks[12], (D, 2 * Q_WIDTH), D ** -0.5),
        "k_norm": gain(ks[13], (N_GROUPS, HEAD_DIM)),
        "attn_norm": gain(ks[14], (N_B_LAYERS, D)),
        "w_q": nrm(ks[15], (N_B_LAYERS, D, Q_WIDTH), D ** -0.5),
        "q_norm": gain(ks[16], (N_B_LAYERS, N_GROUPS, HEAD_DIM)),
        "w_o": nrm(ks[17], (N_B_LAYERS, N_HEADS * HEAD_DIM, D), (N_HEADS * HEAD_DIM) ** -0.5),
        "ffn_norm": gain(ks[18], (DEPTH, D)),
        "ffn_w_gate": nrm(ks[19], (N_EVEN, D, D_FF), D ** -0.5),
        "ffn_w_up": nrm(ks[20], (N_EVEN, D, D_FF), D ** -0.5),
        "ffn_w_down": nrm(ks[21], (N_EVEN, D_FF, D), D_FF ** -0.5),
        "moe_router": nrm(ks[22], (N_ODD, D, N_EXPERTS), D ** -0.5),
        "moe_w_gate": nrm(ks[23], (N_ODD, N_EXPERTS, D, D_FF_EXPERT), D ** -0.5),
        "moe_w_up": nrm(ks[24], (N_ODD, N_EXPERTS, D, D_FF_EXPERT), D ** -0.5),
        "moe_w_down": nrm(ks[25], (N_ODD, N_EXPERTS, D_FF_EXPERT, D), D_FF_EXPERT ** -0.5),
    }


def reference(x, rel_bias, conv_norm, conv_w_in, conv_b_in, conv_dw_w, conv_dw_b,
              conv_ln_g, conv_ln_b, conv_w_out, conv_b_out, kv_norm, w_kv, k_norm,
              attn_norm, w_q, q_norm, w_o, ffn_norm, ffn_w_gate, ffn_w_up, ffn_w_down,
              moe_router, moe_w_gate, moe_w_up, moe_w_down):
    band_biases = [make_band_bias(rel_bias, g) for g in range(N_GROUPS)]
    ks, vs = None, None
    for l in range(DEPTH):
        if l == N_A_LAYERS:
            ks, vs = shared_kv(x, kv_norm, w_kv, k_norm)
        if l < N_A_LAYERS:
            x = x + conv_module(x, conv_norm[l], conv_w_in[l], conv_b_in[l], conv_dw_w[l],
                                conv_dw_b[l], conv_ln_g[l], conv_ln_b[l], conv_w_out[l],
                                conv_b_out[l])
        else:
            j = l - N_A_LAYERS
            x = x + dilated_attention(x, attn_norm[j], w_q[j], q_norm[j], w_o[j],
                                      ks, vs, band_biases)
        if l % 2 == 0:
            e = l // 2
            x = x + swiglu(rmsnorm(x, ffn_norm[l]), ffn_w_gate[e], ffn_w_up[e], ffn_w_down[e])
        else:
            e = l // 2
            x = x + moe_ffn(x, ffn_norm[l], moe_router[e], moe_w_gate[e], moe_w_up[e],
                            moe_w_down[e])
    return x
```

```cpp
#include <hip/hip_runtime.h>
#include <cstdio>
#include <cstdint>
#ifndef MK_N_LAUNCHES
#define MK_N_LAUNCHES 1
#endif
namespace pg8 {
#define PG8_LAS __attribute__((address_space(3)))
typedef unsigned short bf16_t;
typedef short bf16x8 __attribute__((ext_vector_type(8)));
typedef float f32x4 __attribute__((ext_vector_type(4)));
typedef float f32x2 __attribute__((ext_vector_type(2)));
typedef unsigned u32x4 __attribute__((ext_vector_type(4)));
typedef unsigned u32x2 __attribute__((ext_vector_type(2)));
constexpr int BM = 256, BK = 64, HALF = 128, HTB = HALF * BK * 2  , STAGE_BYTES = 8 * HTB, NXCD = 8, WGM = 8;

__host__ __device__ __forceinline__ int lds_byte(int r, int c) { const int st = (r >> 4) * 2 + (c >> 5), rr = r & 15, cc = c & 31, ob = rr * 64 + cc * 2; return st * 1024 + (ob ^ (((ob >> 9) & 1) << 5)); }
__host__ __device__ __forceinline__ void stage_rc(int b, int& R, int& C) { const int st = b / 1024, sb = b % 1024, swz = sb ^ (((sb >> 9) & 1) << 5); R = (st >> 1) * 16 + swz / 64; C = (st & 1) * 32 + (swz % 64) / 2; }
__host__ __device__ __forceinline__ int perm32(int rho) { const int n = rho >> 4, i = rho & 15; return 8 * (i >> 2) + 4 * n + (i & 3); }

struct Unit { int pm, pn, be; };
struct Gemm { const bf16_t* A; const bf16_t* Bt; int M, N, K; size_t bstride; const int* rowtok; };

struct StaticOrder {
    int nM, nN, nwg, G, c;
    __host__ __device__ void init(int M, int N, int G_, int c_) { nM = M / BM; nN = N / BM; nwg = nM * nN; G = G_; c = c_; }
    __host__ __device__ bool next(int i, Unit& u) const {
        const long L = (long)i * G + c; if (L >= nwg) return false;
        int wgid = (int)L; { const int q = nwg / NXCD, r = nwg % NXCD, xcd = wgid % NXCD, off = wgid / NXCD; wgid = (xcd < r ? xcd * (q + 1) : r * (q + 1) + (xcd - r) * q) + off; }
        const int nig = WGM * nN, gid = wgid / nig, fm = gid * WGM, gsz = (nM - fm) < WGM ? (nM - fm) : WGM;
        u.pm = fm + ((wgid % nig) % gsz); u.pn = (wgid % nig) / gsz; u.be = 0; return true;
    }
};
struct MoeOrder {
    StaticOrder so; int t1, t2, t3, t4, t5, t6, t7;
    __device__ bool next(int i, Unit& u) const {
        if (!so.next(i, u)) return false;
        const int p = u.pm; u.be = (p >= t1) + (p >= t2) + (p >= t3) + (p >= t4) + (p >= t5) + (p >= t6) + (p >= t7); return true;
    }
};

__device__ __forceinline__ unsigned cvt_pk_bf16(float lo, float hi) { unsigned r; asm volatile("v_cvt_pk_bf16_f32 %0, %1, %2" : "=v"(r) : "v"(lo), "v"(hi)); return r; }
__device__ __forceinline__ float fast_sigmoid(float x) { return __builtin_amdgcn_rcpf(1.0f + __builtin_amdgcn_exp2f(-1.4426950408889634f * x)); }
__device__ __forceinline__ float row_rstd(const float* part, int row) {
    const f32x4* p = (const f32x4*)(part + (size_t)row * 16);
    const f32x4 a = p[0], b = p[1], c = p[2], d = p[3];
    const float s = ((a[0] + a[1]) + (a[2] + a[3])) + ((b[0] + b[1]) + (b[2] + b[3])) + ((c[0] + c[1]) + (c[2] + c[3])) + ((d[0] + d[1]) + (d[2] + d[3]));
    return __builtin_amdgcn_rsqf(s * (1.0f / 1024.0f) + 1e-6f);
}


template <int MODE> struct EpiGated {
    static constexpr bool PERM = true, AFTER_DRAIN = false;
    bf16_t* O; int ldo; const float* bias; int bias_half; const float* part;
    __device__ __forceinline__ void operator()(const f32x4 (&acc)[2][2][4][2], const Unit& u, int wr, int wc, int fr, int fq) const {
        const int row0 = u.pm * BM + wr * 64 + fr, col0 = u.pn * 128 + wc * 32 + 8 * fq;
        f32x4 ba[2], bg[2];
#pragma unroll
        for (int n = 0; n < 2; ++n) { if (MODE == 0) { ba[n] = *(const f32x4*)(bias + col0 + 4 * n); bg[n] = *(const f32x4*)(bias + bias_half + col0 + 4 * n); } else { ba[n] = (f32x4){0.f, 0.f, 0.f, 0.f}; bg[n] = ba[n]; } }
#pragma unroll
        for (int ai = 0; ai < 2; ++ai)
#pragma unroll
            for (int m = 0; m < 4; ++m) { const int row = row0 + ai * HALF + m * 16;
                float r = 1.f; if (MODE == 1) r = row_rstd(part, row);
                f32x4 o[2];
#pragma unroll
                for (int n = 0; n < 2; ++n) { f32x4 a = acc[ai][0][m][n], g = acc[ai][1][m][n];
                    if (MODE == 0) { a = a + ba[n]; g = g + bg[n];
#pragma unroll
                        for (int e = 0; e < 4; ++e) o[n][e] = a[e] * fast_sigmoid(g[e]); }
                    else { if (MODE == 1) { a = a * r; g = g * r; }
#pragma unroll
                        for (int e = 0; e < 4; ++e) o[n][e] = a[e] * fast_sigmoid(a[e]) * g[e]; } }
                u32x4 w; w.x = cvt_pk_bf16(o[0][0], o[0][1]); w.y = cvt_pk_bf16(o[0][2], o[0][3]); w.z = cvt_pk_bf16(o[1][0], o[1][1]); w.w = cvt_pk_bf16(o[1][2], o[1][3]);
                *(u32x4*)(O + (size_t)row * ldo + col0) = w;
                if (MODE == 1) asm volatile("" ::: "memory"); }
    }
};
template <bool BIAS, bool AUX> struct EpiResid {
    static constexpr bool PERM = false, AFTER_DRAIN = false;
    const float* resid; float* out; const float* bias; bf16_t* xb; float* part;
    __device__ __forceinline__ void operator()(const f32x4 (&acc)[2][2][4][2], const Unit& u, int wr, int wc, int fr, int fq) const {
        const int row0 = u.pm * BM + wr * 64 + fr, col0 = u.pn * BM + wc * 32 + 4 * fq;
        f32x4 bv[2][2];
#pragma unroll
        for (int bj = 0; bj < 2; ++bj)
#pragma unroll
            for (int n = 0; n < 2; ++n) bv[bj][n] = BIAS ? *(const f32x4*)(bias + col0 + bj * HALF + n * 16) : (f32x4){0.f, 0.f, 0.f, 0.f};
#pragma unroll
        for (int ai = 0; ai < 2; ++ai)
#pragma unroll
            for (int m = 0; m < 4; ++m) { const int row = row0 + ai * HALF + m * 16; const size_t off = (size_t)row * 1024 + col0; float ss = 0.f;
#pragma unroll
                for (int bj = 0; bj < 2; ++bj)
#pragma unroll
                    for (int n = 0; n < 2; ++n) { const f32x4 x = *(const f32x4*)(resid + off + bj * HALF + n * 16) + acc[ai][bj][m][n] + bv[bj][n];
                        *(f32x4*)(out + off + bj * HALF + n * 16) = x;
                        if (AUX) { ss += (x[0] * x[0] + x[1] * x[1]) + (x[2] * x[2] + x[3] * x[3]); u32x2 w; w.x = cvt_pk_bf16(x[0], x[1]); w.y = cvt_pk_bf16(x[2], x[3]); *(u32x2*)(xb + off + bj * HALF + n * 16) = w; } }
                if (AUX) { ss += __shfl_xor(ss, 16); ss += __shfl_xor(ss, 32); if (fq == 0) part[(size_t)row * 16 + u.pn * 4 + wc] = ss; }
                if (m & 1) asm volatile("" ::: "memory"); }
    }
};
struct EpiQKV {
    static constexpr bool PERM = true, AFTER_DRAIN = false;
    bf16_t* Kb; size_t kvq_stride; const float* part; const float* kgain; const float* qgain; float qscale;
    __device__ __forceinline__ void operator()(const f32x4 (&acc)[2][2][4][2], const Unit& u, int wr, int wc, int fr, int fq) const {
        const int kind = u.pn >> 2, head = (u.pn & 3) * 4 + wc;
        bf16_t* dst = Kb + (size_t)kind * kvq_stride;
        const float* gsrc = kind == 0 ? kgain : qgain; const float gs = kind == 2 ? qscale : 1.f;
        const int row0 = u.pm * BM + wr * 64 + fr, colb = head * 64 + 8 * fq;
        f32x4 gv[2][2];
#pragma unroll
        for (int bj = 0; bj < 2; ++bj)
#pragma unroll
            for (int n = 0; n < 2; ++n) gv[bj][n] = *(const f32x4*)(gsrc + 32 * bj + 8 * fq + 4 * n) * gs;
#pragma unroll
        for (int ai = 0; ai < 2; ++ai)
#pragma unroll
            for (int m = 0; m < 4; ++m) { const int row = row0 + ai * HALF + m * 16; const float r = row_rstd(part, row);
                f32x4 v[2][2]; float ss = 0.f;
#pragma unroll
                for (int bj = 0; bj < 2; ++bj)
#pragma unroll
                    for (int n = 0; n < 2; ++n) { v[bj][n] = acc[ai][bj][m][n] * r; const f32x4 x = v[bj][n]; ss += (x[0] * x[0] + x[1] * x[1]) + (x[2] * x[2] + x[3] * x[3]); }
                ss += __shfl_xor(ss, 16); ss += __shfl_xor(ss, 32);
                if (kind != 1) { const float inv = __builtin_amdgcn_rsqf(ss * (1.0f / 64.0f) + 1e-6f);
#pragma unroll
                    for (int bj = 0; bj < 2; ++bj)
#pragma unroll
                        for (int n = 0; n < 2; ++n) v[bj][n] = v[bj][n] * gv[bj][n] * inv; }
#pragma unroll
                for (int bj = 0; bj < 2; ++bj) { u32x4 w; w.x = cvt_pk_bf16(v[bj][0][0], v[bj][0][1]); w.y = cvt_pk_bf16(v[bj][0][2], v[bj][0][3]); w.z = cvt_pk_bf16(v[bj][1][0], v[bj][1][1]); w.w = cvt_pk_bf16(v[bj][1][2], v[bj][1][3]);
                    *(u32x4*)(dst + (size_t)row * 1024 + colb + 32 * bj) = w; }
                asm volatile("" ::: "memory"); }
    }
};
struct EpiMoeDown {
    static constexpr bool PERM = false, AFTER_DRAIN = false;
    float* out; const int* rowtok; const float* rowgate;
    __device__ __forceinline__ void operator()(const f32x4 (&acc)[2][2][4][2], const Unit& u, int wr, int wc, int fr, int fq) const {
        const int rt0 = u.pm * BM + wr * 64 + fr, col0 = u.pn * BM + wc * 32 + 4 * fq;
#pragma unroll
        for (int ai = 0; ai < 2; ++ai)
#pragma unroll
            for (int m = 0; m < 4; ++m) { const int rt = rt0 + ai * HALF + m * 16; const int tok = rowtok[rt];
                if (tok >= 0) { const float gt = rowgate[rt]; float* p = out + (size_t)tok * 1024 + col0;
#pragma unroll
                    for (int bj = 0; bj < 2; ++bj)
#pragma unroll
                        for (int n = 0; n < 2; ++n) { f32x4 x = *(const f32x4*)(p + bj * HALF + n * 16); x = x + acc[ai][bj][m][n] * gt; *(f32x4*)(p + bj * HALF + n * 16) = x; } }
                if (m & 1) asm volatile("" ::: "memory"); }
    }
};

template <class Epi, class Sched, bool GATHER>
__device__ __forceinline__ void gemm_phase(PG8_LAS unsigned char* lds, const Gemm g, const Sched& S, const Epi& E, const int tid) {
    const int wid = __builtin_amdgcn_readfirstlane(tid >> 6), lane = tid & 63, wr = wid >> 2, wc = wid & 3, fr = lane & 15, fq = lane >> 4;
    const int K = g.K, nt = K / BK;
    unsigned voffB[2]; unsigned vC0[2], vC1[2], vN0[2], vN1[2]; int Rr[2], Cc[2];
#pragma unroll
    for (int i = 0; i < 2; ++i) { int R, C; stage_rc(tid * 16 + i * 8192, R, C); const int Rb = Epi::PERM ? ((R & ~31) + perm32(R & 31)) : R;
        Rr[i] = R; Cc[i] = C; vC0[i] = (unsigned)(R * K + C) * 2u; vC1[i] = vC0[i]; vN0[i] = vC0[i]; vN1[i] = vC0[i]; voffB[i] = (unsigned)(Rb * K + C) * 2u; }
    const size_t kstep = (size_t)(BK * 2);
    const size_t hstep = (size_t)HALF * K * 2;
    const size_t hstepA = GATHER ? 0 : hstep;
    const size_t tstep = 2 * hstep;
    const unsigned ldsw = (unsigned)wid * 1024u;
    const int aoff = lds_byte(wr * 64 + fr, fq * 8), boff = lds_byte(wc * 32 + fr, fq * 8);
#define PG8_SA(b, h) (((b) * 2 + (h)) * HTB)
#define PG8_SB(b, h) ((4 + (b) * 2 + (h)) * HTB)
#define PG8_STAGE(bufoff, gbase, v0, v1) do { \
        __builtin_amdgcn_global_load_lds((const unsigned*)((const char*)(gbase) + (v0)), (PG8_LAS unsigned*)(lds + (bufoff) + ldsw), 16, 0, 0); \
        __builtin_amdgcn_global_load_lds((const unsigned*)((const char*)(gbase) + (v1)), (PG8_LAS unsigned*)(lds + (bufoff) + ldsw + 8192), 16, 0, 0); } while (0)
#define PG8_LDA(dst, b, h) do { _Pragma("unroll") for (int m = 0; m < 4; ++m) _Pragma("unroll") for (int k = 0; k < 2; ++k) dst[m][k] = *(const PG8_LAS bf16x8*)(lds + PG8_SA(b, h) + aoff + m * 2048 + k * 1024); } while (0)
#define PG8_LDB(dst, b, h) do { _Pragma("unroll") for (int n = 0; n < 2; ++n) _Pragma("unroll") for (int k = 0; k < 2; ++k) dst[n][k] = *(const PG8_LAS bf16x8*)(lds + PG8_SB(b, h) + boff + n * 2048 + k * 1024); } while (0)
#define PG8_MMA(ai, bj, At, Bt) do { __builtin_amdgcn_s_setprio(1); _Pragma("unroll") for (int m = 0; m < 4; ++m) _Pragma("unroll") for (int n = 0; n < 2; ++n) _Pragma("unroll") for (int k = 0; k < 2; ++k) \
        acc[ai][bj][m][n] = __builtin_amdgcn_mfma_f32_16x16x32_bf16(Bt[n][k], At[m][k], acc[ai][bj][m][n], 0, 0, 0); __builtin_amdgcn_s_setprio(0); } while (0)
#define PG8_WAIT_V(n) asm volatile("s_waitcnt vmcnt(" #n ")" ::: "memory")
#define PG8_WAIT_L(n) asm volatile("s_waitcnt lgkmcnt(" #n ")" ::: "memory")
#define PG8_BAR __builtin_amdgcn_s_barrier()
#define PG8_SCHED __builtin_amdgcn_sched_barrier(0)
#define PG8_TOKOFF(pm_, h_, i_) ({ int t_ = g.rowtok[(pm_) * BM + (h_) * HALF + Rr[i_]]; t_ = t_ < 0 ? 0 : t_; (unsigned)(t_ * K + Cc[i_]) * 2u; })
    Unit cur, nxt; int ui = 0;
    if (!S.next(0, cur)) return;
    f32x4 acc[2][2][4][2];
#pragma unroll
    for (int a = 0; a < 2; ++a)
#pragma unroll
        for (int b = 0; b < 2; ++b)
#pragma unroll
            for (int m = 0; m < 4; ++m)
#pragma unroll
                for (int n = 0; n < 2; ++n) acc[a][b][m][n] = (f32x4){0.f, 0.f, 0.f, 0.f};
    bf16x8 At[4][2], B0[2][2], B1[2][2];
    if (GATHER) {
#pragma unroll
        for (int i = 0; i < 2; ++i) { vC0[i] = PG8_TOKOFF(cur.pm, 0, i); vC1[i] = PG8_TOKOFF(cur.pm, 1, i); }
    }
    const char* cA = GATHER ? (const char*)g.A : (const char*)g.A + (size_t)cur.pm * tstep;
    const char* cB = (const char*)g.Bt + (size_t)cur.be * g.bstride + (size_t)cur.pn * tstep;
    PG8_STAGE(PG8_SB(0, 0), cB, voffB[0], voffB[1]); PG8_STAGE(PG8_SB(0, 1), cB + hstep, voffB[0], voffB[1]); PG8_STAGE(PG8_SA(0, 0), cA, vC0[0], vC0[1]); PG8_STAGE(PG8_SA(0, 1), cA + hstepA, vC1[0], vC1[1]);
    if (wr == 1) PG8_BAR;
    PG8_WAIT_V(2); PG8_BAR;
    PG8_STAGE(PG8_SB(1, 0), cB + kstep, voffB[0], voffB[1]); PG8_STAGE(PG8_SA(1, 0), cA + kstep, vC0[0], vC0[1]); PG8_STAGE(PG8_SB(1, 1), cB + hstep + kstep, voffB[0], voffB[1]);
    PG8_WAIT_V(6); PG8_BAR;
    for (;;) {
        const bool has_next = S.next(ui + 1, nxt);
        const char* nA = GATHER ? (const char*)g.A : (has_next ? (const char*)g.A + (size_t)nxt.pm * tstep : cA);
        const char* nB = has_next ? (const char*)g.Bt + (size_t)nxt.be * g.bstride + (size_t)nxt.pn * tstep : cB;
        if (GATHER) {
            if (has_next) {
#pragma unroll
                for (int i = 0; i < 2; ++i) { vN0[i] = PG8_TOKOFF(nxt.pm, 0, i); vN1[i] = PG8_TOKOFF(nxt.pm, 1, i); }
            } else {
#pragma unroll
                for (int i = 0; i < 2; ++i) { vN0[i] = vC0[i]; vN1[i] = vC1[i]; }
            }
        }
        for (int t = 0; t < nt; t += 2) {
            const bool last = (t == nt - 2);
            const char* a1 = cA + (size_t)(t + 1) * kstep;
            const char* a2 = last ? nA : cA + (size_t)(t + 2) * kstep; const char* b2 = last ? nB : cB + (size_t)(t + 2) * kstep;
            const char* a3 = a2 + kstep; const char* b3 = b2 + kstep;
            const unsigned x00 = (GATHER && last) ? vN0[0] : vC0[0], x01 = (GATHER && last) ? vN0[1] : vC0[1], x10 = (GATHER && last) ? vN1[0] : vC1[0], x11 = (GATHER && last) ? vN1[1] : vC1[1];
            PG8_LDB(B0, 0, 0); PG8_LDB(B1, 0, 1); PG8_SCHED; PG8_LDA(At, 0, 0); PG8_STAGE(PG8_SA(1, 1), a1 + hstepA, vC1[0], vC1[1]);
            PG8_WAIT_V(8); PG8_WAIT_L(0); PG8_BAR; PG8_MMA(0, 0, At, B0); PG8_MMA(0, 1, At, B1); PG8_BAR; PG8_SCHED;
            PG8_LDA(At, 0, 1); PG8_STAGE(PG8_SB(0, 0), b2, voffB[0], voffB[1]); PG8_STAGE(PG8_SB(0, 1), b2 + hstep, voffB[0], voffB[1]); PG8_STAGE(PG8_SA(0, 0), a2, x00, x01);
            PG8_WAIT_V(8); PG8_WAIT_L(0); PG8_BAR; PG8_MMA(1, 0, At, B0); PG8_MMA(1, 1, At, B1); PG8_BAR; PG8_SCHED;
            PG8_LDB(B0, 1, 0); PG8_LDB(B1, 1, 1); PG8_SCHED; PG8_LDA(At, 1, 0); PG8_STAGE(PG8_SA(0, 1), a2 + hstepA, x10, x11);
            PG8_WAIT_V(8); PG8_WAIT_L(0); PG8_BAR; PG8_MMA(0, 0, At, B0); PG8_MMA(0, 1, At, B1); PG8_BAR; PG8_SCHED;
            PG8_LDA(At, 1, 1); PG8_STAGE(PG8_SB(1, 0), b3, voffB[0], voffB[1]); PG8_STAGE(PG8_SB(1, 1), b3 + hstep, voffB[0], voffB[1]); PG8_STAGE(PG8_SA(1, 0), a3, x00, x01);
            PG8_WAIT_V(8); PG8_WAIT_L(0); PG8_BAR; PG8_MMA(1, 0, At, B0); PG8_MMA(1, 1, At, B1); PG8_BAR; PG8_SCHED;
        }
        if (wr == 0) PG8_BAR;
        E(acc, cur, wr, wc, fr, fq);
        if (!has_next) break;
#pragma unroll
        for (int a = 0; a < 2; ++a)
#pragma unroll
            for (int b = 0; b < 2; ++b)
#pragma unroll
                for (int m = 0; m < 4; ++m)
#pragma unroll
                    for (int n = 0; n < 2; ++n) acc[a][b][m][n] = (f32x4){0.f, 0.f, 0.f, 0.f};
        cur = nxt; cA = nA; cB = nB; ++ui;
        if (GATHER) {
#pragma unroll
            for (int i = 0; i < 2; ++i) { vC0[i] = vN0[i]; vC1[i] = vN1[i]; }
        }
        if (wr == 1) PG8_BAR;
    }
    PG8_WAIT_V(0);
    PG8_BAR;
#undef PG8_SA
#undef PG8_SB
#undef PG8_STAGE
#undef PG8_LDA
#undef PG8_LDB
#undef PG8_MMA
#undef PG8_WAIT_V
#undef PG8_WAIT_L
#undef PG8_BAR
#undef PG8_SCHED
#undef PG8_TOKOFF
}
}
#define GAS __attribute__((address_space(1)))
#define LAS __attribute__((address_space(3)))
typedef unsigned short bf16;
typedef unsigned v4u __attribute__((ext_vector_type(4)));
typedef float f32x4 __attribute__((ext_vector_type(4)));
typedef short bf16x8 __attribute__((ext_vector_type(8)));
typedef GAS unsigned gu32;
typedef GAS unsigned long long gu64;
#define RLX_AGENT __ATOMIC_RELAXED, __HIP_MEMORY_SCOPE_AGENT
#define LDS_WAIT() asm volatile("s_waitcnt lgkmcnt(0)" ::: "memory")
#define VM_WAIT() asm volatile("s_waitcnt vmcnt(0)" ::: "memory")
__device__ __forceinline__ unsigned long long rt() { return __builtin_amdgcn_s_memrealtime(); }
__device__ __forceinline__ unsigned f2bf(float f) { unsigned u = __builtin_bit_cast(unsigned, f); return (u + 0x7fffu + ((u >> 16) & 1u)) >> 16; }
__device__ __forceinline__ unsigned pk2(float lo, float hi) { return f2bf(lo) | (f2bf(hi) << 16); }

#define XB_TMO      128
#define XB_XCNT(j)  (256  + 64 * (j))
#define XB_XSUB(j)  (1280 + 64 * (j))
#define XB_XGEN(j)  (2304 + 64 * (j))
#define XB_TOP      3328
#define XB_TOPGEN   3392
#define XCD_BAR_WORDS 3456
#define XB_SPIN_CAP (1u << 18)

__device__ __forceinline__ unsigned xb_ld(unsigned* p)              { return __hip_atomic_load(p, __ATOMIC_RELAXED, __HIP_MEMORY_SCOPE_AGENT); }
__device__ __forceinline__ unsigned xb_add(unsigned* p, unsigned v) { return __hip_atomic_fetch_add(p, v, __ATOMIC_RELAXED, __HIP_MEMORY_SCOPE_AGENT); }
__device__ __forceinline__ unsigned xb_xcc_id() { return (unsigned)__builtin_amdgcn_s_getreg((3 << 11) | 20) & 0xFu; }
#define XB_SPIN(cond, bar) do { unsigned _sp = 0; while (cond) { __builtin_amdgcn_s_sleep(1); \
    if ((++_sp & 255u) == 0u) { if (xb_ld(&(bar)[XB_TMO])) break; if (_sp > XB_SPIN_CAP) { atomicAdd(&(bar)[XB_TMO], 1u); break; } } } } while (0)

struct XcdBarrier {
    unsigned* bar; unsigned x;
    volatile LAS unsigned* st;
};

__device__ __forceinline__ XcdBarrier xcd_barrier_post(unsigned* bar, volatile LAS unsigned* st) {
    XcdBarrier b; b.bar = bar; b.x = xb_xcc_id(); b.st = st;
    if (threadIdx.x == 0) (void)xb_add(&bar[XB_XCNT(b.x)], 1u);
    return b;
}
__device__ __forceinline__ void xcd_barrier_complete(unsigned* bar, unsigned x, unsigned& nloc, unsigned& nx) {
    const unsigned G = gridDim.x * gridDim.y * gridDim.z;
    unsigned sum, cnt, mine, sp = 0u;
    for (;;) {
        sum = 0u; cnt = 0u; mine = 0u;
#pragma unroll
        for (unsigned j = 0; j < 16; ++j) { const unsigned c = xb_ld(&bar[XB_XCNT(j)]); sum += c; cnt += (c > 0u) ? 1u : 0u; mine = (j == x) ? c : mine; }
        if (sum == G) break;
        __builtin_amdgcn_s_sleep(1);
        if ((++sp & 255u) == 0u) { if (xb_ld(&bar[XB_TMO])) break; if (sp > XB_SPIN_CAP) { atomicAdd(&bar[XB_TMO], 1u); break; } }
    }
    nloc = mine > 0u ? mine : 1u; nx = cnt > 0u ? cnt : 1u;
}

__device__ __forceinline__ void xcd_barrier(const XcdBarrier& b) {
    asm volatile("s_waitcnt vmcnt(0)" ::: "memory");
    __syncthreads();
    if (threadIdx.x == 0) {
        unsigned* bar = b.bar;
        __builtin_amdgcn_s_waitcnt(0);
        unsigned nloc = b.st[0], nx = b.st[1];
        if (nloc == 0u) { xcd_barrier_complete(bar, b.x, nloc, nx); b.st[0] = nloc; b.st[1] = nx; }
        const unsigned old = xb_add(&bar[XB_XSUB(b.x)], 1u);
        const unsigned gen = old / nloc;
        if (old + 1u == (gen + 1u) * nloc) {
            __builtin_amdgcn_fence(__ATOMIC_RELEASE, "agent");
            asm volatile("s_waitcnt vmcnt(0)" ::: "memory");
            const unsigned og = xb_add(&bar[XB_TOP], 1u);
            const unsigned tg = og / nx;
            if (og + 1u == (tg + 1u) * nx) xb_add(&bar[XB_TOPGEN], 1u);
            else XB_SPIN(xb_ld(&bar[XB_TOPGEN]) == tg, bar);
            __builtin_amdgcn_fence(__ATOMIC_ACQUIRE, "agent");
            xb_add(&bar[XB_XGEN(b.x)], 1u);
            asm volatile("s_waitcnt vmcnt(0)" ::: "memory");
        } else {
            XB_SPIN(xb_ld(&bar[XB_XGEN(b.x)]) == gen, bar);
            __builtin_amdgcn_fence(__ATOMIC_ACQUIRE, "agent");
            asm volatile("s_waitcnt vmcnt(0)" ::: "memory");
        }
    }
    __syncthreads();
}

constexpr int NWAVES = 8;
constexpr int T = 32768, D = 1024, SEQ = 4096, NBATCH = 8;
constexpr int DFF = 2752, DFFP = 2816, DFFE = 3584, NEXP = 8;
constexpr int ROWCAP = 34816;
constexpr float EPS = 1e-6f;
constexpr float LOG2E = 1.4426950408889634f;
constexpr float QSCALE = 0.125f * LOG2E;
constexpr size_t MiB = 1u << 20;
constexpr size_t WS_CTL = 0, CTL_ZERO_BYTES = 1 * MiB;
constexpr size_t WS_PART1 = 1 * MiB, WS_PART2 = 3 * MiB, WS_LSE = 5 * MiB;
constexpr size_t WS_ROUTE = 7 * MiB, WS_GATE1 = WS_ROUTE + 128 * 1024, WS_GATE2 = WS_ROUTE + 256 * 1024, WS_WAVECNT = WS_ROUTE + 384 * 1024, WS_BLOCKCNT = WS_ROUTE + 448 * 1024, WS_GOFS = WS_ROUTE + 480 * 1024;
constexpr size_t WS_ROWTOK = 8 * MiB, WS_ROWGATE = 8 * MiB + 512 * 1024;
constexpr size_t SLOT_STRIDE = 256 * 1024;
constexpr size_t WS_WIN = 12 * MiB, WS_WOUT = 16 * MiB, WS_WF13 = 18 * MiB, WS_WFD = 29 * MiB, WS_WQKV = 35 * MiB, WS_WO = 53 * MiB;
constexpr size_t WS_WM13 = 56 * MiB, WS_WM2 = 168 * MiB;
constexpr size_t WS_A0 = 224 * MiB;
constexpr size_t WS_H0 = WS_A0, WS_GLU = WS_A0 + 64 * MiB, WS_V = WS_A0 + 128 * MiB;
constexpr size_t WS_X1B = WS_A0, WS_HB = WS_A0 + 64 * MiB;
constexpr size_t WS_X2B = WS_A0, WS_KG = WS_A0 + 64 * MiB, WS_VG = WS_A0 + 128 * MiB, WS_QG = WS_A0 + 192 * MiB, WS_O = WS_A0 + 256 * MiB;
constexpr size_t WS_H3 = WS_A0, WS_HM = WS_A0 + 64 * MiB;
constexpr size_t WS_END = 548 * MiB;
static_assert(WS_HB + (size_t)T * DFFP * 2 <= WS_END && WS_O + (size_t)T * D * 2 <= WS_END && WS_HM + (size_t)ROWCAP * DFFE * 2 <= WS_END, "arena");
static_assert(WS_WFD + (size_t)D * DFFP * 2 <= WS_WQKV && WS_WO + (size_t)D * D * 2 <= WS_WM13 && WS_WM2 + (size_t)NEXP * D * DFFE * 2 <= WS_A0, "weights");
constexpr int CW_TMO = 0, CW_CODE = 1, CW_BAR = 4096;

constexpr int RING_OFF = 0, RING_BYTES = 131072;
constexpr int LDSCTL_OFF = RING_BYTES, MISC_OFF = LDSCTL_OFF + 320;
constexpr int XTRA_OFF = RING_BYTES + 512;
constexpr int LDS_BYTES = 147456;

constexpr int NPHASE = 19;

__constant__ unsigned char T5_BUCKET[3][132] = {
 {0,1,2,3,4,5,6,7,8,9,10,11,12,13,14,15,16,16,16,16,16,16,17,17,17,17,17,17,17,17,18,18,18,18,18,18,18,18,18,18,19,19,19,19,19,19,19,19,19,19,19,19,19,19,20,20,20,20,20,20,20,20,20,20,20,20,20,20,20,20,20,20,20,21,21,21,21,21,21,21,21,21,21,21,21,21,21,21,21,21,21,21,21,21,21,21,21,21,21,22,22,22,22,22,22,22,22,22,22,22,22,22,22,22,22,22,22,22,22,22,22,22,22,22,22,22,22,22,22,0,0,0},
 {0,4,8,12,16,16,17,17,18,18,19,19,19,19,20,20,20,20,20,21,21,21,21,21,21,22,22,22,22,22,22,22,22,22,23,23,23,23,23,23,23,23,23,23,23,23,24,24,24,24,24,24,24,24,24,24,24,24,24,24,24,24,25,25,25,25,25,25,25,25,25,25,25,25,25,25,25,25,25,25,25,25,25,26,26,26,26,26,26,26,26,26,26,26,26,26,26,26,26,26,26,26,26,26,26,26,26,26,26,26,26,26,26,27,27,27,27,27,27,27,27,27,27,27,27,27,27,27,27,0,0,0},
 {0,16,18,19,20,21,21,22,22,23,23,23,24,24,24,24,25,25,25,25,25,26,26,26,26,26,26,26,26,27,27,27,27,27,27,27,27,27,27,28,28,28,28,28,28,28,28,28,28,28,28,28,29,29,29,29,29,29,29,29,29,29,29,29,29,29,29,29,29,29,30,30,30,30,30,30,30,30,30,30,30,30,30,30,30,30,30,30,30,30,30,30,30,30,30,31,31,31,31,31,31,31,31,31,31,31,31,31,31,31,31,31,31,31,31,31,31,31,31,31,31,31,31,31,31,31,31,31,31,0,0,0}};

typedef float f32x16 __attribute__((ext_vector_type(16)));
typedef float f32x2v __attribute__((ext_vector_type(2)));
typedef __bf16 bf16x2v __attribute__((ext_vector_type(2)));
typedef short v4i16_t __attribute__((ext_vector_type(4)));
__device__ __forceinline__ unsigned pkbf(float lo, float hi) { f32x2v v = {lo, hi}; bf16x2v b = __builtin_convertvector(v, bf16x2v); return __builtin_bit_cast(unsigned, b); }
__device__ __forceinline__ float bflo(unsigned u) { return __uint_as_float(u << 16); }
__device__ __forceinline__ float bfhi(unsigned u) { return __uint_as_float(u & 0xffff0000u); }
__device__ __forceinline__ float wave_sum(float v) {
#pragma unroll
    for (int o = 1; o < 64; o <<= 1) v += __shfl_xor(v, o);
    return v;
}
__device__ __forceinline__ int crow(int r, int hi) { return (r & 3) + 8 * (r >> 2) + 4 * hi; }

__device__ __forceinline__ void tr_item(const float* W, int ldw, const float* gsc, bf16* WT, int Kp, int drow0, int k0, int n0src, LAS float* scr, int lane) {
#pragma unroll 8
    for (int i = 0; i < 32; ++i) { const int kk = 2 * i + (lane >> 5); float w = W[(size_t)(k0 + kk) * ldw + n0src + (lane & 31)]; if (gsc) w *= gsc[k0 + kk]; scr[kk * 33 + (lane & 31)] = w; }
    LDS_WAIT(); asm volatile("" ::: "memory");
    const int c = lane & 7;
#pragma unroll
    for (int j = 0; j < 4; ++j) { const int n = (lane >> 3) + 8 * j; const LAS float* s = scr + (8 * c) * 33 + n;
        v4u o; o.x = pkbf(s[0 * 33], s[1 * 33]); o.y = pkbf(s[2 * 33], s[3 * 33]); o.z = pkbf(s[4 * 33], s[5 * 33]); o.w = pkbf(s[6 * 33], s[7 * 33]);
        *(GAS v4u*)(WT + (size_t)(drow0 + n) * Kp + k0 + 8 * c) = o; }
    LDS_WAIT(); asm volatile("" ::: "memory");
}
__device__ __forceinline__ int hmap_row0(int L) { const int lc = L & 255; return (L & ~255) + 128 * ((lc >> 5) & 1) + 32 * (lc >> 6); }

constexpr int IT_MG = NEXP * 16 * 112, IT_MU = IT_MG, IT_MD = NEXP * 56 * 32, IT_WIN = 16 * 64, IT_WOUT = 16 * 32, IT_FG = 16 * 86, IT_FU = IT_FG, IT_FD = 43 * 32, IT_KV = 16 * 192, IT_Q = 16 * 96, IT_WO = 16 * 32;
constexpr int IT_TOTAL = IT_MG + IT_MU + IT_MD + IT_WIN + IT_WOUT + IT_FG + IT_FU + IT_FD + IT_KV + IT_Q + IT_WO;

typedef const __attribute__((address_space(4))) unsigned char* kargp0_t;
#define P0IN(i) (*(const float* const __attribute__((address_space(4)))*)(kp + 8 * (i)))
__device__ __forceinline__ void p0_prologue(kargp0_t kp, unsigned char* ws, LAS unsigned char* lds, int G, int vcu, int tid, int lane, int wave) {
    LAS float* scr = (LAS float*)(lds + RING_OFF + wave * 16384);
    const int gw = vcu * NWAVES + wave, NGW = G * NWAVES;
    bf16* WIN = (bf16*)(ws + WS_WIN); bf16* WOUT = (bf16*)(ws + WS_WOUT); bf16* WF13 = (bf16*)(ws + WS_WF13); bf16* WFD = (bf16*)(ws + WS_WFD);
    bf16* WQKV = (bf16*)(ws + WS_WQKV); bf16* WO = (bf16*)(ws + WS_WO); bf16* WM13 = (bf16*)(ws + WS_WM13); bf16* WM2 = (bf16*)(ws + WS_WM2);
    for (int it = gw; it < IT_TOTAL; it += NGW) {
        int r = it;
        if (r < IT_MG) { const int e = r / 1792, rr = r % 1792, kb = rr / 112, j = (rr % 112) * 32;
            tr_item(P0IN(23) + (size_t)e * D * DFFE, DFFE, nullptr, WM13 + (size_t)e * 7168 * 1024, 1024, 256 * (j >> 7) + (j & 127), kb * 64, j, scr, lane); continue; } r -= IT_MG;
        if (r < IT_MU) { const int e = r / 1792, rr = r % 1792, kb = rr / 112, j = (rr % 112) * 32;
            tr_item(P0IN(24) + (size_t)e * D * DFFE, DFFE, nullptr, WM13 + (size_t)e * 7168 * 1024, 1024, 256 * (j >> 7) + 128 + (j & 127), kb * 64, j, scr, lane); continue; } r -= IT_MU;
        if (r < IT_MD) { const int e = r / 1792, rr = r % 1792, kb = rr / 32, j = (rr % 32) * 32;
            tr_item(P0IN(25) + (size_t)e * DFFE * D, D, nullptr, WM2 + (size_t)e * 1024 * DFFE, DFFE, j, kb * 64, j, scr, lane); continue; } r -= IT_MD;
        if (r < IT_WIN) { const int kb = r / 64, c = (r % 64) * 32, sel = c >> 10, j = c & 1023;
            tr_item(P0IN(3), 2048, nullptr, WIN, 1024, 256 * (j >> 7) + 128 * sel + (j & 127), kb * 64, c, scr, lane); continue; } r -= IT_WIN;
        if (r < IT_WOUT) { const int kb = r / 32, j = (r % 32) * 32;
            tr_item(P0IN(9), 1024, nullptr, WOUT, 1024, j, kb * 64, j, scr, lane); continue; } r -= IT_WOUT;
        if (r < IT_FG) { const int kb = r / 86, j = (r % 86) * 32;
            tr_item(P0IN(19), DFF, P0IN(18), WF13, 1024, 256 * (j >> 7) + (j & 127), kb * 64, j, scr, lane); continue; } r -= IT_FG;
        if (r < IT_FU) { const int kb = r / 86, j = (r % 86) * 32;
            tr_item(P0IN(20), DFF, P0IN(18), WF13, 1024, 256 * (j >> 7) + 128 + (j & 127), kb * 64, j, scr, lane); continue; } r -= IT_FU;
        if (r < IT_FD) { const int kb = r / 32, j = (r % 32) * 32;
            tr_item(P0IN(21), 1024, nullptr, WFD, DFFP, j, kb * 64, j, scr, lane); continue; } r -= IT_FD;
        if (r < IT_KV) { const int kb = r / 192, c = (r % 192) * 32, kvsel = c / 3072, cg = c % 3072, g = cg >> 10, hc = cg & 1023, L = kvsel * 1024 + hc;
            tr_item(P0IN(12), 6144, P0IN(11), WQKV + (size_t)g * 3072 * 1024, 1024, hmap_row0(L), kb * 64, c, scr, lane); continue; } r -= IT_KV;
        if (r < IT_Q) { const int kb = r / 96, c = (r % 96) * 32, g = c >> 10, hc = c & 1023, L = 2048 + hc;
            tr_item(P0IN(15), 3072, P0IN(14), WQKV + (size_t)g * 3072 * 1024, 1024, hmap_row0(L), kb * 64, c, scr, lane); continue; } r -= IT_Q;
        { const int kb = r / 32, j = (r % 32) * 32; tr_item(P0IN(17), 1024, nullptr, WO, 1024, j, kb * 64, j, scr, lane); }
    }
    const int gt = vcu * (NWAVES * 64) + tid, NGT = G * NWAVES * 64; const v4u z = {0u, 0u, 0u, 0u};
    for (int i = gt; i < 2 * 64 * 128; i += NGT) { const int sel = i >> 13, rr = (i >> 7) & 63, ch = i & 127; *(GAS v4u*)(WF13 + (size_t)(256 * 21 + 128 * sel + 64 + rr) * 1024 + ch * 8) = z; }
    for (int i = gt; i < 1024 * 8; i += NGT) { const int row = i >> 3, ch = i & 7; *(GAS v4u*)(WFD + (size_t)row * DFFP + DFF + ch * 8) = z; }
    const float* x = P0IN(0); const float* gn = P0IN(2); bf16* H0 = (bf16*)(ws + WS_H0);
    f32x4 gv[4];
#pragma unroll
    for (int j = 0; j < 4; ++j) gv[j] = *(const f32x4*)(gn + 4 * lane + 256 * j);
    for (int m = gw; m < T; m += NGW) {
        const GAS f32x4* xr = (const GAS f32x4*)(x + (size_t)m * D) + lane; f32x4 v[4]; float s = 0.f;
#pragma unroll
        for (int j = 0; j < 4; ++j) { v[j] = xr[64 * j]; s += (v[j].x * v[j].x + v[j].y * v[j].y) + (v[j].z * v[j].z + v[j].w * v[j].w); }
        const float rstd = 1.f / sqrtf(wave_sum(s) * (1.f / D) + EPS);
        GAS unsigned long long* o8 = (GAS unsigned long long*)(H0 + (size_t)m * D) + lane;
#pragma unroll
        for (int j = 0; j < 4; ++j) { const f32x4 y = v[j] * rstd * gv[j]; o8[64 * j] = (unsigned long long)pkbf(y.x, y.y) | ((unsigned long long)pkbf(y.z, y.w) << 32); }
    }
}

__device__ __forceinline__ void conv_phase(const bf16* glu, const float* dw_w, const float* dw_b, const float* ln_g, const float* ln_b, bf16* vout, LAS unsigned char* lds, int G, int vcu, int tid, int lane, int wave) {
    LAS float* ybuf = (LAS float*)(lds + RING_OFF);
    const int c0 = 2 * tid;
    float w0[31], w1[31];
#pragma unroll
    for (int k = 0; k < 31; ++k) { const f32x2v w = *(const f32x2v*)(dw_w + k * 1024 + c0); w0[k] = w.x; w1[k] = w.y; }
    const f32x2v dbv = *(const f32x2v*)(dw_b + c0);
    LAS float* lnp = (LAS float*)(lds + XTRA_OFF);
    for (int i = tid; i < 1024; i += NWAVES * 64) { lnp[i] = ln_g[i]; lnp[1024 + i] = ln_b[i]; }
    __syncthreads();
    for (int item = vcu; item < T / 128; item += G) {
        const int b = item >> 5, s0 = (item & 31) * 128;
        const bf16* ub = glu + (size_t)b * SEQ * D + c0;
        float r0[31], r1[31];
        r0[0] = 0.f; r1[0] = 0.f;
#pragma unroll
        for (int i = 0; i < 30; ++i) { const int s = s0 - 30 + i; unsigned v = 0u; if (s >= 0) v = *(const unsigned*)(ub + (size_t)s * D); r0[i + 1] = bflo(v); r1[i + 1] = bfhi(v); }
        for (int base = 0; base < 128; base += 31) {
            unsigned nu[31];
#pragma unroll
            for (int j = 0; j < 31; ++j) { const int s = base + j; nu[j] = 0u; if (s < 128) nu[j] = *(const unsigned*)(ub + (size_t)(s0 + s) * D); }
#pragma unroll
            for (int j = 0; j < 31; ++j) {
                r0[j] = bflo(nu[j]); r1[j] = bfhi(nu[j]);
                float y0 = dbv.x, y1 = dbv.y;
#pragma unroll
                for (int k = 0; k < 31; ++k) { const int idx = (j + 1 + k) % 31; y0 += r0[idx] * w0[k]; y1 += r1[idx] * w1[k]; }
                *(LAS f32x2v*)(ybuf + j * 1024 + c0) = (f32x2v){y0, y1};
            }
            __syncthreads();
            const int ntok = (128 - base) < 31 ? (128 - base) : 31;
            for (int j = wave; j < ntok; j += NWAVES) {
                f32x4 y[4]; float s = 0.f;
#pragma unroll
                for (int i = 0; i < 4; ++i) { y[i] = *(const LAS f32x4*)(ybuf + j * 1024 + 4 * lane + 256 * i); s += (y[i].x + y[i].y) + (y[i].z + y[i].w); }
                const float mean = wave_sum(s) * (1.f / D); float q = 0.f;
#pragma unroll
                for (int i = 0; i < 4; ++i) { y[i] = y[i] - mean; q += (y[i].x * y[i].x + y[i].y * y[i].y) + (y[i].z * y[i].z + y[i].w * y[i].w); }
                const float rstd = 1.f / sqrtf(wave_sum(q) * (1.f / D) + EPS);
                GAS unsigned long long* o8 = (GAS unsigned long long*)(vout + ((size_t)b * SEQ + s0 + base + j) * D) + lane;
#pragma unroll
                for (int i = 0; i < 4; ++i) { const f32x4 lgv = *(const LAS f32x4*)(lnp + 4 * lane + 256 * i), lbv = *(const LAS f32x4*)(lnp + 1024 + 4 * lane + 256 * i); f32x4 z = y[i] * rstd * lgv + lbv;
                    z.x *= pg8::fast_sigmoid(z.x); z.y *= pg8::fast_sigmoid(z.y); z.z *= pg8::fast_sigmoid(z.z); z.w *= pg8::fast_sigmoid(z.w);
                    o8[64 * i] = (unsigned long long)pkbf(z.x, z.y) | ((unsigned long long)pkbf(z.z, z.w) << 32); }
            }
            __syncthreads();
        }
    }
}

__device__ __forceinline__ void attn_phase(LAS unsigned char* lds, int grp, const bf16* Kb, const bf16* Vb, const bf16* Qb, bf16* Ob, float* lse, const float* rel_bias, int G, int vcu, int tid, int lane, int wave) {
    const int dsh = 2 * grp, dil = 1 << dsh;
    LAS unsigned char* Kl = lds + RING_OFF;
    LAS unsigned char* Vl = lds + RING_OFF + 55296;
    LAS float* btab = (LAS float*)(lds + RING_OFF + 104448);
    const int lq = lane & 31, hi = lane >> 5;
    for (int idx = vcu; idx < 2048; idx += G) {
        const int bh = idx >> 4, w16 = idx & 15, b = bh >> 4, h = bh & 15, res = w16 & (dil - 1), n0 = (w16 >> dsh) * 256;
        __syncthreads();
#pragma unroll
        for (int i = 0; i < 6; ++i) { const int cidx = tid + 512 * i, j = cidx >> 3, c16 = cidx & 7, sub = n0 - 128 + j;
            v4u kv = {0u, 0u, 0u, 0u}, vv = {0u, 0u, 0u, 0u};
            if (sub >= 0) { const size_t off = ((size_t)b * SEQ + ((size_t)sub << dsh) + res) * D + h * 64 + c16 * 8; kv = *(const GAS v4u*)(Kb + off); vv = *(const GAS v4u*)(Vb + off); }
            *(LAS v4u*)(Kl + j * 144 + c16 * 16) = kv; *(LAS v4u*)(Vl + (c16 >> 2) * 24576 + j * 64 + (c16 & 3) * 16) = vv; }
        if (tid < 192) { const int dist = 159 - tid; btab[tid] = (dist >= 0 && dist <= 128) ? rel_bias[(int)T5_BUCKET[grp][dist] * 48 + grp * 16 + h] * LOG2E : -1.0e30f; }
        const int ql = 32 * wave + lq;
        const size_t qrow = (size_t)b * SEQ + ((size_t)(n0 + ql) << dsh) + res;
        pg8::bf16x8 qr[4];
#pragma unroll
        for (int c = 0; c < 4; ++c) qr[c] = *(const pg8::bf16x8*)(Qb + qrow * D + h * 64 + 16 * c + 8 * hi);
        __syncthreads();
        float sv[5][16]; float m = -3.0e38f;
        const int kofs = n0 - 128 + 32 * wave;
        const LAS float* brow = btab + (31 - lq + 4 * hi);
#pragma unroll
        for (int kt = 0; kt < 5; ++kt) {
            f32x16 S = (f32x16){0.f, 0.f, 0.f, 0.f, 0.f, 0.f, 0.f, 0.f, 0.f, 0.f, 0.f, 0.f, 0.f, 0.f, 0.f, 0.f};
#pragma unroll
            for (int c = 0; c < 4; ++c) { const pg8::bf16x8 a = *(const LAS pg8::bf16x8*)(Kl + (32 * wave + 32 * kt + lq) * 144 + (16 * c + 8 * hi) * 2);
                S = __builtin_amdgcn_mfma_f32_32x32x16_bf16(a, qr[c], S, 0, 0, 0); }
#pragma unroll
            for (int r = 0; r < 16; ++r) { const float s = S[r] + brow[32 * kt + (r & 3) + 8 * (r >> 2)]; sv[kt][r] = s; }
            __builtin_amdgcn_sched_barrier(0);
        }
        if (kofs < 0) {
#pragma unroll
            for (int kt = 0; kt < 5; ++kt)
#pragma unroll
                for (int r = 0; r < 16; ++r) { const int kk = 32 * kt + crow(r, hi); if (kofs + kk < 0) sv[kt][r] = -1.0e30f; }
        }
#pragma unroll
        for (int kt = 0; kt < 5; ++kt)
#pragma unroll
            for (int r = 0; r < 16; ++r) m = fmaxf(m, sv[kt][r]);
        m = fmaxf(m, __shfl_xor(m, 32));
        float l = 0.f; unsigned pw[5][8];
#pragma unroll
        for (int kt = 0; kt < 5; ++kt) {
#pragma unroll
            for (int r = 0; r < 16; r += 2) { const float p0 = __builtin_amdgcn_exp2f(sv[kt][r] - m), p1 = __builtin_amdgcn_exp2f(sv[kt][r + 1] - m); l += p0 + p1; pw[kt][r >> 1] = pkbf(p0, p1); }
            __builtin_amdgcn_sched_barrier(0);
        }
        l += __shfl_xor(l, 32);
        f32x16 O0 = (f32x16){0.f, 0.f, 0.f, 0.f, 0.f, 0.f, 0.f, 0.f, 0.f, 0.f, 0.f, 0.f, 0.f, 0.f, 0.f, 0.f}, O1 = O0;
        const int vlane = ((lane & 15) >> 2) * 64 + ((lane >> 4) & 1) * 32 + (lane & 3) * 8;
#pragma unroll
        for (int kt = 0; kt < 5; ++kt)
#pragma unroll
            for (int s2 = 0; s2 < 2; ++s2) {
                v4u pq; pq.x = pw[kt][4 * s2 + 0]; pq.y = pw[kt][4 * s2 + 1]; pq.z = pw[kt][4 * s2 + 2]; pq.w = pw[kt][4 * s2 + 3];
                const pg8::bf16x8 pf = __builtin_bit_cast(pg8::bf16x8, pq);
                const int vrow = 32 * wave + 32 * kt + 16 * s2 + 4 * hi;
                LAS unsigned char* vp = Vl + vrow * 64 + vlane;
                const v4i16_t a0 = __builtin_amdgcn_ds_read_tr16_b64_v4i16((LAS v4i16_t*)(vp)), a1 = __builtin_amdgcn_ds_read_tr16_b64_v4i16((LAS v4i16_t*)(vp + 512));
                const v4i16_t b0 = __builtin_amdgcn_ds_read_tr16_b64_v4i16((LAS v4i16_t*)(vp + 24576)), b1 = __builtin_amdgcn_ds_read_tr16_b64_v4i16((LAS v4i16_t*)(vp + 24576 + 512));
                const pg8::bf16x8 vf0 = (pg8::bf16x8){a0[0], a0[1], a0[2], a0[3], a1[0], a1[1], a1[2], a1[3]};
                const pg8::bf16x8 vf1 = (pg8::bf16x8){b0[0], b0[1], b0[2], b0[3], b1[0], b1[1], b1[2], b1[3]};
                O0 = __builtin_amdgcn_mfma_f32_32x32x16_bf16(vf0, pf, O0, 0, 0, 0);
                O1 = __builtin_amdgcn_mfma_f32_32x32x16_bf16(vf1, pf, O1, 0, 0, 0);
                __builtin_amdgcn_sched_barrier(0);
            }
        const float inv_l = 1.f / l, lse2 = m + __builtin_amdgcn_logf(l);
        const size_t orow = qrow;
        float co = 0.f, cg = inv_l, lnew = lse2;
        if (grp != 0) { const float lo_ = lse[orow * 16 + h]; const float M = fmaxf(lo_, lse2); const float wo = __builtin_amdgcn_exp2f(lo_ - M), wg = __builtin_amdgcn_exp2f(lse2 - M), den = wo + wg;
            co = wo / den; cg = wg / den * inv_l; lnew = M + __builtin_amdgcn_logf(den); }
        bf16* op = Ob + orow * D + h * 64 + 4 * hi;
#pragma unroll
        for (int rg = 0; rg < 4; ++rg) {
            float a0 = O0[4 * rg] * cg, a1 = O0[4 * rg + 1] * cg, a2 = O0[4 * rg + 2] * cg, a3 = O0[4 * rg + 3] * cg;
            float c0 = O1[4 * rg] * cg, c1 = O1[4 * rg + 1] * cg, c2 = O1[4 * rg + 2] * cg, c3 = O1[4 * rg + 3] * cg;
            if (grp != 0) { const pg8::u32x2 oa = *(const pg8::u32x2*)(op + 8 * rg), ob = *(const pg8::u32x2*)(op + 32 + 8 * rg);
                a0 += co * bflo(oa.x); a1 += co * bfhi(oa.x); a2 += co * bflo(oa.y); a3 += co * bfhi(oa.y);
                c0 += co * bflo(ob.x); c1 += co * bfhi(ob.x); c2 += co * bflo(ob.y); c3 += co * bfhi(ob.y); }
            pg8::u32x2 wa, wb; wa.x = pkbf(a0, a1); wa.y = pkbf(a2, a3); wb.x = pkbf(c0, c1); wb.y = pkbf(c2, c3);
            *(pg8::u32x2*)(op + 8 * rg) = wa; *(pg8::u32x2*)(op + 32 + 8 * rg) = wb;
        }
        if (hi == 0) lse[orow * 16 + h] = lnew;
    }
    __syncthreads();
}

__device__ __forceinline__ void route_phase(const float* x3, const float* gnorm, const float* wr, unsigned char* ws, LAS unsigned char* lds, int G, int vcu, int tid, int lane, int wave) {
    LAS float* WrT = (LAS float*)(lds + RING_OFF);
    LAS unsigned* wcL = (LAS unsigned*)(lds + RING_OFF + 32768);
    for (int i = tid; i < 8192; i += NWAVES * 64) { const int e = i >> 10, k = i & 1023; WrT[i] = wr[k * 8 + e] * gnorm[k]; }
    __syncthreads();
    unsigned* route = (unsigned*)(ws + WS_ROUTE); float* gate1 = (float*)(ws + WS_GATE1); float* gate2 = (float*)(ws + WS_GATE2);
    unsigned* wavecnt = (unsigned*)(ws + WS_WAVECNT); int* blockcnt = (int*)(ws + WS_BLOCKCNT); bf16* H3 = (bf16*)(ws + WS_H3);
    const int gw = vcu * NWAVES + wave, NGW = G * NWAVES, tpw = (T + NGW - 1) / NGW;
    const int t0 = gw * tpw, t1 = (t0 + tpw) < T ? (t0 + tpw) : T;
    f32x4 gv[4];
#pragma unroll
    for (int j = 0; j < 4; ++j) gv[j] = *(const f32x4*)(gnorm + 4 * lane + 256 * j);
    unsigned long long cnt0 = 0ull, cnt1 = 0ull;
    for (int t = t0; t < t1; ++t) {
        const GAS f32x4* xr = (const GAS f32x4*)(x3 + (size_t)t * D) + lane; f32x4 v[4]; float ss = 0.f;
#pragma unroll
        for (int j = 0; j < 4; ++j) { v[j] = xr[64 * j]; ss += (v[j].x * v[j].x + v[j].y * v[j].y) + (v[j].z * v[j].z + v[j].w * v[j].w); }
        float dt[8];
#pragma unroll
        for (int e = 0; e < 8; ++e) { float a = 0.f;
#pragma unroll
            for (int j = 0; j < 4; ++j) { const f32x4 w = *(const LAS f32x4*)(WrT + e * 1024 + 4 * lane + 256 * j); a += (v[j].x * w.x + v[j].y * w.y) + (v[j].z * w.z + v[j].w * w.w); }
            dt[e] = a; }
        ss = wave_sum(ss);
#pragma unroll
        for (int e = 0; e < 8; ++e) dt[e] = wave_sum(dt[e]);
        const float rstd = 1.f / sqrtf(ss * (1.f / D) + EPS);
        GAS unsigned long long* o8 = (GAS unsigned long long*)(H3 + (size_t)t * D) + lane;
#pragma unroll
        for (int j = 0; j < 4; ++j) { const f32x4 y = v[j] * rstd * gv[j]; o8[64 * j] = (unsigned long long)pkbf(y.x, y.y) | ((unsigned long long)pkbf(y.z, y.w) << 32); }
        int e1 = 0; float v1 = dt[0] * rstd;
#pragma unroll
        for (int e = 1; e < 8; ++e) { const float x = dt[e] * rstd; if (x > v1) { v1 = x; e1 = e; } }
        int e2 = -1; float v2 = -3.0e38f;
#pragma unroll
        for (int e = 0; e < 8; ++e) { const float x = dt[e] * rstd; if (e != e1 && x > v2) { v2 = x; e2 = e; } }
        const float g2 = 1.f / (1.f + __expf(v1 - v2)), g1 = 1.f - g2;
        cnt0 += 1ull << (8 * e1); cnt1 += 1ull << (8 * e2);
        if (lane == 0) { route[t] = (unsigned)e1 | ((unsigned)e2 << 8); gate1[t] = g1; gate2[t] = g2; }
    }
    if (lane == 0) { v4u c; c.x = (unsigned)cnt0; c.y = (unsigned)(cnt0 >> 32); c.z = (unsigned)cnt1; c.w = (unsigned)(cnt1 >> 32);
        *(GAS v4u*)(wavecnt + (size_t)gw * 4) = c; wcL[wave * 4 + 0] = c.x; wcL[wave * 4 + 1] = c.y; wcL[wave * 4 + 2] = c.z; wcL[wave * 4 + 3] = c.w; }
    __syncthreads();
    if (tid < 16) { const int slot = tid >> 3, e = tid & 7; int s = 0;
#pragma unroll
        for (int w = 0; w < NWAVES; ++w) s += (int)((wcL[w * 4 + slot * 2 + (e >> 2)] >> (8 * (e & 3))) & 255u);
        blockcnt[vcu * 16 + tid] = s; }
    __syncthreads();
}

__device__ __forceinline__ void pos_phase(unsigned char* ws, LAS unsigned char* lds, int G, int vcu, int tid, int lane, int wave) {
    LAS int* cntL = (LAS int*)(lds + RING_OFF);
    LAS int* pAll = (LAS int*)(lds + RING_OFF + 65536);
    LAS int* pBef = pAll + 512;
    LAS int* totL = pBef + 512;
    const int* blockcnt = (const int*)(ws + WS_BLOCKCNT); const unsigned* wavecnt = (const unsigned*)(ws + WS_WAVECNT);
    const unsigned* route = (const unsigned*)(ws + WS_ROUTE); const float* gate1 = (const float*)(ws + WS_GATE1); const float* gate2 = (const float*)(ws + WS_GATE2);
    int* gofs = (int*)(ws + WS_GOFS);
    for (int i = tid; i < G * 16; i += NWAVES * 64) cntL[i] = blockcnt[i];
    __syncthreads();
    { const int c = tid & 15, part = tid >> 4, bpp = (G + 31) / 32; int sa = 0, sb = 0;
      for (int bb = part * bpp; bb < (part + 1) * bpp && bb < G; ++bb) { const int v = cntL[bb * 16 + c]; sa += v; if (bb < vcu) sb += v; }
      pAll[part * 16 + c] = sa; pBef[part * 16 + c] = sb; }
    __syncthreads();
    if (tid < 16) { int sa = 0, sb = 0;
        for (int p = 0; p < 32; ++p) { sa += pAll[p * 16 + tid]; sb += pBef[p * 16 + tid]; }
        totL[tid] = sa; totL[16 + tid] = sb; }
    __syncthreads();
    if (tid < 2) { int off = 0;
        for (int e = 0; e < 8; ++e) { totL[32 + tid * 8 + e] = off; if (vcu == 0) { gofs[tid * 8 + e] = off; gofs[32 + tid * 8 + e] = off >> 8; } off += ((totL[tid * 8 + e] + 255) >> 8) << 8; }
        if (vcu == 0) gofs[16 + tid] = off >> 8; }
    __syncthreads();
    const int gw = vcu * NWAVES + wave, NGW = G * NWAVES, tpw = (T + NGW - 1) / NGW;
    const int t0 = gw * tpw, t1 = (t0 + tpw) < T ? (t0 + tpw) : T;
    int mypos = 0;
    if (lane < 16) { mypos = totL[32 + lane] + totL[16 + lane];
        for (int w = 0; w < wave; ++w) mypos += (int)((wavecnt[(size_t)(vcu * NWAVES + w) * 4 + (lane >> 3) * 2 + ((lane & 7) >> 2)] >> (8 * (lane & 3))) & 255u); }
    int* rowtok0 = (int*)(ws + WS_ROWTOK); int* rowtok1 = (int*)(ws + WS_ROWTOK + SLOT_STRIDE); float* rowgate0 = (float*)(ws + WS_ROWGATE); float* rowgate1 = (float*)(ws + WS_ROWGATE + SLOT_STRIDE);
    for (int t = t0; t < t1; ++t) {
        const unsigned rt = route[t]; const int e1 = (int)(rt & 255u), e2 = (int)((rt >> 8) & 255u);
        const int p1 = __shfl(mypos, e1), p2 = __shfl(mypos, 8 + e2);
        if (lane == e1 || lane == 8 + e2) mypos += 1;
        if (lane == 0) { rowtok0[p1] = t; rowgate0[p1] = gate1[t]; rowtok1[p2] = t; rowgate1[p2] = gate2[t]; }
    }
    if (vcu < 16) { const int slot = vcu >> 3; int* rtk = (int*)(ws + WS_ROWTOK + (size_t)slot * SLOT_STRIDE); float* rgt = (float*)(ws + WS_ROWGATE + (size_t)slot * SLOT_STRIDE);
        const int beg = totL[32 + vcu] + totL[vcu], end = totL[32 + vcu] + (((totL[vcu] + 255) >> 8) << 8);
        for (int i = beg + tid; i < end; i += NWAVES * 64) { rtk[i] = -1; rgt[i] = 0.f; } }
    __syncthreads();
}

constexpr int N_LAUNCHES = MK_N_LAUNCHES;
struct Args { const float* in[26]; float* out; unsigned char* ws; int ph_lo, ph_hi; };
typedef const __attribute__((address_space(4))) unsigned char* kargp_t;
#define PH_ENTER() kargp_t kp_ = kp0; asm volatile("" : "+s"(kp_)); int tid = tid0; asm volatile("" : "+v"(tid)); const int lane = tid & 63, wave = __builtin_amdgcn_readfirstlane(tid >> 6); \
    unsigned char* ws = *(unsigned char* const __attribute__((address_space(4)))*)(kp_ + 216); float* out = *(float* const __attribute__((address_space(4)))*)(kp_ + 208); (void)lane; (void)wave; (void)out
#define INP(i) (*(const float* const __attribute__((address_space(4)))*)(kp_ + 8 * (i)))
__global__ void __launch_bounds__(NWAVES * 64, 2) mk_fwd(Args args) {
    extern __shared__ __attribute__((aligned(16))) unsigned char lds_raw[];
    LAS unsigned char* lds = (LAS unsigned char*)lds_raw;
    static_assert(sizeof(Args) == 232 && __builtin_offsetof(Args, out) == 208 && __builtin_offsetof(Args, ws) == 216, "Args layout");
    const kargp_t kp0 = (kargp_t)__builtin_amdgcn_kernarg_segment_ptr();
    const int tid0 = threadIdx.x;
    const int G = gridDim.x, bx = blockIdx.x, vcu = (G % 8 == 0) ? (bx % 8) * (G / 8) + bx / 8 : bx;
    for (int u = tid0; u < (XTRA_OFF - LDSCTL_OFF) / 4; u += NWAVES * 64) ((LAS unsigned*)(lds + LDSCTL_OFF))[u] = 0u;
    __syncthreads();
    XcdBarrier bar; bar.bar = (unsigned*)(args.ws + WS_CTL) + CW_BAR; bar.x = 0; bar.st = (volatile LAS unsigned*)(lds + MISC_OFF) + 8;
    if (N_LAUNCHES == 1) bar = xcd_barrier_post((unsigned*)(args.ws + WS_CTL) + CW_BAR, (volatile LAS unsigned*)(lds + MISC_OFF) + 8);
#define GRID_BAR() do { if (N_LAUNCHES == 1) xcd_barrier(bar); } while (0)
    const int lo = args.ph_lo, hi = args.ph_hi;
#ifndef PH_MASK
#define PH_MASK 0xFFFFFFFFu
#endif
#define IN(k) (((PH_MASK >> (k)) & 1u) && lo <= (k) && (k) < hi)
#define BOTH(k) (IN(k) && IN((k) + 1))

    if (IN(0)) { PH_ENTER(); p0_prologue(kp_, ws, lds, G, vcu, tid, lane, wave); __syncthreads(); if (BOTH(0)) GRID_BAR(); }
    if (IN(1)) { PH_ENTER();
        pg8::Gemm g{(const bf16*)(ws + WS_H0), (const bf16*)(ws + WS_WIN), T, 2048, 1024, 0, nullptr}; pg8::StaticOrder S; S.init(T, 2048, G, bx);
        pg8::EpiGated<0> E{(bf16*)(ws + WS_GLU), 1024, INP(4), 1024, nullptr};
        pg8::gemm_phase<pg8::EpiGated<0>, pg8::StaticOrder, false>(lds + RING_OFF, g, S, E, tid);
        if (BOTH(1)) GRID_BAR();
    }
    if (IN(2)) { PH_ENTER(); conv_phase((const bf16*)(ws + WS_GLU), INP(5), INP(6), INP(7), INP(8), (bf16*)(ws + WS_V), lds, G, vcu, tid, lane, wave); if (BOTH(2)) GRID_BAR(); }
    if (IN(3)) { PH_ENTER();
        pg8::Gemm g{(const bf16*)(ws + WS_V), (const bf16*)(ws + WS_WOUT), T, 1024, 1024, 0, nullptr}; pg8::StaticOrder S; S.init(T, 1024, G, bx);
        pg8::EpiResid<true, true> E{INP(0), out, INP(10), (bf16*)(ws + WS_X1B), (float*)(ws + WS_PART1)};
        pg8::gemm_phase<pg8::EpiResid<true, true>, pg8::StaticOrder, false>(lds + RING_OFF, g, S, E, tid);
        if (BOTH(3)) GRID_BAR();
    }
    if (IN(4)) { PH_ENTER();
        pg8::Gemm g{(const bf16*)(ws + WS_X1B), (const bf16*)(ws + WS_WF13), T, 5632, 1024, 0, nullptr}; pg8::StaticOrder S; S.init(T, 5632, G, bx);
        pg8::EpiGated<1> E{(bf16*)(ws + WS_HB), DFFP, nullptr, 0, (const float*)(ws + WS_PART1)};
        pg8::gemm_phase<pg8::EpiGated<1>, pg8::StaticOrder, false>(lds + RING_OFF, g, S, E, tid);
        if (BOTH(4)) GRID_BAR();
    }
    if (IN(5)) { PH_ENTER();
        pg8::Gemm g{(const bf16*)(ws + WS_HB), (const bf16*)(ws + WS_WFD), T, 1024, DFFP, 0, nullptr}; pg8::StaticOrder S; S.init(T, 1024, G, bx);
        pg8::EpiResid<false, true> E{out, out, nullptr, (bf16*)(ws + WS_X2B), (float*)(ws + WS_PART2)};
        pg8::gemm_phase<pg8::EpiResid<false, true>, pg8::StaticOrder, false>(lds + RING_OFF, g, S, E, tid);
        if (BOTH(5)) GRID_BAR();
    }
    for (int grp = 0; grp < 3; ++grp) {
        if (IN(6 + 2 * grp)) { PH_ENTER();
            pg8::Gemm g{(const bf16*)(ws + WS_X2B), (const bf16*)(ws + WS_WQKV) + (size_t)grp * 3072 * 1024, T, 3072, 1024, 0, nullptr}; pg8::StaticOrder S; S.init(T, 3072, G, bx);
            pg8::EpiQKV E{(bf16*)(ws + WS_KG), (size_t)T * D, (const float*)(ws + WS_PART2), INP(13) + grp * 64, INP(16) + grp * 64, QSCALE};
            pg8::gemm_phase<pg8::EpiQKV, pg8::StaticOrder, false>(lds + RING_OFF, g, S, E, tid);
            if (BOTH(6 + 2 * grp)) GRID_BAR();
        }
        if (IN(7 + 2 * grp)) { PH_ENTER();
            attn_phase(lds, grp, (const bf16*)(ws + WS_KG), (const bf16*)(ws + WS_VG), (const bf16*)(ws + WS_QG), (bf16*)(ws + WS_O), (float*)(ws + WS_LSE), INP(1), G, vcu, tid, lane, wave);
            if (BOTH(7 + 2 * grp)) GRID_BAR();
        }
    }
    if (IN(12)) { PH_ENTER();
        pg8::Gemm g{(const bf16*)(ws + WS_O), (const bf16*)(ws + WS_WO), T, 1024, 1024, 0, nullptr}; pg8::StaticOrder S; S.init(T, 1024, G, bx);
        pg8::EpiResid<false, false> E{out, out, nullptr, nullptr, nullptr};
        pg8::gemm_phase<pg8::EpiResid<false, false>, pg8::StaticOrder, false>(lds + RING_OFF, g, S, E, tid);
        if (BOTH(12)) GRID_BAR();
    }
    if (IN(13)) { PH_ENTER(); route_phase(out, INP(18) + 1024, INP(22), ws, lds, G, vcu, tid, lane, wave); if (BOTH(13)) GRID_BAR(); }
    if (IN(14)) { PH_ENTER(); pos_phase(ws, lds, G, vcu, tid, lane, wave); if (BOTH(14)) GRID_BAR(); }
    for (int slot = 0; slot < 2; ++slot) {
        if (IN(15 + 2 * slot)) { PH_ENTER();
            const int* gofs = (const int*)(ws + WS_GOFS); const int* rowtok = (const int*)(ws + WS_ROWTOK + (size_t)slot * SLOT_STRIDE);
            const int ntile = gofs[16 + slot];
            pg8::MoeOrder S; S.so.init(ntile * 256, 7168, G, bx);
            S.t1 = gofs[32 + slot * 8 + 1]; S.t2 = gofs[32 + slot * 8 + 2]; S.t3 = gofs[32 + slot * 8 + 3]; S.t4 = gofs[32 + slot * 8 + 4]; S.t5 = gofs[32 + slot * 8 + 5]; S.t6 = gofs[32 + slot * 8 + 6]; S.t7 = gofs[32 + slot * 8 + 7];
            pg8::Gemm g{(const bf16*)(ws + WS_H3), (const bf16*)(ws + WS_WM13), ntile * 256, 7168, 1024, (size_t)7168 * 1024 * 2, rowtok};
            pg8::EpiGated<2> E{(bf16*)(ws + WS_HM), DFFE, nullptr, 0, nullptr};
            pg8::gemm_phase<pg8::EpiGated<2>, pg8::MoeOrder, true>(lds + RING_OFF, g, S, E, tid);
            if (BOTH(15 + 2 * slot)) GRID_BAR();
        }
        if (IN(16 + 2 * slot)) { PH_ENTER();
            const int* gofs = (const int*)(ws + WS_GOFS); const int* rowtok = (const int*)(ws + WS_ROWTOK + (size_t)slot * SLOT_STRIDE); const float* rowgate = (const float*)(ws + WS_ROWGATE + (size_t)slot * SLOT_STRIDE);
            const int ntile = gofs[16 + slot];
            pg8::MoeOrder S; S.so.init(ntile * 256, 1024, G, bx);
            S.t1 = gofs[32 + slot * 8 + 1]; S.t2 = gofs[32 + slot * 8 + 2]; S.t3 = gofs[32 + slot * 8 + 3]; S.t4 = gofs[32 + slot * 8 + 4]; S.t5 = gofs[32 + slot * 8 + 5]; S.t6 = gofs[32 + slot * 8 + 6]; S.t7 = gofs[32 + slot * 8 + 7];
            pg8::Gemm g{(const bf16*)(ws + WS_HM), (const bf16*)(ws + WS_WM2), ntile * 256, 1024, DFFE, (size_t)1024 * DFFE * 2, nullptr};
            pg8::EpiMoeDown E{out, rowtok, rowgate};
            pg8::gemm_phase<pg8::EpiMoeDown, pg8::MoeOrder, false>(lds + RING_OFF, g, S, E, tid);
            if (BOTH(16 + 2 * slot)) GRID_BAR();
        }
    }
#undef IN
#undef BOTH
#undef GRID_BAR
}

extern "C" void kernel_launch(void* const* d_in, const int* in_sizes, int n_in, void* d_out, int out_size, void* d_ws, size_t ws_size, hipStream_t stream) {
    static int grid = 0;
    if (grid == 0) {
        if (n_in != 26 || in_sizes[0] != T * D || out_size != T * D || ws_size < WS_END) { fprintf(stderr, "kernel_launch: unexpected shapes: n_in %d in0 %d out %d ws %zu (need >= %zu); nothing launched\n", n_in, n_in > 0 ? in_sizes[0] : -1, out_size, ws_size, (size_t)WS_END); grid = -1; return; }
        int dev = 0, cus = 0;
        if (hipGetDevice(&dev) != hipSuccess || hipDeviceGetAttribute(&cus, hipDeviceAttributeMultiprocessorCount, dev) != hipSuccess) { fprintf(stderr, "kernel_launch: device query failed\n"); grid = -1; return; }
        if (hipFuncSetAttribute((const void*)mk_fwd, hipFuncAttributeMaxDynamicSharedMemorySize, LDS_BYTES) != hipSuccess) { fprintf(stderr, "kernel_launch: hipFuncSetAttribute failed\n"); grid = -1; return; }
        int per_cu = 0;
        if (hipOccupancyMaxActiveBlocksPerMultiprocessor(&per_cu, (const void*)mk_fwd, NWAVES * 64, LDS_BYTES) != hipSuccess || per_cu < 1) fprintf(stderr, "kernel_launch: note: occupancy query reports %d workgroups per CU\n", per_cu);
        (void)hipGetLastError();
        grid = cus;
    }
    if (grid < 0) return;
    if (hipMemsetAsync((char*)d_ws + WS_CTL, 0, CTL_ZERO_BYTES, stream) != hipSuccess) { fprintf(stderr, "kernel_launch: hipMemsetAsync failed\n"); return; }
    Args a{};
    for (int i = 0; i < 26; ++i) a.in[i] = (const float*)d_in[i];
    a.out = (float*)d_out; a.ws = (unsigned char*)d_ws;
    for (int li = 0; li < N_LAUNCHES; ++li) {
        a.ph_lo = (N_LAUNCHES == 1) ? 0 : li; a.ph_hi = (N_LAUNCHES == 1) ? NPHASE : li + 1;
        hipLaunchKernelGGL(mk_fwd, dim3(grid), dim3(NWAVES * 64), LDS_BYTES, stream, a);
        const hipError_t le = hipPeekAtLastError();
        if (le != hipSuccess) { fprintf(stderr, "kernel_launch: launch %d failed: %s\n", li, hipGetErrorName(le)); break; }
    }
}
```

```cpp
#include <hip/hip_runtime.h>
#include <cstdio>
#include <cstdint>
#ifndef MK_N_LAUNCHES
#define MK_N_LAUNCHES 1
#endif
namespace pg8 {
#define PG8_LAS __attribute__((address_space(3)))
#define PG8_GAS __attribute__((address_space(1)))
typedef unsigned short bf16_t;
typedef short bf16x8 __attribute__((ext_vector_type(8)));
typedef float f32x4 __attribute__((ext_vector_type(4)));
typedef float f32x2 __attribute__((ext_vector_type(2)));
typedef unsigned u32x4 __attribute__((ext_vector_type(4)));
typedef unsigned u32x2 __attribute__((ext_vector_type(2)));
typedef int v4i_t __attribute__((ext_vector_type(4)));
typedef int v8i_t __attribute__((ext_vector_type(8)));
constexpr int BM = 256, BK = 64, HALF = 128, HTB = HALF * BK * 2  , STAGE_BYTES = 8 * HTB, NXCD = 8, WGM = 8;

__host__ __device__ __forceinline__ int lds_byte(int r, int c) { const int st = (r >> 4) * 2 + (c >> 5), rr = r & 15, cc = c & 31, ob = rr * 64 + cc * 2; return st * 1024 + (ob ^ (((ob >> 9) & 1) << 5)); }
__host__ __device__ __forceinline__ void stage_rc(int b, int& R, int& C) { const int st = b / 1024, sb = b % 1024, swz = sb ^ (((sb >> 9) & 1) << 5); R = (st >> 1) * 16 + swz / 64; C = (st & 1) * 32 + (swz % 64) / 2; }
__host__ __device__ __forceinline__ int perm32(int rho) { const int n = rho >> 4, i = rho & 15; return 8 * (i >> 2) + 4 * n + (i & 3); }

struct Unit { int pm, pn, be, kt0, nkt, part; };
struct Gemm { const bf16_t* A; const bf16_t* Bt; int M, N, K; size_t bstride; const int* rowtok; unsigned char* slab; unsigned* skflag; unsigned* tmo; int noepi; };

struct StaticOrder {
    static constexpr bool STREAMK = false;
    int nM, nN, nwg, G, c, nt;
    __host__ __device__ __forceinline__ void init(int M, int N, int G_, int c_, int nt_) { nM = M / BM; nN = N / BM; nwg = nM * nN; G = G_; c = c_; nt = nt_; }
    __host__ __device__ __forceinline__ int wg() const { return c; }
    __host__ __device__ __forceinline__ bool next(int i, Unit& u) const { const long L = (long)i * G + c; if (L >= nwg) return false; map((int)L, u); return true; }
    __host__ __device__ __forceinline__ void map_linear(int wgid, Unit& u) const {
        const int nig = WGM * nN, gid = wgid / nig, fm = gid * WGM, gsz = (nM - fm) < WGM ? (nM - fm) : WGM;
        u.pm = fm + ((wgid % nig) % gsz); u.pn = (wgid % nig) / gsz; u.be = 0; u.kt0 = 0; u.nkt = nt; u.part = 0;
    }
    __host__ __device__ __forceinline__ void map(int L, Unit& u) const {
        int wgid = L; { const int q = nwg / NXCD, r = nwg % NXCD, xcd = wgid % NXCD, off = wgid / NXCD; wgid = (xcd < r ? xcd * (q + 1) : r * (q + 1) + (xcd - r) * q) + off; }
        const int nig = WGM * nN, gid = wgid / nig, fm = gid * WGM, gsz = (nM - fm) < WGM ? (nM - fm) : WGM;
        u.pm = fm + ((wgid % nig) % gsz); u.pn = (wgid % nig) / gsz; u.be = 0; u.kt0 = 0; u.nkt = nt; u.part = 0;
    }
};
template <bool STREAMK_> struct MoeOrderT {
    static constexpr bool STREAMK = STREAMK_;
    StaticOrder so; int t1, t2, t3, t4, t5, t6, t7; int p0, p1, ppu;
    __device__ __forceinline__ int wg() const { return so.c; }
    __device__ __forceinline__ void plan() { ppu = so.nt / 2; const long tot = (long)so.nwg * ppu; p0 = (int)(tot * so.c / so.G); p1 = (int)(tot * (so.c + 1) / so.G); }
    __device__ __forceinline__ bool next(int i, Unit& u) const {
#if defined(PROBE_DOUBLE_KLOOP)
        if (!STREAMK) { if (!so.next(i >> 1, u)) return false; if (!(i & 1)) u.part = 3; }
#else
        if (!STREAMK) { if (!so.next(i, u)) return false; }
#endif
        else { const int first = p0 / ppu, uidx = first + i; const int s = (i == 0) ? (p0 - first * ppu) : 0; const int rem = p1 - uidx * ppu;
            if (rem <= s) return false;
            const int e = rem < ppu ? rem : ppu;
            so.map_linear(uidx, u); u.kt0 = 2 * s; u.nkt = 2 * (e - s); u.part = (s > 0) ? 1 : ((e < ppu) ? 2 : 0); }
        const int q = u.pm; u.be = (q >= t1) + (q >= t2) + (q >= t3) + (q >= t4) + (q >= t5) + (q >= t6) + (q >= t7); return true;
    }
};
typedef MoeOrderT<false> MoeOrder;
typedef MoeOrderT<true> MoeOrderSK;

__device__ __forceinline__ unsigned cvt_pk_bf16(float lo, float hi) { unsigned r; asm volatile("v_cvt_pk_bf16_f32 %0, %1, %2" : "=v"(r) : "v"(lo), "v"(hi)); return r; }
__device__ __forceinline__ float fast_sigmoid(float x) { return __builtin_amdgcn_rcpf(1.0f + __builtin_amdgcn_exp2f(-1.4426950408889634f * x)); }
__device__ __forceinline__ float row_rstd(const float* part, int row) {
    const f32x4 a = *(const f32x4*)(part + (size_t)row * 4);
    return __builtin_amdgcn_rsqf(((a[0] + a[1]) + (a[2] + a[3])) * (1.0f / 1024.0f) + 1e-6f);
}
__device__ __forceinline__ void row_rstd8(const float* part, int row0, float (&r)[2][4]) {
#pragma unroll
    for (int ai = 0; ai < 2; ++ai)
#pragma unroll
        for (int m = 0; m < 4; ++m) r[ai][m] = row_rstd(part, row0 + ai * HALF + m * 16);
}
__device__ __forceinline__ unsigned pk_fp8x4(float a, float b, float c, float d) {
    a = __builtin_amdgcn_fmed3f(a, -448.f, 448.f); b = __builtin_amdgcn_fmed3f(b, -448.f, 448.f); c = __builtin_amdgcn_fmed3f(c, -448.f, 448.f); d = __builtin_amdgcn_fmed3f(d, -448.f, 448.f);
    unsigned w = 0u; w = __builtin_amdgcn_cvt_pk_fp8_f32(a, b, w, false); w = __builtin_amdgcn_cvt_pk_fp8_f32(c, d, w, true); return w;
}
__device__ __forceinline__ unsigned pk_i8x4(float a, float b, float c, float d) {
    const int ia = (int)__builtin_rintf(__builtin_amdgcn_fmed3f(a, -127.f, 127.f)), ib = (int)__builtin_rintf(__builtin_amdgcn_fmed3f(b, -127.f, 127.f));
    const int ic = (int)__builtin_rintf(__builtin_amdgcn_fmed3f(c, -127.f, 127.f)), id = (int)__builtin_rintf(__builtin_amdgcn_fmed3f(d, -127.f, 127.f));
    return ((unsigned)ia & 255u) | (((unsigned)ib & 255u) << 8) | (((unsigned)ic & 255u) << 16) | ((unsigned)id << 24);
}

template <int MODE> struct EpiGated {
    static constexpr bool PERM = true, AFTER_DRAIN = false;
    bf16_t* O; int ldo; const float* bias; int bias_half; const float* part; float descale, out_scale;
    mutable float r8c[2][4]; mutable int pmc;
    __device__ __forceinline__ void operator()(const f32x4 (&acc)[2][2][4][2], const Unit& u, int wr, int wc, int fr, int fq) const {
        const int row0 = u.pm * BM + wr * 64 + fr, col0 = u.pn * 128 + wc * 32 + 8 * fq;
        f32x4 ba[2], bg[2];
#pragma unroll
        for (int n = 0; n < 2; ++n) { if (MODE == 0) { ba[n] = *(const f32x4*)(bias + col0 + 4 * n); bg[n] = *(const f32x4*)(bias + bias_half + col0 + 4 * n); } else { ba[n] = (f32x4){0.f, 0.f, 0.f, 0.f}; bg[n] = ba[n]; } }
        if ((MODE == 1 || MODE == 4) && u.pm != pmc) { row_rstd8(part, row0, r8c); pmc = u.pm; }
#pragma unroll
        for (int ai = 0; ai < 2; ++ai)
#pragma unroll
            for (int m = 0; m < 4; ++m) { const int row = row0 + ai * HALF + m * 16;
                float r = 1.f; if (MODE == 1 || MODE == 4) r = r8c[ai][m];
                f32x4 o[2];
#pragma unroll
                for (int n = 0; n < 2; ++n) { f32x4 a = acc[ai][0][m][n], g = acc[ai][1][m][n];
                    if (MODE == 0) { a = a * descale + ba[n]; g = g * descale + bg[n];
#pragma unroll
                        for (int e = 0; e < 4; ++e) o[n][e] = a[e] * fast_sigmoid(g[e]); }
                    else if (MODE == 3) {
                        const float c1 = -1.4426950408889634f * descale, c2 = descale * descale * out_scale;
#pragma unroll
                        for (int e = 0; e < 4; ++e) o[n][e] = (a[e] * g[e]) * __builtin_amdgcn_rcpf(1.0f + __builtin_amdgcn_exp2f(a[e] * c1)) * c2; }
                    else { if (MODE == 1) { a = a * (r * descale); g = g * (r * descale); } if (MODE == 4) { a = a * (r * descale); g = g * (r * descale * out_scale); }
#pragma unroll
                        for (int e = 0; e < 4; ++e) o[n][e] = a[e] * fast_sigmoid(a[e]) * g[e]; } }
                if (MODE == 3 || MODE == 4) { u32x2 w; w.x = pk_fp8x4(o[0][0], o[0][1], o[0][2], o[0][3]); w.y = pk_fp8x4(o[1][0], o[1][1], o[1][2], o[1][3]); *(u32x2*)((unsigned char*)O + (size_t)row * ldo + col0) = w; }
                else { u32x4 w; w.x = cvt_pk_bf16(o[0][0], o[0][1]); w.y = cvt_pk_bf16(o[0][2], o[0][3]); w.z = cvt_pk_bf16(o[1][0], o[1][1]); w.w = cvt_pk_bf16(o[1][2], o[1][3]);
                *(u32x4*)(O + (size_t)row * ldo + col0) = w; }
                }
    }
};
template <bool BIAS, bool AUX, int XB8 = 0> struct EpiResid {
    static constexpr bool PERM = false, AFTER_DRAIN = false;
    const float* resid; float* out; const float* bias; unsigned char* xb; float* part; float descale, xb_scale; PG8_LAS float* red;
    __device__ __forceinline__ void operator()(const f32x4 (&acc)[2][2][4][2], const Unit& u, int wr, int wc, int fr, int fq) const {
        const int row0 = u.pm * BM + wr * 64 + fr, col0 = u.pn * BM + wc * 32 + 4 * fq;
        f32x4 bv[2][2];
#pragma unroll
        for (int bj = 0; bj < 2; ++bj)
#pragma unroll
            for (int n = 0; n < 2; ++n) bv[bj][n] = BIAS ? *(const f32x4*)(bias + col0 + bj * HALF + n * 16) : (f32x4){0.f, 0.f, 0.f, 0.f};
#pragma unroll
        for (int ai = 0; ai < 2; ++ai)
#pragma unroll
            for (int m = 0; m < 4; ++m) { const int row = row0 + ai * HALF + m * 16; const size_t off = (size_t)row * 1024 + col0; float ss = 0.f;
#pragma unroll
                for (int bj = 0; bj < 2; ++bj)
#pragma unroll
                    for (int n = 0; n < 2; ++n) { const f32x4 x = *(const f32x4*)(resid + off + bj * HALF + n * 16) + acc[ai][bj][m][n] * descale + bv[bj][n];
                        *(f32x4*)(out + off + bj * HALF + n * 16) = x;
                        if (AUX) { ss += (x[0] * x[0] + x[1] * x[1]) + (x[2] * x[2] + x[3] * x[3]); if (XB8 == 1) *(unsigned*)(xb + off + bj * HALF + n * 16) = pk_fp8x4(x[0] * xb_scale, x[1] * xb_scale, x[2] * xb_scale, x[3] * xb_scale);
                            else if (XB8 == 2) *(unsigned*)(xb + off + bj * HALF + n * 16) = pk_i8x4(x[0] * xb_scale, x[1] * xb_scale, x[2] * xb_scale, x[3] * xb_scale);
                            else { u32x2 w; w.x = cvt_pk_bf16(x[0], x[1]); w.y = cvt_pk_bf16(x[2], x[3]); *(u32x2*)((bf16_t*)xb + off + bj * HALF + n * 16) = w; } } }
                if (AUX) { ss += __shfl_xor(ss, 16); ss += __shfl_xor(ss, 32); if (fq == 0) red[(ai * HALF + wr * 64 + m * 16 + fr) * 4 + wc] = ss; }
                if (m == 3) asm volatile("" ::: "memory"); }
        if (AUX) {
            __syncthreads();
            const int t = ((wr * 4 + wc) << 6) | (fq * 16 + fr);
            if (t < BM) { const f32x4 q = *(const PG8_LAS f32x4*)(red + t * 4); part[(size_t)(u.pm * BM + t) * 4 + u.pn] = (q[0] + q[1]) + (q[2] + q[3]); }
            __syncthreads();
        }
    }
};
struct EpiQKV {
    static constexpr bool PERM = true, AFTER_DRAIN = false;
    bf16_t* Kb; size_t kvq_stride; const float* part; const float* kgain; const float* qgain; float qscale, descale;
    mutable float r8c[2][4]; mutable int pmc;
    __device__ __forceinline__ void operator()(const f32x4 (&acc)[2][2][4][2], const Unit& u, int wr, int wc, int fr, int fq) const {
        const int kind = u.pn >> 2, head = (u.pn & 3) * 4 + wc;
        bf16_t* dst = Kb + (size_t)kind * kvq_stride;
        const float* gsrc = kind == 0 ? kgain : qgain; const float gs = kind == 2 ? qscale : 1.f;
        const int row0 = u.pm * BM + wr * 64 + fr, colb = head * 64 + 8 * fq;
        f32x4 gv[2][2];
#pragma unroll
        for (int bj = 0; bj < 2; ++bj)
#pragma unroll
            for (int n = 0; n < 2; ++n) gv[bj][n] = *(const f32x4*)(gsrc + 32 * bj + 8 * fq + 4 * n) * gs;
        if (u.pm != pmc) { row_rstd8(part, row0, r8c); pmc = u.pm; }
#pragma unroll
        for (int ai = 0; ai < 2; ++ai)
#pragma unroll
            for (int m = 0; m < 4; ++m) { const int row = row0 + ai * HALF + m * 16; const float r = r8c[ai][m] * descale;
                f32x4 v[2][2]; float ss = 0.f;
#pragma unroll
                for (int bj = 0; bj < 2; ++bj)
#pragma unroll
                    for (int n = 0; n < 2; ++n) { v[bj][n] = acc[ai][bj][m][n] * r; const f32x4 x = v[bj][n]; ss += (x[0] * x[0] + x[1] * x[1]) + (x[2] * x[2] + x[3] * x[3]); }
                ss += __shfl_xor(ss, 16); ss += __shfl_xor(ss, 32);
                if (kind != 1) { const float inv = __builtin_amdgcn_rsqf(ss * (1.0f / 64.0f) + 1e-6f);
#pragma unroll
                    for (int bj = 0; bj < 2; ++bj)
#pragma unroll
                        for (int n = 0; n < 2; ++n) v[bj][n] = v[bj][n] * gv[bj][n] * inv; }
#pragma unroll
                for (int bj = 0; bj < 2; ++bj) { u32x4 w; w.x = cvt_pk_bf16(v[bj][0][0], v[bj][0][1]); w.y = cvt_pk_bf16(v[bj][0][2], v[bj][0][3]); w.z = cvt_pk_bf16(v[bj][1][0], v[bj][1][1]); w.w = cvt_pk_bf16(v[bj][1][2], v[bj][1][3]);
                    *(u32x4*)(dst + (size_t)row * 1024 + colb + 32 * bj) = w; }
                __builtin_amdgcn_sched_barrier(0); }
    }
};
struct EpiMoeDown {
    static constexpr bool PERM = true, AFTER_DRAIN = false;
    unsigned char* Y; const float* rowgate; float descale;
    template <bool ADD> __device__ __forceinline__ void run(const f32x4 (&acc)[2][2][4][2], const Unit& u, int wr, int wc, int fr, int fq, const PG8_GAS u32x2* sl) const {
        const int rt0 = u.pm * BM + wr * 64 + fr, col0 = u.pn * BM + wc * 32 + 8 * fq;
        float gtv[2][4];
#pragma unroll
        for (int ai = 0; ai < 2; ++ai)
#pragma unroll
            for (int m = 0; m < 4; ++m) gtv[ai][m] = rowgate[rt0 + ai * HALF + m * 16] * descale;
#pragma unroll
        for (int ai = 0; ai < 2; ++ai) {
#pragma unroll
            for (int m = 0; m < 4; ++m) { const float gt = gtv[ai][m]; unsigned char* p = Y + (size_t)(rt0 + ai * HALF + m * 16) * 1024 + col0;
#pragma unroll
                for (int bj = 0; bj < 2; ++bj) { f32x4 s0 = acc[ai][bj][m][0], s1 = acc[ai][bj][m][1];
                    if (ADD) { const u32x2 q0 = sl[bj * 2 + 0], q1 = sl[bj * 2 + 1];
                        s0[0] += __uint_as_float(q0.x << 16); s0[1] += __uint_as_float(q0.x & 0xffff0000u); s0[2] += __uint_as_float(q0.y << 16); s0[3] += __uint_as_float(q0.y & 0xffff0000u);
                        s1[0] += __uint_as_float(q1.x << 16); s1[1] += __uint_as_float(q1.x & 0xffff0000u); s1[2] += __uint_as_float(q1.y << 16); s1[3] += __uint_as_float(q1.y & 0xffff0000u); }
                    s0 = s0 * gt; s1 = s1 * gt;
                    u32x2 w; w.x = pk_i8x4(s0[0], s0[1], s0[2], s0[3]); w.y = pk_i8x4(s1[0], s1[1], s1[2], s1[3]);
                    *(u32x2*)(p + bj * HALF) = w; }
                if (ADD) { sl += 512 * 4; asm volatile("" : "+v"(sl)); } }
            asm volatile("" ::: "memory"); }
    }
    __device__ __forceinline__ void operator()(const f32x4 (&acc)[2][2][4][2], const Unit& u, int wr, int wc, int fr, int fq) const { run<false>(acc, u, wr, wc, fr, fq, nullptr); }
};

template <class Epi, class Sched, bool GATHER, int PREC = 0>
__device__ __forceinline__ void gemm_phase(PG8_LAS unsigned char* lds, const Gemm g, const Sched& S, const Epi& E, const int tid) {
    constexpr bool FP8 = (PREC == 1), I8 = (PREC == 2), BYTE1 = (PREC != 0);
    const int wid = __builtin_amdgcn_readfirstlane(tid >> 6), lane = tid & 63, wr = wid >> 2, wc = wid & 3, fr = lane & 15, fq = lane >> 4;
    const int K = g.K;
    const int rowb = BYTE1 ? K : 2 * K;
    unsigned voffB[2]; unsigned vC0[2], vC1[2], vN0[2], vN1[2]; int Rr[2], Cc[2];
#pragma unroll
    for (int i = 0; i < 2; ++i) { int R, C; stage_rc(tid * 16 + i * 8192, R, C); const int Rb = Epi::PERM ? ((R & ~31) + perm32(R & 31)) : R;
        Rr[i] = R; Cc[i] = C; vC0[i] = (unsigned)(R * rowb + C * 2); vC1[i] = vC0[i]; vN0[i] = vC0[i]; vN1[i] = vC0[i]; voffB[i] = (unsigned)(Rb * rowb + C * 2); }
    const size_t kstep = (size_t)(BK * 2);
    const size_t hstep = (size_t)HALF * rowb;
    const size_t hstepA = GATHER ? 0 : hstep;
    const size_t tstep = 2 * hstep;
    const unsigned ldsw = (unsigned)wid * 1024u;
    const int aoff = lds_byte(wr * 64 + fr, fq * 8), boff = lds_byte(wc * 32 + fr, fq * 8);
#define PG8_SA(b, h) (((b) * 2 + (h)) * HTB)
#define PG8_SB(b, h) ((4 + (b) * 2 + (h)) * HTB)
#define PG8_STAGE(bufoff, gbase, v0, v1) do { \
        __builtin_amdgcn_global_load_lds((const unsigned*)((const char*)(gbase) + (v0)), (PG8_LAS unsigned*)(lds + (bufoff) + ldsw), 16, 0, 0); \
        __builtin_amdgcn_global_load_lds((const unsigned*)((const char*)(gbase) + (v1)), (PG8_LAS unsigned*)(lds + (bufoff) + ldsw + 8192), 16, 0, 0); } while (0)
#define PG8_LD8(addr) __builtin_shufflevector(*(const PG8_LAS v4i_t*)(addr), *(const PG8_LAS v4i_t*)((addr) + 1024), 0, 1, 2, 3, 4, 5, 6, 7)
#define PG8_LDA(dst, b, h) do { if (FP8) { _Pragma("unroll") for (int m = 0; m < 4; ++m) dst##8[m] = PG8_LD8(lds + PG8_SA(b, h) + aoff + m * 2048); } else { \
        _Pragma("unroll") for (int m = 0; m < 4; ++m) _Pragma("unroll") for (int k = 0; k < 2; ++k) dst[m][k] = *(const PG8_LAS bf16x8*)(lds + PG8_SA(b, h) + aoff + m * 2048 + k * 1024); } } while (0)
#define PG8_LDB(dst, b, h) do { if (FP8) { _Pragma("unroll") for (int n = 0; n < 2; ++n) dst##8[n] = PG8_LD8(lds + PG8_SB(b, h) + boff + n * 2048); } else { \
        _Pragma("unroll") for (int n = 0; n < 2; ++n) _Pragma("unroll") for (int k = 0; k < 2; ++k) dst[n][k] = *(const PG8_LAS bf16x8*)(lds + PG8_SB(b, h) + boff + n * 2048 + k * 1024); } } while (0)
#if defined(PROBE_HALF_MFMA)
#define PG8_SKIP(ai) ((ai) == 1 && cur.part == 3)
#else
#define PG8_SKIP(ai) false
#endif
#define PG8_MMA(ai, bj, At, Bt) do { if (PG8_SKIP(ai)) break; __builtin_amdgcn_s_setprio(1); _Pragma("unroll") for (int m = 0; m < 4; ++m) _Pragma("unroll") for (int n = 0; n < 2; ++n) { \
        if (FP8) asm volatile("v_mfma_scale_f32_16x16x128_f8f6f4 %0, %1, %2, %0, %3, %3 op_sel_hi:[0,0,0]" : "+v"(acc[ai][bj][m][n]) : "v"(Bt##8[n]), "v"(At##8[m]), "v"(sc1)); \
        else if (I8) { _Pragma("unroll") for (int k = 0; k < 2; ++k) acc[ai][bj][m][n] = __builtin_bit_cast(f32x4, __builtin_amdgcn_mfma_i32_16x16x64_i8(__builtin_bit_cast(v4i_t, Bt[n][k]), __builtin_bit_cast(v4i_t, At[m][k]), __builtin_bit_cast(v4i_t, acc[ai][bj][m][n]), 0, 0, 0)); } \
        else { _Pragma("unroll") for (int k = 0; k < 2; ++k) acc[ai][bj][m][n] = __builtin_amdgcn_mfma_f32_16x16x32_bf16(Bt[n][k], At[m][k], acc[ai][bj][m][n], 0, 0, 0); } } __builtin_amdgcn_s_setprio(0); } while (0)
#define PG8_WAIT_V(n) asm volatile("s_waitcnt vmcnt(" #n ")" ::: "memory")
#define PG8_WAIT_L(n) asm volatile("s_waitcnt lgkmcnt(" #n ")" ::: "memory")
#define PG8_BAR __builtin_amdgcn_s_barrier()
#define PG8_SCHED __builtin_amdgcn_sched_barrier(0)
#define PG8_TOKOFF(pm_, h_, i_) ({ int t_ = g.rowtok[(pm_) * BM + (h_) * HALF + Rr[i_]]; t_ = t_ < 0 ? 0 : t_; (unsigned)(t_ * rowb + Cc[i_] * 2); })
    unsigned sc1 = 0u; if (FP8) asm volatile("v_mov_b32 %0, 0x7f7f7f7f" : "=v"(sc1));
    Unit cur, nxt; int ui = 0;
    if (!S.next(0, cur)) return;
    f32x4 acc[2][2][4][2];
#pragma unroll
    for (int a = 0; a < 2; ++a)
#pragma unroll
        for (int b = 0; b < 2; ++b)
#pragma unroll
            for (int m = 0; m < 4; ++m)
#pragma unroll
                for (int n = 0; n < 2; ++n) acc[a][b][m][n] = (f32x4){0.f, 0.f, 0.f, 0.f};
    bf16x8 At[4][2], B0[2][2], B1[2][2]; v8i_t At8[4], B08[2], B18[2];
    if (GATHER) {
#pragma unroll
        for (int i = 0; i < 2; ++i) { vC0[i] = PG8_TOKOFF(cur.pm, 0, i); vC1[i] = PG8_TOKOFF(cur.pm, 1, i); }
    }
    const char* cA = (GATHER ? (const char*)g.A : (const char*)g.A + (size_t)cur.pm * tstep) + (size_t)cur.kt0 * kstep;
    const char* cB = (const char*)g.Bt + (size_t)cur.be * g.bstride + (size_t)cur.pn * tstep + (size_t)cur.kt0 * kstep;
    PG8_STAGE(PG8_SB(0, 0), cB, voffB[0], voffB[1]); PG8_STAGE(PG8_SB(0, 1), cB + hstep, voffB[0], voffB[1]); PG8_STAGE(PG8_SA(0, 0), cA, vC0[0], vC0[1]); PG8_STAGE(PG8_SA(0, 1), cA + hstepA, vC1[0], vC1[1]);
    if (wr == 1) PG8_BAR;
    PG8_WAIT_V(2); PG8_BAR;
    PG8_STAGE(PG8_SB(1, 0), cB + kstep, voffB[0], voffB[1]); PG8_STAGE(PG8_SA(1, 0), cA + kstep, vC0[0], vC0[1]); PG8_STAGE(PG8_SB(1, 1), cB + hstep + kstep, voffB[0], voffB[1]);
    PG8_WAIT_V(6); PG8_BAR;
    for (;;) {
        const bool has_next = S.next(ui + 1, nxt);
        const char* nA = has_next ? (GATHER ? (const char*)g.A : (const char*)g.A + (size_t)nxt.pm * tstep) + (size_t)nxt.kt0 * kstep : cA;
        const char* nB = has_next ? (const char*)g.Bt + (size_t)nxt.be * g.bstride + (size_t)nxt.pn * tstep + (size_t)nxt.kt0 * kstep : cB;
        if (GATHER) {
            if (has_next && nxt.pm != cur.pm) {
#pragma unroll
                for (int i = 0; i < 2; ++i) { vN0[i] = PG8_TOKOFF(nxt.pm, 0, i); vN1[i] = PG8_TOKOFF(nxt.pm, 1, i); }
            } else {
#pragma unroll
                for (int i = 0; i < 2; ++i) { vN0[i] = vC0[i]; vN1[i] = vC1[i]; }
            }
        }
        const int nkt = cur.nkt;
        for (int t = 0; t < nkt; t += 2) {
            const bool last = (t == nkt - 2);
            const char* a1 = cA + (size_t)(t + 1) * kstep;
            const char* a2 = last ? nA : cA + (size_t)(t + 2) * kstep; const char* b2 = last ? nB : cB + (size_t)(t + 2) * kstep;
            const char* a3 = a2 + kstep; const char* b3 = b2 + kstep;
            const unsigned x00 = (GATHER && last) ? vN0[0] : vC0[0], x01 = (GATHER && last) ? vN0[1] : vC0[1], x10 = (GATHER && last) ? vN1[0] : vC1[0], x11 = (GATHER && last) ? vN1[1] : vC1[1];
            PG8_LDB(B0, 0, 0); PG8_LDB(B1, 0, 1); PG8_SCHED; PG8_LDA(At, 0, 0); PG8_STAGE(PG8_SA(1, 1), a1 + hstepA, vC1[0], vC1[1]);
            PG8_WAIT_V(8); PG8_WAIT_L(0); PG8_BAR; PG8_MMA(0, 0, At, B0); PG8_MMA(0, 1, At, B1); PG8_BAR; PG8_SCHED;
            PG8_LDA(At, 0, 1); PG8_STAGE(PG8_SB(0, 0), b2, voffB[0], voffB[1]); PG8_STAGE(PG8_SB(0, 1), b2 + hstep, voffB[0], voffB[1]); PG8_STAGE(PG8_SA(0, 0), a2, x00, x01);
            PG8_WAIT_V(8); PG8_WAIT_L(0); PG8_BAR; PG8_MMA(1, 0, At, B0); PG8_MMA(1, 1, At, B1); PG8_BAR; PG8_SCHED;
            PG8_LDB(B0, 1, 0); PG8_LDB(B1, 1, 1); PG8_SCHED; PG8_LDA(At, 1, 0); PG8_STAGE(PG8_SA(0, 1), a2 + hstepA, x10, x11);
            PG8_WAIT_V(8); PG8_WAIT_L(0); PG8_BAR; PG8_MMA(0, 0, At, B0); PG8_MMA(0, 1, At, B1); PG8_BAR; PG8_SCHED;
            PG8_LDA(At, 1, 1); PG8_STAGE(PG8_SB(1, 0), b3, voffB[0], voffB[1]); PG8_STAGE(PG8_SB(1, 1), b3 + hstep, voffB[0], voffB[1]); PG8_STAGE(PG8_SA(1, 0), a3, x00, x01);
            PG8_WAIT_V(8); PG8_WAIT_L(0); PG8_BAR; PG8_MMA(1, 0, At, B0); PG8_MMA(1, 1, At, B1); PG8_BAR; PG8_SCHED;
        }
        if (wr == 0) PG8_BAR;
        if (FP8) { asm volatile("s_nop 15\n\ts_nop 15" ::: "memory");
#pragma unroll
            for (int a = 0; a < 2; ++a)
#pragma unroll
                for (int b = 0; b < 2; ++b)
#pragma unroll
                    for (int m = 0; m < 4; ++m)
#pragma unroll
                        for (int n = 0; n < 2; ++n) asm volatile("" : "+v"(acc[a][b][m][n])); }
        if (I8) {
#pragma unroll
            for (int a = 0; a < 2; ++a)
#pragma unroll
                for (int b = 0; b < 2; ++b)
#pragma unroll
                    for (int m = 0; m < 4; ++m)
#pragma unroll
                        for (int n = 0; n < 2; ++n) { const v4i_t q = __builtin_bit_cast(v4i_t, acc[a][b][m][n]); acc[a][b][m][n] = (f32x4){(float)q[0], (float)q[1], (float)q[2], (float)q[3]}; } }
        if (g.noepi) {} else
        if constexpr (Sched::STREAMK) {
            if (cur.part == 1) {
                PG8_GAS u32x2* sl = (PG8_GAS u32x2*)g.slab + (size_t)S.wg() * (32 * 512) + tid * 4;
#pragma unroll
                for (int a = 0; a < 2; ++a)
#pragma unroll
                    for (int m = 0; m < 4; ++m) {
#pragma unroll
                        for (int b = 0; b < 2; ++b)
#pragma unroll
                            for (int n = 0; n < 2; ++n) { u32x2 w; w.x = cvt_pk_bf16(acc[a][b][m][n][0], acc[a][b][m][n][1]); w.y = cvt_pk_bf16(acc[a][b][m][n][2], acc[a][b][m][n][3]); sl[b * 2 + n] = w; }
                        sl += 512 * 4; asm volatile("" : "+v"(sl)); }
                asm volatile("s_waitcnt vmcnt(0)" ::: "memory");
                __syncthreads();
                if (tid == 0) { __builtin_amdgcn_fence(__ATOMIC_RELEASE, "agent"); asm volatile("s_waitcnt vmcnt(0)" ::: "memory");
                    __hip_atomic_store(g.skflag + 16 * S.wg(), 1u, __ATOMIC_RELAXED, __HIP_MEMORY_SCOPE_AGENT); }
            } else if (cur.part == 2) {
                if (wid == 0) { unsigned sp = 0;
                    while (__hip_atomic_load(g.skflag + 16 * (S.wg() + 1), __ATOMIC_RELAXED, __HIP_MEMORY_SCOPE_AGENT) == 0u) { __builtin_amdgcn_s_sleep(2);
                        if (++sp > (1u << 22)) { if (lane == 0) __hip_atomic_store(g.tmo, 1u, __ATOMIC_RELAXED, __HIP_MEMORY_SCOPE_AGENT); break; } }
                    __builtin_amdgcn_fence(__ATOMIC_ACQUIRE, "agent"); }
                asm volatile("s_waitcnt vmcnt(0)" ::: "memory");
                __syncthreads();
                E.template run<true>(acc, cur, wr, wc, fr, fq, (const PG8_GAS u32x2*)g.slab + (size_t)(S.wg() + 1) * (32 * 512) + tid * 4);
            } else { if (cur.part != 3) E(acc, cur, wr, wc, fr, fq); }
        } else { if (cur.part != 3) E(acc, cur, wr, wc, fr, fq); }
        if (!has_next) break;
#pragma unroll
        for (int a = 0; a < 2; ++a)
#pragma unroll
            for (int b = 0; b < 2; ++b)
#pragma unroll
                for (int m = 0; m < 4; ++m)
#pragma unroll
                    for (int n = 0; n < 2; ++n) acc[a][b][m][n] = (f32x4){0.f, 0.f, 0.f, 0.f};
        cur = nxt; cA = nA; cB = nB; ++ui;
        if (GATHER) {
#pragma unroll
            for (int i = 0; i < 2; ++i) { vC0[i] = vN0[i]; vC1[i] = vN1[i]; }
        }
        if (wr == 1) PG8_BAR;
    }
    PG8_WAIT_V(0);
    PG8_BAR;
#undef PG8_SA
#undef PG8_SB
#undef PG8_STAGE
#undef PG8_LDA
#undef PG8_LDB
#undef PG8_MMA
#undef PG8_LD8
#undef PG8_WAIT_V
#undef PG8_WAIT_L
#undef PG8_BAR
#undef PG8_SCHED
#undef PG8_TOKOFF
}
}
#define GAS __attribute__((address_space(1)))
#define LAS __attribute__((address_space(3)))
typedef unsigned short bf16;
typedef unsigned v4u __attribute__((ext_vector_type(4)));
typedef float f32x4 __attribute__((ext_vector_type(4)));
typedef short bf16x8 __attribute__((ext_vector_type(8)));
typedef GAS unsigned gu32;
typedef GAS unsigned long long gu64;
#define RLX_AGENT __ATOMIC_RELAXED, __HIP_MEMORY_SCOPE_AGENT
#define LDS_WAIT() asm volatile("s_waitcnt lgkmcnt(0)" ::: "memory")
#define VM_WAIT() asm volatile("s_waitcnt vmcnt(0)" ::: "memory")
__device__ __forceinline__ unsigned long long rt() { return __builtin_amdgcn_s_memrealtime(); }
__device__ __forceinline__ unsigned f2bf(float f) { unsigned u = __builtin_bit_cast(unsigned, f); return (u + 0x7fffu + ((u >> 16) & 1u)) >> 16; }
__device__ __forceinline__ unsigned pk2(float lo, float hi) { return f2bf(lo) | (f2bf(hi) << 16); }

#define XB_TMO      128
#define XB_XCNT(j)  (256  + 64 * (j))
#define XB_XSUB(j)  (1280 + 64 * (j))
#define XB_XGEN(j)  (2304 + 64 * (j))
#define XB_TOP      3328
#define XB_TOPGEN   3392
#define XCD_BAR_WORDS 3456
#define XB_SPIN_CAP (1u << 18)

__device__ __forceinline__ unsigned xb_ld(unsigned* p)              { return __hip_atomic_load(p, __ATOMIC_RELAXED, __HIP_MEMORY_SCOPE_AGENT); }
__device__ __forceinline__ unsigned xb_add(unsigned* p, unsigned v) { return __hip_atomic_fetch_add(p, v, __ATOMIC_RELAXED, __HIP_MEMORY_SCOPE_AGENT); }
__device__ __forceinline__ unsigned xb_xcc_id() { return (unsigned)__builtin_amdgcn_s_getreg((3 << 11) | 20) & 0xFu; }
#define XB_SPIN(cond, bar) do { unsigned _sp = 0; while (cond) { __builtin_amdgcn_s_sleep(1); \
    if ((++_sp & 255u) == 0u) { if (xb_ld(&(bar)[XB_TMO])) break; if (_sp > XB_SPIN_CAP) { atomicAdd(&(bar)[XB_TMO], 1u); break; } } } } while (0)

struct XcdBarrier {
    unsigned* bar; unsigned x;
    volatile LAS unsigned* st;
};

__device__ __forceinline__ XcdBarrier xcd_barrier_post(unsigned* bar, volatile LAS unsigned* st) {
    XcdBarrier b; b.bar = bar; b.x = xb_xcc_id(); b.st = st;
    if (threadIdx.x == 0) (void)xb_add(&bar[XB_XCNT(b.x)], 1u);
    return b;
}
__device__ __forceinline__ void xcd_barrier_complete(unsigned* bar, unsigned x, unsigned& nloc, unsigned& nx) {
    const unsigned G = gridDim.x * gridDim.y * gridDim.z;
    unsigned sum, cnt, mine, sp = 0u;
    for (;;) {
        sum = 0u; cnt = 0u; mine = 0u;
#pragma unroll
        for (unsigned j = 0; j < 16; ++j) { const unsigned c = xb_ld(&bar[XB_XCNT(j)]); sum += c; cnt += (c > 0u) ? 1u : 0u; mine = (j == x) ? c : mine; }
        if (sum == G) break;
        __builtin_amdgcn_s_sleep(1);
        if ((++sp & 255u) == 0u) { if (xb_ld(&bar[XB_TMO])) break; if (sp > XB_SPIN_CAP) { atomicAdd(&bar[XB_TMO], 1u); break; } }
    }
    nloc = mine > 0u ? mine : 1u; nx = cnt > 0u ? cnt : 1u;
}

__device__ __forceinline__ void xcd_barrier(const XcdBarrier& b) {
    asm volatile("s_waitcnt vmcnt(0)" ::: "memory");
    __syncthreads();
    if (threadIdx.x == 0) {
        unsigned* bar = b.bar;
        __builtin_amdgcn_s_waitcnt(0);
        unsigned nloc = b.st[0], nx = b.st[1];
        if (nloc == 0u) { xcd_barrier_complete(bar, b.x, nloc, nx); b.st[0] = nloc; b.st[1] = nx; }
        const unsigned old = xb_add(&bar[XB_XSUB(b.x)], 1u);
        const unsigned gen = old / nloc;
        if (old + 1u == (gen + 1u) * nloc) {
            __builtin_amdgcn_fence(__ATOMIC_RELEASE, "agent");
            asm volatile("s_waitcnt vmcnt(0)" ::: "memory");
            const unsigned og = xb_add(&bar[XB_TOP], 1u);
            const unsigned tg = og / nx;
            if (og + 1u == (tg + 1u) * nx) xb_add(&bar[XB_TOPGEN], 1u);
            else XB_SPIN(xb_ld(&bar[XB_TOPGEN]) == tg, bar);
            __builtin_amdgcn_fence(__ATOMIC_ACQUIRE, "agent");
            xb_add(&bar[XB_XGEN(b.x)], 1u);
            asm volatile("s_waitcnt vmcnt(0)" ::: "memory");
        } else {
            XB_SPIN(xb_ld(&bar[XB_XGEN(b.x)]) == gen, bar);
            __builtin_amdgcn_fence(__ATOMIC_ACQUIRE, "agent");
            asm volatile("s_waitcnt vmcnt(0)" ::: "memory");
        }
    }
    __syncthreads();
}

constexpr int NWAVES = 8;
constexpr int T = 32768, D = 1024, SEQ = 4096, NBATCH = 8;
constexpr int DFF = 2752, DFFP = 2816, DFFE = 3584, NEXP = 8;
constexpr int ROWCAP = 67584;
constexpr float EPS = 1e-6f;
constexpr float LOG2E = 1.4426950408889634f;
constexpr float SOFTMAX_OFS = 16.f;
constexpr float QSCALE = 0.125f * LOG2E;
#ifndef I8_P1
#define I8_P1 1
#endif
#ifndef I8_P3
#define I8_P3 0
#endif
#ifndef I8_P4
#define I8_P4 1
#endif
constexpr float SA_N = 127.f / 5.f, SA_X = 127.f / 6.f, SW_I8 = 127.f * 32.f / 4.5f;
constexpr float Y_SCALE = 127.f / 2.5f;
constexpr float W8_SCALE = 64.f, H3_SCALE = 16.f, HM_SCALE = 8.f, X8_SCALE = 16.f, HB_SCALE = 8.f, O8_SCALE = 64.f;
constexpr size_t MiB = 1u << 20;
constexpr size_t WS_CTL = 0, CTL_ZERO_BYTES = 1 * MiB;
constexpr size_t WS_PART1 = 1 * MiB, WS_PART2 = 3 * MiB, WS_LSE = 5 * MiB;
constexpr size_t WS_ROUTE = 7 * MiB, WS_GATE1 = WS_ROUTE + 128 * 1024, WS_GATE2 = WS_ROUTE + 256 * 1024, WS_WAVECNT = WS_ROUTE + 384 * 1024, WS_BLOCKCNT = WS_ROUTE + 448 * 1024, WS_GOFS = WS_ROUTE + 480 * 1024;
constexpr size_t WS_ROWTOK = 8 * MiB, WS_ROWGATE = 8 * MiB + 512 * 1024;
constexpr size_t WS_WIN = 12 * MiB, WS_WOUT = 16 * MiB, WS_WF13 = 18 * MiB, WS_WFD = 29 * MiB, WS_WQKV = 35 * MiB, WS_WO = 53 * MiB;
constexpr size_t WS_WM13 = 56 * MiB, WS_WM2 = 168 * MiB;
constexpr size_t WS_A0 = 224 * MiB;
constexpr size_t WS_H0 = WS_A0, WS_GLU = WS_A0 + 64 * MiB, WS_V = WS_A0 + 128 * MiB;
constexpr size_t WS_X1B = WS_A0, WS_HB = WS_A0 + 64 * MiB;
constexpr size_t WS_X2B = WS_A0, WS_KG = WS_A0 + 64 * MiB, WS_VG = WS_A0 + 128 * MiB, WS_QG = WS_A0 + 192 * MiB, WS_O = WS_A0 + 256 * MiB, WS_O8 = WS_A0 + 32 * MiB;
constexpr size_t WS_H3 = WS_A0, WS_HM = WS_A0 + 66 * MiB;
constexpr size_t WS_END = 548 * MiB;
static_assert(WS_HB + (size_t)T * DFFP * 2 <= WS_END && WS_O + (size_t)T * D * 2 <= WS_END && WS_HM + (size_t)ROWCAP * DFFE <= WS_END, "arena");
static_assert(WS_WFD + (size_t)D * DFFP * 2 <= WS_WQKV && WS_WO + (size_t)D * D * 2 <= WS_WM13 && WS_WM2 + (size_t)NEXP * D * DFFE * 2 <= WS_A0, "weights");
constexpr int CW_AQ = 50000;
constexpr int CW_TMO = 0, CW_CODE = 1, CW_BAR = 4096, CW_SKFLAG = 16384;
constexpr size_t WS_SLAB = 12 * MiB;
constexpr size_t WS_POS = 9 * MiB;
constexpr size_t WS_Y = WS_A0;
static_assert(WS_SLAB + (size_t)256 * 131072 <= 56 * MiB && WS_Y + (size_t)ROWCAP * 1024 <= WS_HM, "slab / Y");

constexpr int RING_OFF = 0, RING_BYTES = 131072;
constexpr int LDSCTL_OFF = RING_BYTES, MISC_OFF = LDSCTL_OFF + 320;
constexpr int XTRA_OFF = RING_BYTES + 512;
constexpr int LDS_BYTES = 147456;

constexpr int NPHASE = 18;

__constant__ unsigned char T5_BUCKET[3][132] = {
 {0,1,2,3,4,5,6,7,8,9,10,11,12,13,14,15,16,16,16,16,16,16,17,17,17,17,17,17,17,17,18,18,18,18,18,18,18,18,18,18,19,19,19,19,19,19,19,19,19,19,19,19,19,19,20,20,20,20,20,20,20,20,20,20,20,20,20,20,20,20,20,20,20,21,21,21,21,21,21,21,21,21,21,21,21,21,21,21,21,21,21,21,21,21,21,21,21,21,21,22,22,22,22,22,22,22,22,22,22,22,22,22,22,22,22,22,22,22,22,22,22,22,22,22,22,22,22,22,22,0,0,0},
 {0,4,8,12,16,16,17,17,18,18,19,19,19,19,20,20,20,20,20,21,21,21,21,21,21,22,22,22,22,22,22,22,22,22,23,23,23,23,23,23,23,23,23,23,23,23,24,24,24,24,24,24,24,24,24,24,24,24,24,24,24,24,25,25,25,25,25,25,25,25,25,25,25,25,25,25,25,25,25,25,25,25,25,26,26,26,26,26,26,26,26,26,26,26,26,26,26,26,26,26,26,26,26,26,26,26,26,26,26,26,26,26,26,27,27,27,27,27,27,27,27,27,27,27,27,27,27,27,27,0,0,0},
 {0,16,18,19,20,21,21,22,22,23,23,23,24,24,24,24,25,25,25,25,25,26,26,26,26,26,26,26,26,27,27,27,27,27,27,27,27,27,27,28,28,28,28,28,28,28,28,28,28,28,28,28,29,29,29,29,29,29,29,29,29,29,29,29,29,29,29,29,29,29,30,30,30,30,30,30,30,30,30,30,30,30,30,30,30,30,30,30,30,30,30,30,30,30,30,31,31,31,31,31,31,31,31,31,31,31,31,31,31,31,31,31,31,31,31,31,31,31,31,31,31,31,31,31,31,31,31,31,31,0,0,0}};

typedef float f32x16 __attribute__((ext_vector_type(16)));
typedef float f32x2v __attribute__((ext_vector_type(2)));
typedef __bf16 bf16x2v __attribute__((ext_vector_type(2)));
typedef short v4i16_t __attribute__((ext_vector_type(4)));
__device__ __forceinline__ unsigned pkbf(float lo, float hi) { f32x2v v = {lo, hi}; bf16x2v b = __builtin_convertvector(v, bf16x2v); return __builtin_bit_cast(unsigned, b); }
__device__ __forceinline__ float bflo(unsigned u) { return __uint_as_float(u << 16); }
__device__ __forceinline__ float bfhi(unsigned u) { return __uint_as_float(u & 0xffff0000u); }
template <int N> __device__ __forceinline__ float dpp_row_ror(float v) { return __builtin_bit_cast(float, __builtin_amdgcn_update_dpp(0, __builtin_bit_cast(int, v), 0x120 + N, 0xf, 0xf, true)); }
__device__ __forceinline__ float wave_sum(float v) {
    v += dpp_row_ror<8>(v); v += dpp_row_ror<4>(v); v += dpp_row_ror<2>(v); v += dpp_row_ror<1>(v);
    const int b = __builtin_bit_cast(int, v);
    return (__builtin_bit_cast(float, __builtin_amdgcn_readlane(b, 0)) + __builtin_bit_cast(float, __builtin_amdgcn_readlane(b, 16))) + (__builtin_bit_cast(float, __builtin_amdgcn_readlane(b, 32)) + __builtin_bit_cast(float, __builtin_amdgcn_readlane(b, 48)));
}
__device__ __forceinline__ int crow(int r, int hi) { return (r & 3) + 8 * (r >> 2) + 4 * hi; }

struct TrDesc { const float* W; const float* gsc; unsigned char* WT; int ldw, Kp, drow0, k0, n0src, is8; float scale; };
__device__ __forceinline__ int hmap_row0(int L) { const int lc = L & 255; return (L & ~255) + 128 * ((lc >> 5) & 1) + 32 * (lc >> 6); }

constexpr int IT_MG = NEXP * 16 * 112, IT_MU = IT_MG, IT_MD = NEXP * 56 * 32, IT_WIN = 16 * 64, IT_WOUT = 16 * 32, IT_FG = 16 * 86, IT_FU = IT_FG, IT_FD = 43 * 32, IT_KV = 16 * 192, IT_Q = 16 * 96, IT_WO = 16 * 32;
constexpr int IT_TOTAL = IT_MG + IT_MU + IT_MD + IT_WIN + IT_WOUT + IT_FG + IT_FU + IT_FD + IT_KV + IT_Q + IT_WO;
typedef const __attribute__((address_space(4))) unsigned char* kargp0_t;
#define P0IN(i) (*(const float* const __attribute__((address_space(4)))*)(kp + 8 * (i)))
__device__ __forceinline__ void tr_desc(int it, kargp0_t kp, unsigned char* ws, TrDesc& d) {
    int r = it; d.gsc = nullptr; d.is8 = 2; d.scale = SW_I8; d.Kp = 1024;
    if (r < IT_MG) { const int e = r / 1792, rr = r % 1792, j = (rr % 112) * 32; d.W = P0IN(23) + (size_t)e * D * DFFE; d.ldw = DFFE; d.WT = ws + WS_WM13 + (size_t)e * 7168 * 1024; d.drow0 = 256 * (j >> 7) + (j & 127); d.k0 = (rr / 112) * 64; d.n0src = j; return; } r -= IT_MG;
    if (r < IT_MU) { const int e = r / 1792, rr = r % 1792, j = (rr % 112) * 32; d.W = P0IN(24) + (size_t)e * D * DFFE; d.ldw = DFFE; d.WT = ws + WS_WM13 + (size_t)e * 7168 * 1024; d.drow0 = 256 * (j >> 7) + 128 + (j & 127); d.k0 = (rr / 112) * 64; d.n0src = j; return; } r -= IT_MU;
    if (r < IT_MD) { const int e = r / 1792, rr = r % 1792, j = (rr % 32) * 32; d.W = P0IN(25) + (size_t)e * DFFE * D; d.ldw = D; d.WT = ws + WS_WM2 + (size_t)e * 1024 * DFFE; d.Kp = DFFE; d.is8 = 1; d.scale = W8_SCALE; d.drow0 = j; d.k0 = (rr / 32) * 64; d.n0src = j; return; } r -= IT_MD;
    if (r < IT_KV) { const int c = (r % 192) * 32, kvsel = c / 3072, cg = c % 3072, g = cg >> 10, hc = cg & 1023, L = kvsel * 1024 + hc; d.W = P0IN(12); d.ldw = 6144; d.gsc = P0IN(11); d.WT = ws + WS_WQKV + (size_t)g * 3072 * 1024; d.drow0 = hmap_row0(L); d.k0 = (r / 192) * 64; d.n0src = c; return; } r -= IT_KV;
    if (r < IT_Q) { const int c = (r % 96) * 32, g = c >> 10, hc = c & 1023, L = 2048 + hc; d.W = P0IN(15); d.ldw = 3072; d.gsc = P0IN(14); d.WT = ws + WS_WQKV + (size_t)g * 3072 * 1024; d.drow0 = hmap_row0(L); d.k0 = (r / 96) * 64; d.n0src = c; return; } r -= IT_Q;
    if (r < IT_WIN) { const int c = (r % 64) * 32, sel = c >> 10, j = c & 1023; d.W = P0IN(3); d.ldw = 2048; d.WT = ws + WS_WIN; if (!I8_P1) { d.is8 = 0; d.scale = 1.f; } d.drow0 = 256 * (j >> 7) + 128 * sel + (j & 127); d.k0 = (r / 64) * 64; d.n0src = c; return; } r -= IT_WIN;
    if (r < IT_WOUT) { const int j = (r % 32) * 32; d.W = P0IN(9); d.ldw = 1024; d.WT = ws + WS_WOUT; if (!I8_P3) { d.is8 = 0; d.scale = 1.f; } d.drow0 = j; d.k0 = (r / 32) * 64; d.n0src = j; return; } r -= IT_WOUT;
    if (r < IT_FG) { const int j = (r % 86) * 32; d.W = P0IN(19); d.ldw = DFF; d.gsc = P0IN(18); d.WT = ws + WS_WF13; if (!I8_P4) { d.is8 = 0; d.scale = 1.f; } d.drow0 = 256 * (j >> 7) + (j & 127); d.k0 = (r / 86) * 64; d.n0src = j; return; } r -= IT_FG;
    if (r < IT_FU) { const int j = (r % 86) * 32; d.W = P0IN(20); d.ldw = DFF; d.gsc = P0IN(18); d.WT = ws + WS_WF13; if (!I8_P4) { d.is8 = 0; d.scale = 1.f; } d.drow0 = 256 * (j >> 7) + 128 + (j & 127); d.k0 = (r / 86) * 64; d.n0src = j; return; } r -= IT_FU;
    if (r < IT_FD) { const int j = (r % 32) * 32; d.W = P0IN(21); d.ldw = 1024; d.WT = ws + WS_WFD; d.Kp = DFFP; d.is8 = 0; d.scale = 1.f; d.drow0 = j; d.k0 = (r / 32) * 64; d.n0src = j; return; } r -= IT_FD;
    { const int j = (r % 32) * 32; d.W = P0IN(17); d.ldw = 1024; d.WT = ws + WS_WO; d.drow0 = j; d.k0 = (r / 32) * 64; d.n0src = j; d.is8 = 1; d.scale = W8_SCALE; }
}
__device__ __forceinline__ void tr_load(const TrDesc& d, float (&v)[32], f32x4 (&gv)[2], int lane) {
#pragma unroll
    for (int i = 0; i < 32; ++i) v[i] = __builtin_nontemporal_load(d.W + (size_t)(d.k0 + 2 * i + (lane >> 5)) * d.ldw + d.n0src + (lane & 31));
    gv[0] = (f32x4){1.f, 1.f, 1.f, 1.f}; gv[1] = gv[0];
    if (d.gsc) { gv[0] = *(const f32x4*)(d.gsc + d.k0 + 8 * (lane & 7)); gv[1] = *(const f32x4*)(d.gsc + d.k0 + 8 * (lane & 7) + 4); }
}
__device__ __forceinline__ void tr_store(const TrDesc& d, const float (&v)[32], const f32x4 (&gv)[2], LAS float* scr, int lane) {
#pragma unroll
    for (int i = 0; i < 32; ++i) scr[(2 * i + (lane >> 5)) * 33 + (lane & 31)] = v[i];
    LDS_WAIT(); asm volatile("" ::: "memory");
    const int c = lane & 7; const float sc = d.scale;
#pragma unroll
    for (int j = 0; j < 4; ++j) { const int n = (lane >> 3) + 8 * j; const LAS float* s = scr + (8 * c) * 33 + n;
        const float x0 = s[0 * 33] * gv[0].x * sc, x1 = s[1 * 33] * gv[0].y * sc, x2 = s[2 * 33] * gv[0].z * sc, x3 = s[3 * 33] * gv[0].w * sc, x4 = s[4 * 33] * gv[1].x * sc, x5 = s[5 * 33] * gv[1].y * sc, x6 = s[6 * 33] * gv[1].z * sc, x7 = s[7 * 33] * gv[1].w * sc;
        if (d.is8 == 2) { pg8::u32x2 o; o.x = pg8::pk_i8x4(x0, x1, x2, x3); o.y = pg8::pk_i8x4(x4, x5, x6, x7); *(GAS pg8::u32x2*)(d.WT + (size_t)(d.drow0 + n) * d.Kp + d.k0 + 8 * c) = o; }
        else if (d.is8) { pg8::u32x2 o; o.x = pg8::pk_fp8x4(x0, x1, x2, x3); o.y = pg8::pk_fp8x4(x4, x5, x6, x7); *(GAS pg8::u32x2*)(d.WT + (size_t)(d.drow0 + n) * d.Kp + d.k0 + 8 * c) = o; }
        else { v4u o; o.x = pkbf(x0, x1); o.y = pkbf(x2, x3); o.z = pkbf(x4, x5); o.w = pkbf(x6, x7); *(GAS v4u*)((bf16*)d.WT + (size_t)(d.drow0 + n) * d.Kp + d.k0 + 8 * c) = o; } }
    LDS_WAIT(); asm volatile("" ::: "memory");
}

__device__ __forceinline__ void p0_prologue(kargp0_t kp, unsigned char* ws, LAS unsigned char* lds, int G, int vcu, int tid, int lane, int wave) {
    LAS float* scr = (LAS float*)(lds + RING_OFF + wave * 16384);
    const int gw = vcu * NWAVES + wave, NGW = G * NWAVES;
    bf16* WF13 = (bf16*)(ws + WS_WF13); bf16* WFD = (bf16*)(ws + WS_WFD);
    {
        TrDesc da, db, dc; float va[32], vb[32], vc[32]; f32x4 ga[2], gb[2], gc[2];
        int it = gw;
        if (it < IT_TOTAL) { tr_desc(it, kp, ws, da); tr_load(da, va, ga, lane); }
        if (it + NGW < IT_TOTAL) { tr_desc(it + NGW, kp, ws, db); tr_load(db, vb, gb, lane); }
        while (it < IT_TOTAL) {
            if (it + 2 * NGW < IT_TOTAL) { tr_desc(it + 2 * NGW, kp, ws, dc); tr_load(dc, vc, gc, lane); }
            tr_store(da, va, ga, scr, lane);
            if (it + NGW >= IT_TOTAL) break;
            if (it + 3 * NGW < IT_TOTAL) { tr_desc(it + 3 * NGW, kp, ws, da); tr_load(da, va, ga, lane); }
            tr_store(db, vb, gb, scr, lane);
            if (it + 2 * NGW >= IT_TOTAL) break;
            if (it + 4 * NGW < IT_TOTAL) { tr_desc(it + 4 * NGW, kp, ws, db); tr_load(db, vb, gb, lane); }
            tr_store(dc, vc, gc, scr, lane);
            it += 3 * NGW;
        }
    }
    const int gt = vcu * (NWAVES * 64) + tid, NGT = G * NWAVES * 64; const v4u z = {0u, 0u, 0u, 0u};
    { constexpr int RB = I8_P4 ? 1024 : 2048, CH = RB / 16;
      for (int i = gt; i < 2 * 64 * CH; i += NGT) { const int sel = i / (64 * CH), rr = (i / CH) & 63, ch = i % CH; *(GAS v4u*)((unsigned char*)WF13 + (size_t)(256 * 21 + 128 * sel + 64 + rr) * RB + ch * 16) = z; } }
    for (int i = gt; i < 1024 * 8; i += NGT) { const int row = i >> 3, ch = i & 7; *(GAS v4u*)(WFD + (size_t)row * DFFP + DFF + ch * 8) = z; }
    const float* x = P0IN(0); const float* gn = P0IN(2); bf16* H0 = (bf16*)(ws + WS_H0);
    f32x4 gv[4];
#pragma unroll
    for (int j = 0; j < 4; ++j) gv[j] = *(const f32x4*)(gn + 4 * lane + 256 * j);
    for (int m0 = gw * 4; m0 < T; m0 += NGW * 4) {
        f32x4 v[4][4];
#pragma unroll
        for (int q = 0; q < 4; ++q) { const GAS f32x4* xr = (const GAS f32x4*)(x + (size_t)(m0 + q) * D) + lane;
#pragma unroll
            for (int j = 0; j < 4; ++j) v[q][j] = __builtin_nontemporal_load(xr + 64 * j); }
#pragma unroll
        for (int q = 0; q < 4; ++q) { float s = 0.f;
#pragma unroll
            for (int j = 0; j < 4; ++j) s += (v[q][j].x * v[q][j].x + v[q][j].y * v[q][j].y) + (v[q][j].z * v[q][j].z + v[q][j].w * v[q][j].w);
            const float rstd = 1.f / sqrtf(wave_sum(s) * (1.f / D) + EPS);
            if (I8_P1) { GAS unsigned* o4 = (GAS unsigned*)((unsigned char*)H0 + (size_t)(m0 + q) * D) + lane;
#pragma unroll
                for (int j = 0; j < 4; ++j) { const f32x4 y = v[q][j] * (rstd * SA_N) * gv[j]; o4[64 * j] = pg8::pk_i8x4(y.x, y.y, y.z, y.w); } }
            else { GAS unsigned long long* o8 = (GAS unsigned long long*)(H0 + (size_t)(m0 + q) * D) + lane;
#pragma unroll
                for (int j = 0; j < 4; ++j) { const f32x4 y = v[q][j] * rstd * gv[j]; o8[64 * j] = (unsigned long long)pkbf(y.x, y.y) | ((unsigned long long)pkbf(y.z, y.w) << 32); } } }
    }
}

__device__ __forceinline__ void conv_phase(const bf16* glu, const float* dw_w, const float* dw_b, const float* ln_g, const float* ln_b, bf16* vout, LAS unsigned char* lds, int G, int vcu, int tid, int lane, int wave) {
    LAS float* ybuf = (LAS float*)(lds + RING_OFF);
    const int c0 = 2 * tid;
    float w0[31], w1[31];
#pragma unroll
    for (int k = 0; k < 31; ++k) { const f32x2v w = *(const f32x2v*)(dw_w + k * 1024 + c0); w0[k] = w.x; w1[k] = w.y; }
    const f32x2v dbv = *(const f32x2v*)(dw_b + c0);
    LAS float* lnp = (LAS float*)(lds + XTRA_OFF);
    for (int i = tid; i < 1024; i += NWAVES * 64) { lnp[i] = ln_g[i]; lnp[1024 + i] = ln_b[i]; }
    __syncthreads();
    for (int item = vcu; item < T / 128; item += G) {
        const int b = item >> 5, s0 = (item & 31) * 128;
        const bf16* ub = glu + (size_t)b * SEQ * D + c0;
        float r0[32], r1[32];
        r0[0] = 0.f; r1[0] = 0.f; r0[1] = 0.f; r1[1] = 0.f;
#pragma unroll
        for (int i = 0; i < 30; ++i) { const int s = s0 - 30 + i; unsigned v = 0u; if (s >= 0) v = *(const unsigned*)(ub + (size_t)s * D); r0[i + 2] = bflo(v); r1[i + 2] = bfhi(v); }
        for (int base = 0; base < 128; base += 32) {
            unsigned nu[32];
#pragma unroll
            for (int j = 0; j < 32; ++j) nu[j] = *(const unsigned*)(ub + (size_t)(s0 + base + j) * D);
#pragma unroll
            for (int j = 0; j < 32; ++j) {
                r0[j] = bflo(nu[j]); r1[j] = bfhi(nu[j]);
                float y0 = dbv.x, y1 = dbv.y;
#pragma unroll
                for (int k = 0; k < 31; ++k) { const int idx = (j + 2 + k) & 31; y0 += r0[idx] * w0[k]; y1 += r1[idx] * w1[k]; }
                *(LAS f32x2v*)(ybuf + j * 1024 + c0) = (f32x2v){y0, y1};
            }
            __syncthreads();
            const int ntok = 32;
            for (int j = wave; j < ntok; j += NWAVES) {
                f32x4 y[4]; float s = 0.f;
#pragma unroll
                for (int i = 0; i < 4; ++i) { y[i] = *(const LAS f32x4*)(ybuf + j * 1024 + 4 * lane + 256 * i); s += (y[i].x + y[i].y) + (y[i].z + y[i].w); }
                const float mean = wave_sum(s) * (1.f / D); float q = 0.f;
#pragma unroll
                for (int i = 0; i < 4; ++i) { y[i] = y[i] - mean; q += (y[i].x * y[i].x + y[i].y * y[i].y) + (y[i].z * y[i].z + y[i].w * y[i].w); }
                const float rstd = 1.f / sqrtf(wave_sum(q) * (1.f / D) + EPS);
                GAS unsigned* o4 = (GAS unsigned*)((unsigned char*)vout + ((size_t)b * SEQ + s0 + base + j) * D) + lane;
                GAS unsigned long long* o8 = (GAS unsigned long long*)(vout + ((size_t)b * SEQ + s0 + base + j) * D) + lane;
#pragma unroll
                for (int i = 0; i < 4; ++i) { const f32x4 lgv = *(const LAS f32x4*)(lnp + 4 * lane + 256 * i), lbv = *(const LAS f32x4*)(lnp + 1024 + 4 * lane + 256 * i); f32x4 z = y[i] * rstd * lgv + lbv;
                    z.x *= pg8::fast_sigmoid(z.x); z.y *= pg8::fast_sigmoid(z.y); z.z *= pg8::fast_sigmoid(z.z); z.w *= pg8::fast_sigmoid(z.w);
                    if (I8_P3) o4[64 * i] = pg8::pk_i8x4(z.x * SA_N, z.y * SA_N, z.z * SA_N, z.w * SA_N);
                    else o8[64 * i] = (unsigned long long)pkbf(z.x, z.y) | ((unsigned long long)pkbf(z.z, z.w) << 32); }
            }
            __syncthreads();
        }
    }
}

__device__ __forceinline__ void attn_phase(LAS unsigned char* lds, int grp, const bf16* Kb, const bf16* Vb, const bf16* Qb, bf16* Ob, unsigned char* O8, float* lse, const float* rel_bias, unsigned* qheads, int G, int vcu, int tid, int lane, int wave) {
    const int dsh = 2 * grp, dil = 1 << dsh;
    LAS unsigned char* Kl = lds + RING_OFF;
    LAS unsigned char* Vl = lds + RING_OFF + 55296;
    LAS float* btab_all = (LAS float*)(lds + XTRA_OFF);
    for (int i = tid; i < 16 * 192; i += NWAVES * 64) { const int hh = i / 192, j = i % 192, dist = 159 - j;
        btab_all[i] = (dist >= 0 && dist <= 128) ? rel_bias[(int)T5_BUCKET[grp][dist] * 48 + grp * 16 + hh] * LOG2E - SOFTMAX_OFS : -1.0e30f; }
    const int lq = lane & 31, hi = lane >> 5;
    v4u kvp[6], vvp[6];
#define ATT_DECODE(IDX, b_, h_, res_, n0_) const int bh_##b_ = (IDX) >> 4, w16_##b_ = (IDX) & 15, b_ = bh_##b_ >> 4, h_ = bh_##b_ & 15, res_ = w16_##b_ & (dil - 1), n0_ = (w16_##b_ >> dsh) * 256
#define ATT_LOAD(IDX) do { ATT_DECODE(IDX, pb, ph, pres, pn0); \
        _Pragma("unroll") for (int i = 0; i < 6; ++i) { const int cidx = tid + 512 * i, j = cidx >> 3, c16 = cidx & 7, sub = pn0 - 128 + j; \
            kvp[i] = (v4u){0u, 0u, 0u, 0u}; vvp[i] = kvp[i]; \
            if (sub >= 0) { const size_t off = ((size_t)pb * SEQ + ((size_t)sub << dsh) + pres) * D + ph * 64 + c16 * 8; kvp[i] = *(const GAS v4u*)(Kb + off); vvp[i] = *(const GAS v4u*)(Vb + off); } } } while (0)
    pg8::bf16x8 qnext[4];
#define ATT_LOADQ(IDX) do { ATT_DECODE(IDX, qb_, qh_, qres_, qn0_); const size_t qrow_ = (size_t)qb_ * SEQ + ((size_t)(qn0_ + 32 * wave + lq) << dsh) + qres_; \
        _Pragma("unroll") for (int c = 0; c < 4; ++c) qnext[c] = *(const pg8::bf16x8*)(Qb + qrow_ * D + qh_ * 64 + 16 * c + 8 * hi); } while (0)
    const bool dyn = (G == 256);
    const int xq = vcu >> 5;
    LAS int* qL = (LAS int*)(lds + XTRA_OFF + 12288 + 64);
    int idx = vcu;
    if (idx < 2048) { ATT_LOAD(idx); ATT_LOADQ(idx); }
    __syncthreads();
    while (idx < 2048) {
        int claimed = 0;
        if (dyn && tid == 0) claimed = (int)__hip_atomic_fetch_add(qheads + 16 * xq, 1u, __ATOMIC_RELAXED, __HIP_MEMORY_SCOPE_AGENT);
        ATT_DECODE(idx, b, h, res, n0);
        const int ql = 32 * wave + lq;
        const size_t qrow = (size_t)b * SEQ + ((size_t)(n0 + ql) << dsh) + res;
        pg8::bf16x8 qr[4];
#pragma unroll
        for (int c = 0; c < 4; ++c) qr[c] = qnext[c];
        __syncthreads();
#pragma unroll
        for (int i = 0; i < 6; ++i) { const int cidx = tid + 512 * i, j = cidx >> 3, c16 = cidx & 7;
            *(LAS v4u*)(Kl + j * 144 + c16 * 16) = kvp[i]; *(LAS v4u*)(Vl + (c16 >> 2) * 24576 + j * 64 + (c16 & 3) * 16) = vvp[i]; }
        if (dyn && tid == 0) qL[0] = 32 + claimed;
        __syncthreads();
        int nidx = idx + G;
        if (dyn) { const int jn = qL[0]; nidx = jn < 256 ? ((jn >> 5) << 8) + (xq << 5) + (jn & 31) : 2048; }
        if (nidx < 2048) ATT_LOAD(nidx);
        float sv[5][16]; float m = -3.0e38f;
        const int kofs = n0 - 128 + 32 * wave;
        const LAS float* brow = btab_all + h * 192 + (31 - lq + 4 * hi);
#pragma unroll
        for (int kt = 0; kt < 5; ++kt) {
            f32x16 S = (f32x16){0.f, 0.f, 0.f, 0.f, 0.f, 0.f, 0.f, 0.f, 0.f, 0.f, 0.f, 0.f, 0.f, 0.f, 0.f, 0.f};
#pragma unroll
            for (int c = 0; c < 4; ++c) { const pg8::bf16x8 a = *(const LAS pg8::bf16x8*)(Kl + (32 * wave + 32 * kt + lq) * 144 + (16 * c + 8 * hi) * 2);
                S = __builtin_amdgcn_mfma_f32_32x32x16_bf16(a, qr[c], S, 0, 0, 0); }
#pragma unroll
            for (int r = 0; r < 16; ++r) { const float s = S[r] + brow[32 * kt + (r & 3) + 8 * (r >> 2)]; sv[kt][r] = s; }
            __builtin_amdgcn_sched_barrier(0);
        }
        if (kofs < 0) {
#pragma unroll
            for (int kt = 0; kt < 5; ++kt)
#pragma unroll
                for (int r = 0; r < 16; ++r) { const int kk = 32 * kt + crow(r, hi); if (kofs + kk < 0) sv[kt][r] = -1.0e30f; }
        }
        m = SOFTMAX_OFS;
        float l = 0.f; unsigned pw[5][8];
#pragma unroll
        for (int kt = 0; kt < 5; ++kt) {
#pragma unroll
            for (int r = 0; r < 16; r += 2) { const float p0 = __builtin_amdgcn_exp2f(sv[kt][r]), p1 = __builtin_amdgcn_exp2f(sv[kt][r + 1]); l += p0 + p1; pw[kt][r >> 1] = pkbf(p0, p1); }
            __builtin_amdgcn_sched_barrier(0);
        }
        l += __shfl_xor(l, 32);
        f32x16 O0 = (f32x16){0.f, 0.f, 0.f, 0.f, 0.f, 0.f, 0.f, 0.f, 0.f, 0.f, 0.f, 0.f, 0.f, 0.f, 0.f, 0.f}, O1 = O0;
        const int vlane = ((lane & 15) >> 2) * 64 + ((lane >> 4) & 1) * 32 + (lane & 3) * 8;
#pragma unroll
        for (int kt = 0; kt < 5; ++kt)
#pragma unroll
            for (int s2 = 0; s2 < 2; ++s2) {
                v4u pq; pq.x = pw[kt][4 * s2 + 0]; pq.y = pw[kt][4 * s2 + 1]; pq.z = pw[kt][4 * s2 + 2]; pq.w = pw[kt][4 * s2 + 3];
                const pg8::bf16x8 pf = __builtin_bit_cast(pg8::bf16x8, pq);
                const int vrow = 32 * wave + 32 * kt + 16 * s2 + 4 * hi;
                LAS unsigned char* vp = Vl + vrow * 64 + vlane;
                const v4i16_t a0 = __builtin_amdgcn_ds_read_tr16_b64_v4i16((LAS v4i16_t*)(vp)), a1 = __builtin_amdgcn_ds_read_tr16_b64_v4i16((LAS v4i16_t*)(vp + 512));
                const v4i16_t b0 = __builtin_amdgcn_ds_read_tr16_b64_v4i16((LAS v4i16_t*)(vp + 24576)), b1 = __builtin_amdgcn_ds_read_tr16_b64_v4i16((LAS v4i16_t*)(vp + 24576 + 512));
                const pg8::bf16x8 vf0 = (pg8::bf16x8){a0[0], a0[1], a0[2], a0[3], a1[0], a1[1], a1[2], a1[3]};
                const pg8::bf16x8 vf1 = (pg8::bf16x8){b0[0], b0[1], b0[2], b0[3], b1[0], b1[1], b1[2], b1[3]};
                O0 = __builtin_amdgcn_mfma_f32_32x32x16_bf16(vf0, pf, O0, 0, 0, 0);
                O1 = __builtin_amdgcn_mfma_f32_32x32x16_bf16(vf1, pf, O1, 0, 0, 0);
                __builtin_amdgcn_sched_barrier(0);
            }
        if (nidx < 2048) ATT_LOADQ(nidx);
        const float inv_l = 1.f / l, lse2 = m + __builtin_amdgcn_logf(l);
        const size_t orow = qrow;
        v4u oldv[4];
        if (grp != 0) {
#pragma unroll
            for (int i = 0; i < 4; ++i) { const int ch = lane + 64 * i, qq = ch >> 3, c8 = ch & 7; oldv[i] = *(const GAS v4u*)(Ob + ((size_t)b * SEQ + ((size_t)(n0 + 32 * wave + qq) << dsh) + res) * D + h * 64 + c8 * 8); } }
        float co = 0.f, cg = inv_l, lnew = lse2;
        if (grp != 0) { const float lo_ = lse[orow * 16 + h]; const float M = fmaxf(lo_, lse2); const float wo = __builtin_amdgcn_exp2f(lo_ - M), wg = __builtin_amdgcn_exp2f(lse2 - M), den = wo + wg;
            co = wo / den; cg = wg / den * inv_l; lnew = M + __builtin_amdgcn_logf(den); }
        __syncthreads();
        LAS unsigned char* stg = Kl + wave * 4608;
        LAS float* cot = (LAS float*)(Kl + 8 * 4608) + wave * 32;
#pragma unroll
        for (int rg = 0; rg < 4; ++rg) {
            pg8::u32x2 wa, wb; wa.x = pkbf(O0[4 * rg] * cg, O0[4 * rg + 1] * cg); wa.y = pkbf(O0[4 * rg + 2] * cg, O0[4 * rg + 3] * cg);
            wb.x = pkbf(O1[4 * rg] * cg, O1[4 * rg + 1] * cg); wb.y = pkbf(O1[4 * rg + 2] * cg, O1[4 * rg + 3] * cg);
            *(LAS pg8::u32x2*)(stg + lq * 144 + (8 * rg + 4 * hi) * 2) = wa; *(LAS pg8::u32x2*)(stg + lq * 144 + (32 + 8 * rg + 4 * hi) * 2) = wb; }
        if (hi == 0) cot[lq] = co;
        if (hi == 0) lse[orow * 16 + h] = lnew;
#pragma unroll
        for (int i = 0; i < 4; ++i) { const int ch = lane + 64 * i, qq = ch >> 3, c8 = ch & 7;
            const v4u sv4 = *(const LAS v4u*)(stg + qq * 144 + c8 * 16);
            bf16* op = Ob + ((size_t)b * SEQ + ((size_t)(n0 + 32 * wave + qq) << dsh) + res) * D + h * 64 + c8 * 8;
            v4u ov = sv4;
            if (grp != 0) { const float cq = cot[qq]; const v4u old = oldv[i];
                ov.x = pkbf(bflo(sv4.x) + cq * bflo(old.x), bfhi(sv4.x) + cq * bfhi(old.x)); ov.y = pkbf(bflo(sv4.y) + cq * bflo(old.y), bfhi(sv4.y) + cq * bfhi(old.y));
                ov.z = pkbf(bflo(sv4.z) + cq * bflo(old.z), bfhi(sv4.z) + cq * bfhi(old.z)); ov.w = pkbf(bflo(sv4.w) + cq * bflo(old.w), bfhi(sv4.w) + cq * bfhi(old.w)); }
            if (grp == 2) { unsigned char* o8 = O8 + ((size_t)b * SEQ + ((size_t)(n0 + 32 * wave + qq) << dsh) + res) * D + h * 64 + c8 * 8;
                pg8::u32x2 w8; w8.x = pg8::pk_fp8x4(bflo(ov.x) * O8_SCALE, bfhi(ov.x) * O8_SCALE, bflo(ov.y) * O8_SCALE, bfhi(ov.y) * O8_SCALE); w8.y = pg8::pk_fp8x4(bflo(ov.z) * O8_SCALE, bfhi(ov.z) * O8_SCALE, bflo(ov.w) * O8_SCALE, bfhi(ov.w) * O8_SCALE);
                *(GAS pg8::u32x2*)o8 = w8; }
            else *(GAS v4u*)op = ov; }
        idx = nidx;
    }
    __syncthreads();
#undef ATT_DECODE
#undef ATT_LOAD
#undef ATT_LOADQ
}

__device__ __forceinline__ void route_phase(const float* x3, const float* gnorm, const float* wr, unsigned char* ws, LAS unsigned char* lds, int G, int vcu, int tid, int lane, int wave) {
    LAS float* WrT = (LAS float*)(lds + RING_OFF);
    LAS unsigned* wcL = (LAS unsigned*)(lds + RING_OFF + 32768);
    for (int i = tid; i < 8192; i += NWAVES * 64) { const int e = i >> 10, k = i & 1023; WrT[i] = wr[k * 8 + e] * gnorm[k]; }
    __syncthreads();
    unsigned* route = (unsigned*)(ws + WS_ROUTE); float* gate1 = (float*)(ws + WS_GATE1); float* gate2 = (float*)(ws + WS_GATE2);
    unsigned* wavecnt = (unsigned*)(ws + WS_WAVECNT); int* blockcnt = (int*)(ws + WS_BLOCKCNT); unsigned char* H3 = ws + WS_H3;
    const int gw = vcu * NWAVES + wave, NGW = G * NWAVES, tpw = (T + NGW - 1) / NGW;
    const int t0 = gw * tpw, t1 = (t0 + tpw) < T ? (t0 + tpw) : T;
    f32x4 gv[4];
#pragma unroll
    for (int j = 0; j < 4; ++j) gv[j] = *(const f32x4*)(gnorm + 4 * lane + 256 * j);
    unsigned long long cnt0 = 0ull, cnt1 = 0ull;
    f32x4 vn[4];
    if (t0 < t1) { const GAS f32x4* xr = (const GAS f32x4*)(x3 + (size_t)t0 * D) + lane;
#pragma unroll
        for (int j = 0; j < 4; ++j) vn[j] = xr[64 * j]; }
    for (int t = t0; t < t1; ++t) {
        f32x4 v[4]; float ss = 0.f;
#pragma unroll
        for (int j = 0; j < 4; ++j) { v[j] = vn[j]; ss += (v[j].x * v[j].x + v[j].y * v[j].y) + (v[j].z * v[j].z + v[j].w * v[j].w); }
        if (t + 1 < t1) { const GAS f32x4* xr = (const GAS f32x4*)(x3 + (size_t)(t + 1) * D) + lane;
#pragma unroll
            for (int j = 0; j < 4; ++j) vn[j] = xr[64 * j]; }
        float dt[8];
#pragma unroll
        for (int e = 0; e < 8; ++e) { float a = 0.f;
#pragma unroll
            for (int j = 0; j < 4; ++j) { const f32x4 w = *(const LAS f32x4*)(WrT + e * 1024 + 4 * lane + 256 * j); a += (v[j].x * w.x + v[j].y * w.y) + (v[j].z * w.z + v[j].w * w.w); }
            dt[e] = a; }
        ss = wave_sum(ss);
#pragma unroll
        for (int e = 0; e < 8; ++e) dt[e] = wave_sum(dt[e]);
        const float rstd = 1.f / sqrtf(ss * (1.f / D) + EPS);
        GAS unsigned* o4 = (GAS unsigned*)(H3 + (size_t)t * D) + lane;
#pragma unroll
        for (int j = 0; j < 4; ++j) { const f32x4 y = v[j] * (rstd * SA_N) * gv[j]; o4[64 * j] = pg8::pk_i8x4(y.x, y.y, y.z, y.w); }
        int e1 = 0; float v1 = dt[0] * rstd;
#pragma unroll
        for (int e = 1; e < 8; ++e) { const float x = dt[e] * rstd; if (x > v1) { v1 = x; e1 = e; } }
        int e2 = -1; float v2 = -3.0e38f;
#pragma unroll
        for (int e = 0; e < 8; ++e) { const float x = dt[e] * rstd; if (e != e1 && x > v2) { v2 = x; e2 = e; } }
        const float g2 = 1.f / (1.f + __expf(v1 - v2)), g1 = 1.f - g2;
        cnt0 += 1ull << (8 * e1); cnt1 += 1ull << (8 * e2);
        if (lane == 0) { route[t] = (unsigned)e1 | ((unsigned)e2 << 8); gate1[t] = g1; gate2[t] = g2; }
    }
    if (lane == 0) { v4u c; c.x = (unsigned)cnt0; c.y = (unsigned)(cnt0 >> 32); c.z = (unsigned)cnt1; c.w = (unsigned)(cnt1 >> 32);
        *(GAS v4u*)(wavecnt + (size_t)gw * 4) = c; wcL[wave * 4 + 0] = c.x; wcL[wave * 4 + 1] = c.y; wcL[wave * 4 + 2] = c.z; wcL[wave * 4 + 3] = c.w; }
    __syncthreads();
    if (tid < 16) { const int slot = tid >> 3, e = tid & 7; int s = 0;
#pragma unroll
        for (int w = 0; w < NWAVES; ++w) s += (int)((wcL[w * 4 + slot * 2 + (e >> 2)] >> (8 * (e & 3))) & 255u);
        blockcnt[vcu * 16 + tid] = s; }
    __syncthreads();
}

__device__ __forceinline__ void pos_phase(unsigned char* ws, LAS unsigned char* lds, int G, int vcu, int tid, int lane, int wave) {
    LAS int* cntL = (LAS int*)(lds + RING_OFF);
    LAS int* pAll = (LAS int*)(lds + RING_OFF + 65536);
    LAS int* pBef = pAll + 512;
    LAS int* totL = pBef + 512;
    const int* blockcnt = (const int*)(ws + WS_BLOCKCNT); const unsigned* wavecnt = (const unsigned*)(ws + WS_WAVECNT);
    const unsigned* route = (const unsigned*)(ws + WS_ROUTE); const float* gate1 = (const float*)(ws + WS_GATE1); const float* gate2 = (const float*)(ws + WS_GATE2);
    int* gofs = (int*)(ws + WS_GOFS);
    for (int i = tid; i < G * 16; i += NWAVES * 64) cntL[i] = blockcnt[i];
    __syncthreads();
    { const int c = tid & 15, part = tid >> 4, bpp = (G + 31) / 32; int sa = 0, sb = 0;
      for (int bb = part * bpp; bb < (part + 1) * bpp && bb < G; ++bb) { const int v = cntL[bb * 16 + c]; sa += v; if (bb < vcu) sb += v; }
      pAll[part * 16 + c] = sa; pBef[part * 16 + c] = sb; }
    __syncthreads();
    if (tid < 16) { int sa = 0, sb = 0;
        for (int p = 0; p < 32; ++p) { sa += pAll[p * 16 + tid]; sb += pBef[p * 16 + tid]; }
        totL[tid] = sa; totL[16 + tid] = sb; }
    __syncthreads();
    if (tid == 0) { int off = 0;
        for (int e = 0; e < 8; ++e) { totL[32 + e] = off; totL[32 + 8 + e] = off + totL[e]; if (vcu == 0) { gofs[e] = off; gofs[8 + e] = off + totL[e]; gofs[32 + e] = off >> 8; } off += ((totL[e] + totL[8 + e] + 255) >> 8) << 8; }
        if (vcu == 0) gofs[16] = off >> 8; }
    __syncthreads();
    const int gw = vcu * NWAVES + wave, NGW = G * NWAVES, tpw = (T + NGW - 1) / NGW;
    const int t0 = gw * tpw, t1 = (t0 + tpw) < T ? (t0 + tpw) : T;
    int mypos = 0;
    if (lane < 16) { mypos = totL[32 + lane] + totL[16 + lane];
        for (int w = 0; w < wave; ++w) mypos += (int)((wavecnt[(size_t)(vcu * NWAVES + w) * 4 + (lane >> 3) * 2 + ((lane & 7) >> 2)] >> (8 * (lane & 3))) & 255u); }
    int* pos01 = (int*)(ws + WS_POS);
    int* rowtok0 = (int*)(ws + WS_ROWTOK); int* rowtok1 = rowtok0; float* rowgate0 = (float*)(ws + WS_ROWGATE); float* rowgate1 = rowgate0;
    for (int t = t0; t < t1; ++t) {
        const unsigned rt = route[t]; const int e1 = (int)(rt & 255u), e2 = (int)((rt >> 8) & 255u);
        const int p1 = __shfl(mypos, e1), p2 = __shfl(mypos, 8 + e2);
        if (lane == e1 || lane == 8 + e2) mypos += 1;
        if (lane == 0) { rowtok0[p1] = t; rowgate0[p1] = gate1[t]; rowtok1[p2] = t; rowgate1[p2] = gate2[t]; pos01[t] = p1; pos01[T + t] = p2; }
    }
    if (vcu < 8) { int* rtk = (int*)(ws + WS_ROWTOK); float* rgt = (float*)(ws + WS_ROWGATE);
        const int beg = totL[32 + vcu] + totL[vcu] + totL[8 + vcu], end = totL[32 + vcu] + (((totL[vcu] + totL[8 + vcu] + 255) >> 8) << 8);
        for (int i = beg + tid; i < end; i += NWAVES * 64) { rtk[i] = -1; rgt[i] = 0.f; } }
    __syncthreads();
}

__device__ __forceinline__ void combine_phase(float* out, unsigned char* ws, int G, int vcu, int tid, int lane, int wave) {
    const int* pos01 = (const int*)(ws + WS_POS); const unsigned char* Y = ws + WS_Y;
    const int gw = vcu * NWAVES + wave, NGW = G * NWAVES; const float ys = 1.f / Y_SCALE;
    for (int t0 = gw * 4; t0 < T; t0 += NGW * 4) {
        v4u ya[4], yb[4]; f32x4 o[4][4];
#pragma unroll
        for (int q = 0; q < 4; ++q) { const int t = t0 + q; const int p0 = pos01[t], p1 = pos01[T + t];
            ya[q] = *(const GAS v4u*)(Y + (size_t)p0 * 1024 + 16 * lane); yb[q] = *(const GAS v4u*)(Y + (size_t)p1 * 1024 + 16 * lane);
#pragma unroll
            for (int j = 0; j < 4; ++j) o[q][j] = *(const GAS f32x4*)(out + (size_t)t * 1024 + 16 * lane + 4 * j); }
#pragma unroll
        for (int q = 0; q < 4; ++q)
#pragma unroll
            for (int j = 0; j < 4; ++j) { const unsigned a = ya[q][j], c = yb[q][j]; f32x4 x = o[q][j];
                x.x += (float)(((int)(a << 24) >> 24) + ((int)(c << 24) >> 24)) * ys; x.y += (float)(((int)(a << 16) >> 24) + ((int)(c << 16) >> 24)) * ys;
                x.z += (float)(((int)(a << 8) >> 24) + ((int)(c << 8) >> 24)) * ys; x.w += (float)(((int)a >> 24) + ((int)c >> 24)) * ys;
                __builtin_nontemporal_store(x, (GAS f32x4*)(out + (size_t)(t0 + q) * 1024 + 16 * lane + 4 * j)); }
    }
}

constexpr int N_LAUNCHES = MK_N_LAUNCHES;
struct Args { const float* in[26]; float* out; unsigned char* ws; int ph_lo, ph_hi; };
typedef const __attribute__((address_space(4))) unsigned char* kargp_t;
#ifdef PROBE_CLK_PHASE
#define CLK_BEGIN(k) unsigned long long ck0_ = 0, rt0_ = 0; if ((k) == PROBE_CLK_PHASE) { ck0_ = __builtin_amdgcn_s_memtime(); rt0_ = __builtin_amdgcn_s_memrealtime(); }
#define CLK_END(k) if ((k) == PROBE_CLK_PHASE && bx == 0 && tid == 0) { const unsigned long long ck1_ = __builtin_amdgcn_s_memtime(), rt1_ = __builtin_amdgcn_s_memrealtime(); const float qv_ = floorf((float)(ck1_ - ck0_) / (float)(rt1_ - rt0_) + 0.5f); ((float*)(ws + WS_GOFS))[100] = 100.f * qv_ * qv_; }
#else
#define CLK_BEGIN(k)
#define CLK_END(k)
#endif
#define PH_ENTER() kargp_t kp_ = kp0; asm volatile("" : "+s"(kp_)); int tid = tid0; asm volatile("" : "+v"(tid)); const int lane = tid & 63, wave = __builtin_amdgcn_readfirstlane(tid >> 6); \
    unsigned char* ws = *(unsigned char* const __attribute__((address_space(4)))*)(kp_ + 216); float* out = *(float* const __attribute__((address_space(4)))*)(kp_ + 208); (void)lane; (void)wave; (void)out
#define INP(i) (*(const float* const __attribute__((address_space(4)))*)(kp_ + 8 * (i)))
__global__ void __launch_bounds__(NWAVES * 64, 2) mk_fwd(Args args) {
    extern __shared__ __attribute__((aligned(16))) unsigned char lds_raw[];
    LAS unsigned char* lds = (LAS unsigned char*)lds_raw;
    static_assert(sizeof(Args) == 232 && __builtin_offsetof(Args, out) == 208 && __builtin_offsetof(Args, ws) == 216, "Args layout");
    const kargp_t kp0 = (kargp_t)__builtin_amdgcn_kernarg_segment_ptr();
    const int tid0 = threadIdx.x;
    const int G = gridDim.x, bx = blockIdx.x, vcu = (G % 8 == 0) ? (bx % 8) * (G / 8) + bx / 8 : bx;
    for (int u = tid0; u < (XTRA_OFF - LDSCTL_OFF) / 4; u += NWAVES * 64) ((LAS unsigned*)(lds + LDSCTL_OFF))[u] = 0u;
    __syncthreads();
    XcdBarrier bar; bar.bar = (unsigned*)(args.ws + WS_CTL) + CW_BAR; bar.x = 0; bar.st = (volatile LAS unsigned*)(lds + MISC_OFF) + 8;
    if (N_LAUNCHES == 1) bar = xcd_barrier_post((unsigned*)(args.ws + WS_CTL) + CW_BAR, (volatile LAS unsigned*)(lds + MISC_OFF) + 8);
#define GRID_BAR() do { if (N_LAUNCHES == 1) xcd_barrier(bar); } while (0)
    const int lo = args.ph_lo, hi = args.ph_hi;
#ifndef PH_MASK
#define PH_MASK 0xFFFFFFFFu
#endif
#define IN(k) (((PH_MASK >> (k)) & 1u) && lo <= (k) && (k) < hi)
#define BOTH(k) (IN(k) && IN((k) + 1))
#ifndef PROBE_NOEPI
#define PROBE_NOEPI 0
#endif
#ifndef PROBE_REP_MASK
#define PROBE_REP_MASK 0u
#define PROBE_REP_N 1
#endif
#define REPS(k) (((PROBE_REP_MASK >> (k)) & 1u) ? PROBE_REP_N : 1)

    _Pragma("nounroll") for (int rep_ = 0; rep_ < REPS(0); ++rep_) if (IN(0)) { PH_ENTER(); CLK_BEGIN(0); p0_prologue(kp_, ws, lds, G, vcu, tid, lane, wave); __syncthreads(); CLK_END(0); if (BOTH(0)) GRID_BAR(); }
    _Pragma("nounroll") for (int rep_ = 0; rep_ < REPS(1); ++rep_) if (IN(1)) { PH_ENTER(); CLK_BEGIN(1);
        pg8::Gemm g{(const bf16*)(ws + WS_H0), (const bf16*)(ws + WS_WIN), T, 2048, 1024, 0, nullptr, nullptr, nullptr, nullptr, 0}; pg8::StaticOrder S; S.init(T, 2048, G, bx, I8_P1 ? 1024 / 128 : 1024 / 64);
        pg8::EpiGated<0> E{(bf16*)(ws + WS_GLU), 1024, INP(4), 1024, nullptr, I8_P1 ? 1.f / (SA_N * SW_I8) : 1.f, 1.f, {}, -1};
        pg8::gemm_phase<pg8::EpiGated<0>, pg8::StaticOrder, false, I8_P1 ? 2 : 0>(lds + RING_OFF, g, S, E, tid);
        CLK_END(1); if (BOTH(1)) GRID_BAR();
    }
    _Pragma("nounroll") for (int rep_ = 0; rep_ < REPS(2); ++rep_) if (IN(2)) { PH_ENTER(); CLK_BEGIN(2); conv_phase((const bf16*)(ws + WS_GLU), INP(5), INP(6), INP(7), INP(8), (bf16*)(ws + WS_V), lds, G, vcu, tid, lane, wave); CLK_END(2); if (BOTH(2)) GRID_BAR(); }
    _Pragma("nounroll") for (int rep_ = 0; rep_ < REPS(3); ++rep_) if (IN(3)) { PH_ENTER(); CLK_BEGIN(3);
        pg8::Gemm g{(const bf16*)(ws + WS_V), (const bf16*)(ws + WS_WOUT), T, 1024, 1024, 0, nullptr, nullptr, nullptr, nullptr, 0}; pg8::StaticOrder S; S.init(T, 1024, G, bx, I8_P3 ? 1024 / 128 : 1024 / 64);
        pg8::EpiResid<true, true, I8_P4 ? 2 : 0> E{INP(0), out, INP(10), ws + WS_X1B, (float*)(ws + WS_PART1), I8_P3 ? 1.f / (SA_N * SW_I8) : 1.f, I8_P4 ? SA_X : 1.f, (LAS float*)(lds + XTRA_OFF)};
        pg8::gemm_phase<pg8::EpiResid<true, true, I8_P4 ? 2 : 0>, pg8::StaticOrder, false, I8_P3 ? 2 : 0>(lds + RING_OFF, g, S, E, tid);
        CLK_END(3); if (BOTH(3)) GRID_BAR();
    }
    _Pragma("nounroll") for (int rep_ = 0; rep_ < REPS(4); ++rep_) if (IN(4)) { PH_ENTER(); CLK_BEGIN(4);
        pg8::Gemm g{(const bf16*)(ws + WS_X1B), (const bf16*)(ws + WS_WF13), T, 5632, 1024, 0, nullptr, nullptr, nullptr, nullptr, 0}; pg8::StaticOrder S; S.init(T, 5632, G, bx, I8_P4 ? 1024 / 128 : 1024 / 64);
        pg8::EpiGated<1> E{(bf16*)(ws + WS_HB), DFFP, nullptr, 0, (const float*)(ws + WS_PART1), I8_P4 ? 1.f / (SA_X * SW_I8) : 1.f, 1.f, {}, -1};
        pg8::gemm_phase<pg8::EpiGated<1>, pg8::StaticOrder, false, I8_P4 ? 2 : 0>(lds + RING_OFF, g, S, E, tid);
        CLK_END(4); if (BOTH(4)) GRID_BAR();
    }
    _Pragma("nounroll") for (int rep_ = 0; rep_ < REPS(5); ++rep_) if (IN(5)) { PH_ENTER(); CLK_BEGIN(5);
        pg8::Gemm g{(const bf16*)(ws + WS_HB), (const bf16*)(ws + WS_WFD), T, 1024, DFFP, 0, nullptr, nullptr, nullptr, nullptr, 0}; pg8::StaticOrder S; S.init(T, 1024, G, bx, DFFP / 64);
        pg8::EpiResid<false, true, 2> E{out, out, nullptr, ws + WS_X2B, (float*)(ws + WS_PART2), 1.f, SA_X, (LAS float*)(lds + XTRA_OFF)};
        pg8::gemm_phase<pg8::EpiResid<false, true, 2>, pg8::StaticOrder, false>(lds + RING_OFF, g, S, E, tid);
        CLK_END(5); if (BOTH(5)) GRID_BAR();
    }
    for (int grp = 0; grp < 3; ++grp) {
        _Pragma("nounroll") for (int rep_ = 0; rep_ < REPS(6 + 2 * grp); ++rep_) if (IN(6 + 2 * grp)) { PH_ENTER(); CLK_BEGIN(6 + 2 * grp);
            pg8::Gemm g{(const bf16*)(ws + WS_X2B), (const bf16*)(ws + WS_WQKV + (size_t)grp * 3072 * 1024), T, 3072, 1024, 0, nullptr, nullptr, nullptr, nullptr, 0}; pg8::StaticOrder S; S.init(T, 3072, G, bx, 1024 / 128);
            pg8::EpiQKV E{(bf16*)(ws + WS_KG), (size_t)T * D, (const float*)(ws + WS_PART2), INP(13) + grp * 64, INP(16) + grp * 64, QSCALE, 1.f / (SA_X * SW_I8), {}, -1};
            pg8::gemm_phase<pg8::EpiQKV, pg8::StaticOrder, false, 2>(lds + RING_OFF, g, S, E, tid);
            CLK_END(6 + 2 * grp); if (BOTH(6 + 2 * grp)) GRID_BAR();
        }
        _Pragma("nounroll") for (int rep_ = 0; rep_ < REPS(7 + 2 * grp); ++rep_) if (IN(7 + 2 * grp)) { PH_ENTER(); CLK_BEGIN(7 + 2 * grp);
            attn_phase(lds, grp, (const bf16*)(ws + WS_KG), (const bf16*)(ws + WS_VG), (const bf16*)(ws + WS_QG), (bf16*)(ws + WS_O), ws + WS_O8, (float*)(ws + WS_LSE), INP(1), (unsigned*)(ws + WS_CTL) + CW_AQ + grp * 128, G, vcu, tid, lane, wave);
            CLK_END(7 + 2 * grp); if (BOTH(7 + 2 * grp)) GRID_BAR();
        }
    }
    _Pragma("nounroll") for (int rep_ = 0; rep_ < REPS(12); ++rep_) if (IN(12)) { PH_ENTER(); CLK_BEGIN(12);
        pg8::Gemm g{(const bf16*)(ws + WS_O8), (const bf16*)(ws + WS_WO), T, 1024, 1024, 0, nullptr, nullptr, nullptr, nullptr, 0}; pg8::StaticOrder S; S.init(T, 1024, G, bx, 1024 / 128);
        pg8::EpiResid<false, false> E{out, out, nullptr, nullptr, nullptr, 1.f / (W8_SCALE * O8_SCALE), 1.f, nullptr};
        pg8::gemm_phase<pg8::EpiResid<false, false>, pg8::StaticOrder, false, 1>(lds + RING_OFF, g, S, E, tid);
        CLK_END(12); if (BOTH(12)) GRID_BAR();
    }
    _Pragma("nounroll") for (int rep_ = 0; rep_ < REPS(13); ++rep_) if (IN(13)) { PH_ENTER(); CLK_BEGIN(13); route_phase(out, INP(18) + 1024, INP(22), ws, lds, G, vcu, tid, lane, wave); CLK_END(13); if (BOTH(13)) GRID_BAR(); }
    _Pragma("nounroll") for (int rep_ = 0; rep_ < REPS(14); ++rep_) if (IN(14)) { PH_ENTER(); CLK_BEGIN(14); pos_phase(ws, lds, G, vcu, tid, lane, wave); CLK_END(14); if (BOTH(14)) GRID_BAR(); }
    _Pragma("nounroll") for (int rep_ = 0; rep_ < REPS(15); ++rep_) if (IN(15)) { PH_ENTER(); CLK_BEGIN(15);
        const int* gofs = (const int*)(ws + WS_GOFS); const int* rowtok = (const int*)(ws + WS_ROWTOK);
        const int ntile = gofs[16];
        pg8::MoeOrder S; S.so.init(ntile * 256, 7168, G, bx, 1024 / 128); S.p0 = 0; S.p1 = 0; S.ppu = 0;
        S.t1 = gofs[32 + 1]; S.t2 = gofs[32 + 2]; S.t3 = gofs[32 + 3]; S.t4 = gofs[32 + 4]; S.t5 = gofs[32 + 5]; S.t6 = gofs[32 + 6]; S.t7 = gofs[32 + 7];
        pg8::Gemm g{(const bf16*)(ws + WS_H3), (const bf16*)(ws + WS_WM13), ntile * 256, 7168, 1024, (size_t)7168 * 1024, rowtok, nullptr, nullptr, nullptr, 0};
        pg8::EpiGated<3> E{(bf16*)(ws + WS_HM), DFFE, nullptr, 0, nullptr, 1.f / (SA_N * SW_I8), HM_SCALE, {}, -1};
        pg8::gemm_phase<pg8::EpiGated<3>, pg8::MoeOrder, true, 2>(lds + RING_OFF, g, S, E, tid);
        CLK_END(15); if (BOTH(15)) GRID_BAR();
    }
    _Pragma("nounroll") for (int rep_ = 0; rep_ < REPS(16); ++rep_) if (IN(16)) { PH_ENTER(); CLK_BEGIN(16);
        const int* gofs = (const int*)(ws + WS_GOFS); const float* rowgate = (const float*)(ws + WS_ROWGATE);
        const int ntile = gofs[16];
        pg8::MoeOrderSK S; S.so.init(ntile * 256, 1024, G, vcu, DFFE / 128); S.plan();
        S.t1 = gofs[32 + 1]; S.t2 = gofs[32 + 2]; S.t3 = gofs[32 + 3]; S.t4 = gofs[32 + 4]; S.t5 = gofs[32 + 5]; S.t6 = gofs[32 + 6]; S.t7 = gofs[32 + 7];
        pg8::Gemm g{(const bf16*)(ws + WS_HM), (const bf16*)(ws + WS_WM2), ntile * 256, 1024, DFFE, (size_t)1024 * DFFE, nullptr, ws + WS_SLAB, (unsigned*)(ws + WS_CTL) + CW_SKFLAG + (rep_ & 1) * 8192, (unsigned*)(ws + WS_CTL) + CW_TMO, 0};
        pg8::EpiMoeDown E{ws + WS_Y, rowgate, Y_SCALE / (W8_SCALE * HM_SCALE)};
        pg8::gemm_phase<pg8::EpiMoeDown, pg8::MoeOrderSK, false, 1>(lds + RING_OFF, g, S, E, tid);
        CLK_END(16); if (BOTH(16)) GRID_BAR();
    }
    _Pragma("nounroll") for (int rep_ = 0; rep_ < REPS(17); ++rep_) if (IN(17)) { PH_ENTER(); CLK_BEGIN(17); combine_phase(out, ws, G, vcu, tid, lane, wave); }
#ifdef PROBE_CLK_PHASE
    if (bx == 0 && tid0 == 0) { asm volatile("s_waitcnt vmcnt(0)" ::: "memory"); args.out[(size_t)T * D - 1] = ((float*)(args.ws + WS_GOFS))[100]; }
#endif
#undef IN
#undef BOTH
#undef GRID_BAR
}

extern "C" void kernel_launch(void* const* d_in, const int* in_sizes, int n_in, void* d_out, int out_size, void* d_ws, size_t ws_size, hipStream_t stream) {
    static int grid = 0;
    if (grid == 0) {
        if (n_in != 26 || in_sizes[0] != T * D || out_size != T * D || ws_size < WS_END) { fprintf(stderr, "kernel_launch: unexpected shapes: n_in %d in0 %d out %d ws %zu (need >= %zu); nothing launched\n", n_in, n_in > 0 ? in_sizes[0] : -1, out_size, ws_size, (size_t)WS_END); grid = -1; return; }
        int dev = 0, cus = 0;
        if (hipGetDevice(&dev) != hipSuccess || hipDeviceGetAttribute(&cus, hipDeviceAttributeMultiprocessorCount, dev) != hipSuccess) { fprintf(stderr, "kernel_launch: device query failed\n"); grid = -1; return; }
        if (hipFuncSetAttribute((const void*)mk_fwd, hipFuncAttributeMaxDynamicSharedMemorySize, LDS_BYTES) != hipSuccess) { fprintf(stderr, "kernel_launch: hipFuncSetAttribute failed\n"); grid = -1; return; }
        int per_cu = 0;
        if (hipOccupancyMaxActiveBlocksPerMultiprocessor(&per_cu, (const void*)mk_fwd, NWAVES * 64, LDS_BYTES) != hipSuccess || per_cu < 1) fprintf(stderr, "kernel_launch: note: occupancy query reports %d workgroups per CU\n", per_cu);
        (void)hipGetLastError();
        grid = cus;
    }
    if (grid < 0) return;
    if (hipMemsetAsync((char*)d_ws + WS_CTL, 0, CTL_ZERO_BYTES, stream) != hipSuccess) { fprintf(stderr, "kernel_launch: hipMemsetAsync failed\n"); return; }
    Args a{};
    for (int i = 0; i < 26; ++i) a.in[i] = (const float*)d_in[i];
    a.out = (float*)d_out; a.ws = (unsigned char*)d_ws;
    for (int li = 0; li < N_LAUNCHES; ++li) {
        a.ph_lo = (N_LAUNCHES == 1) ? 0 : li; a.ph_hi = (N_LAUNCHES == 1) ? NPHASE : li + 1;
        hipLaunchKernelGGL(mk_fwd, dim3(grid), dim3(NWAVES * 64), LDS_BYTES, stream, a);
        const hipError_t le = hipPeekAtLastError();
        if (le != hipSuccess) { fprintf(stderr, "kernel_launch: launch %d failed: %s\n", li, hipGetErrorName(le)); break; }
    }
}
```

```cpp
#include <hip/hip_runtime.h>
#include <cstdio>
#include <cstdint>
#ifndef MK_N_LAUNCHES
#define MK_N_LAUNCHES 1
#endif
namespace pg8 {
#define PG8_LAS __attribute__((address_space(3)))
#define PG8_GAS __attribute__((address_space(1)))
typedef unsigned short bf16_t;
typedef short bf16x8 __attribute__((ext_vector_type(8)));
typedef float f32x4 __attribute__((ext_vector_type(4)));
typedef float f32x2 __attribute__((ext_vector_type(2)));
typedef unsigned u32x4 __attribute__((ext_vector_type(4)));
typedef unsigned u32x2 __attribute__((ext_vector_type(2)));
typedef int v4i_t __attribute__((ext_vector_type(4)));
typedef int v8i_t __attribute__((ext_vector_type(8)));
constexpr int BM = 256, BK = 64, HALF = 128, HTB = HALF * BK * 2  , STAGE_BYTES = 8 * HTB, NXCD = 8, WGM = 8;

__host__ __device__ __forceinline__ int lds_byte(int r, int c) { const int st = (r >> 4) * 2 + (c >> 5), rr = r & 15, cc = c & 31, ob = rr * 64 + cc * 2; return st * 1024 + (ob ^ (((ob >> 9) & 1) << 5)); }
__host__ __device__ __forceinline__ void stage_rc(int b, int& R, int& C) { const int st = b / 1024, sb = b % 1024, swz = sb ^ (((sb >> 9) & 1) << 5); R = (st >> 1) * 16 + swz / 64; C = (st & 1) * 32 + (swz % 64) / 2; }
__host__ __device__ __forceinline__ int perm32(int rho) { const int n = rho >> 4, i = rho & 15; return 8 * (i >> 2) + 4 * n + (i & 3); }

struct Unit { int pm, pn, be, kt0, nkt, part; };
struct Gemm { const bf16_t* A; const bf16_t* Bt; int M, N, K; size_t bstride; const int* rowtok; unsigned char* slab; unsigned* skflag; unsigned* tmo; int noepi; };

struct StaticOrder {
    static constexpr bool STREAMK = false;
    int nM, nN, nwg, G, c, nt, i0, i1;
    __host__ __device__ __forceinline__ void init(int M, int N, int G_, int c_, int nt_) { nM = M / BM; nN = N / BM; nwg = nM * nN; G = G_; c = c_; nt = nt_; i0 = 0; i1 = 0x7fffffff; }
    __host__ __device__ __forceinline__ int wg() const { return c; }
    __host__ __device__ __forceinline__ bool next(int i, Unit& u) const { const int ii = i + i0; if (ii >= i1) return false; const long L = (long)ii * G + c; if (L >= nwg) return false; map((int)L, u); return true; }
    __host__ __device__ __forceinline__ void map_linear(int wgid, Unit& u) const {
        const int nig = WGM * nN, gid = wgid / nig, fm = gid * WGM, gsz = (nM - fm) < WGM ? (nM - fm) : WGM;
        u.pm = fm + ((wgid % nig) % gsz); u.pn = (wgid % nig) / gsz; u.be = 0; u.kt0 = 0; u.nkt = nt; u.part = 0;
    }
    __host__ __device__ __forceinline__ void map(int L, Unit& u) const {
        int wgid = L; { const int q = nwg / NXCD, r = nwg % NXCD, xcd = wgid % NXCD, off = wgid / NXCD; wgid = (xcd < r ? xcd * (q + 1) : r * (q + 1) + (xcd - r) * q) + off; }
        const int nig = WGM * nN, gid = wgid / nig, fm = gid * WGM, gsz = (nM - fm) < WGM ? (nM - fm) : WGM;
        u.pm = fm + ((wgid % nig) % gsz); u.pn = (wgid % nig) / gsz; u.be = 0; u.kt0 = 0; u.nkt = nt; u.part = 0;
    }
};
template <bool STREAMK_> struct MoeOrderT {
    static constexpr bool STREAMK = STREAMK_;
    StaticOrder so; int t1, t2, t3, t4, t5, t6, t7; int p0, p1, ppu;
    __device__ __forceinline__ int wg() const { return so.c; }
    __device__ __forceinline__ void plan() { ppu = so.nt / 2; const long tot = (long)so.nwg * ppu; p0 = (int)(tot * so.c / so.G); p1 = (int)(tot * (so.c + 1) / so.G); }
    __device__ __forceinline__ bool next(int i, Unit& u) const {
#if defined(PROBE_DOUBLE_KLOOP)
        if (!STREAMK) { if (!so.next(i >> 1, u)) return false; if (!(i & 1)) u.part = 3; }
#else
        if (!STREAMK) { if (!so.next(i, u)) return false; }
#endif
        else { const int first = p0 / ppu, uidx = first + i; const int s = (i == 0) ? (p0 - first * ppu) : 0; const int rem = p1 - uidx * ppu;
            if (rem <= s) return false;
            const int e = rem < ppu ? rem : ppu;
            so.map_linear(uidx, u); u.kt0 = 2 * s; u.nkt = 2 * (e - s); u.part = (s > 0) ? 1 : ((e < ppu) ? 2 : 0); }
        const int q = u.pm; u.be = (q >= t1) + (q >= t2) + (q >= t3) + (q >= t4) + (q >= t5) + (q >= t6) + (q >= t7); return true;
    }
};
typedef MoeOrderT<false> MoeOrder;
typedef MoeOrderT<true> MoeOrderSK;

__device__ __forceinline__ unsigned cvt_pk_bf16(float lo, float hi) { unsigned r; asm volatile("v_cvt_pk_bf16_f32 %0, %1, %2" : "=v"(r) : "v"(lo), "v"(hi)); return r; }
__device__ __forceinline__ float fast_sigmoid(float x) { return __builtin_amdgcn_rcpf(1.0f + __builtin_amdgcn_exp2f(-1.4426950408889634f * x)); }
__device__ __forceinline__ float row_rstd(const float* part, int row) {
    const f32x4 a = *(const f32x4*)(part + (size_t)row * 4);
    return __builtin_amdgcn_rsqf(((a[0] + a[1]) + (a[2] + a[3])) * (1.0f / 1024.0f) + 1e-6f);
}
__device__ __forceinline__ void row_rstd8(const float* part, int row0, float (&r)[2][4]) {
#pragma unroll
    for (int ai = 0; ai < 2; ++ai)
#pragma unroll
        for (int m = 0; m < 4; ++m) r[ai][m] = row_rstd(part, row0 + ai * HALF + m * 16);
}
__device__ __forceinline__ unsigned pk_fp8x4(float a, float b, float c, float d) {
    a = __builtin_amdgcn_fmed3f(a, -448.f, 448.f); b = __builtin_amdgcn_fmed3f(b, -448.f, 448.f); c = __builtin_amdgcn_fmed3f(c, -448.f, 448.f); d = __builtin_amdgcn_fmed3f(d, -448.f, 448.f);
    unsigned w = 0u; w = __builtin_amdgcn_cvt_pk_fp8_f32(a, b, w, false); w = __builtin_amdgcn_cvt_pk_fp8_f32(c, d, w, true); return w;
}
__device__ __forceinline__ unsigned pk_i8x4(float a, float b, float c, float d) {
    const int ia = (int)__builtin_rintf(__builtin_amdgcn_fmed3f(a, -127.f, 127.f)), ib = (int)__builtin_rintf(__builtin_amdgcn_fmed3f(b, -127.f, 127.f));
    const int ic = (int)__builtin_rintf(__builtin_amdgcn_fmed3f(c, -127.f, 127.f)), id = (int)__builtin_rintf(__builtin_amdgcn_fmed3f(d, -127.f, 127.f));
    return ((unsigned)ia & 255u) | (((unsigned)ib & 255u) << 8) | (((unsigned)ic & 255u) << 16) | ((unsigned)id << 24);
}

template <int MODE> struct EpiGated {
    static constexpr bool PERM = true, AFTER_DRAIN = false;
    bf16_t* O; int ldo; const float* bias; int bias_half; const float* part; float descale, out_scale;
    mutable float r8c[2][4]; mutable int pmc;
    __device__ __forceinline__ void operator()(const f32x4 (&acc)[2][2][4][2], const Unit& u, int wr, int wc, int fr, int fq) const {
        const int row0 = u.pm * BM + wr * 64 + fr, col0 = u.pn * 128 + wc * 32 + 8 * fq;
        f32x4 ba[2], bg[2];
#pragma unroll
        for (int n = 0; n < 2; ++n) { if (MODE == 0) { ba[n] = *(const f32x4*)(bias + col0 + 4 * n); bg[n] = *(const f32x4*)(bias + bias_half + col0 + 4 * n); } else { ba[n] = (f32x4){0.f, 0.f, 0.f, 0.f}; bg[n] = ba[n]; } }
        if ((MODE == 1 || MODE == 4) && u.pm != pmc) { row_rstd8(part, row0, r8c); pmc = u.pm; }
#pragma unroll
        for (int ai = 0; ai < 2; ++ai)
#pragma unroll
            for (int m = 0; m < 4; ++m) { const int row = row0 + ai * HALF + m * 16;
                float r = 1.f; if (MODE == 1 || MODE == 4) r = r8c[ai][m];
                f32x4 o[2];
#pragma unroll
                for (int n = 0; n < 2; ++n) { f32x4 a = acc[ai][0][m][n], g = acc[ai][1][m][n];
                    if (MODE == 0) { a = a * descale + ba[n]; g = g * descale + bg[n];
#pragma unroll
                        for (int e = 0; e < 4; ++e) o[n][e] = a[e] * fast_sigmoid(g[e]); }
                    else if (MODE == 3) {
                        const float c1 = -1.4426950408889634f * descale, c2 = descale * descale * out_scale;
#pragma unroll
                        for (int e = 0; e < 4; ++e) o[n][e] = (a[e] * g[e]) * __builtin_amdgcn_rcpf(1.0f + __builtin_amdgcn_exp2f(a[e] * c1)) * c2; }
                    else { if (MODE == 1) { a = a * (r * descale); g = g * (r * descale); } if (MODE == 4) { a = a * (r * descale); g = g * (r * descale * out_scale); }
#pragma unroll
                        for (int e = 0; e < 4; ++e) o[n][e] = a[e] * fast_sigmoid(a[e]) * g[e]; } }
                if (MODE == 3 || MODE == 4) { u32x2 w; w.x = pk_fp8x4(o[0][0], o[0][1], o[0][2], o[0][3]); w.y = pk_fp8x4(o[1][0], o[1][1], o[1][2], o[1][3]); *(u32x2*)((unsigned char*)O + (size_t)row * ldo + col0) = w; }
                else { u32x4 w; w.x = cvt_pk_bf16(o[0][0], o[0][1]); w.y = cvt_pk_bf16(o[0][2], o[0][3]); w.z = cvt_pk_bf16(o[1][0], o[1][1]); w.w = cvt_pk_bf16(o[1][2], o[1][3]);
                *(u32x4*)(O + (size_t)row * ldo + col0) = w; }
                }
    }
};
template <bool BIAS, bool AUX, int XB8 = 0> struct EpiResid {
    static constexpr bool PERM = false, AFTER_DRAIN = false;
    const float* resid; float* out; const float* bias; unsigned char* xb; float* part; float descale, xb_scale; PG8_LAS float* red;
    __device__ __forceinline__ void operator()(const f32x4 (&acc)[2][2][4][2], const Unit& u, int wr, int wc, int fr, int fq) const {
        const int row0 = u.pm * BM + wr * 64 + fr, col0 = u.pn * BM + wc * 32 + 4 * fq;
        f32x4 bv[2][2];
#pragma unroll
        for (int bj = 0; bj < 2; ++bj)
#pragma unroll
            for (int n = 0; n < 2; ++n) bv[bj][n] = BIAS ? *(const f32x4*)(bias + col0 + bj * HALF + n * 16) : (f32x4){0.f, 0.f, 0.f, 0.f};
#pragma unroll
        for (int ai = 0; ai < 2; ++ai)
#pragma unroll
            for (int m = 0; m < 4; ++m) { const int row = row0 + ai * HALF + m * 16; const size_t off = (size_t)row * 1024 + col0; float ss = 0.f;
#pragma unroll
                for (int bj = 0; bj < 2; ++bj)
#pragma unroll
                    for (int n = 0; n < 2; ++n) { const f32x4 x = *(const f32x4*)(resid + off + bj * HALF + n * 16) + acc[ai][bj][m][n] * descale + bv[bj][n];
                        *(f32x4*)(out + off + bj * HALF + n * 16) = x;
                        if (AUX) { ss += (x[0] * x[0] + x[1] * x[1]) + (x[2] * x[2] + x[3] * x[3]); if (XB8 == 1) *(unsigned*)(xb + off + bj * HALF + n * 16) = pk_fp8x4(x[0] * xb_scale, x[1] * xb_scale, x[2] * xb_scale, x[3] * xb_scale);
                            else if (XB8 == 2) *(unsigned*)(xb + off + bj * HALF + n * 16) = pk_i8x4(x[0] * xb_scale, x[1] * xb_scale, x[2] * xb_scale, x[3] * xb_scale);
                            else { u32x2 w; w.x = cvt_pk_bf16(x[0], x[1]); w.y = cvt_pk_bf16(x[2], x[3]); *(u32x2*)((bf16_t*)xb + off + bj * HALF + n * 16) = w; } } }
                if (AUX) { ss += __shfl_xor(ss, 16); ss += __shfl_xor(ss, 32); if (fq == 0) red[(ai * HALF + wr * 64 + m * 16 + fr) * 4 + wc] = ss; }
                if (m == 3) asm volatile("" ::: "memory"); }
        if (AUX) {
            __syncthreads();
            const int t = ((wr * 4 + wc) << 6) | (fq * 16 + fr);
            if (t < BM) { const f32x4 q = *(const PG8_LAS f32x4*)(red + t * 4); part[(size_t)(u.pm * BM + t) * 4 + u.pn] = (q[0] + q[1]) + (q[2] + q[3]); }
            __syncthreads();
        }
    }
};
struct EpiQKV {
    static constexpr bool PERM = true, AFTER_DRAIN = false;
    bf16_t* Kb; size_t kvq_stride; const float* part; const float* kgain; const float* qgain; float qscale, descale;
    mutable float r8c[2][4]; mutable int pmc;
    __device__ __forceinline__ void operator()(const f32x4 (&acc)[2][2][4][2], const Unit& u, int wr, int wc, int fr, int fq) const {
        const int kind = u.pn >> 2, head = (u.pn & 3) * 4 + wc;
        bf16_t* dst = Kb + (size_t)kind * kvq_stride;
        const float* gsrc = kind == 0 ? kgain : qgain; const float gs = kind == 2 ? qscale : 1.f;
        const int row0 = u.pm * BM + wr * 64 + fr, colb = head * 64 + 8 * fq;
        f32x4 gv[2][2];
#pragma unroll
        for (int bj = 0; bj < 2; ++bj)
#pragma unroll
            for (int n = 0; n < 2; ++n) gv[bj][n] = *(const f32x4*)(gsrc + 32 * bj + 8 * fq + 4 * n) * gs;
        if (u.pm != pmc) { row_rstd8(part, row0, r8c); pmc = u.pm; }
#pragma unroll
        for (int ai = 0; ai < 2; ++ai)
#pragma unroll
            for (int m = 0; m < 4; ++m) { const int row = row0 + ai * HALF + m * 16; const float r = r8c[ai][m] * descale;
                f32x4 v[2][2]; float ss = 0.f;
#pragma unroll
                for (int bj = 0; bj < 2; ++bj)
#pragma unroll
                    for (int n = 0; n < 2; ++n) { v[bj][n] = acc[ai][bj][m][n] * r; const f32x4 x = v[bj][n]; ss += (x[0] * x[0] + x[1] * x[1]) + (x[2] * x[2] + x[3] * x[3]); }
                ss += __shfl_xor(ss, 16); ss += __shfl_xor(ss, 32);
                if (kind != 1) { const float inv = __builtin_amdgcn_rsqf(ss * (1.0f / 64.0f) + 1e-6f);
#pragma unroll
                    for (int bj = 0; bj < 2; ++bj)
#pragma unroll
                        for (int n = 0; n < 2; ++n) v[bj][n] = v[bj][n] * gv[bj][n] * inv; }
#pragma unroll
                for (int bj = 0; bj < 2; ++bj) { u32x4 w; w.x = cvt_pk_bf16(v[bj][0][0], v[bj][0][1]); w.y = cvt_pk_bf16(v[bj][0][2], v[bj][0][3]); w.z = cvt_pk_bf16(v[bj][1][0], v[bj][1][1]); w.w = cvt_pk_bf16(v[bj][1][2], v[bj][1][3]);
                    *(u32x4*)(dst + (size_t)row * 1024 + colb + 32 * bj) = w; }
                __builtin_amdgcn_sched_barrier(0); }
    }
};
struct EpiMoeDown {
    static constexpr bool PERM = true, AFTER_DRAIN = false;
    unsigned char* Y; const float* rowgate; float descale;
    template <bool ADD> __device__ __forceinline__ void run(const f32x4 (&acc)[2][2][4][2], const Unit& u, int wr, int wc, int fr, int fq, const PG8_GAS u32x2* sl) const {
        const int rt0 = u.pm * BM + wr * 64 + fr, col0 = u.pn * BM + wc * 32 + 8 * fq;
        float gtv[2][4];
#pragma unroll
        for (int ai = 0; ai < 2; ++ai)
#pragma unroll
            for (int m = 0; m < 4; ++m) gtv[ai][m] = rowgate[rt0 + ai * HALF + m * 16] * descale;
#pragma unroll
        for (int ai = 0; ai < 2; ++ai) {
#pragma unroll
            for (int m = 0; m < 4; ++m) { const float gt = gtv[ai][m]; unsigned char* p = Y + (size_t)(rt0 + ai * HALF + m * 16) * 1024 + col0;
#pragma unroll
                for (int bj = 0; bj < 2; ++bj) { f32x4 s0 = acc[ai][bj][m][0], s1 = acc[ai][bj][m][1];
                    if (ADD) { const u32x2 q0 = sl[bj * 2 + 0], q1 = sl[bj * 2 + 1];
                        s0[0] += __uint_as_float(q0.x << 16); s0[1] += __uint_as_float(q0.x & 0xffff0000u); s0[2] += __uint_as_float(q0.y << 16); s0[3] += __uint_as_float(q0.y & 0xffff0000u);
                        s1[0] += __uint_as_float(q1.x << 16); s1[1] += __uint_as_float(q1.x & 0xffff0000u); s1[2] += __uint_as_float(q1.y << 16); s1[3] += __uint_as_float(q1.y & 0xffff0000u); }
                    s0 = s0 * gt; s1 = s1 * gt;
                    u32x2 w; w.x = pk_i8x4(s0[0], s0[1], s0[2], s0[3]); w.y = pk_i8x4(s1[0], s1[1], s1[2], s1[3]);
                    *(u32x2*)(p + bj * HALF) = w; }
                if (ADD) { sl += 512 * 4; asm volatile("" : "+v"(sl)); } }
            asm volatile("" ::: "memory"); }
    }
    __device__ __forceinline__ void operator()(const f32x4 (&acc)[2][2][4][2], const Unit& u, int wr, int wc, int fr, int fq) const { run<false>(acc, u, wr, wc, fr, fq, nullptr); }
};

template <class Epi, class Sched, bool GATHER, int PREC = 0>
__device__ __forceinline__ void gemm_phase(PG8_LAS unsigned char* lds, const Gemm g, const Sched& S, const Epi& E, const int tid) {
    constexpr bool FP8 = (PREC == 1), I8 = (PREC == 2), BYTE1 = (PREC != 0);
    const int wid = __builtin_amdgcn_readfirstlane(tid >> 6), lane = tid & 63, wr = wid >> 2, wc = wid & 3, fr = lane & 15, fq = lane >> 4;
    const int K = g.K;
    const int rowb = BYTE1 ? K : 2 * K;
    unsigned voffB[2]; unsigned vC0[2], vC1[2], vN0[2], vN1[2]; int Rr[2], Cc[2];
#pragma unroll
    for (int i = 0; i < 2; ++i) { int R, C; stage_rc(tid * 16 + i * 8192, R, C); const int Rb = Epi::PERM ? ((R & ~31) + perm32(R & 31)) : R;
        Rr[i] = R; Cc[i] = C; vC0[i] = (unsigned)(R * rowb + C * 2); vC1[i] = vC0[i]; vN0[i] = vC0[i]; vN1[i] = vC0[i]; voffB[i] = (unsigned)(Rb * rowb + C * 2); }
    const size_t kstep = (size_t)(BK * 2);
    const size_t hstep = (size_t)HALF * rowb;
    const size_t hstepA = GATHER ? 0 : hstep;
    const size_t tstep = 2 * hstep;
    const unsigned ldsw = (unsigned)wid * 1024u;
    const int aoff = lds_byte(wr * 64 + fr, fq * 8), boff = lds_byte(wc * 32 + fr, fq * 8);
#define PG8_SA(b, h) (((b) * 2 + (h)) * HTB)
#define PG8_SB(b, h) ((4 + (b) * 2 + (h)) * HTB)
#define PG8_STAGE(bufoff, gbase, v0, v1) do { \
        __builtin_amdgcn_global_load_lds((const unsigned*)((const char*)(gbase) + (v0)), (PG8_LAS unsigned*)(lds + (bufoff) + ldsw), 16, 0, 0); \
        __builtin_amdgcn_global_load_lds((const unsigned*)((const char*)(gbase) + (v1)), (PG8_LAS unsigned*)(lds + (bufoff) + ldsw + 8192), 16, 0, 0); } while (0)
#define PG8_LD8(addr) __builtin_shufflevector(*(const PG8_LAS v4i_t*)(addr), *(const PG8_LAS v4i_t*)((addr) + 1024), 0, 1, 2, 3, 4, 5, 6, 7)
#define PG8_LDA(dst, b, h) do { if (FP8) { _Pragma("unroll") for (int m = 0; m < 4; ++m) dst##8[m] = PG8_LD8(lds + PG8_SA(b, h) + aoff + m * 2048); } else { \
        _Pragma("unroll") for (int m = 0; m < 4; ++m) _Pragma("unroll") for (int k = 0; k < 2; ++k) dst[m][k] = *(const PG8_LAS bf16x8*)(lds + PG8_SA(b, h) + aoff + m * 2048 + k * 1024); } } while (0)
#define PG8_LDB(dst, b, h) do { if (FP8) { _Pragma("unroll") for (int n = 0; n < 2; ++n) dst##8[n] = PG8_LD8(lds + PG8_SB(b, h) + boff + n * 2048); } else { \
        _Pragma("unroll") for (int n = 0; n < 2; ++n) _Pragma("unroll") for (int k = 0; k < 2; ++k) dst[n][k] = *(const PG8_LAS bf16x8*)(lds + PG8_SB(b, h) + boff + n * 2048 + k * 1024); } } while (0)
#if defined(PROBE_HALF_MFMA)
#define PG8_SKIP(ai) ((ai) == 1 && cur.part == 3)
#else
#define PG8_SKIP(ai) false
#endif
#define PG8_MMA(ai, bj, At, Bt) do { if (PG8_SKIP(ai)) break; __builtin_amdgcn_s_setprio(1); _Pragma("unroll") for (int m = 0; m < 4; ++m) _Pragma("unroll") for (int n = 0; n < 2; ++n) { \
        if (FP8) asm volatile("v_mfma_scale_f32_16x16x128_f8f6f4 %0, %1, %2, %0, %3, %3 op_sel_hi:[0,0,0]" : "+v"(acc[ai][bj][m][n]) : "v"(Bt##8[n]), "v"(At##8[m]), "v"(sc1)); \
        else if (I8) { _Pragma("unroll") for (int k = 0; k < 2; ++k) acc[ai][bj][m][n] = __builtin_bit_cast(f32x4, __builtin_amdgcn_mfma_i32_16x16x64_i8(__builtin_bit_cast(v4i_t, Bt[n][k]), __builtin_bit_cast(v4i_t, At[m][k]), __builtin_bit_cast(v4i_t, acc[ai][bj][m][n]), 0, 0, 0)); } \
        else { _Pragma("unroll") for (int k = 0; k < 2; ++k) acc[ai][bj][m][n] = __builtin_amdgcn_mfma_f32_16x16x32_bf16(Bt[n][k], At[m][k], acc[ai][bj][m][n], 0, 0, 0); } } __builtin_amdgcn_s_setprio(0); } while (0)
#define PG8_WAIT_V(n) asm volatile("s_waitcnt vmcnt(" #n ")" ::: "memory")
#define PG8_WAIT_L(n) asm volatile("s_waitcnt lgkmcnt(" #n ")" ::: "memory")
#define PG8_BAR __builtin_amdgcn_s_barrier()
#define PG8_SCHED __builtin_amdgcn_sched_barrier(0)
#define PG8_TOKOFF(pm_, h_, i_) ({ int t_ = g.rowtok[(pm_) * BM + (h_) * HALF + Rr[i_]]; t_ = t_ < 0 ? 0 : t_; (unsigned)(t_ * rowb + Cc[i_] * 2); })
    unsigned sc1 = 0u; if (FP8) asm volatile("v_mov_b32 %0, 0x7f7f7f7f" : "=v"(sc1));
    Unit cur, nxt; int ui = 0;
    if (!S.next(0, cur)) return;
    f32x4 acc[2][2][4][2];
#pragma unroll
    for (int a = 0; a < 2; ++a)
#pragma unroll
        for (int b = 0; b < 2; ++b)
#pragma unroll
            for (int m = 0; m < 4; ++m)
#pragma unroll
                for (int n = 0; n < 2; ++n) acc[a][b][m][n] = (f32x4){0.f, 0.f, 0.f, 0.f};
    bf16x8 At[4][2], B0[2][2], B1[2][2]; v8i_t At8[4], B08[2], B18[2];
    if (GATHER) {
#pragma unroll
        for (int i = 0; i < 2; ++i) { vC0[i] = PG8_TOKOFF(cur.pm, 0, i); vC1[i] = PG8_TOKOFF(cur.pm, 1, i); }
    }
    const char* cA = (GATHER ? (const char*)g.A : (const char*)g.A + (size_t)cur.pm * tstep) + (size_t)cur.kt0 * kstep;
    const char* cB = (const char*)g.Bt + (size_t)cur.be * g.bstride + (size_t)cur.pn * tstep + (size_t)cur.kt0 * kstep;
    PG8_STAGE(PG8_SB(0, 0), cB, voffB[0], voffB[1]); PG8_STAGE(PG8_SB(0, 1), cB + hstep, voffB[0], voffB[1]); PG8_STAGE(PG8_SA(0, 0), cA, vC0[0], vC0[1]); PG8_STAGE(PG8_SA(0, 1), cA + hstepA, vC1[0], vC1[1]);
    if (wr == 1) PG8_BAR;
    PG8_WAIT_V(2); PG8_BAR;
    PG8_STAGE(PG8_SB(1, 0), cB + kstep, voffB[0], voffB[1]); PG8_STAGE(PG8_SA(1, 0), cA + kstep, vC0[0], vC0[1]); PG8_STAGE(PG8_SB(1, 1), cB + hstep + kstep, voffB[0], voffB[1]);
    PG8_WAIT_V(6); PG8_BAR;
    for (;;) {
        const bool has_next = S.next(ui + 1, nxt);
        const char* nA = has_next ? (GATHER ? (const char*)g.A : (const char*)g.A + (size_t)nxt.pm * tstep) + (size_t)nxt.kt0 * kstep : cA;
        const char* nB = has_next ? (const char*)g.Bt + (size_t)nxt.be * g.bstride + (size_t)nxt.pn * tstep + (size_t)nxt.kt0 * kstep : cB;
        if (GATHER) {
            if (has_next && nxt.pm != cur.pm) {
#pragma unroll
                for (int i = 0; i < 2; ++i) { vN0[i] = PG8_TOKOFF(nxt.pm, 0, i); vN1[i] = PG8_TOKOFF(nxt.pm, 1, i); }
            } else {
#pragma unroll
                for (int i = 0; i < 2; ++i) { vN0[i] = vC0[i]; vN1[i] = vC1[i]; }
            }
        }
        const int nkt = cur.nkt;
        for (int t = 0; t < nkt; t += 2) {
            const bool last = (t == nkt - 2);
            const char* a1 = cA + (size_t)(t + 1) * kstep;
            const char* a2 = last ? nA : cA + (size_t)(t + 2) * kstep; const char* b2 = last ? nB : cB + (size_t)(t + 2) * kstep;
            const char* a3 = a2 + kstep; const char* b3 = b2 + kstep;
            const unsigned x00 = (GATHER && last) ? vN0[0] : vC0[0], x01 = (GATHER && last) ? vN0[1] : vC0[1], x10 = (GATHER && last) ? vN1[0] : vC1[0], x11 = (GATHER && last) ? vN1[1] : vC1[1];
            PG8_LDB(B0, 0, 0); PG8_LDB(B1, 0, 1); PG8_SCHED; PG8_LDA(At, 0, 0); PG8_STAGE(PG8_SA(1, 1), a1 + hstepA, vC1[0], vC1[1]);
            PG8_WAIT_V(8); PG8_WAIT_L(0); PG8_BAR; PG8_MMA(0, 0, At, B0); PG8_MMA(0, 1, At, B1); PG8_BAR; PG8_SCHED;
            PG8_LDA(At, 0, 1); PG8_STAGE(PG8_SB(0, 0), b2, voffB[0], voffB[1]); PG8_STAGE(PG8_SB(0, 1), b2 + hstep, voffB[0], voffB[1]); PG8_STAGE(PG8_SA(0, 0), a2, x00, x01);
            PG8_WAIT_V(8); PG8_WAIT_L(0); PG8_BAR; PG8_MMA(1, 0, At, B0); PG8_MMA(1, 1, At, B1); PG8_BAR; PG8_SCHED;
            PG8_LDB(B0, 1, 0); PG8_LDB(B1, 1, 1); PG8_SCHED; PG8_LDA(At, 1, 0); PG8_STAGE(PG8_SA(0, 1), a2 + hstepA, x10, x11);
            PG8_WAIT_V(8); PG8_WAIT_L(0); PG8_BAR; PG8_MMA(0, 0, At, B0); PG8_MMA(0, 1, At, B1); PG8_BAR; PG8_SCHED;
            PG8_LDA(At, 1, 1); PG8_STAGE(PG8_SB(1, 0), b3, voffB[0], voffB[1]); PG8_STAGE(PG8_SB(1, 1), b3 + hstep, voffB[0], voffB[1]); PG8_STAGE(PG8_SA(1, 0), a3, x00, x01);
            PG8_WAIT_V(8); PG8_WAIT_L(0); PG8_BAR; PG8_MMA(1, 0, At, B0); PG8_MMA(1, 1, At, B1); PG8_BAR; PG8_SCHED;
        }
        if (wr == 0) PG8_BAR;
        if (FP8) { asm volatile("s_nop 15\n\ts_nop 15" ::: "memory");
#pragma unroll
            for (int a = 0; a < 2; ++a)
#pragma unroll
                for (int b = 0; b < 2; ++b)
#pragma unroll
                    for (int m = 0; m < 4; ++m)
#pragma unroll
                        for (int n = 0; n < 2; ++n) asm volatile("" : "+v"(acc[a][b][m][n])); }
        if (I8) {
#pragma unroll
            for (int a = 0; a < 2; ++a)
#pragma unroll
                for (int b = 0; b < 2; ++b)
#pragma unroll
                    for (int m = 0; m < 4; ++m)
#pragma unroll
                        for (int n = 0; n < 2; ++n) { const v4i_t q = __builtin_bit_cast(v4i_t, acc[a][b][m][n]); acc[a][b][m][n] = (f32x4){(float)q[0], (float)q[1], (float)q[2], (float)q[3]}; } }
        if (g.noepi) {} else
        if constexpr (Sched::STREAMK) {
            if (cur.part == 1) {
                PG8_GAS u32x2* sl = (PG8_GAS u32x2*)g.slab + (size_t)S.wg() * (32 * 512) + tid * 4;
#pragma unroll
                for (int a = 0; a < 2; ++a)
#pragma unroll
                    for (int m = 0; m < 4; ++m) {
#pragma unroll
                        for (int b = 0; b < 2; ++b)
#pragma unroll
                            for (int n = 0; n < 2; ++n) { u32x2 w; w.x = cvt_pk_bf16(acc[a][b][m][n][0], acc[a][b][m][n][1]); w.y = cvt_pk_bf16(acc[a][b][m][n][2], acc[a][b][m][n][3]); sl[b * 2 + n] = w; }
                        sl += 512 * 4; asm volatile("" : "+v"(sl)); }
                asm volatile("s_waitcnt vmcnt(0)" ::: "memory");
                __syncthreads();
                if (tid == 0) { __builtin_amdgcn_fence(__ATOMIC_RELEASE, "agent"); asm volatile("s_waitcnt vmcnt(0)" ::: "memory");
                    __hip_atomic_store(g.skflag + 16 * S.wg(), 1u, __ATOMIC_RELAXED, __HIP_MEMORY_SCOPE_AGENT); }
            } else if (cur.part == 2) {
                if (wid == 0) { unsigned sp = 0;
                    while (__hip_atomic_load(g.skflag + 16 * (S.wg() + 1), __ATOMIC_RELAXED, __HIP_MEMORY_SCOPE_AGENT) == 0u) { __builtin_amdgcn_s_sleep(2);
                        if (++sp > (1u << 22)) { if (lane == 0) __hip_atomic_store(g.tmo, 1u, __ATOMIC_RELAXED, __HIP_MEMORY_SCOPE_AGENT); break; } }
                    __builtin_amdgcn_fence(__ATOMIC_ACQUIRE, "agent"); }
                asm volatile("s_waitcnt vmcnt(0)" ::: "memory");
                __syncthreads();
                E.template run<true>(acc, cur, wr, wc, fr, fq, (const PG8_GAS u32x2*)g.slab + (size_t)(S.wg() + 1) * (32 * 512) + tid * 4);
            } else { if (cur.part != 3) E(acc, cur, wr, wc, fr, fq); }
        } else { if (cur.part != 3) E(acc, cur, wr, wc, fr, fq); }
        if (!has_next) break;
#pragma unroll
        for (int a = 0; a < 2; ++a)
#pragma unroll
            for (int b = 0; b < 2; ++b)
#pragma unroll
                for (int m = 0; m < 4; ++m)
#pragma unroll
                    for (int n = 0; n < 2; ++n) acc[a][b][m][n] = (f32x4){0.f, 0.f, 0.f, 0.f};
        cur = nxt; cA = nA; cB = nB; ++ui;
        if (GATHER) {
#pragma unroll
            for (int i = 0; i < 2; ++i) { vC0[i] = vN0[i]; vC1[i] = vN1[i]; }
        }
        if (wr == 1) PG8_BAR;
    }
    PG8_WAIT_V(0);
    PG8_BAR;
#undef PG8_SA
#undef PG8_SB
#undef PG8_STAGE
#undef PG8_LDA
#undef PG8_LDB
#undef PG8_MMA
#undef PG8_LD8
#undef PG8_WAIT_V
#undef PG8_WAIT_L
#undef PG8_BAR
#undef PG8_SCHED
#undef PG8_TOKOFF
}
}
#define GAS __attribute__((address_space(1)))
#define LAS __attribute__((address_space(3)))
typedef unsigned short bf16;
typedef unsigned v4u __attribute__((ext_vector_type(4)));
typedef float f32x4 __attribute__((ext_vector_type(4)));
typedef short bf16x8 __attribute__((ext_vector_type(8)));
typedef GAS unsigned gu32;
typedef GAS unsigned long long gu64;
#define RLX_AGENT __ATOMIC_RELAXED, __HIP_MEMORY_SCOPE_AGENT
#define LDS_WAIT() asm volatile("s_waitcnt lgkmcnt(0)" ::: "memory")
#define VM_WAIT() asm volatile("s_waitcnt vmcnt(0)" ::: "memory")
__device__ __forceinline__ unsigned long long rt() { return __builtin_amdgcn_s_memrealtime(); }
__device__ __forceinline__ unsigned f2bf(float f) { unsigned u = __builtin_bit_cast(unsigned, f); return (u + 0x7fffu + ((u >> 16) & 1u)) >> 16; }
__device__ __forceinline__ unsigned pk2(float lo, float hi) { return f2bf(lo) | (f2bf(hi) << 16); }

#define XB_TMO      128
#define XB_XCNT(j)  (256  + 64 * (j))
#define XB_XSUB(j)  (1280 + 64 * (j))
#define XB_XGEN(j)  (2304 + 64 * (j))
#define XB_TOP      3328
#define XB_TOPGEN   3392
#define XCD_BAR_WORDS 3456
#define XB_SPIN_CAP (1u << 18)

__device__ __forceinline__ unsigned xb_ld(unsigned* p)              { return __hip_atomic_load(p, __ATOMIC_RELAXED, __HIP_MEMORY_SCOPE_AGENT); }
__device__ __forceinline__ unsigned xb_add(unsigned* p, unsigned v) { return __hip_atomic_fetch_add(p, v, __ATOMIC_RELAXED, __HIP_MEMORY_SCOPE_AGENT); }
__device__ __forceinline__ unsigned xb_xcc_id() { return (unsigned)__builtin_amdgcn_s_getreg((3 << 11) | 20) & 0xFu; }
#define XB_SPIN(cond, bar) do { unsigned _sp = 0; while (cond) { __builtin_amdgcn_s_sleep(1); \
    if ((++_sp & 255u) == 0u) { if (xb_ld(&(bar)[XB_TMO])) break; if (_sp > XB_SPIN_CAP) { atomicAdd(&(bar)[XB_TMO], 1u); break; } } } } while (0)

struct XcdBarrier {
    unsigned* bar; unsigned x;
    volatile LAS unsigned* st;
};

__device__ __forceinline__ XcdBarrier xcd_barrier_post(unsigned* bar, volatile LAS unsigned* st) {
    XcdBarrier b; b.bar = bar; b.x = xb_xcc_id(); b.st = st;
    if (threadIdx.x == 0) (void)xb_add(&bar[XB_XCNT(b.x)], 1u);
    return b;
}
__device__ __forceinline__ void xcd_barrier_complete(unsigned* bar, unsigned x, unsigned& nloc, unsigned& nx) {
    const unsigned G = gridDim.x * gridDim.y * gridDim.z;
    unsigned sum, cnt, mine, sp = 0u;
    for (;;) {
        sum = 0u; cnt = 0u; mine = 0u;
#pragma unroll
        for (unsigned j = 0; j < 16; ++j) { const unsigned c = xb_ld(&bar[XB_XCNT(j)]); sum += c; cnt += (c > 0u) ? 1u : 0u; mine = (j == x) ? c : mine; }
        if (sum == G) break;
        __builtin_amdgcn_s_sleep(1);
        if ((++sp & 255u) == 0u) { if (xb_ld(&bar[XB_TMO])) break; if (sp > XB_SPIN_CAP) { atomicAdd(&bar[XB_TMO], 1u); break; } }
    }
    nloc = mine > 0u ? mine : 1u; nx = cnt > 0u ? cnt : 1u;
}

__device__ __forceinline__ void xcd_barrier(const XcdBarrier& b) {
    asm volatile("s_waitcnt vmcnt(0)" ::: "memory");
    __syncthreads();
    if (threadIdx.x == 0) {
        unsigned* bar = b.bar;
        __builtin_amdgcn_s_waitcnt(0);
        unsigned nloc = b.st[0], nx = b.st[1];
        if (nloc == 0u) { xcd_barrier_complete(bar, b.x, nloc, nx); b.st[0] = nloc; b.st[1] = nx; }
        const unsigned old = xb_add(&bar[XB_XSUB(b.x)], 1u);
        const unsigned gen = old / nloc;
        if (old + 1u == (gen + 1u) * nloc) {
            __builtin_amdgcn_fence(__ATOMIC_RELEASE, "agent");
            asm volatile("s_waitcnt vmcnt(0)" ::: "memory");
            const unsigned og = xb_add(&bar[XB_TOP], 1u);
            const unsigned tg = og / nx;
            if (og + 1u == (tg + 1u) * nx) xb_add(&bar[XB_TOPGEN], 1u);
            else XB_SPIN(xb_ld(&bar[XB_TOPGEN]) == tg, bar);
            __builtin_amdgcn_fence(__ATOMIC_ACQUIRE, "agent");
            xb_add(&bar[XB_XGEN(b.x)], 1u);
            asm volatile("s_waitcnt vmcnt(0)" ::: "memory");
        } else {
            XB_SPIN(xb_ld(&bar[XB_XGEN(b.x)]) == gen, bar);
            __builtin_amdgcn_fence(__ATOMIC_ACQUIRE, "agent");
            asm volatile("s_waitcnt vmcnt(0)" ::: "memory");
        }
    }
    __syncthreads();
}

constexpr int NWAVES = 8;
constexpr int T = 32768, D = 1024, SEQ = 4096, NBATCH = 8;
constexpr int DFF = 2752, DFFP = 2816, DFFE = 3584, NEXP = 8;
constexpr int ROWCAP = 67584;
constexpr float EPS = 1e-6f;
constexpr float LOG2E = 1.4426950408889634f;
constexpr float SOFTMAX_OFS = 16.f;
constexpr float QSCALE = 0.125f * LOG2E;
#ifndef I8_P1
#define I8_P1 1
#endif
#ifndef I8_P3
#define I8_P3 0
#endif
#ifndef I8_P4
#define I8_P4 1
#endif
constexpr float SA_N = 127.f / 5.f, SA_X = 127.f / 6.f, SW_I8 = 127.f * 32.f / 4.5f;
constexpr float Y_SCALE = 127.f / 2.5f;
constexpr float W8_SCALE = 64.f, H3_SCALE = 16.f, HM_SCALE = 8.f, X8_SCALE = 16.f, HB_SCALE = 8.f, O8_SCALE = 64.f;
constexpr size_t MiB = 1u << 20;
constexpr size_t WS_CTL = 0, CTL_ZERO_BYTES = 1 * MiB;
constexpr size_t WS_PART1 = 1 * MiB, WS_PART2 = 3 * MiB, WS_LSE = 5 * MiB;
constexpr size_t WS_ROUTE = 7 * MiB, WS_GATE1 = WS_ROUTE + 128 * 1024, WS_GATE2 = WS_ROUTE + 256 * 1024, WS_WAVECNT = WS_ROUTE + 384 * 1024, WS_BLOCKCNT = WS_ROUTE + 448 * 1024, WS_GOFS = WS_ROUTE + 480 * 1024;
constexpr size_t WS_ROWTOK = 8 * MiB, WS_ROWGATE = 8 * MiB + 512 * 1024;
constexpr size_t WS_WIN = 12 * MiB, WS_WOUT = 16 * MiB, WS_WF13 = 18 * MiB, WS_WFD = 29 * MiB, WS_WQKV = 35 * MiB, WS_WO = 53 * MiB;
constexpr size_t WS_WM13 = 56 * MiB, WS_WM2 = 168 * MiB;
constexpr size_t WS_A0 = 224 * MiB;
constexpr size_t WS_H0 = WS_A0, WS_GLU = WS_A0 + 64 * MiB, WS_V = WS_A0 + 128 * MiB;
constexpr size_t WS_X1B = WS_A0, WS_HB = WS_A0 + 64 * MiB;
constexpr size_t WS_X2B = WS_A0, WS_KG = WS_A0 + 64 * MiB, WS_VG = WS_A0 + 128 * MiB, WS_QG = WS_A0 + 192 * MiB, WS_O = WS_A0 + 256 * MiB, WS_O8 = WS_A0 + 32 * MiB;
constexpr size_t WS_H3 = WS_A0, WS_HM = WS_A0 + 66 * MiB;
constexpr size_t WS_END = 548 * MiB;
static_assert(WS_HB + (size_t)T * DFFP * 2 <= WS_END && WS_O + (size_t)T * D * 2 <= WS_END && WS_HM + (size_t)ROWCAP * DFFE <= WS_END, "arena");
static_assert(WS_WFD + (size_t)D * DFFP * 2 <= WS_WQKV && WS_WO + (size_t)D * D * 2 <= WS_WM13 && WS_WM2 + (size_t)NEXP * D * DFFE * 2 <= WS_A0, "weights");
constexpr int CW_AQ = 50000;
constexpr int CW_TMO = 0, CW_CODE = 1, CW_BAR = 4096, CW_SKFLAG = 16384;
constexpr size_t WS_SLAB = 12 * MiB;
constexpr size_t WS_POS = 9 * MiB;
constexpr size_t WS_Y = WS_A0;
static_assert(WS_SLAB + (size_t)256 * 131072 <= 56 * MiB && WS_Y + (size_t)ROWCAP * 1024 <= WS_HM, "slab / Y");

constexpr int RING_OFF = 0, RING_BYTES = 131072;
constexpr int LDSCTL_OFF = RING_BYTES, MISC_OFF = LDSCTL_OFF + 320;
constexpr int XTRA_OFF = RING_BYTES + 512;
constexpr int LDS_BYTES = 147456;

constexpr int NPHASE = 18;

__constant__ unsigned char T5_BUCKET[3][132] = {
 {0,1,2,3,4,5,6,7,8,9,10,11,12,13,14,15,16,16,16,16,16,16,17,17,17,17,17,17,17,17,18,18,18,18,18,18,18,18,18,18,19,19,19,19,19,19,19,19,19,19,19,19,19,19,20,20,20,20,20,20,20,20,20,20,20,20,20,20,20,20,20,20,20,21,21,21,21,21,21,21,21,21,21,21,21,21,21,21,21,21,21,21,21,21,21,21,21,21,21,22,22,22,22,22,22,22,22,22,22,22,22,22,22,22,22,22,22,22,22,22,22,22,22,22,22,22,22,22,22,0,0,0},
 {0,4,8,12,16,16,17,17,18,18,19,19,19,19,20,20,20,20,20,21,21,21,21,21,21,22,22,22,22,22,22,22,22,22,23,23,23,23,23,23,23,23,23,23,23,23,24,24,24,24,24,24,24,24,24,24,24,24,24,24,24,24,25,25,25,25,25,25,25,25,25,25,25,25,25,25,25,25,25,25,25,25,25,26,26,26,26,26,26,26,26,26,26,26,26,26,26,26,26,26,26,26,26,26,26,26,26,26,26,26,26,26,26,27,27,27,27,27,27,27,27,27,27,27,27,27,27,27,27,0,0,0},
 {0,16,18,19,20,21,21,22,22,23,23,23,24,24,24,24,25,25,25,25,25,26,26,26,26,26,26,26,26,27,27,27,27,27,27,27,27,27,27,28,28,28,28,28,28,28,28,28,28,28,28,28,29,29,29,29,29,29,29,29,29,29,29,29,29,29,29,29,29,29,30,30,30,30,30,30,30,30,30,30,30,30,30,30,30,30,30,30,30,30,30,30,30,30,30,31,31,31,31,31,31,31,31,31,31,31,31,31,31,31,31,31,31,31,31,31,31,31,31,31,31,31,31,31,31,31,31,31,31,0,0,0}};

typedef float f32x16 __attribute__((ext_vector_type(16)));
typedef float f32x2v __attribute__((ext_vector_type(2)));
typedef __bf16 bf16x2v __attribute__((ext_vector_type(2)));
typedef short v4i16_t __attribute__((ext_vector_type(4)));
__device__ __forceinline__ unsigned pkbf(float lo, float hi) { f32x2v v = {lo, hi}; bf16x2v b = __builtin_convertvector(v, bf16x2v); return __builtin_bit_cast(unsigned, b); }
__device__ __forceinline__ float bflo(unsigned u) { return __uint_as_float(u << 16); }
__device__ __forceinline__ float bfhi(unsigned u) { return __uint_as_float(u & 0xffff0000u); }
template <int N> __device__ __forceinline__ float dpp_row_ror(float v) { return __builtin_bit_cast(float, __builtin_amdgcn_update_dpp(0, __builtin_bit_cast(int, v), 0x120 + N, 0xf, 0xf, true)); }
__device__ __forceinline__ float wave_sum(float v) {
    v += dpp_row_ror<8>(v); v += dpp_row_ror<4>(v); v += dpp_row_ror<2>(v); v += dpp_row_ror<1>(v);
    const int b = __builtin_bit_cast(int, v);
    return (__builtin_bit_cast(float, __builtin_amdgcn_readlane(b, 0)) + __builtin_bit_cast(float, __builtin_amdgcn_readlane(b, 16))) + (__builtin_bit_cast(float, __builtin_amdgcn_readlane(b, 32)) + __builtin_bit_cast(float, __builtin_amdgcn_readlane(b, 48)));
}
__device__ __forceinline__ int crow(int r, int hi) { return (r & 3) + 8 * (r >> 2) + 4 * hi; }

struct TrDesc { const float* W; const float* gsc; unsigned char* WT; int ldw, Kp, drow0, k0, n0src, is8; float scale; };
__device__ __forceinline__ int hmap_row0(int L) { const int lc = L & 255; return (L & ~255) + 128 * ((lc >> 5) & 1) + 32 * (lc >> 6); }

constexpr int IT_MG = NEXP * 16 * 112, IT_MU = IT_MG, IT_MD = NEXP * 56 * 32, IT_WIN = 16 * 64, IT_WOUT = 16 * 32, IT_FG = 16 * 86, IT_FU = IT_FG, IT_FD = 43 * 32, IT_KV = 16 * 192, IT_Q = 16 * 96, IT_WO = 16 * 32;
constexpr int IT_MOE = IT_MG + IT_MU + IT_MD;
static_assert(IT_MOE == 3 * 256 * 56, "expert-weight items per attention phase and workgroup");
constexpr int IT_TOTAL = IT_MG + IT_MU + IT_MD + IT_WIN + IT_WOUT + IT_FG + IT_FU + IT_FD + IT_KV + IT_Q + IT_WO;
typedef const __attribute__((address_space(4))) unsigned char* kargp0_t;
#define P0IN(i) (*(const float* const __attribute__((address_space(4)))*)(kp + 8 * (i)))
__device__ __forceinline__ void tr_desc(int it, kargp0_t kp, unsigned char* ws, TrDesc& d) {
    int r = it; d.gsc = nullptr; d.is8 = 2; d.scale = SW_I8; d.Kp = 1024;
    if (r < IT_MG) { const int e = r / 1792, rr = r % 1792, j = (rr % 112) * 32; d.W = P0IN(23) + (size_t)e * D * DFFE; d.ldw = DFFE; d.WT = ws + WS_WM13 + (size_t)e * 7168 * 1024; d.drow0 = 256 * (j >> 7) + (j & 127); d.k0 = (rr / 112) * 64; d.n0src = j; return; } r -= IT_MG;
    if (r < IT_MU) { const int e = r / 1792, rr = r % 1792, j = (rr % 112) * 32; d.W = P0IN(24) + (size_t)e * D * DFFE; d.ldw = DFFE; d.WT = ws + WS_WM13 + (size_t)e * 7168 * 1024; d.drow0 = 256 * (j >> 7) + 128 + (j & 127); d.k0 = (rr / 112) * 64; d.n0src = j; return; } r -= IT_MU;
    if (r < IT_MD) { const int e = r / 1792, rr = r % 1792, j = (rr % 32) * 32; d.W = P0IN(25) + (size_t)e * DFFE * D; d.ldw = D; d.WT = ws + WS_WM2 + (size_t)e * 1024 * DFFE; d.Kp = DFFE; d.is8 = 1; d.scale = W8_SCALE; d.drow0 = j; d.k0 = (rr / 32) * 64; d.n0src = j; return; } r -= IT_MD;
    if (r < IT_KV) { const int c = (r % 192) * 32, kvsel = c / 3072, cg = c % 3072, g = cg >> 10, hc = cg & 1023, L = kvsel * 1024 + hc; d.W = P0IN(12); d.ldw = 6144; d.gsc = P0IN(11); d.WT = ws + WS_WQKV + (size_t)g * 3072 * 1024; d.drow0 = hmap_row0(L); d.k0 = (r / 192) * 64; d.n0src = c; return; } r -= IT_KV;
    if (r < IT_Q) { const int c = (r % 96) * 32, g = c >> 10, hc = c & 1023, L = 2048 + hc; d.W = P0IN(15); d.ldw = 3072; d.gsc = P0IN(14); d.WT = ws + WS_WQKV + (size_t)g * 3072 * 1024; d.drow0 = hmap_row0(L); d.k0 = (r / 96) * 64; d.n0src = c; return; } r -= IT_Q;
    if (r < IT_WIN) { const int c = (r % 64) * 32, sel = c >> 10, j = c & 1023; d.W = P0IN(3); d.ldw = 2048; d.WT = ws + WS_WIN; if (!I8_P1) { d.is8 = 0; d.scale = 1.f; } d.drow0 = 256 * (j >> 7) + 128 * sel + (j & 127); d.k0 = (r / 64) * 64; d.n0src = c; return; } r -= IT_WIN;
    if (r < IT_WOUT) { const int j = (r % 32) * 32; d.W = P0IN(9); d.ldw = 1024; d.WT = ws + WS_WOUT; if (!I8_P3) { d.is8 = 0; d.scale = 1.f; } d.drow0 = j; d.k0 = (r / 32) * 64; d.n0src = j; return; } r -= IT_WOUT;
    if (r < IT_FG) { const int j = (r % 86) * 32; d.W = P0IN(19); d.ldw = DFF; d.gsc = P0IN(18); d.WT = ws + WS_WF13; if (!I8_P4) { d.is8 = 0; d.scale = 1.f; } d.drow0 = 256 * (j >> 7) + (j & 127); d.k0 = (r / 86) * 64; d.n0src = j; return; } r -= IT_FG;
    if (r < IT_FU) { const int j = (r % 86) * 32; d.W = P0IN(20); d.ldw = DFF; d.gsc = P0IN(18); d.WT = ws + WS_WF13; if (!I8_P4) { d.is8 = 0; d.scale = 1.f; } d.drow0 = 256 * (j >> 7) + 128 + (j & 127); d.k0 = (r / 86) * 64; d.n0src = j; return; } r -= IT_FU;
    if (r < IT_FD) { const int j = (r % 32) * 32; d.W = P0IN(21); d.ldw = 1024; d.WT = ws + WS_WFD; d.Kp = DFFP; d.is8 = 0; d.scale = 1.f; d.drow0 = j; d.k0 = (r / 32) * 64; d.n0src = j; return; } r -= IT_FD;
    { const int j = (r % 32) * 32; d.W = P0IN(17); d.ldw = 1024; d.WT = ws + WS_WO; d.drow0 = j; d.k0 = (r / 32) * 64; d.n0src = j; d.is8 = 1; d.scale = W8_SCALE; }
}
__device__ __forceinline__ void tr_load(const TrDesc& d, f32x4 (&v)[8], f32x4 (&gv)[2], int lane) {
#pragma unroll
    for (int i = 0; i < 8; ++i) v[i] = __builtin_nontemporal_load((const f32x4*)(d.W + (size_t)(d.k0 + 8 * i + (lane >> 3)) * d.ldw + d.n0src + 4 * (lane & 7)));
    const float* gp = d.gsc ? d.gsc + d.k0 + 8 * (lane & 7) : d.W + (size_t)d.k0 * d.ldw + d.n0src;
    gv[0] = *(const f32x4*)gp; gv[1] = *(const f32x4*)(gp + 4);
}
__device__ __forceinline__ void tr_store(const TrDesc& d, const f32x4 (&v)[8], const f32x4 (&gv)[2], LAS float* scr, int lane) {
#pragma unroll
    for (int i = 0; i < 8; ++i) { LAS float* w = scr + (8 * i + (lane >> 3)) * 33 + 4 * (lane & 7); w[0] = v[i].x; w[1] = v[i].y; w[2] = v[i].z; w[3] = v[i].w; }
    LDS_WAIT(); asm volatile("" ::: "memory");
    const int c = lane & 7; const float sc = d.scale;
    const f32x4 one4 = {1.f, 1.f, 1.f, 1.f}; const f32x4 gv0 = d.gsc ? gv[0] : one4, gv1 = d.gsc ? gv[1] : one4;
#pragma unroll
    for (int j = 0; j < 4; ++j) { const int n = (lane >> 3) + 8 * j; const LAS float* s = scr + (8 * c) * 33 + n;
        const float x0 = s[0 * 33] * gv0.x * sc, x1 = s[1 * 33] * gv0.y * sc, x2 = s[2 * 33] * gv0.z * sc, x3 = s[3 * 33] * gv0.w * sc, x4 = s[4 * 33] * gv1.x * sc, x5 = s[5 * 33] * gv1.y * sc, x6 = s[6 * 33] * gv1.z * sc, x7 = s[7 * 33] * gv1.w * sc;
        if (d.is8 == 2) { pg8::u32x2 o; o.x = pg8::pk_i8x4(x0, x1, x2, x3); o.y = pg8::pk_i8x4(x4, x5, x6, x7); *(GAS pg8::u32x2*)(d.WT + (size_t)(d.drow0 + n) * d.Kp + d.k0 + 8 * c) = o; }
        else if (d.is8) { pg8::u32x2 o; o.x = pg8::pk_fp8x4(x0, x1, x2, x3); o.y = pg8::pk_fp8x4(x4, x5, x6, x7); *(GAS pg8::u32x2*)(d.WT + (size_t)(d.drow0 + n) * d.Kp + d.k0 + 8 * c) = o; }
        else { v4u o; o.x = pkbf(x0, x1); o.y = pkbf(x2, x3); o.z = pkbf(x4, x5); o.w = pkbf(x6, x7); *(GAS v4u*)((bf16*)d.WT + (size_t)(d.drow0 + n) * d.Kp + d.k0 + 8 * c) = o; } }
    LDS_WAIT(); asm volatile("" ::: "memory");
}

__device__ __forceinline__ void p0_items(kargp0_t kp, unsigned char* ws, LAS float* scr, int first, int stride, int lo, int hi, int lane) {
    TrDesc da, db, dc; f32x4 va[8], vb[8], vc[8]; f32x4 ga[2], gb[2], gc[2];
    int it = lo + first; const int NGW = stride;
    if (it < hi) { tr_desc(it, kp, ws, da); tr_load(da, va, ga, lane); }
    if (it + NGW < hi) { tr_desc(it + NGW, kp, ws, db); tr_load(db, vb, gb, lane); }
    while (it < hi) {
        if (it + 2 * NGW < hi) { tr_desc(it + 2 * NGW, kp, ws, dc); tr_load(dc, vc, gc, lane); }
        tr_store(da, va, ga, scr, lane);
        if (it + NGW >= hi) break;
        if (it + 3 * NGW < hi) { tr_desc(it + 3 * NGW, kp, ws, da); tr_load(da, va, ga, lane); }
        tr_store(db, vb, gb, scr, lane);
        if (it + 2 * NGW >= hi) break;
        if (it + 4 * NGW < hi) { tr_desc(it + 4 * NGW, kp, ws, db); tr_load(db, vb, gb, lane); }
        tr_store(dc, vc, gc, scr, lane);
        it += 3 * NGW;
    }
}
__device__ __forceinline__ void p0_items2(kargp0_t kp, unsigned char* ws, LAS float* scr, int first, int stride, int lo, int hi, int lane) {
    if (first >= hi - lo) return;
    const int n = (hi - lo - first + stride - 1) / stride, base = lo + first, last = n - 1;
    TrDesc da, db; f32x4 va[8], vb[8]; f32x4 ga[2], gb[2];
#define P0_ITEM(k) (base + ((k) < last ? (k) : last) * stride)
    tr_desc(base, kp, ws, da); tr_load(da, va, ga, lane);
    for (int k = 0; k + 1 < n; k += 2) {
        tr_desc(P0_ITEM(k + 1), kp, ws, db); tr_load(db, vb, gb, lane);
        tr_store(da, va, ga, scr, lane);
        tr_desc(P0_ITEM(k + 2), kp, ws, da); tr_load(da, va, ga, lane);
        tr_store(db, vb, gb, scr, lane);
    }
    if (n & 1) tr_store(da, va, ga, scr, lane);
#undef P0_ITEM
}
__device__ __forceinline__ void p0_prologue(kargp0_t kp, unsigned char* ws, LAS unsigned char* lds, int G, int vcu, int tid, int lane, int wave) {
    LAS float* scr = (LAS float*)(lds + RING_OFF + wave * 16384);
    const int gw = vcu * NWAVES + wave, NGW = G * NWAVES;
    bf16* WF13 = (bf16*)(ws + WS_WF13); bf16* WFD = (bf16*)(ws + WS_WFD);
    p0_items(kp, ws, scr, gw, NGW, (G == 256) ? IT_MOE : 0, IT_TOTAL, lane);
#ifdef PROBE_CONV_NC
    if ((vcu & 31) < PROBE_CONV_NC) p0_items(kp, ws, scr, ((vcu >> 5) * PROBE_CONV_NC + (vcu & 31)) * NWAVES + wave, 8 * PROBE_CONV_NC * NWAVES, 0, IT_MOE, lane);
#endif
    const int gt = vcu * (NWAVES * 64) + tid, NGT = G * NWAVES * 64; const v4u z = {0u, 0u, 0u, 0u};
    { constexpr int RB = I8_P4 ? 1024 : 2048, CH = RB / 16;
      for (int i = gt; i < 2 * 64 * CH; i += NGT) { const int sel = i / (64 * CH), rr = (i / CH) & 63, ch = i % CH; *(GAS v4u*)((unsigned char*)WF13 + (size_t)(256 * 21 + 128 * sel + 64 + rr) * RB + ch * 16) = z; } }
    for (int i = gt; i < 1024 * 8; i += NGT) { const int row = i >> 3, ch = i & 7; *(GAS v4u*)(WFD + (size_t)row * DFFP + DFF + ch * 8) = z; }
    const float* x = P0IN(0); const float* gn = P0IN(2); bf16* H0 = (bf16*)(ws + WS_H0);
    f32x4 gv[4];
#pragma unroll
    for (int j = 0; j < 4; ++j) gv[j] = *(const f32x4*)(gn + 4 * lane + 256 * j);
    for (int m0 = gw * 4; m0 < T; m0 += NGW * 4) {
        f32x4 v[4][4];
#pragma unroll
        for (int q = 0; q < 4; ++q) { const GAS f32x4* xr = (const GAS f32x4*)(x + (size_t)(m0 + q) * D) + lane;
#pragma unroll
            for (int j = 0; j < 4; ++j) v[q][j] = __builtin_nontemporal_load(xr + 64 * j); }
#pragma unroll
        for (int q = 0; q < 4; ++q) { float s = 0.f;
#pragma unroll
            for (int j = 0; j < 4; ++j) s += (v[q][j].x * v[q][j].x + v[q][j].y * v[q][j].y) + (v[q][j].z * v[q][j].z + v[q][j].w * v[q][j].w);
            const float rstd = 1.f / sqrtf(wave_sum(s) * (1.f / D) + EPS);
            if (I8_P1) { GAS unsigned* o4 = (GAS unsigned*)((unsigned char*)H0 + (size_t)(m0 + q) * D) + lane;
#pragma unroll
                for (int j = 0; j < 4; ++j) { const f32x4 y = v[q][j] * (rstd * SA_N) * gv[j]; o4[64 * j] = pg8::pk_i8x4(y.x, y.y, y.z, y.w); } }
            else { GAS unsigned long long* o8 = (GAS unsigned long long*)(H0 + (size_t)(m0 + q) * D) + lane;
#pragma unroll
                for (int j = 0; j < 4; ++j) { const f32x4 y = v[q][j] * rstd * gv[j]; o8[64 * j] = (unsigned long long)pkbf(y.x, y.y) | ((unsigned long long)pkbf(y.z, y.w) << 32); } } }
    }
}

__device__ __forceinline__ void conv_phase(const bf16* glu, const float* dw_w, const float* dw_b, const float* ln_g, const float* ln_b, bf16* vout, LAS unsigned char* lds, int G, int vcu, int tid, int lane, int wave) {
    LAS float* ybuf = (LAS float*)(lds + RING_OFF);
    const int c0 = 2 * tid;
    float w0[31], w1[31];
#pragma unroll
    for (int k = 0; k < 31; ++k) { const f32x2v w = *(const f32x2v*)(dw_w + k * 1024 + c0); w0[k] = w.x; w1[k] = w.y; }
    const f32x2v dbv = *(const f32x2v*)(dw_b + c0);
    LAS float* lnp = (LAS float*)(lds + XTRA_OFF);
    for (int i = tid; i < 1024; i += NWAVES * 64) { lnp[i] = ln_g[i]; lnp[1024 + i] = ln_b[i]; }
    __syncthreads();
    for (int item = vcu; item < T / 128; item += G) {
        const int b = item >> 5, s0 = (item & 31) * 128;
        const bf16* ub = glu + (size_t)b * SEQ * D + c0;
        float r0[32], r1[32];
        r0[0] = 0.f; r1[0] = 0.f; r0[1] = 0.f; r1[1] = 0.f;
#pragma unroll
        for (int i = 0; i < 30; ++i) { const int s = s0 - 30 + i; unsigned v = 0u; if (s >= 0) v = *(const unsigned*)(ub + (size_t)s * D); r0[i + 2] = bflo(v); r1[i + 2] = bfhi(v); }
        for (int base = 0; base < 128; base += 32) {
            unsigned nu[32];
#pragma unroll
            for (int j = 0; j < 32; ++j) nu[j] = *(const unsigned*)(ub + (size_t)(s0 + base + j) * D);
#pragma unroll
            for (int j = 0; j < 32; ++j) {
                r0[j] = bflo(nu[j]); r1[j] = bfhi(nu[j]);
                float y0 = dbv.x, y1 = dbv.y;
#pragma unroll
                for (int k = 0; k < 31; ++k) { const int idx = (j + 2 + k) & 31; y0 += r0[idx] * w0[k]; y1 += r1[idx] * w1[k]; }
                *(LAS f32x2v*)(ybuf + j * 1024 + c0) = (f32x2v){y0, y1};
            }
            __syncthreads();
            const int ntok = 32;
            for (int j = wave; j < ntok; j += NWAVES) {
                f32x4 y[4]; float s = 0.f;
#pragma unroll
                for (int i = 0; i < 4; ++i) { y[i] = *(const LAS f32x4*)(ybuf + j * 1024 + 4 * lane + 256 * i); s += (y[i].x + y[i].y) + (y[i].z + y[i].w); }
                const float mean = wave_sum(s) * (1.f / D); float q = 0.f;
#pragma unroll
                for (int i = 0; i < 4; ++i) { y[i] = y[i] - mean; q += (y[i].x * y[i].x + y[i].y * y[i].y) + (y[i].z * y[i].z + y[i].w * y[i].w); }
                const float rstd = 1.f / sqrtf(wave_sum(q) * (1.f / D) + EPS);
                GAS unsigned* o4 = (GAS unsigned*)((unsigned char*)vout + ((size_t)b * SEQ + s0 + base + j) * D) + lane;
                GAS unsigned long long* o8 = (GAS unsigned long long*)(vout + ((size_t)b * SEQ + s0 + base + j) * D) + lane;
#pragma unroll
                for (int i = 0; i < 4; ++i) { const f32x4 lgv = *(const LAS f32x4*)(lnp + 4 * lane + 256 * i), lbv = *(const LAS f32x4*)(lnp + 1024 + 4 * lane + 256 * i); f32x4 z = y[i] * rstd * lgv + lbv;
                    z.x *= pg8::fast_sigmoid(z.x); z.y *= pg8::fast_sigmoid(z.y); z.z *= pg8::fast_sigmoid(z.z); z.w *= pg8::fast_sigmoid(z.w);
                    if (I8_P3) o4[64 * i] = pg8::pk_i8x4(z.x * SA_N, z.y * SA_N, z.z * SA_N, z.w * SA_N);
                    else o8[64 * i] = (unsigned long long)pkbf(z.x, z.y) | ((unsigned long long)pkbf(z.z, z.w) << 32); }
            }
            __syncthreads();
        }
    }
}

__device__ __forceinline__ void attn_phase(LAS unsigned char* lds, int grp, const bf16* Kb, const bf16* Vb, const bf16* Qb, bf16* Ob, unsigned char* O8, float* lse, const float* rel_bias, unsigned* qheads, int G, int vcu, int tid, int lane, int wave) {
    const int dsh = 2 * grp, dil = 1 << dsh;
    LAS unsigned char* Kl = lds + RING_OFF;
    LAS unsigned char* Vl = lds + RING_OFF + 55296;
    LAS float* btab_all = (LAS float*)(lds + XTRA_OFF);
    for (int i = tid; i < 16 * 192; i += NWAVES * 64) { const int hh = i / 192, j = i % 192, dist = 159 - j;
        btab_all[i] = (dist >= 0 && dist <= 128) ? rel_bias[(int)T5_BUCKET[grp][dist] * 48 + grp * 16 + hh] * LOG2E - SOFTMAX_OFS : -1.0e30f; }
    const int lq = lane & 31, hi = lane >> 5;
    v4u kvp[6], vvp[6];
#define ATT_DECODE(IDX, b_, h_, res_, n0_) const int bh_##b_ = (IDX) >> 4, w16_##b_ = (IDX) & 15, b_ = bh_##b_ >> 4, h_ = bh_##b_ & 15, res_ = w16_##b_ & (dil - 1), n0_ = (w16_##b_ >> dsh) * 256
#define ATT_LOAD(IDX) do { ATT_DECODE(IDX, pb, ph, pres, pn0); \
        _Pragma("unroll") for (int i = 0; i < 6; ++i) { const int cidx = tid + 512 * i, j = cidx >> 3, c16 = cidx & 7, sub = pn0 - 128 + j; \
            kvp[i] = (v4u){0u, 0u, 0u, 0u}; vvp[i] = kvp[i]; \
            if (sub >= 0) { const size_t off = ((size_t)pb * SEQ + ((size_t)sub << dsh) + pres) * D + ph * 64 + c16 * 8; kvp[i] = *(const GAS v4u*)(Kb + off); vvp[i] = *(const GAS v4u*)(Vb + off); } } } while (0)
    pg8::bf16x8 qnext[4];
#define ATT_LOADQ(IDX) do { ATT_DECODE(IDX, qb_, qh_, qres_, qn0_); const size_t qrow_ = (size_t)qb_ * SEQ + ((size_t)(qn0_ + 32 * wave + lq) << dsh) + qres_; \
        _Pragma("unroll") for (int c = 0; c < 4; ++c) qnext[c] = *(const pg8::bf16x8*)(Qb + qrow_ * D + qh_ * 64 + 16 * c + 8 * hi); } while (0)
    const bool dyn = (G == 256);
    const int xq = vcu >> 5;
    LAS int* qL = (LAS int*)(lds + XTRA_OFF + 12288 + 64);
    int idx = vcu;
    if (idx < 2048) { ATT_LOAD(idx); ATT_LOADQ(idx); }
    __syncthreads();
    while (idx < 2048) {
        int claimed = 0;
        if (dyn && tid == 0) claimed = (int)__hip_atomic_fetch_add(qheads + 16 * xq, 1u, __ATOMIC_RELAXED, __HIP_MEMORY_SCOPE_AGENT);
        ATT_DECODE(idx, b, h, res, n0);
        const int ql = 32 * wave + lq;
        const size_t qrow = (size_t)b * SEQ + ((size_t)(n0 + ql) << dsh) + res;
        pg8::bf16x8 qr[4];
#pragma unroll
        for (int c = 0; c < 4; ++c) qr[c] = qnext[c];
        __syncthreads();
#pragma unroll
        for (int i = 0; i < 6; ++i) { const int cidx = tid + 512 * i, j = cidx >> 3, c16 = cidx & 7;
            *(LAS v4u*)(Kl + j * 144 + c16 * 16) = kvp[i]; *(LAS v4u*)(Vl + (c16 >> 2) * 24576 + j * 64 + (c16 & 3) * 16) = vvp[i]; }
        if (dyn && tid == 0) qL[0] = 32 + claimed;
        __syncthreads();
        int nidx = idx + G;
        if (dyn) { const int jn = qL[0]; nidx = jn < 256 ? ((jn >> 5) << 8) + (xq << 5) + (jn & 31) : 2048; }
        if (nidx < 2048) ATT_LOAD(nidx);
        float sv[5][16]; float m = -3.0e38f;
        const int kofs = n0 - 128 + 32 * wave;
        const LAS float* brow = btab_all + h * 192 + (31 - lq + 4 * hi);
#pragma unroll
        for (int kt = 0; kt < 5; ++kt) {
            f32x16 S = (f32x16){0.f, 0.f, 0.f, 0.f, 0.f, 0.f, 0.f, 0.f, 0.f, 0.f, 0.f, 0.f, 0.f, 0.f, 0.f, 0.f};
#pragma unroll
            for (int c = 0; c < 4; ++c) { const pg8::bf16x8 a = *(const LAS pg8::bf16x8*)(Kl + (32 * wave + 32 * kt + lq) * 144 + (16 * c + 8 * hi) * 2);
                S = __builtin_amdgcn_mfma_f32_32x32x16_bf16(a, qr[c], S, 0, 0, 0); }
#pragma unroll
            for (int r = 0; r < 16; ++r) { const float s = S[r] + brow[32 * kt + (r & 3) + 8 * (r >> 2)]; sv[kt][r] = s; }
            __builtin_amdgcn_sched_barrier(0);
        }
        if (kofs < 0) {
#pragma unroll
            for (int kt = 0; kt < 5; ++kt)
#pragma unroll
                for (int r = 0; r < 16; ++r) { const int kk = 32 * kt + crow(r, hi); if (kofs + kk < 0) sv[kt][r] = -1.0e30f; }
        }
        m = SOFTMAX_OFS;
        float l = 0.f; unsigned pw[5][8];
#pragma unroll
        for (int kt = 0; kt < 5; ++kt) {
#pragma unroll
            for (int r = 0; r < 16; r += 2) { const float p0 = __builtin_amdgcn_exp2f(sv[kt][r]), p1 = __builtin_amdgcn_exp2f(sv[kt][r + 1]); l += p0 + p1; pw[kt][r >> 1] = pkbf(p0, p1); }
            __builtin_amdgcn_sched_barrier(0);
        }
        l += __shfl_xor(l, 32);
        f32x16 O0 = (f32x16){0.f, 0.f, 0.f, 0.f, 0.f, 0.f, 0.f, 0.f, 0.f, 0.f, 0.f, 0.f, 0.f, 0.f, 0.f, 0.f}, O1 = O0;
        const int vlane = ((lane & 15) >> 2) * 64 + ((lane >> 4) & 1) * 32 + (lane & 3) * 8;
#pragma unroll
        for (int kt = 0; kt < 5; ++kt)
#pragma unroll
            for (int s2 = 0; s2 < 2; ++s2) {
                v4u pq; pq.x = pw[kt][4 * s2 + 0]; pq.y = pw[kt][4 * s2 + 1]; pq.z = pw[kt][4 * s2 + 2]; pq.w = pw[kt][4 * s2 + 3];
                const pg8::bf16x8 pf = __builtin_bit_cast(pg8::bf16x8, pq);
                const int vrow = 32 * wave + 32 * kt + 16 * s2 + 4 * hi;
                LAS unsigned char* vp = Vl + vrow * 64 + vlane;
                const v4i16_t a0 = __builtin_amdgcn_ds_read_tr16_b64_v4i16((LAS v4i16_t*)(vp)), a1 = __builtin_amdgcn_ds_read_tr16_b64_v4i16((LAS v4i16_t*)(vp + 512));
                const v4i16_t b0 = __builtin_amdgcn_ds_read_tr16_b64_v4i16((LAS v4i16_t*)(vp + 24576)), b1 = __builtin_amdgcn_ds_read_tr16_b64_v4i16((LAS v4i16_t*)(vp + 24576 + 512));
                const pg8::bf16x8 vf0 = (pg8::bf16x8){a0[0], a0[1], a0[2], a0[3], a1[0], a1[1], a1[2], a1[3]};
                const pg8::bf16x8 vf1 = (pg8::bf16x8){b0[0], b0[1], b0[2], b0[3], b1[0], b1[1], b1[2], b1[3]};
                O0 = __builtin_amdgcn_mfma_f32_32x32x16_bf16(vf0, pf, O0, 0, 0, 0);
                O1 = __builtin_amdgcn_mfma_f32_32x32x16_bf16(vf1, pf, O1, 0, 0, 0);
                __builtin_amdgcn_sched_barrier(0);
            }
        if (nidx < 2048) ATT_LOADQ(nidx);
        const float inv_l = 1.f / l, lse2 = m + __builtin_amdgcn_logf(l);
        const size_t orow = qrow;
        v4u oldv[4];
        if (grp != 0) {
#pragma unroll
            for (int i = 0; i < 4; ++i) { const int ch = lane + 64 * i, qq = ch >> 3, c8 = ch & 7; oldv[i] = *(const GAS v4u*)(Ob + ((size_t)b * SEQ + ((size_t)(n0 + 32 * wave + qq) << dsh) + res) * D + h * 64 + c8 * 8); } }
        float co = 0.f, cg = inv_l, lnew = lse2;
        if (grp != 0) { const float lo_ = lse[orow * 16 + h]; const float M = fmaxf(lo_, lse2); const float wo = __builtin_amdgcn_exp2f(lo_ - M), wg = __builtin_amdgcn_exp2f(lse2 - M), den = wo + wg;
            co = wo / den; cg = wg / den * inv_l; lnew = M + __builtin_amdgcn_logf(den); }
        __syncthreads();
        LAS unsigned char* stg = Kl + wave * 4608;
        LAS float* cot = (LAS float*)(Kl + 8 * 4608) + wave * 32;
#pragma unroll
        for (int rg = 0; rg < 4; ++rg) {
            pg8::u32x2 wa, wb; wa.x = pkbf(O0[4 * rg] * cg, O0[4 * rg + 1] * cg); wa.y = pkbf(O0[4 * rg + 2] * cg, O0[4 * rg + 3] * cg);
            wb.x = pkbf(O1[4 * rg] * cg, O1[4 * rg + 1] * cg); wb.y = pkbf(O1[4 * rg + 2] * cg, O1[4 * rg + 3] * cg);
            *(LAS pg8::u32x2*)(stg + lq * 144 + (8 * rg + 4 * hi) * 2) = wa; *(LAS pg8::u32x2*)(stg + lq * 144 + (32 + 8 * rg + 4 * hi) * 2) = wb; }
        if (hi == 0) cot[lq] = co;
        if (hi == 0) lse[orow * 16 + h] = lnew;
#pragma unroll
        for (int i = 0; i < 4; ++i) { const int ch = lane + 64 * i, qq = ch >> 3, c8 = ch & 7;
            const v4u sv4 = *(const LAS v4u*)(stg + qq * 144 + c8 * 16);
            bf16* op = Ob + ((size_t)b * SEQ + ((size_t)(n0 + 32 * wave + qq) << dsh) + res) * D + h * 64 + c8 * 8;
            v4u ov = sv4;
            if (grp != 0) { const float cq = cot[qq]; const v4u old = oldv[i];
                ov.x = pkbf(bflo(sv4.x) + cq * bflo(old.x), bfhi(sv4.x) + cq * bfhi(old.x)); ov.y = pkbf(bflo(sv4.y) + cq * bflo(old.y), bfhi(sv4.y) + cq * bfhi(old.y));
                ov.z = pkbf(bflo(sv4.z) + cq * bflo(old.z), bfhi(sv4.z) + cq * bfhi(old.z)); ov.w = pkbf(bflo(sv4.w) + cq * bflo(old.w), bfhi(sv4.w) + cq * bfhi(old.w)); }
            if (grp == 2) { unsigned char* o8 = O8 + ((size_t)b * SEQ + ((size_t)(n0 + 32 * wave + qq) << dsh) + res) * D + h * 64 + c8 * 8;
                pg8::u32x2 w8; w8.x = pg8::pk_fp8x4(bflo(ov.x) * O8_SCALE, bfhi(ov.x) * O8_SCALE, bflo(ov.y) * O8_SCALE, bfhi(ov.y) * O8_SCALE); w8.y = pg8::pk_fp8x4(bflo(ov.z) * O8_SCALE, bfhi(ov.z) * O8_SCALE, bflo(ov.w) * O8_SCALE, bfhi(ov.w) * O8_SCALE);
                *(GAS pg8::u32x2*)o8 = w8; }
            else *(GAS v4u*)op = ov; }
        idx = nidx;
    }
    __syncthreads();
#undef ATT_DECODE
#undef ATT_LOAD
#undef ATT_LOADQ
}

__device__ __forceinline__ void route_phase(const float* x3, const float* gnorm, const float* wr, unsigned char* ws, LAS unsigned char* lds, int G, int vcu, int tid, int lane, int wave) {
    LAS float* WrT = (LAS float*)(lds + RING_OFF);
    LAS unsigned* wcL = (LAS unsigned*)(lds + RING_OFF + 32768);
    for (int i = tid; i < 8192; i += NWAVES * 64) { const int e = i >> 10, k = i & 1023; WrT[i] = wr[k * 8 + e] * gnorm[k]; }
    __syncthreads();
    unsigned* route = (unsigned*)(ws + WS_ROUTE); float* gate1 = (float*)(ws + WS_GATE1); float* gate2 = (float*)(ws + WS_GATE2);
    unsigned* wavecnt = (unsigned*)(ws + WS_WAVECNT); int* blockcnt = (int*)(ws + WS_BLOCKCNT); unsigned char* H3 = ws + WS_H3;
    const int gw = vcu * NWAVES + wave, NGW = G * NWAVES, tpw = (T + NGW - 1) / NGW;
    const int t0 = gw * tpw, t1 = (t0 + tpw) < T ? (t0 + tpw) : T;
    f32x4 gv[4];
#pragma unroll
    for (int j = 0; j < 4; ++j) gv[j] = *(const f32x4*)(gnorm + 4 * lane + 256 * j);
    unsigned long long cnt0 = 0ull, cnt1 = 0ull;
    f32x4 vn[4];
    if (t0 < t1) { const GAS f32x4* xr = (const GAS f32x4*)(x3 + (size_t)t0 * D) + lane;
#pragma unroll
        for (int j = 0; j < 4; ++j) vn[j] = xr[64 * j]; }
    for (int t = t0; t < t1; ++t) {
        f32x4 v[4]; float ss = 0.f;
#pragma unroll
        for (int j = 0; j < 4; ++j) { v[j] = vn[j]; ss += (v[j].x * v[j].x + v[j].y * v[j].y) + (v[j].z * v[j].z + v[j].w * v[j].w); }
        if (t + 1 < t1) { const GAS f32x4* xr = (const GAS f32x4*)(x3 + (size_t)(t + 1) * D) + lane;
#pragma unroll
            for (int j = 0; j < 4; ++j) vn[j] = xr[64 * j]; }
        float dt[8];
#pragma unroll
        for (int e = 0; e < 8; ++e) { float a = 0.f;
#pragma unroll
            for (int j = 0; j < 4; ++j) { const f32x4 w = *(const LAS f32x4*)(WrT + e * 1024 + 4 * lane + 256 * j); a += (v[j].x * w.x + v[j].y * w.y) + (v[j].z * w.z + v[j].w * w.w); }
            dt[e] = a; }
        ss = wave_sum(ss);
#pragma unroll
        for (int e = 0; e < 8; ++e) dt[e] = wave_sum(dt[e]);
        const float rstd = 1.f / sqrtf(ss * (1.f / D) + EPS);
        GAS unsigned* o4 = (GAS unsigned*)(H3 + (size_t)t * D) + lane;
#pragma unroll
        for (int j = 0; j < 4; ++j) { const f32x4 y = v[j] * (rstd * SA_N) * gv[j]; o4[64 * j] = pg8::pk_i8x4(y.x, y.y, y.z, y.w); }
        int e1 = 0; float v1 = dt[0] * rstd;
#pragma unroll
        for (int e = 1; e < 8; ++e) { const float x = dt[e] * rstd; if (x > v1) { v1 = x; e1 = e; } }
        int e2 = -1; float v2 = -3.0e38f;
#pragma unroll
        for (int e = 0; e < 8; ++e) { const float x = dt[e] * rstd; if (e != e1 && x > v2) { v2 = x; e2 = e; } }
        const float g2 = 1.f / (1.f + __expf(v1 - v2)), g1 = 1.f - g2;
        cnt0 += 1ull << (8 * e1); cnt1 += 1ull << (8 * e2);
        if (lane == 0) { route[t] = (unsigned)e1 | ((unsigned)e2 << 8); gate1[t] = g1; gate2[t] = g2; }
    }
    if (lane == 0) { v4u c; c.x = (unsigned)cnt0; c.y = (unsigned)(cnt0 >> 32); c.z = (unsigned)cnt1; c.w = (unsigned)(cnt1 >> 32);
        *(GAS v4u*)(wavecnt + (size_t)gw * 4) = c; wcL[wave * 4 + 0] = c.x; wcL[wave * 4 + 1] = c.y; wcL[wave * 4 + 2] = c.z; wcL[wave * 4 + 3] = c.w; }
    __syncthreads();
    if (tid < 16) { const int slot = tid >> 3, e = tid & 7; int s = 0;
#pragma unroll
        for (int w = 0; w < NWAVES; ++w) s += (int)((wcL[w * 4 + slot * 2 + (e >> 2)] >> (8 * (e & 3))) & 255u);
        blockcnt[vcu * 16 + tid] = s; }
    __syncthreads();
}

__device__ __forceinline__ void pos_phase(unsigned char* ws, LAS unsigned char* lds, int G, int vcu, int tid, int lane, int wave) {
    LAS int* cntL = (LAS int*)(lds + RING_OFF);
    LAS int* pAll = (LAS int*)(lds + RING_OFF + 65536);
    LAS int* pBef = pAll + 512;
    LAS int* totL = pBef + 512;
    const int* blockcnt = (const int*)(ws + WS_BLOCKCNT); const unsigned* wavecnt = (const unsigned*)(ws + WS_WAVECNT);
    const unsigned* route = (const unsigned*)(ws + WS_ROUTE); const float* gate1 = (const float*)(ws + WS_GATE1); const float* gate2 = (const float*)(ws + WS_GATE2);
    int* gofs = (int*)(ws + WS_GOFS);
    for (int i = tid; i < G * 16; i += NWAVES * 64) cntL[i] = blockcnt[i];
    __syncthreads();
    { const int c = tid & 15, part = tid >> 4, bpp = (G + 31) / 32; int sa = 0, sb = 0;
      for (int bb = part * bpp; bb < (part + 1) * bpp && bb < G; ++bb) { const int v = cntL[bb * 16 + c]; sa += v; if (bb < vcu) sb += v; }
      pAll[part * 16 + c] = sa; pBef[part * 16 + c] = sb; }
    __syncthreads();
    if (tid < 16) { int sa = 0, sb = 0;
        for (int p = 0; p < 32; ++p) { sa += pAll[p * 16 + tid]; sb += pBef[p * 16 + tid]; }
        totL[tid] = sa; totL[16 + tid] = sb; }
    __syncthreads();
    if (tid == 0) { int off = 0;
        for (int e = 0; e < 8; ++e) { totL[32 + e] = off; totL[32 + 8 + e] = off + totL[e]; if (vcu == 0) { gofs[e] = off; gofs[8 + e] = off + totL[e]; gofs[32 + e] = off >> 8; } off += ((totL[e] + totL[8 + e] + 255) >> 8) << 8; }
        if (vcu == 0) gofs[16] = off >> 8; }
    __syncthreads();
    const int gw = vcu * NWAVES + wave, NGW = G * NWAVES, tpw = (T + NGW - 1) / NGW;
    const int t0 = gw * tpw, t1 = (t0 + tpw) < T ? (t0 + tpw) : T;
    int mypos = 0;
    if (lane < 16) { mypos = totL[32 + lane] + totL[16 + lane];
        for (int w = 0; w < wave; ++w) mypos += (int)((wavecnt[(size_t)(vcu * NWAVES + w) * 4 + (lane >> 3) * 2 + ((lane & 7) >> 2)] >> (8 * (lane & 3))) & 255u); }
    int* pos01 = (int*)(ws + WS_POS);
    int* rowtok0 = (int*)(ws + WS_ROWTOK); int* rowtok1 = rowtok0; float* rowgate0 = (float*)(ws + WS_ROWGATE); float* rowgate1 = rowgate0;
    for (int t = t0; t < t1; ++t) {
        const unsigned rt = route[t]; const int e1 = (int)(rt & 255u), e2 = (int)((rt >> 8) & 255u);
        const int p1 = __shfl(mypos, e1), p2 = __shfl(mypos, 8 + e2);
        if (lane == e1 || lane == 8 + e2) mypos += 1;
        if (lane == 0) { rowtok0[p1] = t; rowgate0[p1] = gate1[t]; rowtok1[p2] = t; rowgate1[p2] = gate2[t]; pos01[t] = p1; pos01[T + t] = p2; }
    }
    if (vcu < 8) { int* rtk = (int*)(ws + WS_ROWTOK); float* rgt = (float*)(ws + WS_ROWGATE);
        const int beg = totL[32 + vcu] + totL[vcu] + totL[8 + vcu], end = totL[32 + vcu] + (((totL[vcu] + totL[8 + vcu] + 255) >> 8) << 8);
        for (int i = beg + tid; i < end; i += NWAVES * 64) { rtk[i] = -1; rgt[i] = 0.f; } }
    __syncthreads();
}

__device__ __forceinline__ void combine_phase(float* out, unsigned char* ws, int G, int vcu, int tid, int lane, int wave) {
    const int* pos01 = (const int*)(ws + WS_POS); const unsigned char* Y = ws + WS_Y;
    const int gw = vcu * NWAVES + wave, NGW = G * NWAVES; const float ys = 1.f / Y_SCALE;
    for (int t0 = gw * 4; t0 < T; t0 += NGW * 4) {
        v4u ya[4], yb[4]; f32x4 o[4][4];
#pragma unroll
        for (int q = 0; q < 4; ++q) { const int t = t0 + q; const int p0 = pos01[t], p1 = pos01[T + t];
            ya[q] = *(const GAS v4u*)(Y + (size_t)p0 * 1024 + 16 * lane); yb[q] = *(const GAS v4u*)(Y + (size_t)p1 * 1024 + 16 * lane);
#pragma unroll
            for (int j = 0; j < 4; ++j) o[q][j] = *(const GAS f32x4*)(out + (size_t)t * 1024 + 16 * lane + 4 * j); }
#pragma unroll
        for (int q = 0; q < 4; ++q)
#pragma unroll
            for (int j = 0; j < 4; ++j) { const unsigned a = ya[q][j], c = yb[q][j]; f32x4 x = o[q][j];
                x.x += (float)(((int)(a << 24) >> 24) + ((int)(c << 24) >> 24)) * ys; x.y += (float)(((int)(a << 16) >> 24) + ((int)(c << 16) >> 24)) * ys;
                x.z += (float)(((int)(a << 8) >> 24) + ((int)(c << 8) >> 24)) * ys; x.w += (float)(((int)a >> 24) + ((int)c >> 24)) * ys;
                __builtin_nontemporal_store(x, (GAS f32x4*)(out + (size_t)(t0 + q) * 1024 + 16 * lane + 4 * j)); }
    }
}

constexpr int N_LAUNCHES = MK_N_LAUNCHES;
struct Args { const float* in[26]; float* out; unsigned char* ws; int ph_lo, ph_hi; };
typedef const __attribute__((address_space(4))) unsigned char* kargp_t;
#ifdef PROBE_CLK_PHASE
#define CLK_BEGIN(k) unsigned long long ck0_ = 0, rt0_ = 0; if ((k) == PROBE_CLK_PHASE) { ck0_ = __builtin_amdgcn_s_memtime(); rt0_ = __builtin_amdgcn_s_memrealtime(); }
#define CLK_END(k) if ((k) == PROBE_CLK_PHASE && bx == 0 && tid == 0) { const unsigned long long ck1_ = __builtin_amdgcn_s_memtime(), rt1_ = __builtin_amdgcn_s_memrealtime(); const float qv_ = floorf((float)(ck1_ - ck0_) / (float)(rt1_ - rt0_) + 0.5f); ((float*)(ws + WS_GOFS))[100] = 100.f * qv_ * qv_; }
#else
#define CLK_BEGIN(k)
#define CLK_END(k)
#endif
#define PH_ENTER() kargp_t kp_ = kp0; asm volatile("" : "+s"(kp_)); int tid = tid0; asm volatile("" : "+v"(tid)); const int lane = tid & 63, wave = __builtin_amdgcn_readfirstlane(tid >> 6); \
    unsigned char* ws = *(unsigned char* const __attribute__((address_space(4)))*)(kp_ + 216); float* out = *(float* const __attribute__((address_space(4)))*)(kp_ + 208); (void)lane; (void)wave; (void)out
#define INP(i) (*(const float* const __attribute__((address_space(4)))*)(kp_ + 8 * (i)))
__global__ void __launch_bounds__(NWAVES * 64, 2) mk_fwd(Args args) {
    extern __shared__ __attribute__((aligned(16))) unsigned char lds_raw[];
    LAS unsigned char* lds = (LAS unsigned char*)lds_raw;
    static_assert(sizeof(Args) == 232 && __builtin_offsetof(Args, out) == 208 && __builtin_offsetof(Args, ws) == 216, "Args layout");
    const kargp_t kp0 = (kargp_t)__builtin_amdgcn_kernarg_segment_ptr();
    const int tid0 = threadIdx.x;
    const int G = gridDim.x, bx = blockIdx.x, vcu = (G % 8 == 0) ? (bx % 8) * (G / 8) + bx / 8 : bx;
    for (int u = tid0; u < (XTRA_OFF - LDSCTL_OFF) / 4; u += NWAVES * 64) ((LAS unsigned*)(lds + LDSCTL_OFF))[u] = 0u;
    __syncthreads();
    XcdBarrier bar; bar.bar = (unsigned*)(args.ws + WS_CTL) + CW_BAR; bar.x = 0; bar.st = (volatile LAS unsigned*)(lds + MISC_OFF) + 8;
    if (N_LAUNCHES == 1) bar = xcd_barrier_post((unsigned*)(args.ws + WS_CTL) + CW_BAR, (volatile LAS unsigned*)(lds + MISC_OFF) + 8);
#define GRID_BAR() do { if (N_LAUNCHES == 1) xcd_barrier(bar); } while (0)
    const int lo = args.ph_lo, hi = args.ph_hi;
#ifndef PH_MASK
#define PH_MASK 0xFFFFFFFFu
#endif
#define IN(k) (((PH_MASK >> (k)) & 1u) && lo <= (k) && (k) < hi)
#define BOTH(k) (IN(k) && IN((k) + 1))
#ifndef PROBE_NOEPI
#define PROBE_NOEPI 0
#endif
#ifndef PROBE_REP_MASK
#define PROBE_REP_MASK 0u
#define PROBE_REP_N 1
#endif
#define REPS(k) (((PROBE_REP_MASK >> (k)) & 1u) ? PROBE_REP_N : 1)

    _Pragma("nounroll") for (int rep_ = 0; rep_ < REPS(0); ++rep_) if (IN(0)) { PH_ENTER(); CLK_BEGIN(0); p0_prologue(kp_, ws, lds, G, vcu, tid, lane, wave); __syncthreads(); CLK_END(0); if (BOTH(0)) GRID_BAR(); }
    _Pragma("nounroll") for (int rep_ = 0; rep_ < REPS(1); ++rep_) if (IN(1)) { PH_ENTER(); CLK_BEGIN(1);
        pg8::Gemm g{(const bf16*)(ws + WS_H0), (const bf16*)(ws + WS_WIN), T, 2048, 1024, 0, nullptr, nullptr, nullptr, nullptr, 0}; pg8::StaticOrder S; S.init(T, 2048, G, bx, I8_P1 ? 1024 / 128 : 1024 / 64);
        pg8::EpiGated<0> E{(bf16*)(ws + WS_GLU), 1024, INP(4), 1024, nullptr, I8_P1 ? 1.f / (SA_N * SW_I8) : 1.f, 1.f, {}, -1};
        pg8::gemm_phase<pg8::EpiGated<0>, pg8::StaticOrder, false, I8_P1 ? 2 : 0>(lds + RING_OFF, g, S, E, tid);
        CLK_END(1); if (BOTH(1)) GRID_BAR();
    }
    _Pragma("nounroll") for (int rep_ = 0; rep_ < REPS(2); ++rep_) if (IN(2)) { PH_ENTER(); CLK_BEGIN(2); conv_phase((const bf16*)(ws + WS_GLU), INP(5), INP(6), INP(7), INP(8), (bf16*)(ws + WS_V), lds, G, vcu, tid, lane, wave); CLK_END(2); if (BOTH(2)) GRID_BAR(); }
    _Pragma("nounroll") for (int rep_ = 0; rep_ < REPS(3); ++rep_) if (IN(3)) { PH_ENTER(); CLK_BEGIN(3);
        pg8::Gemm g{(const bf16*)(ws + WS_V), (const bf16*)(ws + WS_WOUT), T, 1024, 1024, 0, nullptr, nullptr, nullptr, nullptr, 0}; pg8::StaticOrder S; S.init(T, 1024, G, bx, I8_P3 ? 1024 / 128 : 1024 / 64);
        pg8::EpiResid<true, true, I8_P4 ? 2 : 0> E{INP(0), out, INP(10), ws + WS_X1B, (float*)(ws + WS_PART1), I8_P3 ? 1.f / (SA_N * SW_I8) : 1.f, I8_P4 ? SA_X : 1.f, (LAS float*)(lds + XTRA_OFF)};
        pg8::gemm_phase<pg8::EpiResid<true, true, I8_P4 ? 2 : 0>, pg8::StaticOrder, false, I8_P3 ? 2 : 0>(lds + RING_OFF, g, S, E, tid);
        CLK_END(3); if (BOTH(3)) GRID_BAR();
    }
    _Pragma("nounroll") for (int rep_ = 0; rep_ < REPS(4); ++rep_) if (IN(4)) { PH_ENTER(); CLK_BEGIN(4);
        pg8::Gemm g{(const bf16*)(ws + WS_X1B), (const bf16*)(ws + WS_WF13), T, 5632, 1024, 0, nullptr, nullptr, nullptr, nullptr, 0}; pg8::StaticOrder S; S.init(T, 5632, G, bx, I8_P4 ? 1024 / 128 : 1024 / 64);
        pg8::EpiGated<1> E{(bf16*)(ws + WS_HB), DFFP, nullptr, 0, (const float*)(ws + WS_PART1), I8_P4 ? 1.f / (SA_X * SW_I8) : 1.f, 1.f, {}, -1};
        if (G == 256) {
            const int slot = vcu % 11;
            S.i1 = slot;
            pg8::gemm_phase<pg8::EpiGated<1>, pg8::StaticOrder, false, I8_P4 ? 2 : 0>(lds + RING_OFF, g, S, E, tid);
            __syncthreads();
            p0_items2(kp_, ws, (LAS float*)(lds + RING_OFF + wave * 16384), wave, NWAVES, vcu * (IT_MOE / 256), (vcu + 1) * (IT_MOE / 256), lane);
            __syncthreads();
            S.i0 = slot; S.i1 = 0x7fffffff;
        }
        pg8::gemm_phase<pg8::EpiGated<1>, pg8::StaticOrder, false, I8_P4 ? 2 : 0>(lds + RING_OFF, g, S, E, tid);
        CLK_END(4); if (BOTH(4)) GRID_BAR();
    }
    _Pragma("nounroll") for (int rep_ = 0; rep_ < REPS(5); ++rep_) if (IN(5)) { PH_ENTER(); CLK_BEGIN(5);
        pg8::Gemm g{(const bf16*)(ws + WS_HB), (const bf16*)(ws + WS_WFD), T, 1024, DFFP, 0, nullptr, nullptr, nullptr, nullptr, 0}; pg8::StaticOrder S; S.init(T, 1024, G, bx, DFFP / 64);
        pg8::EpiResid<false, true, 2> E{out, out, nullptr, ws + WS_X2B, (float*)(ws + WS_PART2), 1.f, SA_X, (LAS float*)(lds + XTRA_OFF)};
        pg8::gemm_phase<pg8::EpiResid<false, true, 2>, pg8::StaticOrder, false>(lds + RING_OFF, g, S, E, tid);
        CLK_END(5); if (BOTH(5)) GRID_BAR();
    }
    for (int grp = 0; grp < 3; ++grp) {
        _Pragma("nounroll") for (int rep_ = 0; rep_ < REPS(6 + 2 * grp); ++rep_) if (IN(6 + 2 * grp)) { PH_ENTER(); CLK_BEGIN(6 + 2 * grp);
            pg8::Gemm g{(const bf16*)(ws + WS_X2B), (const bf16*)(ws + WS_WQKV + (size_t)grp * 3072 * 1024), T, 3072, 1024, 0, nullptr, nullptr, nullptr, nullptr, 0}; pg8::StaticOrder S; S.init(T, 3072, G, bx, 1024 / 128);
            pg8::EpiQKV E{(bf16*)(ws + WS_KG), (size_t)T * D, (const float*)(ws + WS_PART2), INP(13) + grp * 64, INP(16) + grp * 64, QSCALE, 1.f / (SA_X * SW_I8), {}, -1};
            pg8::gemm_phase<pg8::EpiQKV, pg8::StaticOrder, false, 2>(lds + RING_OFF, g, S, E, tid);
            CLK_END(6 + 2 * grp); if (BOTH(6 + 2 * grp)) GRID_BAR();
        }
        _Pragma("nounroll") for (int rep_ = 0; rep_ < REPS(7 + 2 * grp); ++rep_) if (IN(7 + 2 * grp)) { PH_ENTER(); CLK_BEGIN(7 + 2 * grp);
            attn_phase(lds, grp, (const bf16*)(ws + WS_KG), (const bf16*)(ws + WS_VG), (const bf16*)(ws + WS_QG), (bf16*)(ws + WS_O), ws + WS_O8, (float*)(ws + WS_LSE), INP(1), (unsigned*)(ws + WS_CTL) + CW_AQ + grp * 128, G, vcu, tid, lane, wave);
            CLK_END(7 + 2 * grp); if (BOTH(7 + 2 * grp)) GRID_BAR();
        }
    }
    _Pragma("nounroll") for (int rep_ = 0; rep_ < REPS(12); ++rep_) if (IN(12)) { PH_ENTER(); CLK_BEGIN(12);
        pg8::Gemm g{(const bf16*)(ws + WS_O8), (const bf16*)(ws + WS_WO), T, 1024, 1024, 0, nullptr, nullptr, nullptr, nullptr, 0}; pg8::StaticOrder S; S.init(T, 1024, G, bx, 1024 / 128);
        pg8::EpiResid<false, false> E{out, out, nullptr, nullptr, nullptr, 1.f / (W8_SCALE * O8_SCALE), 1.f, nullptr};
        pg8::gemm_phase<pg8::EpiResid<false, false>, pg8::StaticOrder, false, 1>(lds + RING_OFF, g, S, E, tid);
        CLK_END(12); if (BOTH(12)) GRID_BAR();
    }
    _Pragma("nounroll") for (int rep_ = 0; rep_ < REPS(13); ++rep_) if (IN(13)) { PH_ENTER(); CLK_BEGIN(13); route_phase(out, INP(18) + 1024, INP(22), ws, lds, G, vcu, tid, lane, wave); CLK_END(13); if (BOTH(13)) GRID_BAR(); }
    _Pragma("nounroll") for (int rep_ = 0; rep_ < REPS(14); ++rep_) if (IN(14)) { PH_ENTER(); CLK_BEGIN(14); pos_phase(ws, lds, G, vcu, tid, lane, wave); CLK_END(14); if (BOTH(14)) GRID_BAR(); }
    _Pragma("nounroll") for (int rep_ = 0; rep_ < REPS(15); ++rep_) if (IN(15)) { PH_ENTER(); CLK_BEGIN(15);
        const int* gofs = (const int*)(ws + WS_GOFS); const int* rowtok = (const int*)(ws + WS_ROWTOK);
        const int ntile = gofs[16];
        pg8::MoeOrder S; S.so.init(ntile * 256, 7168, G, bx, 1024 / 128); S.p0 = 0; S.p1 = 0; S.ppu = 0;
        S.t1 = gofs[32 + 1]; S.t2 = gofs[32 + 2]; S.t3 = gofs[32 + 3]; S.t4 = gofs[32 + 4]; S.t5 = gofs[32 + 5]; S.t6 = gofs[32 + 6]; S.t7 = gofs[32 + 7];
        pg8::Gemm g{(const bf16*)(ws + WS_H3), (const bf16*)(ws + WS_WM13), ntile * 256, 7168, 1024, (size_t)7168 * 1024, rowtok, nullptr, nullptr, nullptr, 0};
        pg8::EpiGated<3> E{(bf16*)(ws + WS_HM), DFFE, nullptr, 0, nullptr, 1.f / (SA_N * SW_I8), HM_SCALE, {}, -1};
        pg8::gemm_phase<pg8::EpiGated<3>, pg8::MoeOrder, true, 2>(lds + RING_OFF, g, S, E, tid);
        CLK_END(15); if (BOTH(15)) GRID_BAR();
    }
    _Pragma("nounroll") for (int rep_ = 0; rep_ < REPS(16); ++rep_) if (IN(16)) { PH_ENTER(); CLK_BEGIN(16);
        const int* gofs = (const int*)(ws + WS_GOFS); const float* rowgate = (const float*)(ws + WS_ROWGATE);
        const int ntile = gofs[16];
        pg8::MoeOrderSK S; S.so.init(ntile * 256, 1024, G, vcu, DFFE / 128); S.plan();
        S.t1 = gofs[32 + 1]; S.t2 = gofs[32 + 2]; S.t3 = gofs[32 + 3]; S.t4 = gofs[32 + 4]; S.t5 = gofs[32 + 5]; S.t6 = gofs[32 + 6]; S.t7 = gofs[32 + 7];
        pg8::Gemm g{(const bf16*)(ws + WS_HM), (const bf16*)(ws + WS_WM2), ntile * 256, 1024, DFFE, (size_t)1024 * DFFE, nullptr, ws + WS_SLAB, (unsigned*)(ws + WS_CTL) + CW_SKFLAG + (rep_ & 1) * 8192, (unsigned*)(ws + WS_CTL) + CW_TMO, 0};
        pg8::EpiMoeDown E{ws + WS_Y, rowgate, Y_SCALE / (W8_SCALE * HM_SCALE)};
        pg8::gemm_phase<pg8::EpiMoeDown, pg8::MoeOrderSK, false, 1>(lds + RING_OFF, g, S, E, tid);
        CLK_END(16); if (BOTH(16)) GRID_BAR();
    }
    _Pragma("nounroll") for (int rep_ = 0; rep_ < REPS(17); ++rep_) if (IN(17)) { PH_ENTER(); CLK_BEGIN(17); combine_phase(out, ws, G, vcu, tid, lane, wave); }
#ifdef PROBE_CLK_PHASE
    if (bx == 0 && tid0 == 0) { asm volatile("s_waitcnt vmcnt(0)" ::: "memory"); args.out[(size_t)T * D - 1] = ((float*)(args.ws + WS_GOFS))[100]; }
#endif
#ifdef PROBE_TCH
    {
        GRID_BAR();
        if (bx == 0 && tid0 == 0) { const unsigned tot = __hip_atomic_load((unsigned*)(args.ws + WS_CTL) + 60000, __ATOMIC_RELAXED, __HIP_MEMORY_SCOPE_AGENT); const unsigned long long wait_ticks = (unsigned long long)(tot / (unsigned)G) * PROBE_TCH;
            const unsigned long long t0_ = __builtin_amdgcn_s_memrealtime(); while (__builtin_amdgcn_s_memrealtime() - t0_ < wait_ticks) __builtin_amdgcn_s_sleep(8); } }
#endif
#undef IN
#undef BOTH
#undef GRID_BAR
}

extern "C" void kernel_launch(void* const* d_in, const int* in_sizes, int n_in, void* d_out, int out_size, void* d_ws, size_t ws_size, hipStream_t stream) {
    static int grid = 0;
    if (grid == 0) {
        if (n_in != 26 || in_sizes[0] != T * D || out_size != T * D || ws_size < WS_END) { fprintf(stderr, "kernel_launch: unexpected shapes: n_in %d in0 %d out %d ws %zu (need >= %zu); nothing launched\n", n_in, n_in > 0 ? in_sizes[0] : -1, out_size, ws_size, (size_t)WS_END); grid = -1; return; }
        int dev = 0, cus = 0;
        if (hipGetDevice(&dev) != hipSuccess || hipDeviceGetAttribute(&cus, hipDeviceAttributeMultiprocessorCount, dev) != hipSuccess) { fprintf(stderr, "kernel_launch: device query failed\n"); grid = -1; return; }
        if (hipFuncSetAttribute((const void*)mk_fwd, hipFuncAttributeMaxDynamicSharedMemorySize, LDS_BYTES) != hipSuccess) { fprintf(stderr, "kernel_launch: hipFuncSetAttribute failed\n"); grid = -1; return; }
        int per_cu = 0;
        if (hipOccupancyMaxActiveBlocksPerMultiprocessor(&per_cu, (const void*)mk_fwd, NWAVES * 64, LDS_BYTES) != hipSuccess || per_cu < 1) fprintf(stderr, "kernel_launch: note: occupancy query reports %d workgroups per CU\n", per_cu);
        (void)hipGetLastError();
        grid = cus;
    }
    if (grid < 0) return;
    if (hipMemsetAsync((char*)d_ws + WS_CTL, 0, CTL_ZERO_BYTES, stream) != hipSuccess) { fprintf(stderr, "kernel_launch: hipMemsetAsync failed\n"); return; }
    Args a{};
    for (int i = 0; i < 26; ++i) a.in[i] = (const float*)d_in[i];
    a.out = (float*)d_out; a.ws = (unsigned char*)d_ws;
    for (int li = 0; li < N_LAUNCHES; ++li) {
        a.ph_lo = (N_LAUNCHES == 1) ? 0 : li; a.ph_hi = (N_LAUNCHES == 1) ? NPHASE : li + 1;
        hipLaunchKernelGGL(mk_fwd, dim3(grid), dim3(NWAVES * 64), LDS_BYTES, stream, a);
        const hipError_t le = hipPeekAtLastError();
        if (le != hipSuccess) { fprintf(stderr, "kernel_launch: launch %d failed: %s\n", li, hipGetErrorName(le)); break; }
    }
}
```

```cpp
#include <hip/hip_runtime.h>
#include <cstdio>
#include <cstdint>
#ifndef MK_N_LAUNCHES
#define MK_N_LAUNCHES 1
#endif
namespace pg8 {
#define PG8_LAS __attribute__((address_space(3)))
#define PG8_GAS __attribute__((address_space(1)))
typedef unsigned short bf16_t;
typedef short bf16x8 __attribute__((ext_vector_type(8)));
typedef float f32x4 __attribute__((ext_vector_type(4)));
typedef float f32x2 __attribute__((ext_vector_type(2)));
typedef unsigned u32x4 __attribute__((ext_vector_type(4)));
typedef unsigned u32x2 __attribute__((ext_vector_type(2)));
typedef int v4i_t __attribute__((ext_vector_type(4)));
typedef int v8i_t __attribute__((ext_vector_type(8)));
constexpr int BM = 256, BK = 64, HALF = 128, HTB = HALF * BK * 2  , STAGE_BYTES = 8 * HTB, NXCD = 8, WGM = 8;

__host__ __device__ __forceinline__ int lds_byte(int r, int c) { const int st = (r >> 4) * 2 + (c >> 5), rr = r & 15, cc = c & 31, ob = rr * 64 + cc * 2; return st * 1024 + (ob ^ (((ob >> 9) & 1) << 5)); }
__host__ __device__ __forceinline__ void stage_rc(int b, int& R, int& C) { const int st = b / 1024, sb = b % 1024, swz = sb ^ (((sb >> 9) & 1) << 5); R = (st >> 1) * 16 + swz / 64; C = (st & 1) * 32 + (swz % 64) / 2; }
__host__ __device__ __forceinline__ int perm32(int rho) { const int n = rho >> 4, i = rho & 15; return 8 * (i >> 2) + 4 * n + (i & 3); }

struct Unit { int pm, pn, be, kt0, nkt, part; };
struct Gemm { const bf16_t* A; const bf16_t* Bt; int M, N, K; size_t bstride; const int* rowtok; unsigned char* slab; unsigned* skflag; unsigned* tmo; int noepi; };

struct StaticOrder {
    static constexpr bool STREAMK = false;
    int nM, nN, nwg, G, c, nt, i0, i1;
    __host__ __device__ __forceinline__ void init(int M, int N, int G_, int c_, int nt_) { nM = M / BM; nN = N / BM; nwg = nM * nN; G = G_; c = c_; nt = nt_; i0 = 0; i1 = 0x7fffffff; }
    __host__ __device__ __forceinline__ int wg() const { return c; }
    __host__ __device__ __forceinline__ bool next(int i, Unit& u) const { const int ii = i + i0; if (ii >= i1) return false; const long L = (long)ii * G + c; if (L >= nwg) return false; map((int)L, u); return true; }
    __host__ __device__ __forceinline__ void map_linear(int wgid, Unit& u) const {
        const int nig = WGM * nN, gid = wgid / nig, fm = gid * WGM, gsz = (nM - fm) < WGM ? (nM - fm) : WGM;
        u.pm = fm + ((wgid % nig) % gsz); u.pn = (wgid % nig) / gsz; u.be = 0; u.kt0 = 0; u.nkt = nt; u.part = 0;
    }
    __host__ __device__ __forceinline__ void map(int L, Unit& u) const {
        int wgid = L; { const int q = nwg / NXCD, r = nwg % NXCD, xcd = wgid % NXCD, off = wgid / NXCD; wgid = (xcd < r ? xcd * (q + 1) : r * (q + 1) + (xcd - r) * q) + off; }
        const int nig = WGM * nN, gid = wgid / nig, fm = gid * WGM, gsz = (nM - fm) < WGM ? (nM - fm) : WGM;
        u.pm = fm + ((wgid % nig) % gsz); u.pn = (wgid % nig) / gsz; u.be = 0; u.kt0 = 0; u.nkt = nt; u.part = 0;
    }
};
template <bool STREAMK_> struct MoeOrderT {
    static constexpr bool STREAMK = STREAMK_;
    StaticOrder so; int t1, t2, t3, t4, t5, t6, t7; int p0, p1, ppu;
    __device__ __forceinline__ int wg() const { return so.c; }
    __device__ __forceinline__ void plan() { ppu = so.nt / 2; const long tot = (long)so.nwg * ppu; p0 = (int)(tot * so.c / so.G); p1 = (int)(tot * (so.c + 1) / so.G); }
    __device__ __forceinline__ bool next(int i, Unit& u) const {
#if defined(PROBE_DOUBLE_KLOOP)
        if (!STREAMK) { if (!so.next(i >> 1, u)) return false; if (!(i & 1)) u.part = 3; }
#else
        if (!STREAMK) { if (!so.next(i, u)) return false; }
#endif
        else { const int first = p0 / ppu, uidx = first + i; const int s = (i == 0) ? (p0 - first * ppu) : 0; const int rem = p1 - uidx * ppu;
            if (rem <= s) return false;
            const int e = rem < ppu ? rem : ppu;
            so.map_linear(uidx, u); u.kt0 = 2 * s; u.nkt = 2 * (e - s); u.part = (s > 0) ? 1 : ((e < ppu) ? 2 : 0); }
        const int q = u.pm; u.be = (q >= t1) + (q >= t2) + (q >= t3) + (q >= t4) + (q >= t5) + (q >= t6) + (q >= t7); return true;
    }
};
typedef MoeOrderT<false> MoeOrder;
typedef MoeOrderT<true> MoeOrderSK;

__device__ __forceinline__ unsigned cvt_pk_bf16(float lo, float hi) { unsigned r; asm volatile("v_cvt_pk_bf16_f32 %0, %1, %2" : "=v"(r) : "v"(lo), "v"(hi)); return r; }
__device__ __forceinline__ float fast_sigmoid(float x) { return __builtin_amdgcn_rcpf(1.0f + __builtin_amdgcn_exp2f(-1.4426950408889634f * x)); }
__device__ __forceinline__ float row_rstd(const float* part, int row) {
    const f32x4 a = *(const f32x4*)(part + (size_t)row * 4);
    return __builtin_amdgcn_rsqf(((a[0] + a[1]) + (a[2] + a[3])) * (1.0f / 1024.0f) + 1e-6f);
}
__device__ __forceinline__ void row_rstd8(const float* part, int row0, float (&r)[2][4]) {
#pragma unroll
    for (int ai = 0; ai < 2; ++ai)
#pragma unroll
        for (int m = 0; m < 4; ++m) r[ai][m] = row_rstd(part, row0 + ai * HALF + m * 16);
}
__device__ __forceinline__ unsigned pk_fp8x4(float a, float b, float c, float d) {
    a = __builtin_amdgcn_fmed3f(a, -448.f, 448.f); b = __builtin_amdgcn_fmed3f(b, -448.f, 448.f); c = __builtin_amdgcn_fmed3f(c, -448.f, 448.f); d = __builtin_amdgcn_fmed3f(d, -448.f, 448.f);
    unsigned w = 0u; w = __builtin_amdgcn_cvt_pk_fp8_f32(a, b, w, false); w = __builtin_amdgcn_cvt_pk_fp8_f32(c, d, w, true); return w;
}
__device__ __forceinline__ unsigned pk_i8x4(float a, float b, float c, float d) {
    const int ia = (int)__builtin_rintf(__builtin_amdgcn_fmed3f(a, -127.f, 127.f)), ib = (int)__builtin_rintf(__builtin_amdgcn_fmed3f(b, -127.f, 127.f));
    const int ic = (int)__builtin_rintf(__builtin_amdgcn_fmed3f(c, -127.f, 127.f)), id = (int)__builtin_rintf(__builtin_amdgcn_fmed3f(d, -127.f, 127.f));
    return ((unsigned)ia & 255u) | (((unsigned)ib & 255u) << 8) | (((unsigned)ic & 255u) << 16) | ((unsigned)id << 24);
}

template <int MODE> struct EpiGated {
    static constexpr bool PERM = true, AFTER_DRAIN = false;
    bf16_t* O; int ldo; const float* bias; int bias_half; const float* part; float descale, out_scale;
    mutable float r8c[2][4]; mutable int pmc;
    __device__ __forceinline__ void operator()(const f32x4 (&acc)[2][2][4][2], const Unit& u, int wr, int wc, int fr, int fq) const {
        const int row0 = u.pm * BM + wr * 64 + fr, col0 = u.pn * 128 + wc * 32 + 8 * fq;
        f32x4 ba[2], bg[2];
#pragma unroll
        for (int n = 0; n < 2; ++n) { if (MODE == 0) { ba[n] = *(const f32x4*)(bias + col0 + 4 * n); bg[n] = *(const f32x4*)(bias + bias_half + col0 + 4 * n); } else { ba[n] = (f32x4){0.f, 0.f, 0.f, 0.f}; bg[n] = ba[n]; } }
        if ((MODE == 1 || MODE == 4) && u.pm != pmc) { row_rstd8(part, row0, r8c); pmc = u.pm; }
#pragma unroll
        for (int ai = 0; ai < 2; ++ai)
#pragma unroll
            for (int m = 0; m < 4; ++m) { const int row = row0 + ai * HALF + m * 16;
                float r = 1.f; if (MODE == 1 || MODE == 4) r = r8c[ai][m];
                f32x4 o[2];
#pragma unroll
                for (int n = 0; n < 2; ++n) { f32x4 a = acc[ai][0][m][n], g = acc[ai][1][m][n];
                    if (MODE == 0) { a = a * descale + ba[n]; g = g * descale + bg[n];
#pragma unroll
                        for (int e = 0; e < 4; ++e) o[n][e] = a[e] * fast_sigmoid(g[e]); }
                    else if (MODE == 3) {
                        const float c1 = -1.4426950408889634f * descale, c2 = descale * descale * out_scale;
#pragma unroll
                        for (int e = 0; e < 4; ++e) o[n][e] = (a[e] * g[e]) * __builtin_amdgcn_rcpf(1.0f + __builtin_amdgcn_exp2f(a[e] * c1)) * c2; }
                    else { if (MODE == 1) { a = a * (r * descale); g = g * (r * descale); } if (MODE == 4) { a = a * (r * descale); g = g * (r * descale * out_scale); }
#pragma unroll
                        for (int e = 0; e < 4; ++e) o[n][e] = a[e] * fast_sigmoid(a[e]) * g[e]; } }
                if (MODE == 3 || MODE == 4) { u32x2 w; w.x = pk_fp8x4(o[0][0], o[0][1], o[0][2], o[0][3]); w.y = pk_fp8x4(o[1][0], o[1][1], o[1][2], o[1][3]); *(u32x2*)((unsigned char*)O + (size_t)row * ldo + col0) = w; }
                else { u32x4 w; w.x = cvt_pk_bf16(o[0][0], o[0][1]); w.y = cvt_pk_bf16(o[0][2], o[0][3]); w.z = cvt_pk_bf16(o[1][0], o[1][1]); w.w = cvt_pk_bf16(o[1][2], o[1][3]);
                *(u32x4*)(O + (size_t)row * ldo + col0) = w; }
                }
    }
};
typedef _Float16 h16x4 __attribute__((ext_vector_type(4)));
template <bool BIAS, bool AUX, int XB8 = 0, int RIN = 0, int ROUT = 0> struct EpiResid {
    static constexpr bool PERM = false, AFTER_DRAIN = false;
    const float* resid; float* out; const float* bias; unsigned char* xb; float* part; float descale, xb_scale; PG8_LAS float* red;
    __device__ __forceinline__ void operator()(const f32x4 (&acc)[2][2][4][2], const Unit& u, int wr, int wc, int fr, int fq) const {
        const int row0 = u.pm * BM + wr * 64 + fr, col0 = u.pn * BM + wc * 32 + 4 * fq;
        f32x4 bv[2][2];
#pragma unroll
        for (int bj = 0; bj < 2; ++bj)
#pragma unroll
            for (int n = 0; n < 2; ++n) bv[bj][n] = BIAS ? *(const f32x4*)(bias + col0 + bj * HALF + n * 16) : (f32x4){0.f, 0.f, 0.f, 0.f};
#pragma unroll
        for (int ai = 0; ai < 2; ++ai)
#pragma unroll
            for (int m = 0; m < 4; ++m) { const int row = row0 + ai * HALF + m * 16; const size_t off = (size_t)row * 1024 + col0; float ss = 0.f;
#pragma unroll
                for (int bj = 0; bj < 2; ++bj)
#pragma unroll
                    for (int n = 0; n < 2; ++n) { const size_t o2 = off + bj * HALF + n * 16;
                        const f32x4 r = RIN ? __builtin_convertvector(*(const h16x4*)((const _Float16*)resid + o2), f32x4) : *(const f32x4*)(resid + o2);
                        const f32x4 x = r + acc[ai][bj][m][n] * descale + bv[bj][n];
                        if (ROUT) *(h16x4*)((_Float16*)out + o2) = __builtin_convertvector(x, h16x4); else *(f32x4*)(out + o2) = x;
                        if (AUX) { ss += (x[0] * x[0] + x[1] * x[1]) + (x[2] * x[2] + x[3] * x[3]); if (XB8 == 1) *(unsigned*)(xb + off + bj * HALF + n * 16) = pk_fp8x4(x[0] * xb_scale, x[1] * xb_scale, x[2] * xb_scale, x[3] * xb_scale);
                            else if (XB8 == 2) *(unsigned*)(xb + off + bj * HALF + n * 16) = pk_i8x4(x[0] * xb_scale, x[1] * xb_scale, x[2] * xb_scale, x[3] * xb_scale);
                            else { u32x2 w; w.x = cvt_pk_bf16(x[0], x[1]); w.y = cvt_pk_bf16(x[2], x[3]); *(u32x2*)((bf16_t*)xb + off + bj * HALF + n * 16) = w; } } }
                if (AUX) { ss += __shfl_xor(ss, 16); ss += __shfl_xor(ss, 32); if (fq == 0) red[(ai * HALF + wr * 64 + m * 16 + fr) * 4 + wc] = ss; }
                if (m == 3) asm volatile("" ::: "memory"); }
        if (AUX) {
            __syncthreads();
            const int t = ((wr * 4 + wc) << 6) | (fq * 16 + fr);
            if (t < BM) { const f32x4 q = *(const PG8_LAS f32x4*)(red + t * 4); part[(size_t)(u.pm * BM + t) * 4 + u.pn] = (q[0] + q[1]) + (q[2] + q[3]); }
            __syncthreads();
        }
    }
};
struct EpiQKV {
    static constexpr bool PERM = true, AFTER_DRAIN = false;
    bf16_t* Kb; size_t kvq_stride; const float* part; const float* kgain; const float* qgain; float qscale, descale;
    mutable float r8c[2][4]; mutable int pmc;
    __device__ __forceinline__ void operator()(const f32x4 (&acc)[2][2][4][2], const Unit& u, int wr, int wc, int fr, int fq) const {
        const int kind = u.pn >> 2, head = (u.pn & 3) * 4 + wc;
        bf16_t* dst = Kb + (size_t)kind * kvq_stride;
        const float* gsrc = kind == 0 ? kgain : qgain; const float gs = kind == 2 ? qscale : 1.f;
        const int row0 = u.pm * BM + wr * 64 + fr, colb = head * 64 + 8 * fq;
        f32x4 gv[2][2];
#pragma unroll
        for (int bj = 0; bj < 2; ++bj)
#pragma unroll
            for (int n = 0; n < 2; ++n) gv[bj][n] = *(const f32x4*)(gsrc + 32 * bj + 8 * fq + 4 * n) * gs;
        if (u.pm != pmc) { row_rstd8(part, row0, r8c); pmc = u.pm; }
#pragma unroll
        for (int ai = 0; ai < 2; ++ai)
#pragma unroll
            for (int m = 0; m < 4; ++m) { const int row = row0 + ai * HALF + m * 16; const float r = r8c[ai][m] * descale;
                f32x4 v[2][2]; float ss = 0.f;
#pragma unroll
                for (int bj = 0; bj < 2; ++bj)
#pragma unroll
                    for (int n = 0; n < 2; ++n) { v[bj][n] = acc[ai][bj][m][n] * r; const f32x4 x = v[bj][n]; ss += (x[0] * x[0] + x[1] * x[1]) + (x[2] * x[2] + x[3] * x[3]); }
                ss += __shfl_xor(ss, 16); ss += __shfl_xor(ss, 32);
                if (kind != 1) { const float inv = __builtin_amdgcn_rsqf(ss * (1.0f / 64.0f) + 1e-6f);
#pragma unroll
                    for (int bj = 0; bj < 2; ++bj)
#pragma unroll
                        for (int n = 0; n < 2; ++n) v[bj][n] = v[bj][n] * gv[bj][n] * inv; }
#pragma unroll
                for (int bj = 0; bj < 2; ++bj) { u32x4 w; w.x = cvt_pk_bf16(v[bj][0][0], v[bj][0][1]); w.y = cvt_pk_bf16(v[bj][0][2], v[bj][0][3]); w.z = cvt_pk_bf16(v[bj][1][0], v[bj][1][1]); w.w = cvt_pk_bf16(v[bj][1][2], v[bj][1][3]);
                    *(u32x4*)(dst + (size_t)row * 1024 + colb + 32 * bj) = w; }
                __builtin_amdgcn_sched_barrier(0); }
    }
};
struct EpiMoeDown {
    static constexpr bool PERM = true, AFTER_DRAIN = false;
    unsigned char* Y; const float* rowgate; float descale;
    template <bool ADD> __device__ __forceinline__ void run(const f32x4 (&acc)[2][2][4][2], const Unit& u, int wr, int wc, int fr, int fq, const PG8_GAS u32x2* sl) const {
        const int rt0 = u.pm * BM + wr * 64 + fr, col0 = u.pn * BM + wc * 32 + 8 * fq;
        float gtv[2][4];
#pragma unroll
        for (int ai = 0; ai < 2; ++ai)
#pragma unroll
            for (int m = 0; m < 4; ++m) gtv[ai][m] = rowgate[rt0 + ai * HALF + m * 16] * descale;
#pragma unroll
        for (int ai = 0; ai < 2; ++ai) {
#pragma unroll
            for (int m = 0; m < 4; ++m) { const float gt = gtv[ai][m]; unsigned char* p = Y + (size_t)(rt0 + ai * HALF + m * 16) * 1024 + col0;
#pragma unroll
                for (int bj = 0; bj < 2; ++bj) { f32x4 s0 = acc[ai][bj][m][0], s1 = acc[ai][bj][m][1];
                    if (ADD) { const u32x2 q0 = sl[bj * 2 + 0], q1 = sl[bj * 2 + 1];
                        s0[0] += __uint_as_float(q0.x << 16); s0[1] += __uint_as_float(q0.x & 0xffff0000u); s0[2] += __uint_as_float(q0.y << 16); s0[3] += __uint_as_float(q0.y & 0xffff0000u);
                        s1[0] += __uint_as_float(q1.x << 16); s1[1] += __uint_as_float(q1.x & 0xffff0000u); s1[2] += __uint_as_float(q1.y << 16); s1[3] += __uint_as_float(q1.y & 0xffff0000u); }
                    s0 = s0 * gt; s1 = s1 * gt;
                    u32x2 w; w.x = pk_i8x4(s0[0], s0[1], s0[2], s0[3]); w.y = pk_i8x4(s1[0], s1[1], s1[2], s1[3]);
                    *(u32x2*)(p + bj * HALF) = w; }
                if (ADD) { sl += 512 * 4; asm volatile("" : "+v"(sl)); } }
            asm volatile("" ::: "memory"); }
    }
    __device__ __forceinline__ void operator()(const f32x4 (&acc)[2][2][4][2], const Unit& u, int wr, int wc, int fr, int fq) const { run<false>(acc, u, wr, wc, fr, fq, nullptr); }
};

template <class Epi, class Sched, bool GATHER, int PREC = 0>
__device__ __forceinline__ void gemm_phase(PG8_LAS unsigned char* lds, const Gemm g, const Sched& S, const Epi& E, const int tid) {
    constexpr bool FP8 = (PREC == 1), I8 = (PREC == 2), BYTE1 = (PREC != 0);
    const int wid = __builtin_amdgcn_readfirstlane(tid >> 6), lane = tid & 63, wr = wid >> 2, wc = wid & 3, fr = lane & 15, fq = lane >> 4;
    const int K = g.K;
    const int rowb = BYTE1 ? K : 2 * K;
    unsigned voffB[2]; unsigned vC0[2], vC1[2], vN0[2], vN1[2]; int Rr[2], Cc[2];
#pragma unroll
    for (int i = 0; i < 2; ++i) { int R, C; stage_rc(tid * 16 + i * 8192, R, C); const int Rb = Epi::PERM ? ((R & ~31) + perm32(R & 31)) : R;
        Rr[i] = R; Cc[i] = C; vC0[i] = (unsigned)(R * rowb + C * 2); vC1[i] = vC0[i]; vN0[i] = vC0[i]; vN1[i] = vC0[i]; voffB[i] = (unsigned)(Rb * rowb + C * 2); }
    const size_t kstep = (size_t)(BK * 2);
    const size_t hstep = (size_t)HALF * rowb;
    const size_t hstepA = GATHER ? 0 : hstep;
    const size_t tstep = 2 * hstep;
    const unsigned ldsw = (unsigned)wid * 1024u;
    const int aoff = lds_byte(wr * 64 + fr, fq * 8), boff = lds_byte(wc * 32 + fr, fq * 8);
#define PG8_SA(b, h) (((b) * 2 + (h)) * HTB)
#define PG8_SB(b, h) ((4 + (b) * 2 + (h)) * HTB)
#define PG8_STAGE(bufoff, gbase, v0, v1) do { \
        __builtin_amdgcn_global_load_lds((const unsigned*)((const char*)(gbase) + (v0)), (PG8_LAS unsigned*)(lds + (bufoff) + ldsw), 16, 0, 0); \
        __builtin_amdgcn_global_load_lds((const unsigned*)((const char*)(gbase) + (v1)), (PG8_LAS unsigned*)(lds + (bufoff) + ldsw + 8192), 16, 0, 0); } while (0)
#define PG8_LD8(addr) __builtin_shufflevector(*(const PG8_LAS v4i_t*)(addr), *(const PG8_LAS v4i_t*)((addr) + 1024), 0, 1, 2, 3, 4, 5, 6, 7)
#define PG8_LDA(dst, b, h) do { if (FP8) { _Pragma("unroll") for (int m = 0; m < 4; ++m) dst##8[m] = PG8_LD8(lds + PG8_SA(b, h) + aoff + m * 2048); } else { \
        _Pragma("unroll") for (int m = 0; m < 4; ++m) _Pragma("unroll") for (int k = 0; k < 2; ++k) dst[m][k] = *(const PG8_LAS bf16x8*)(lds + PG8_SA(b, h) + aoff + m * 2048 + k * 1024); } } while (0)
#define PG8_LDB(dst, b, h) do { if (FP8) { _Pragma("unroll") for (int n = 0; n < 2; ++n) dst##8[n] = PG8_LD8(lds + PG8_SB(b, h) + boff + n * 2048); } else { \
        _Pragma("unroll") for (int n = 0; n < 2; ++n) _Pragma("unroll") for (int k = 0; k < 2; ++k) dst[n][k] = *(const PG8_LAS bf16x8*)(lds + PG8_SB(b, h) + boff + n * 2048 + k * 1024); } } while (0)
#if defined(PROBE_HALF_MFMA)
#define PG8_SKIP(ai) ((ai) == 1 && cur.part == 3)
#else
#define PG8_SKIP(ai) false
#endif
#define PG8_MMA(ai, bj, At, Bt) do { if (PG8_SKIP(ai)) break; __builtin_amdgcn_s_setprio(1); _Pragma("unroll") for (int m = 0; m < 4; ++m) _Pragma("unroll") for (int n = 0; n < 2; ++n) { \
        if (FP8) asm volatile("v_mfma_scale_f32_16x16x128_f8f6f4 %0, %1, %2, %0, %3, %3 op_sel_hi:[0,0,0]" : "+v"(acc[ai][bj][m][n]) : "v"(Bt##8[n]), "v"(At##8[m]), "v"(sc1)); \
        else if (I8) { _Pragma("unroll") for (int k = 0; k < 2; ++k) acc[ai][bj][m][n] = __builtin_bit_cast(f32x4, __builtin_amdgcn_mfma_i32_16x16x64_i8(__builtin_bit_cast(v4i_t, Bt[n][k]), __builtin_bit_cast(v4i_t, At[m][k]), __builtin_bit_cast(v4i_t, acc[ai][bj][m][n]), 0, 0, 0)); } \
        else { _Pragma("unroll") for (int k = 0; k < 2; ++k) acc[ai][bj][m][n] = __builtin_amdgcn_mfma_f32_16x16x32_bf16(Bt[n][k], At[m][k], acc[ai][bj][m][n], 0, 0, 0); } } __builtin_amdgcn_s_setprio(0); } while (0)
#define PG8_WAIT_V(n) asm volatile("s_waitcnt vmcnt(" #n ")" ::: "memory")
#define PG8_WAIT_L(n) asm volatile("s_waitcnt lgkmcnt(" #n ")" ::: "memory")
#define PG8_BAR __builtin_amdgcn_s_barrier()
#define PG8_SCHED __builtin_amdgcn_sched_barrier(0)
#define PG8_TOKOFF(pm_, h_, i_) ({ int t_ = g.rowtok[(pm_) * BM + (h_) * HALF + Rr[i_]]; t_ = t_ < 0 ? 0 : t_; (unsigned)(t_ * rowb + Cc[i_] * 2); })
    unsigned sc1 = 0u; if (FP8) asm volatile("v_mov_b32 %0, 0x7f7f7f7f" : "=v"(sc1));
    Unit cur, nxt; int ui = 0;
    if (!S.next(0, cur)) return;
    f32x4 acc[2][2][4][2];
#pragma unroll
    for (int a = 0; a < 2; ++a)
#pragma unroll
        for (int b = 0; b < 2; ++b)
#pragma unroll
            for (int m = 0; m < 4; ++m)
#pragma unroll
                for (int n = 0; n < 2; ++n) acc[a][b][m][n] = (f32x4){0.f, 0.f, 0.f, 0.f};
    bf16x8 At[4][2], B0[2][2], B1[2][2]; v8i_t At8[4], B08[2], B18[2];
    if (GATHER) {
#pragma unroll
        for (int i = 0; i < 2; ++i) { vC0[i] = PG8_TOKOFF(cur.pm, 0, i); vC1[i] = PG8_TOKOFF(cur.pm, 1, i); }
    }
    const char* cA = (GATHER ? (const char*)g.A : (const char*)g.A + (size_t)cur.pm * tstep) + (size_t)cur.kt0 * kstep;
    const char* cB = (const char*)g.Bt + (size_t)cur.be * g.bstride + (size_t)cur.pn * tstep + (size_t)cur.kt0 * kstep;
    PG8_STAGE(PG8_SB(0, 0), cB, voffB[0], voffB[1]); PG8_STAGE(PG8_SB(0, 1), cB + hstep, voffB[0], voffB[1]); PG8_STAGE(PG8_SA(0, 0), cA, vC0[0], vC0[1]); PG8_STAGE(PG8_SA(0, 1), cA + hstepA, vC1[0], vC1[1]);
    if (wr == 1) PG8_BAR;
    PG8_WAIT_V(2); PG8_BAR;
    PG8_STAGE(PG8_SB(1, 0), cB + kstep, voffB[0], voffB[1]); PG8_STAGE(PG8_SA(1, 0), cA + kstep, vC0[0], vC0[1]); PG8_STAGE(PG8_SB(1, 1), cB + hstep + kstep, voffB[0], voffB[1]);
    PG8_WAIT_V(6); PG8_BAR;
    for (;;) {
        const bool has_next = S.next(ui + 1, nxt);
        const char* nA = has_next ? (GATHER ? (const char*)g.A : (const char*)g.A + (size_t)nxt.pm * tstep) + (size_t)nxt.kt0 * kstep : cA;
        const char* nB = has_next ? (const char*)g.Bt + (size_t)nxt.be * g.bstride + (size_t)nxt.pn * tstep + (size_t)nxt.kt0 * kstep : cB;
        if (GATHER) {
            if (has_next && nxt.pm != cur.pm) {
#pragma unroll
                for (int i = 0; i < 2; ++i) { vN0[i] = PG8_TOKOFF(nxt.pm, 0, i); vN1[i] = PG8_TOKOFF(nxt.pm, 1, i); }
            } else {
#pragma unroll
                for (int i = 0; i < 2; ++i) { vN0[i] = vC0[i]; vN1[i] = vC1[i]; }
            }
        }
        const int nkt = cur.nkt;
        for (int t = 0; t < nkt; t += 2) {
            const bool last = (t == nkt - 2);
            const char* a1 = cA + (size_t)(t + 1) * kstep;
            const char* a2 = last ? nA : cA + (size_t)(t + 2) * kstep; const char* b2 = last ? nB : cB + (size_t)(t + 2) * kstep;
            const char* a3 = a2 + kstep; const char* b3 = b2 + kstep;
            const unsigned x00 = (GATHER && last) ? vN0[0] : vC0[0], x01 = (GATHER && last) ? vN0[1] : vC0[1], x10 = (GATHER && last) ? vN1[0] : vC1[0], x11 = (GATHER && last) ? vN1[1] : vC1[1];
            PG8_LDB(B0, 0, 0); PG8_LDB(B1, 0, 1); PG8_SCHED; PG8_LDA(At, 0, 0); PG8_STAGE(PG8_SA(1, 1), a1 + hstepA, vC1[0], vC1[1]);
            PG8_WAIT_V(8); PG8_WAIT_L(0); PG8_BAR; PG8_MMA(0, 0, At, B0); PG8_MMA(0, 1, At, B1); PG8_BAR; PG8_SCHED;
            PG8_LDA(At, 0, 1); PG8_STAGE(PG8_SB(0, 0), b2, voffB[0], voffB[1]); PG8_STAGE(PG8_SB(0, 1), b2 + hstep, voffB[0], voffB[1]); PG8_STAGE(PG8_SA(0, 0), a2, x00, x01);
            PG8_WAIT_V(8); PG8_WAIT_L(0); PG8_BAR; PG8_MMA(1, 0, At, B0); PG8_MMA(1, 1, At, B1); PG8_BAR; PG8_SCHED;
            PG8_LDB(B0, 1, 0); PG8_LDB(B1, 1, 1); PG8_SCHED; PG8_LDA(At, 1, 0); PG8_STAGE(PG8_SA(0, 1), a2 + hstepA, x10, x11);
            PG8_WAIT_V(8); PG8_WAIT_L(0); PG8_BAR; PG8_MMA(0, 0, At, B0); PG8_MMA(0, 1, At, B1); PG8_BAR; PG8_SCHED;
            PG8_LDA(At, 1, 1); PG8_STAGE(PG8_SB(1, 0), b3, voffB[0], voffB[1]); PG8_STAGE(PG8_SB(1, 1), b3 + hstep, voffB[0], voffB[1]); PG8_STAGE(PG8_SA(1, 0), a3, x00, x01);
            PG8_WAIT_V(8); PG8_WAIT_L(0); PG8_BAR; PG8_MMA(1, 0, At, B0); PG8_MMA(1, 1, At, B1); PG8_BAR; PG8_SCHED;
        }
        if (wr == 0) PG8_BAR;
        if (FP8) { asm volatile("s_nop 15\n\ts_nop 15" ::: "memory");
#pragma unroll
            for (int a = 0; a < 2; ++a)
#pragma unroll
                for (int b = 0; b < 2; ++b)
#pragma unroll
                    for (int m = 0; m < 4; ++m)
#pragma unroll
                        for (int n = 0; n < 2; ++n) asm volatile("" : "+v"(acc[a][b][m][n])); }
        if (I8) {
#pragma unroll
            for (int a = 0; a < 2; ++a)
#pragma unroll
                for (int b = 0; b < 2; ++b)
#pragma unroll
                    for (int m = 0; m < 4; ++m)
#pragma unroll
                        for (int n = 0; n < 2; ++n) { const v4i_t q = __builtin_bit_cast(v4i_t, acc[a][b][m][n]); acc[a][b][m][n] = (f32x4){(float)q[0], (float)q[1], (float)q[2], (float)q[3]}; } }
        if (g.noepi) {} else
        if constexpr (Sched::STREAMK) {
            if (cur.part == 1) {
                PG8_GAS u32x2* sl = (PG8_GAS u32x2*)g.slab + (size_t)S.wg() * (32 * 512) + tid * 4;
#pragma unroll
                for (int a = 0; a < 2; ++a)
#pragma unroll
                    for (int m = 0; m < 4; ++m) {
#pragma unroll
                        for (int b = 0; b < 2; ++b)
#pragma unroll
                            for (int n = 0; n < 2; ++n) { u32x2 w; w.x = cvt_pk_bf16(acc[a][b][m][n][0], acc[a][b][m][n][1]); w.y = cvt_pk_bf16(acc[a][b][m][n][2], acc[a][b][m][n][3]); sl[b * 2 + n] = w; }
                        sl += 512 * 4; asm volatile("" : "+v"(sl)); }
                asm volatile("s_waitcnt vmcnt(0)" ::: "memory");
                __syncthreads();
                if (tid == 0) { __builtin_amdgcn_fence(__ATOMIC_RELEASE, "agent"); asm volatile("s_waitcnt vmcnt(0)" ::: "memory");
                    __hip_atomic_store(g.skflag + 16 * S.wg(), 1u, __ATOMIC_RELAXED, __HIP_MEMORY_SCOPE_AGENT); }
            } else if (cur.part == 2) {
                if (wid == 0) { unsigned sp = 0;
                    while (__hip_atomic_load(g.skflag + 16 * (S.wg() + 1), __ATOMIC_RELAXED, __HIP_MEMORY_SCOPE_AGENT) == 0u) { __builtin_amdgcn_s_sleep(2);
                        if (++sp > (1u << 22)) { if (lane == 0) __hip_atomic_store(g.tmo, 1u, __ATOMIC_RELAXED, __HIP_MEMORY_SCOPE_AGENT); break; } }
                    __builtin_amdgcn_fence(__ATOMIC_ACQUIRE, "agent"); }
                asm volatile("s_waitcnt vmcnt(0)" ::: "memory");
                __syncthreads();
                E.template run<true>(acc, cur, wr, wc, fr, fq, (const PG8_GAS u32x2*)g.slab + (size_t)(S.wg() + 1) * (32 * 512) + tid * 4);
            } else { if (cur.part != 3) E(acc, cur, wr, wc, fr, fq); }
        } else { if (cur.part != 3) E(acc, cur, wr, wc, fr, fq); }
        if (!has_next) break;
#pragma unroll
        for (int a = 0; a < 2; ++a)
#pragma unroll
            for (int b = 0; b < 2; ++b)
#pragma unroll
                for (int m = 0; m < 4; ++m)
#pragma unroll
                    for (int n = 0; n < 2; ++n) acc[a][b][m][n] = (f32x4){0.f, 0.f, 0.f, 0.f};
        cur = nxt; cA = nA; cB = nB; ++ui;
        if (GATHER) {
#pragma unroll
            for (int i = 0; i < 2; ++i) { vC0[i] = vN0[i]; vC1[i] = vN1[i]; }
        }
        if (wr == 1) PG8_BAR;
    }
    PG8_WAIT_V(0);
    PG8_BAR;
#undef PG8_SA
#undef PG8_SB
#undef PG8_STAGE
#undef PG8_LDA
#undef PG8_LDB
#undef PG8_MMA
#undef PG8_LD8
#undef PG8_WAIT_V
#undef PG8_WAIT_L
#undef PG8_BAR
#undef PG8_SCHED
#undef PG8_TOKOFF
}
}
#define GAS __attribute__((address_space(1)))
#define LAS __attribute__((address_space(3)))
typedef unsigned short bf16;
typedef unsigned v4u __attribute__((ext_vector_type(4)));
typedef float f32x4 __attribute__((ext_vector_type(4)));
typedef short bf16x8 __attribute__((ext_vector_type(8)));
typedef GAS unsigned gu32;
typedef GAS unsigned long long gu64;
#define RLX_AGENT __ATOMIC_RELAXED, __HIP_MEMORY_SCOPE_AGENT
#define LDS_WAIT() asm volatile("s_waitcnt lgkmcnt(0)" ::: "memory")
#define VM_WAIT() asm volatile("s_waitcnt vmcnt(0)" ::: "memory")
__device__ __forceinline__ unsigned long long rt() { return __builtin_amdgcn_s_memrealtime(); }
__device__ __forceinline__ unsigned f2bf(float f) { unsigned u = __builtin_bit_cast(unsigned, f); return (u + 0x7fffu + ((u >> 16) & 1u)) >> 16; }
__device__ __forceinline__ unsigned pk2(float lo, float hi) { return f2bf(lo) | (f2bf(hi) << 16); }

#define XB_TMO      128
#define XB_XCNT(j)  (256  + 64 * (j))
#define XB_XSUB(j)  (1280 + 64 * (j))
#define XB_XGEN(j)  (2304 + 64 * (j))
#define XB_TOP      3328
#define XB_TOPGEN   3392
#define XCD_BAR_WORDS 3456
#define XB_SPIN_CAP (1u << 18)

__device__ __forceinline__ unsigned xb_ld(unsigned* p)              { return __hip_atomic_load(p, __ATOMIC_RELAXED, __HIP_MEMORY_SCOPE_AGENT); }
__device__ __forceinline__ unsigned xb_add(unsigned* p, unsigned v) { return __hip_atomic_fetch_add(p, v, __ATOMIC_RELAXED, __HIP_MEMORY_SCOPE_AGENT); }
__device__ __forceinline__ unsigned xb_xcc_id() { return (unsigned)__builtin_amdgcn_s_getreg((3 << 11) | 20) & 0xFu; }
#define XB_SPIN(cond, bar) do { unsigned _sp = 0; while (cond) { __builtin_amdgcn_s_sleep(1); \
    if ((++_sp & 255u) == 0u) { if (xb_ld(&(bar)[XB_TMO])) break; if (_sp > XB_SPIN_CAP) { atomicAdd(&(bar)[XB_TMO], 1u); break; } } } } while (0)

struct XcdBarrier {
    unsigned* bar; unsigned x;
    volatile LAS unsigned* st;
};

__device__ __forceinline__ XcdBarrier xcd_barrier_post(unsigned* bar, volatile LAS unsigned* st) {
    XcdBarrier b; b.bar = bar; b.x = xb_xcc_id(); b.st = st;
    if (threadIdx.x == 0) (void)xb_add(&bar[XB_XCNT(b.x)], 1u);
    return b;
}
__device__ __forceinline__ void xcd_barrier_complete(unsigned* bar, unsigned x, unsigned& nloc, unsigned& nx) {
    const unsigned G = gridDim.x * gridDim.y * gridDim.z;
    unsigned sum, cnt, mine, sp = 0u;
    for (;;) {
        sum = 0u; cnt = 0u; mine = 0u;
#pragma unroll
        for (unsigned j = 0; j < 16; ++j) { const unsigned c = xb_ld(&bar[XB_XCNT(j)]); sum += c; cnt += (c > 0u) ? 1u : 0u; mine = (j == x) ? c : mine; }
        if (sum == G) break;
        __builtin_amdgcn_s_sleep(1);
        if ((++sp & 255u) == 0u) { if (xb_ld(&bar[XB_TMO])) break; if (sp > XB_SPIN_CAP) { atomicAdd(&bar[XB_TMO], 1u); break; } }
    }
    nloc = mine > 0u ? mine : 1u; nx = cnt > 0u ? cnt : 1u;
}

__device__ __forceinline__ void xcd_barrier(const XcdBarrier& b) {
    asm volatile("s_waitcnt vmcnt(0)" ::: "memory");
    __syncthreads();
    if (threadIdx.x == 0) {
        unsigned* bar = b.bar;
        __builtin_amdgcn_s_waitcnt(0);
        unsigned nloc = b.st[0], nx = b.st[1];
        if (nloc == 0u) { xcd_barrier_complete(bar, b.x, nloc, nx); b.st[0] = nloc; b.st[1] = nx; }
        const unsigned old = xb_add(&bar[XB_XSUB(b.x)], 1u);
        const unsigned gen = old / nloc;
        if (old + 1u == (gen + 1u) * nloc) {
            __builtin_amdgcn_fence(__ATOMIC_RELEASE, "agent");
            asm volatile("s_waitcnt vmcnt(0)" ::: "memory");
            const unsigned og = xb_add(&bar[XB_TOP], 1u);
            const unsigned tg = og / nx;
            if (og + 1u == (tg + 1u) * nx) xb_add(&bar[XB_TOPGEN], 1u);
            else XB_SPIN(xb_ld(&bar[XB_TOPGEN]) == tg, bar);
            __builtin_amdgcn_fence(__ATOMIC_ACQUIRE, "agent");
            xb_add(&bar[XB_XGEN(b.x)], 1u);
            asm volatile("s_waitcnt vmcnt(0)" ::: "memory");
        } else {
            XB_SPIN(xb_ld(&bar[XB_XGEN(b.x)]) == gen, bar);
            __builtin_amdgcn_fence(__ATOMIC_ACQUIRE, "agent");
            asm volatile("s_waitcnt vmcnt(0)" ::: "memory");
        }
    }
    __syncthreads();
}

constexpr int NWAVES = 8;
constexpr int T = 32768, D = 1024, SEQ = 4096, NBATCH = 8;
constexpr int DFF = 2752, DFFP = 2816, DFFE = 3584, NEXP = 8;
constexpr int ROWCAP = 67584;
constexpr float EPS = 1e-6f;
constexpr float LOG2E = 1.4426950408889634f;
constexpr float SOFTMAX_OFS = 16.f;
constexpr float QSCALE = 0.125f * LOG2E;
#ifndef I8_P1
#define I8_P1 1
#endif
#ifndef I8_P3
#define I8_P3 0
#endif
#ifndef I8_P4
#define I8_P4 1
#endif
constexpr float SA_N = 127.f / 5.f, SA_X = 127.f / 6.f, SW_I8 = 127.f * 32.f / 4.5f;
constexpr float Y_SCALE = 127.f / 2.5f;
constexpr float W8_SCALE = 64.f, H3_SCALE = 16.f, HM_SCALE = 8.f, X8_SCALE = 16.f, HB_SCALE = 8.f, O8_SCALE = 64.f;
constexpr size_t MiB = 1u << 20;
constexpr size_t WS_CTL = 0, CTL_ZERO_BYTES = 1 * MiB;
constexpr size_t WS_PART1 = 1 * MiB, WS_PART2 = 3 * MiB, WS_LSE = 5 * MiB;
constexpr size_t WS_ROUTE = 7 * MiB, WS_GATE1 = WS_ROUTE + 128 * 1024, WS_GATE2 = WS_ROUTE + 256 * 1024, WS_WAVECNT = WS_ROUTE + 384 * 1024, WS_BLOCKCNT = WS_ROUTE + 448 * 1024, WS_GOFS = WS_ROUTE + 480 * 1024;
constexpr size_t WS_ROWTOK = 8 * MiB, WS_ROWGATE = 8 * MiB + 512 * 1024;
constexpr size_t WS_WIN = 12 * MiB, WS_WOUT = 16 * MiB, WS_WF13 = 18 * MiB, WS_WFD = 29 * MiB, WS_WQKV = 35 * MiB, WS_WO = 53 * MiB;
constexpr size_t WS_WM13 = 56 * MiB, WS_WM2 = 112 * MiB;
constexpr size_t WS_XH = 144 * MiB;
constexpr size_t WS_A0 = 224 * MiB;
constexpr size_t WS_H0 = WS_A0, WS_GLU = WS_A0 + 64 * MiB, WS_V = WS_A0 + 128 * MiB;
constexpr size_t WS_X1B = WS_A0, WS_HB = WS_A0 + 64 * MiB;
constexpr size_t WS_X2B = WS_A0, WS_KG = WS_A0 + 64 * MiB, WS_VG = WS_A0 + 128 * MiB, WS_QG = WS_A0 + 192 * MiB, WS_O = WS_A0 + 256 * MiB, WS_O8 = WS_A0 + 32 * MiB;
constexpr size_t WS_H3 = WS_A0, WS_HM = WS_A0 + 66 * MiB;
constexpr size_t WS_END = 548 * MiB;
static_assert(WS_HB + (size_t)T * DFFP * 2 <= WS_END && WS_O + (size_t)T * D * 2 <= WS_END && WS_HM + (size_t)ROWCAP * DFFE <= WS_END, "arena");
static_assert(WS_WFD + (size_t)D * DFFP * 2 <= WS_WQKV && WS_WO + (size_t)D * D * 2 <= WS_WM13 && WS_WM13 + (size_t)NEXP * 7168 * 1024 <= WS_WM2 && WS_WM2 + (size_t)NEXP * D * DFFE <= WS_XH && WS_XH + (size_t)T * D * 2 <= WS_A0, "weights");
constexpr int CW_AQ = 50000;
constexpr int CW_TMO = 0, CW_CODE = 1, CW_BAR = 4096, CW_SKFLAG = 16384;
constexpr size_t WS_SLAB = 12 * MiB;
constexpr size_t WS_POS = 9 * MiB;
constexpr size_t WS_Y = WS_A0;
static_assert(WS_SLAB + (size_t)256 * 131072 <= 56 * MiB && WS_Y + (size_t)ROWCAP * 1024 <= WS_HM, "slab / Y");

constexpr int RING_OFF = 0, RING_BYTES = 131072;
constexpr int LDSCTL_OFF = RING_BYTES, MISC_OFF = LDSCTL_OFF + 320;
constexpr int XTRA_OFF = RING_BYTES + 512;
constexpr int LDS_BYTES = 147456;

constexpr int NPHASE = 18;

__constant__ unsigned char T5_BUCKET[3][132] = {
 {0,1,2,3,4,5,6,7,8,9,10,11,12,13,14,15,16,16,16,16,16,16,17,17,17,17,17,17,17,17,18,18,18,18,18,18,18,18,18,18,19,19,19,19,19,19,19,19,19,19,19,19,19,19,20,20,20,20,20,20,20,20,20,20,20,20,20,20,20,20,20,20,20,21,21,21,21,21,21,21,21,21,21,21,21,21,21,21,21,21,21,21,21,21,21,21,21,21,21,22,22,22,22,22,22,22,22,22,22,22,22,22,22,22,22,22,22,22,22,22,22,22,22,22,22,22,22,22,22,0,0,0},
 {0,4,8,12,16,16,17,17,18,18,19,19,19,19,20,20,20,20,20,21,21,21,21,21,21,22,22,22,22,22,22,22,22,22,23,23,23,23,23,23,23,23,23,23,23,23,24,24,24,24,24,24,24,24,24,24,24,24,24,24,24,24,25,25,25,25,25,25,25,25,25,25,25,25,25,25,25,25,25,25,25,25,25,26,26,26,26,26,26,26,26,26,26,26,26,26,26,26,26,26,26,26,26,26,26,26,26,26,26,26,26,26,26,27,27,27,27,27,27,27,27,27,27,27,27,27,27,27,27,0,0,0},
 {0,16,18,19,20,21,21,22,22,23,23,23,24,24,24,24,25,25,25,25,25,26,26,26,26,26,26,26,26,27,27,27,27,27,27,27,27,27,27,28,28,28,28,28,28,28,28,28,28,28,28,28,29,29,29,29,29,29,29,29,29,29,29,29,29,29,29,29,29,29,30,30,30,30,30,30,30,30,30,30,30,30,30,30,30,30,30,30,30,30,30,30,30,30,30,31,31,31,31,31,31,31,31,31,31,31,31,31,31,31,31,31,31,31,31,31,31,31,31,31,31,31,31,31,31,31,31,31,31,0,0,0}};

typedef float f32x16 __attribute__((ext_vector_type(16)));
typedef float f32x2v __attribute__((ext_vector_type(2)));
typedef __bf16 bf16x2v __attribute__((ext_vector_type(2)));
typedef short v4i16_t __attribute__((ext_vector_type(4)));
__device__ __forceinline__ unsigned pkbf(float lo, float hi) { f32x2v v = {lo, hi}; bf16x2v b = __builtin_convertvector(v, bf16x2v); return __builtin_bit_cast(unsigned, b); }
__device__ __forceinline__ float bflo(unsigned u) { return __uint_as_float(u << 16); }
__device__ __forceinline__ float bfhi(unsigned u) { return __uint_as_float(u & 0xffff0000u); }
template <int N> __device__ __forceinline__ float dpp_row_ror(float v) { return __builtin_bit_cast(float, __builtin_amdgcn_update_dpp(0, __builtin_bit_cast(int, v), 0x120 + N, 0xf, 0xf, true)); }
__device__ __forceinline__ float wave_sum(float v) {
    v += dpp_row_ror<8>(v); v += dpp_row_ror<4>(v); v += dpp_row_ror<2>(v); v += dpp_row_ror<1>(v);
    const int b = __builtin_bit_cast(int, v);
    return (__builtin_bit_cast(float, __builtin_amdgcn_readlane(b, 0)) + __builtin_bit_cast(float, __builtin_amdgcn_readlane(b, 16))) + (__builtin_bit_cast(float, __builtin_amdgcn_readlane(b, 32)) + __builtin_bit_cast(float, __builtin_amdgcn_readlane(b, 48)));
}
__device__ __forceinline__ int crow(int r, int hi) { return (r & 3) + 8 * (r >> 2) + 4 * hi; }

struct TrDesc { const float* W; const float* gsc; unsigned char* WT; int ldw, Kp, drow0, k0, n0src, is8; float scale; };
__device__ __forceinline__ int hmap_row0(int L) { const int lc = L & 255; return (L & ~255) + 128 * ((lc >> 5) & 1) + 32 * (lc >> 6); }

constexpr int IT_MG = NEXP * 16 * 112, IT_MU = IT_MG, IT_MD = NEXP * 56 * 32, IT_WIN = 16 * 64, IT_WOUT = 16 * 32, IT_FG = 16 * 86, IT_FU = IT_FG, IT_FD = 43 * 32, IT_KV = 16 * 192, IT_Q = 16 * 96, IT_WO = 16 * 32;
constexpr int IT_MOE = IT_MG + IT_MU + IT_MD;
static_assert(IT_MOE == 3 * 256 * 56, "expert-weight items per attention phase and workgroup");
constexpr int IT_TOTAL = IT_MG + IT_MU + IT_MD + IT_WIN + IT_WOUT + IT_FG + IT_FU + IT_FD + IT_KV + IT_Q + IT_WO;
typedef const __attribute__((address_space(4))) unsigned char* kargp0_t;
#define P0IN(i) (*(const float* const __attribute__((address_space(4)))*)(kp + 8 * (i)))
__device__ __forceinline__ void tr_desc(int it, kargp0_t kp, unsigned char* ws, TrDesc& d) {
    int r = it; d.gsc = nullptr; d.is8 = 2; d.scale = SW_I8; d.Kp = 1024;
    if (r < IT_MG) { const int e = r / 1792, rr = r % 1792, j = (rr % 112) * 32; d.W = P0IN(23) + (size_t)e * D * DFFE; d.ldw = DFFE; d.WT = ws + WS_WM13 + (size_t)e * 7168 * 1024; d.drow0 = 256 * (j >> 7) + (j & 127); d.k0 = (rr / 112) * 64; d.n0src = j; return; } r -= IT_MG;
    if (r < IT_MU) { const int e = r / 1792, rr = r % 1792, j = (rr % 112) * 32; d.W = P0IN(24) + (size_t)e * D * DFFE; d.ldw = DFFE; d.WT = ws + WS_WM13 + (size_t)e * 7168 * 1024; d.drow0 = 256 * (j >> 7) + 128 + (j & 127); d.k0 = (rr / 112) * 64; d.n0src = j; return; } r -= IT_MU;
    if (r < IT_MD) { const int e = r / 1792, rr = r % 1792, j = (rr % 32) * 32; d.W = P0IN(25) + (size_t)e * DFFE * D; d.ldw = D; d.WT = ws + WS_WM2 + (size_t)e * 1024 * DFFE; d.Kp = DFFE; d.is8 = 1; d.scale = W8_SCALE; d.drow0 = j; d.k0 = (rr / 32) * 64; d.n0src = j; return; } r -= IT_MD;
    if (r < IT_KV) { const int c = (r % 192) * 32, kvsel = c / 3072, cg = c % 3072, g = cg >> 10, hc = cg & 1023, L = kvsel * 1024 + hc; d.W = P0IN(12); d.ldw = 6144; d.gsc = P0IN(11); d.WT = ws + WS_WQKV + (size_t)g * 3072 * 1024; d.drow0 = hmap_row0(L); d.k0 = (r / 192) * 64; d.n0src = c; return; } r -= IT_KV;
    if (r < IT_Q) { const int c = (r % 96) * 32, g = c >> 10, hc = c & 1023, L = 2048 + hc; d.W = P0IN(15); d.ldw = 3072; d.gsc = P0IN(14); d.WT = ws + WS_WQKV + (size_t)g * 3072 * 1024; d.drow0 = hmap_row0(L); d.k0 = (r / 96) * 64; d.n0src = c; return; } r -= IT_Q;
    if (r < IT_WIN) { const int c = (r % 64) * 32, sel = c >> 10, j = c & 1023; d.W = P0IN(3); d.ldw = 2048; d.WT = ws + WS_WIN; if (!I8_P1) { d.is8 = 0; d.scale = 1.f; } d.drow0 = 256 * (j >> 7) + 128 * sel + (j & 127); d.k0 = (r / 64) * 64; d.n0src = c; return; } r -= IT_WIN;
    if (r < IT_WOUT) { const int j = (r % 32) * 32; d.W = P0IN(9); d.ldw = 1024; d.WT = ws + WS_WOUT; if (!I8_P3) { d.is8 = 0; d.scale = 1.f; } d.drow0 = j; d.k0 = (r / 32) * 64; d.n0src = j; return; } r -= IT_WOUT;
    if (r < IT_FG) { const int j = (r % 86) * 32; d.W = P0IN(19); d.ldw = DFF; d.gsc = P0IN(18); d.WT = ws + WS_WF13; if (!I8_P4) { d.is8 = 0; d.scale = 1.f; } d.drow0 = 256 * (j >> 7) + (j & 127); d.k0 = (r / 86) * 64; d.n0src = j; return; } r -= IT_FG;
    if (r < IT_FU) { const int j = (r % 86) * 32; d.W = P0IN(20); d.ldw = DFF; d.gsc = P0IN(18); d.WT = ws + WS_WF13; if (!I8_P4) { d.is8 = 0; d.scale = 1.f; } d.drow0 = 256 * (j >> 7) + 128 + (j & 127); d.k0 = (r / 86) * 64; d.n0src = j; return; } r -= IT_FU;
    if (r < IT_FD) { const int j = (r % 32) * 32; d.W = P0IN(21); d.ldw = 1024; d.WT = ws + WS_WFD; d.Kp = DFFP; d.is8 = 0; d.scale = 1.f; d.drow0 = j; d.k0 = (r / 32) * 64; d.n0src = j; return; } r -= IT_FD;
    { const int j = (r % 32) * 32; d.W = P0IN(17); d.ldw = 1024; d.WT = ws + WS_WO; d.drow0 = j; d.k0 = (r / 32) * 64; d.n0src = j; d.is8 = 1; d.scale = W8_SCALE; }
}
__device__ __forceinline__ void tr_load(const TrDesc& d, f32x4 (&v)[8], f32x4 (&gv)[2], int lane) {
#pragma unroll
    for (int i = 0; i < 8; ++i) v[i] = __builtin_nontemporal_load((const f32x4*)(d.W + (size_t)(d.k0 + 8 * i + (lane >> 3)) * d.ldw + d.n0src + 4 * (lane & 7)));
    const float* gp = d.gsc ? d.gsc + d.k0 + 8 * (lane & 7) : d.W + (size_t)d.k0 * d.ldw + d.n0src;
    gv[0] = *(const f32x4*)gp; gv[1] = *(const f32x4*)(gp + 4);
}
__device__ __forceinline__ void tr_store(const TrDesc& d, const f32x4 (&v)[8], const f32x4 (&gv)[2], LAS float* scr, int lane) {
#pragma unroll
    for (int i = 0; i < 8; ++i) { LAS float* w = scr + (8 * i + (lane >> 3)) * 33 + 4 * (lane & 7); w[0] = v[i].x; w[1] = v[i].y; w[2] = v[i].z; w[3] = v[i].w; }
    LDS_WAIT(); asm volatile("" ::: "memory");
    const int c = lane & 7; const float sc = d.scale;
    const f32x4 one4 = {1.f, 1.f, 1.f, 1.f}; const f32x4 gv0 = d.gsc ? gv[0] : one4, gv1 = d.gsc ? gv[1] : one4;
#pragma unroll
    for (int j = 0; j < 4; ++j) { const int n = (lane >> 3) + 8 * j; const LAS float* s = scr + (8 * c) * 33 + n;
        const float x0 = s[0 * 33] * gv0.x * sc, x1 = s[1 * 33] * gv0.y * sc, x2 = s[2 * 33] * gv0.z * sc, x3 = s[3 * 33] * gv0.w * sc, x4 = s[4 * 33] * gv1.x * sc, x5 = s[5 * 33] * gv1.y * sc, x6 = s[6 * 33] * gv1.z * sc, x7 = s[7 * 33] * gv1.w * sc;
        if (d.is8 == 2) { pg8::u32x2 o; o.x = pg8::pk_i8x4(x0, x1, x2, x3); o.y = pg8::pk_i8x4(x4, x5, x6, x7); *(GAS pg8::u32x2*)(d.WT + (size_t)(d.drow0 + n) * d.Kp + d.k0 + 8 * c) = o; }
        else if (d.is8) { pg8::u32x2 o; o.x = pg8::pk_fp8x4(x0, x1, x2, x3); o.y = pg8::pk_fp8x4(x4, x5, x6, x7); *(GAS pg8::u32x2*)(d.WT + (size_t)(d.drow0 + n) * d.Kp + d.k0 + 8 * c) = o; }
        else { v4u o; o.x = pkbf(x0, x1); o.y = pkbf(x2, x3); o.z = pkbf(x4, x5); o.w = pkbf(x6, x7); *(GAS v4u*)((bf16*)d.WT + (size_t)(d.drow0 + n) * d.Kp + d.k0 + 8 * c) = o; } }
    LDS_WAIT(); asm volatile("" ::: "memory");
}

__device__ __forceinline__ void p0_items(kargp0_t kp, unsigned char* ws, LAS float* scr, int first, int stride, int lo, int hi, int lane) {
    TrDesc da, db, dc; f32x4 va[8], vb[8], vc[8]; f32x4 ga[2], gb[2], gc[2];
    int it = lo + first; const int NGW = stride;
    if (it < hi) { tr_desc(it, kp, ws, da); tr_load(da, va, ga, lane); }
    if (it + NGW < hi) { tr_desc(it + NGW, kp, ws, db); tr_load(db, vb, gb, lane); }
    while (it < hi) {
        if (it + 2 * NGW < hi) { tr_desc(it + 2 * NGW, kp, ws, dc); tr_load(dc, vc, gc, lane); }
        tr_store(da, va, ga, scr, lane);
        if (it + NGW >= hi) break;
        if (it + 3 * NGW < hi) { tr_desc(it + 3 * NGW, kp, ws, da); tr_load(da, va, ga, lane); }
        tr_store(db, vb, gb, scr, lane);
        if (it + 2 * NGW >= hi) break;
        if (it + 4 * NGW < hi) { tr_desc(it + 4 * NGW, kp, ws, db); tr_load(db, vb, gb, lane); }
        tr_store(dc, vc, gc, scr, lane);
        it += 3 * NGW;
    }
}
__device__ __forceinline__ void p0_items2(kargp0_t kp, unsigned char* ws, LAS float* scr, int first, int stride, int lo, int hi, int lane) {
    if (first >= hi - lo) return;
    const int n = (hi - lo - first + stride - 1) / stride, base = lo + first, last = n - 1;
    TrDesc da, db; f32x4 va[8], vb[8]; f32x4 ga[2], gb[2];
#define P0_ITEM(k) (base + ((k) < last ? (k) : last) * stride)
    tr_desc(base, kp, ws, da); tr_load(da, va, ga, lane);
    for (int k = 0; k + 1 < n; k += 2) {
        tr_desc(P0_ITEM(k + 1), kp, ws, db); tr_load(db, vb, gb, lane);
        tr_store(da, va, ga, scr, lane);
        tr_desc(P0_ITEM(k + 2), kp, ws, da); tr_load(da, va, ga, lane);
        tr_store(db, vb, gb, scr, lane);
    }
    if (n & 1) tr_store(da, va, ga, scr, lane);
#undef P0_ITEM
}
__device__ __forceinline__ void p0_prologue(kargp0_t kp, unsigned char* ws, LAS unsigned char* lds, int G, int vcu, int tid, int lane, int wave) {
    LAS float* scr = (LAS float*)(lds + RING_OFF + wave * 16384);
    const int gw = vcu * NWAVES + wave, NGW = G * NWAVES;
    bf16* WF13 = (bf16*)(ws + WS_WF13); bf16* WFD = (bf16*)(ws + WS_WFD);
    p0_items(kp, ws, scr, gw, NGW, (G == 256) ? IT_MOE : 0, IT_TOTAL, lane);
#ifdef PROBE_CONV_NC
    if ((vcu & 31) < PROBE_CONV_NC) p0_items(kp, ws, scr, ((vcu >> 5) * PROBE_CONV_NC + (vcu & 31)) * NWAVES + wave, 8 * PROBE_CONV_NC * NWAVES, 0, IT_MOE, lane);
#endif
    const int gt = vcu * (NWAVES * 64) + tid, NGT = G * NWAVES * 64; const v4u z = {0u, 0u, 0u, 0u};
    { constexpr int RB = I8_P4 ? 1024 : 2048, CH = RB / 16;
      for (int i = gt; i < 2 * 64 * CH; i += NGT) { const int sel = i / (64 * CH), rr = (i / CH) & 63, ch = i % CH; *(GAS v4u*)((unsigned char*)WF13 + (size_t)(256 * 21 + 128 * sel + 64 + rr) * RB + ch * 16) = z; } }
    for (int i = gt; i < 1024 * 8; i += NGT) { const int row = i >> 3, ch = i & 7; *(GAS v4u*)(WFD + (size_t)row * DFFP + DFF + ch * 8) = z; }
    const float* x = P0IN(0); const float* gn = P0IN(2); bf16* H0 = (bf16*)(ws + WS_H0);
    f32x4 gv[4];
#pragma unroll
    for (int j = 0; j < 4; ++j) gv[j] = *(const f32x4*)(gn + 4 * lane + 256 * j);
    for (int m0 = gw * 4; m0 < T; m0 += NGW * 4) {
        f32x4 v[4][4];
#pragma unroll
        for (int q = 0; q < 4; ++q) { const GAS f32x4* xr = (const GAS f32x4*)(x + (size_t)(m0 + q) * D) + lane;
#pragma unroll
            for (int j = 0; j < 4; ++j) v[q][j] = __builtin_nontemporal_load(xr + 64 * j); }
#pragma unroll
        for (int q = 0; q < 4; ++q) { float s = 0.f;
#pragma unroll
            for (int j = 0; j < 4; ++j) s += (v[q][j].x * v[q][j].x + v[q][j].y * v[q][j].y) + (v[q][j].z * v[q][j].z + v[q][j].w * v[q][j].w);
            const float rstd = 1.f / sqrtf(wave_sum(s) * (1.f / D) + EPS);
            if (I8_P1) { GAS unsigned* o4 = (GAS unsigned*)((unsigned char*)H0 + (size_t)(m0 + q) * D) + lane;
#pragma unroll
                for (int j = 0; j < 4; ++j) { const f32x4 y = v[q][j] * (rstd * SA_N) * gv[j]; o4[64 * j] = pg8::pk_i8x4(y.x, y.y, y.z, y.w); } }
            else { GAS unsigned long long* o8 = (GAS unsigned long long*)(H0 + (size_t)(m0 + q) * D) + lane;
#pragma unroll
                for (int j = 0; j < 4; ++j) { const f32x4 y = v[q][j] * rstd * gv[j]; o8[64 * j] = (unsigned long long)pkbf(y.x, y.y) | ((unsigned long long)pkbf(y.z, y.w) << 32); } } }
    }
}

__device__ __forceinline__ void conv_phase(const bf16* glu, const float* dw_w, const float* dw_b, const float* ln_g, const float* ln_b, bf16* vout, LAS unsigned char* lds, int G, int vcu, int tid, int lane, int wave) {
    LAS float* ybuf = (LAS float*)(lds + RING_OFF);
    const int c0 = 2 * tid;
    float w0[31], w1[31];
#pragma unroll
    for (int k = 0; k < 31; ++k) { const f32x2v w = *(const f32x2v*)(dw_w + k * 1024 + c0); w0[k] = w.x; w1[k] = w.y; }
    const f32x2v dbv = *(const f32x2v*)(dw_b + c0);
    LAS float* lnp = (LAS float*)(lds + XTRA_OFF);
    for (int i = tid; i < 1024; i += NWAVES * 64) { lnp[i] = ln_g[i]; lnp[1024 + i] = ln_b[i]; }
    __syncthreads();
    for (int item = vcu; item < T / 128; item += G) {
        const int b = item >> 5, s0 = (item & 31) * 128;
        const bf16* ub = glu + (size_t)b * SEQ * D + c0;
        float r0[32], r1[32];
        r0[0] = 0.f; r1[0] = 0.f; r0[1] = 0.f; r1[1] = 0.f;
#pragma unroll
        for (int i = 0; i < 30; ++i) { const int s = s0 - 30 + i; unsigned v = 0u; if (s >= 0) v = *(const unsigned*)(ub + (size_t)s * D); r0[i + 2] = bflo(v); r1[i + 2] = bfhi(v); }
        for (int base = 0; base < 128; base += 32) {
            unsigned nu[32];
#pragma unroll
            for (int j = 0; j < 32; ++j) nu[j] = *(const unsigned*)(ub + (size_t)(s0 + base + j) * D);
#pragma unroll
            for (int j = 0; j < 32; ++j) {
                r0[j] = bflo(nu[j]); r1[j] = bfhi(nu[j]);
                float y0 = dbv.x, y1 = dbv.y;
#pragma unroll
                for (int k = 0; k < 31; ++k) { const int idx = (j + 2 + k) & 31; y0 += r0[idx] * w0[k]; y1 += r1[idx] * w1[k]; }
                *(LAS f32x2v*)(ybuf + j * 1024 + c0) = (f32x2v){y0, y1};
            }
            __syncthreads();
            const int ntok = 32;
            for (int j = wave; j < ntok; j += NWAVES) {
                f32x4 y[4]; float s = 0.f;
#pragma unroll
                for (int i = 0; i < 4; ++i) { y[i] = *(const LAS f32x4*)(ybuf + j * 1024 + 4 * lane + 256 * i); s += (y[i].x + y[i].y) + (y[i].z + y[i].w); }
                const float mean = wave_sum(s) * (1.f / D); float q = 0.f;
#pragma unroll
                for (int i = 0; i < 4; ++i) { y[i] = y[i] - mean; q += (y[i].x * y[i].x + y[i].y * y[i].y) + (y[i].z * y[i].z + y[i].w * y[i].w); }
                const float rstd = 1.f / sqrtf(wave_sum(q) * (1.f / D) + EPS);
                GAS unsigned* o4 = (GAS unsigned*)((unsigned char*)vout + ((size_t)b * SEQ + s0 + base + j) * D) + lane;
                GAS unsigned long long* o8 = (GAS unsigned long long*)(vout + ((size_t)b * SEQ + s0 + base + j) * D) + lane;
#pragma unroll
                for (int i = 0; i < 4; ++i) { const f32x4 lgv = *(const LAS f32x4*)(lnp + 4 * lane + 256 * i), lbv = *(const LAS f32x4*)(lnp + 1024 + 4 * lane + 256 * i); f32x4 z = y[i] * rstd * lgv + lbv;
                    z.x *= pg8::fast_sigmoid(z.x); z.y *= pg8::fast_sigmoid(z.y); z.z *= pg8::fast_sigmoid(z.z); z.w *= pg8::fast_sigmoid(z.w);
                    if (I8_P3) o4[64 * i] = pg8::pk_i8x4(z.x * SA_N, z.y * SA_N, z.z * SA_N, z.w * SA_N);
                    else o8[64 * i] = (unsigned long long)pkbf(z.x, z.y) | ((unsigned long long)pkbf(z.z, z.w) << 32); }
            }
            __syncthreads();
        }
    }
}

__device__ __forceinline__ void attn_phase(LAS unsigned char* lds, int grp, const bf16* Kb, const bf16* Vb, const bf16* Qb, bf16* Ob, unsigned char* O8, float* lse, const float* rel_bias, unsigned* qheads, int G, int vcu, int tid, int lane, int wave) {
    const int dsh = 2 * grp, dil = 1 << dsh;
    LAS unsigned char* Kl = lds + RING_OFF;
    LAS unsigned char* Vl = lds + RING_OFF + 55296;
    LAS float* btab_all = (LAS float*)(lds + XTRA_OFF);
    for (int i = tid; i < 16 * 192; i += NWAVES * 64) { const int hh = i / 192, j = i % 192, dist = 159 - j;
        btab_all[i] = (dist >= 0 && dist <= 128) ? rel_bias[(int)T5_BUCKET[grp][dist] * 48 + grp * 16 + hh] * LOG2E - SOFTMAX_OFS : -1.0e30f; }
    const int lq = lane & 31, hi = lane >> 5;
    v4u kvp[6], vvp[6];
#define ATT_DECODE(IDX, b_, h_, res_, n0_) const int bh_##b_ = (IDX) >> 4, w16_##b_ = (IDX) & 15, b_ = bh_##b_ >> 4, h_ = bh_##b_ & 15, res_ = w16_##b_ & (dil - 1), n0_ = (w16_##b_ >> dsh) * 256
#define ATT_LOAD(IDX) do { ATT_DECODE(IDX, pb, ph, pres, pn0); \
        _Pragma("unroll") for (int i = 0; i < 6; ++i) { const int cidx = tid + 512 * i, j = cidx >> 3, c16 = cidx & 7, sub = pn0 - 128 + j; \
            kvp[i] = (v4u){0u, 0u, 0u, 0u}; vvp[i] = kvp[i]; \
            if (sub >= 0) { const size_t off = ((size_t)pb * SEQ + ((size_t)sub << dsh) + pres) * D + ph * 64 + c16 * 8; kvp[i] = *(const GAS v4u*)(Kb + off); vvp[i] = *(const GAS v4u*)(Vb + off); } } } while (0)
    pg8::bf16x8 qnext[4];
#define ATT_LOADQ(IDX) do { ATT_DECODE(IDX, qb_, qh_, qres_, qn0_); const size_t qrow_ = (size_t)qb_ * SEQ + ((size_t)(qn0_ + 32 * wave + lq) << dsh) + qres_; \
        _Pragma("unroll") for (int c = 0; c < 4; ++c) qnext[c] = *(const pg8::bf16x8*)(Qb + qrow_ * D + qh_ * 64 + 16 * c + 8 * hi); } while (0)
    const bool dyn = (G == 256);
    const int xq = vcu >> 5;
    LAS int* qL = (LAS int*)(lds + XTRA_OFF + 12288 + 64);
    int idx = vcu;
    if (idx < 2048) { ATT_LOAD(idx); ATT_LOADQ(idx); }
    __syncthreads();
    while (idx < 2048) {
        int claimed = 0;
        if (dyn && tid == 0) claimed = (int)__hip_atomic_fetch_add(qheads + 16 * xq, 1u, __ATOMIC_RELAXED, __HIP_MEMORY_SCOPE_AGENT);
        ATT_DECODE(idx, b, h, res, n0);
        const int ql = 32 * wave + lq;
        const size_t qrow = (size_t)b * SEQ + ((size_t)(n0 + ql) << dsh) + res;
        pg8::bf16x8 qr[4];
#pragma unroll
        for (int c = 0; c < 4; ++c) qr[c] = qnext[c];
        __syncthreads();
#pragma unroll
        for (int i = 0; i < 6; ++i) { const int cidx = tid + 512 * i, j = cidx >> 3, c16 = cidx & 7;
            *(LAS v4u*)(Kl + j * 144 + c16 * 16) = kvp[i]; *(LAS v4u*)(Vl + (c16 >> 2) * 24576 + j * 64 + (c16 & 3) * 16) = vvp[i]; }
        if (dyn && tid == 0) qL[0] = 32 + claimed;
        __syncthreads();
        int nidx = idx + G;
        if (dyn) { const int jn = qL[0]; nidx = jn < 256 ? ((jn >> 5) << 8) + (xq << 5) + (jn & 31) : 2048; }
        if (nidx < 2048) ATT_LOAD(nidx);
        float sv[5][16]; float m = -3.0e38f;
        const int kofs = n0 - 128 + 32 * wave;
        const LAS float* brow = btab_all + h * 192 + (31 - lq + 4 * hi);
#pragma unroll
        for (int kt = 0; kt < 5; ++kt) {
            f32x16 S = (f32x16){0.f, 0.f, 0.f, 0.f, 0.f, 0.f, 0.f, 0.f, 0.f, 0.f, 0.f, 0.f, 0.f, 0.f, 0.f, 0.f};
#pragma unroll
            for (int c = 0; c < 4; ++c) { const pg8::bf16x8 a = *(const LAS pg8::bf16x8*)(Kl + (32 * wave + 32 * kt + lq) * 144 + (16 * c + 8 * hi) * 2);
                S = __builtin_amdgcn_mfma_f32_32x32x16_bf16(a, qr[c], S, 0, 0, 0); }
#pragma unroll
            for (int r = 0; r < 16; ++r) { const float s = S[r] + brow[32 * kt + (r & 3) + 8 * (r >> 2)]; sv[kt][r] = s; }
            __builtin_amdgcn_sched_barrier(0);
        }
        if (kofs < 0) {
#pragma unroll
            for (int kt = 0; kt < 5; ++kt)
#pragma unroll
                for (int r = 0; r < 16; ++r) { const int kk = 32 * kt + crow(r, hi); if (kofs + kk < 0) sv[kt][r] = -1.0e30f; }
        }
        m = SOFTMAX_OFS;
        float l = 0.f; unsigned pw[5][8];
#pragma unroll
        for (int kt = 0; kt < 5; ++kt) {
#pragma unroll
            for (int r = 0; r < 16; r += 2) { const float p0 = __builtin_amdgcn_exp2f(sv[kt][r]), p1 = __builtin_amdgcn_exp2f(sv[kt][r + 1]); l += p0 + p1; pw[kt][r >> 1] = pkbf(p0, p1); }
            __builtin_amdgcn_sched_barrier(0);
        }
        l += __shfl_xor(l, 32);
        f32x16 O0 = (f32x16){0.f, 0.f, 0.f, 0.f, 0.f, 0.f, 0.f, 0.f, 0.f, 0.f, 0.f, 0.f, 0.f, 0.f, 0.f, 0.f}, O1 = O0;
        const int vlane = ((lane & 15) >> 2) * 64 + ((lane >> 4) & 1) * 32 + (lane & 3) * 8;
#pragma unroll
        for (int kt = 0; kt < 5; ++kt)
#pragma unroll
            for (int s2 = 0; s2 < 2; ++s2) {
                v4u pq; pq.x = pw[kt][4 * s2 + 0]; pq.y = pw[kt][4 * s2 + 1]; pq.z = pw[kt][4 * s2 + 2]; pq.w = pw[kt][4 * s2 + 3];
                const pg8::bf16x8 pf = __builtin_bit_cast(pg8::bf16x8, pq);
                const int vrow = 32 * wave + 32 * kt + 16 * s2 + 4 * hi;
                LAS unsigned char* vp = Vl + vrow * 64 + vlane;
                const v4i16_t a0 = __builtin_amdgcn_ds_read_tr16_b64_v4i16((LAS v4i16_t*)(vp)), a1 = __builtin_amdgcn_ds_read_tr16_b64_v4i16((LAS v4i16_t*)(vp + 512));
                const v4i16_t b0 = __builtin_amdgcn_ds_read_tr16_b64_v4i16((LAS v4i16_t*)(vp + 24576)), b1 = __builtin_amdgcn_ds_read_tr16_b64_v4i16((LAS v4i16_t*)(vp + 24576 + 512));
                const pg8::bf16x8 vf0 = (pg8::bf16x8){a0[0], a0[1], a0[2], a0[3], a1[0], a1[1], a1[2], a1[3]};
                const pg8::bf16x8 vf1 = (pg8::bf16x8){b0[0], b0[1], b0[2], b0[3], b1[0], b1[1], b1[2], b1[3]};
                O0 = __builtin_amdgcn_mfma_f32_32x32x16_bf16(vf0, pf, O0, 0, 0, 0);
                O1 = __builtin_amdgcn_mfma_f32_32x32x16_bf16(vf1, pf, O1, 0, 0, 0);
                __builtin_amdgcn_sched_barrier(0);
            }
        if (nidx < 2048) ATT_LOADQ(nidx);
        const float inv_l = 1.f / l, lse2 = m + __builtin_amdgcn_logf(l);
        const size_t orow = qrow;
        v4u oldv[4];
        if (grp != 0) {
#pragma unroll
            for (int i = 0; i < 4; ++i) { const int ch = lane + 64 * i, qq = ch >> 3, c8 = ch & 7; oldv[i] = *(const GAS v4u*)(Ob + ((size_t)b * SEQ + ((size_t)(n0 + 32 * wave + qq) << dsh) + res) * D + h * 64 + c8 * 8); } }
        float co = 0.f, cg = inv_l, lnew = lse2;
        if (grp != 0) { const float lo_ = lse[orow * 16 + h]; const float M = fmaxf(lo_, lse2); const float wo = __builtin_amdgcn_exp2f(lo_ - M), wg = __builtin_amdgcn_exp2f(lse2 - M), den = wo + wg;
            co = wo / den; cg = wg / den * inv_l; lnew = M + __builtin_amdgcn_logf(den); }
        __syncthreads();
        LAS unsigned char* stg = Kl + wave * 4608;
        LAS float* cot = (LAS float*)(Kl + 8 * 4608) + wave * 32;
#pragma unroll
        for (int rg = 0; rg < 4; ++rg) {
            pg8::u32x2 wa, wb; wa.x = pkbf(O0[4 * rg] * cg, O0[4 * rg + 1] * cg); wa.y = pkbf(O0[4 * rg + 2] * cg, O0[4 * rg + 3] * cg);
            wb.x = pkbf(O1[4 * rg] * cg, O1[4 * rg + 1] * cg); wb.y = pkbf(O1[4 * rg + 2] * cg, O1[4 * rg + 3] * cg);
            *(LAS pg8::u32x2*)(stg + lq * 144 + (8 * rg + 4 * hi) * 2) = wa; *(LAS pg8::u32x2*)(stg + lq * 144 + (32 + 8 * rg + 4 * hi) * 2) = wb; }
        if (hi == 0) cot[lq] = co;
        if (hi == 0) lse[orow * 16 + h] = lnew;
#pragma unroll
        for (int i = 0; i < 4; ++i) { const int ch = lane + 64 * i, qq = ch >> 3, c8 = ch & 7;
            const v4u sv4 = *(const LAS v4u*)(stg + qq * 144 + c8 * 16);
            bf16* op = Ob + ((size_t)b * SEQ + ((size_t)(n0 + 32 * wave + qq) << dsh) + res) * D + h * 64 + c8 * 8;
            v4u ov = sv4;
            if (grp != 0) { const float cq = cot[qq]; const v4u old = oldv[i];
                ov.x = pkbf(bflo(sv4.x) + cq * bflo(old.x), bfhi(sv4.x) + cq * bfhi(old.x)); ov.y = pkbf(bflo(sv4.y) + cq * bflo(old.y), bfhi(sv4.y) + cq * bfhi(old.y));
                ov.z = pkbf(bflo(sv4.z) + cq * bflo(old.z), bfhi(sv4.z) + cq * bfhi(old.z)); ov.w = pkbf(bflo(sv4.w) + cq * bflo(old.w), bfhi(sv4.w) + cq * bfhi(old.w)); }
            if (grp == 2) { unsigned char* o8 = O8 + ((size_t)b * SEQ + ((size_t)(n0 + 32 * wave + qq) << dsh) + res) * D + h * 64 + c8 * 8;
                pg8::u32x2 w8; w8.x = pg8::pk_fp8x4(bflo(ov.x) * O8_SCALE, bfhi(ov.x) * O8_SCALE, bflo(ov.y) * O8_SCALE, bfhi(ov.y) * O8_SCALE); w8.y = pg8::pk_fp8x4(bflo(ov.z) * O8_SCALE, bfhi(ov.z) * O8_SCALE, bflo(ov.w) * O8_SCALE, bfhi(ov.w) * O8_SCALE);
                *(GAS pg8::u32x2*)o8 = w8; }
            else *(GAS v4u*)op = ov; }
        idx = nidx;
    }
    __syncthreads();
#undef ATT_DECODE
#undef ATT_LOAD
#undef ATT_LOADQ
}

__device__ __forceinline__ void route_phase(const _Float16* x3, const float* gnorm, const float* wr, unsigned char* ws, LAS unsigned char* lds, int G, int vcu, int tid, int lane, int wave) {
    LAS float* WrT = (LAS float*)(lds + RING_OFF);
    LAS unsigned* wcL = (LAS unsigned*)(lds + RING_OFF + 32768);
    for (int i = tid; i < 8192; i += NWAVES * 64) { const int e = i >> 10, k = i & 1023; WrT[i] = wr[k * 8 + e] * gnorm[k]; }
    __syncthreads();
    unsigned* route = (unsigned*)(ws + WS_ROUTE); float* gate1 = (float*)(ws + WS_GATE1); float* gate2 = (float*)(ws + WS_GATE2);
    unsigned* wavecnt = (unsigned*)(ws + WS_WAVECNT); int* blockcnt = (int*)(ws + WS_BLOCKCNT); unsigned char* H3 = ws + WS_H3;
    const int gw = vcu * NWAVES + wave, NGW = G * NWAVES, tpw = (T + NGW - 1) / NGW;
    const int t0 = gw * tpw, t1 = (t0 + tpw) < T ? (t0 + tpw) : T;
    f32x4 gv[4];
#pragma unroll
    for (int j = 0; j < 4; ++j) gv[j] = *(const f32x4*)(gnorm + 4 * lane + 256 * j);
    unsigned long long cnt0 = 0ull, cnt1 = 0ull;
    f32x4 vn[4];
    if (t0 < t1) { const GAS pg8::h16x4* xr = (const GAS pg8::h16x4*)(x3 + (size_t)t0 * D) + lane;
#pragma unroll
        for (int j = 0; j < 4; ++j) vn[j] = __builtin_convertvector(xr[64 * j], f32x4); }
    for (int t = t0; t < t1; ++t) {
        f32x4 v[4]; float ss = 0.f;
#pragma unroll
        for (int j = 0; j < 4; ++j) { v[j] = vn[j]; ss += (v[j].x * v[j].x + v[j].y * v[j].y) + (v[j].z * v[j].z + v[j].w * v[j].w); }
        if (t + 1 < t1) { const GAS pg8::h16x4* xr = (const GAS pg8::h16x4*)(x3 + (size_t)(t + 1) * D) + lane;
#pragma unroll
            for (int j = 0; j < 4; ++j) vn[j] = __builtin_convertvector(xr[64 * j], f32x4); }
        float dt[8];
#pragma unroll
        for (int e = 0; e < 8; ++e) { float a = 0.f;
#pragma unroll
            for (int j = 0; j < 4; ++j) { const f32x4 w = *(const LAS f32x4*)(WrT + e * 1024 + 4 * lane + 256 * j); a += (v[j].x * w.x + v[j].y * w.y) + (v[j].z * w.z + v[j].w * w.w); }
            dt[e] = a; }
        ss = wave_sum(ss);
#pragma unroll
        for (int e = 0; e < 8; ++e) dt[e] = wave_sum(dt[e]);
        const float rstd = 1.f / sqrtf(ss * (1.f / D) + EPS);
        GAS unsigned* o4 = (GAS unsigned*)(H3 + (size_t)t * D) + lane;
#pragma unroll
        for (int j = 0; j < 4; ++j) { const f32x4 y = v[j] * (rstd * SA_N) * gv[j]; o4[64 * j] = pg8::pk_i8x4(y.x, y.y, y.z, y.w); }
        int e1 = 0; float v1 = dt[0] * rstd;
#pragma unroll
        for (int e = 1; e < 8; ++e) { const float x = dt[e] * rstd; if (x > v1) { v1 = x; e1 = e; } }
        int e2 = -1; float v2 = -3.0e38f;
#pragma unroll
        for (int e = 0; e < 8; ++e) { const float x = dt[e] * rstd; if (e != e1 && x > v2) { v2 = x; e2 = e; } }
        const float g2 = 1.f / (1.f + __expf(v1 - v2)), g1 = 1.f - g2;
        cnt0 += 1ull << (8 * e1); cnt1 += 1ull << (8 * e2);
        if (lane == 0) { route[t] = (unsigned)e1 | ((unsigned)e2 << 8); gate1[t] = g1; gate2[t] = g2; }
    }
    if (lane == 0) { v4u c; c.x = (unsigned)cnt0; c.y = (unsigned)(cnt0 >> 32); c.z = (unsigned)cnt1; c.w = (unsigned)(cnt1 >> 32);
        *(GAS v4u*)(wavecnt + (size_t)gw * 4) = c; wcL[wave * 4 + 0] = c.x; wcL[wave * 4 + 1] = c.y; wcL[wave * 4 + 2] = c.z; wcL[wave * 4 + 3] = c.w; }
    __syncthreads();
    if (tid < 16) { const int slot = tid >> 3, e = tid & 7; int s = 0;
#pragma unroll
        for (int w = 0; w < NWAVES; ++w) s += (int)((wcL[w * 4 + slot * 2 + (e >> 2)] >> (8 * (e & 3))) & 255u);
        blockcnt[vcu * 16 + tid] = s; }
    __syncthreads();
}

__device__ __forceinline__ void pos_phase(unsigned char* ws, LAS unsigned char* lds, int G, int vcu, int tid, int lane, int wave) {
    LAS int* cntL = (LAS int*)(lds + RING_OFF);
    LAS int* pAll = (LAS int*)(lds + RING_OFF + 65536);
    LAS int* pBef = pAll + 512;
    LAS int* totL = pBef + 512;
    const int* blockcnt = (const int*)(ws + WS_BLOCKCNT); const unsigned* wavecnt = (const unsigned*)(ws + WS_WAVECNT);
    const unsigned* route = (const unsigned*)(ws + WS_ROUTE); const float* gate1 = (const float*)(ws + WS_GATE1); const float* gate2 = (const float*)(ws + WS_GATE2);
    int* gofs = (int*)(ws + WS_GOFS);
    for (int i = tid; i < G * 16; i += NWAVES * 64) cntL[i] = blockcnt[i];
    __syncthreads();
    { const int c = tid & 15, part = tid >> 4, bpp = (G + 31) / 32; int sa = 0, sb = 0;
      for (int bb = part * bpp; bb < (part + 1) * bpp && bb < G; ++bb) { const int v = cntL[bb * 16 + c]; sa += v; if (bb < vcu) sb += v; }
      pAll[part * 16 + c] = sa; pBef[part * 16 + c] = sb; }
    __syncthreads();
    if (tid < 16) { int sa = 0, sb = 0;
        for (int p = 0; p < 32; ++p) { sa += pAll[p * 16 + tid]; sb += pBef[p * 16 + tid]; }
        totL[tid] = sa; totL[16 + tid] = sb; }
    __syncthreads();
    if (tid == 0) { int off = 0;
        for (int e = 0; e < 8; ++e) { totL[32 + e] = off; totL[32 + 8 + e] = off + totL[e]; if (vcu == 0) { gofs[e] = off; gofs[8 + e] = off + totL[e]; gofs[32 + e] = off >> 8; } off += ((totL[e] + totL[8 + e] + 255) >> 8) << 8; }
        if (vcu == 0) gofs[16] = off >> 8; }
    __syncthreads();
    const int gw = vcu * NWAVES + wave, NGW = G * NWAVES, tpw = (T + NGW - 1) / NGW;
    const int t0 = gw * tpw, t1 = (t0 + tpw) < T ? (t0 + tpw) : T;
    int mypos = 0;
    if (lane < 16) { mypos = totL[32 + lane] + totL[16 + lane];
        for (int w = 0; w < wave; ++w) mypos += (int)((wavecnt[(size_t)(vcu * NWAVES + w) * 4 + (lane >> 3) * 2 + ((lane & 7) >> 2)] >> (8 * (lane & 3))) & 255u); }
    int* pos01 = (int*)(ws + WS_POS);
    int* rowtok0 = (int*)(ws + WS_ROWTOK); int* rowtok1 = rowtok0; float* rowgate0 = (float*)(ws + WS_ROWGATE); float* rowgate1 = rowgate0;
    for (int t = t0; t < t1; ++t) {
        const unsigned rt = route[t]; const int e1 = (int)(rt & 255u), e2 = (int)((rt >> 8) & 255u);
        const int p1 = __shfl(mypos, e1), p2 = __shfl(mypos, 8 + e2);
        if (lane == e1 || lane == 8 + e2) mypos += 1;
        if (lane == 0) { rowtok0[p1] = t; rowgate0[p1] = gate1[t]; rowtok1[p2] = t; rowgate1[p2] = gate2[t]; pos01[t] = p1; pos01[T + t] = p2; }
    }
    if (vcu < 8) { int* rtk = (int*)(ws + WS_ROWTOK); float* rgt = (float*)(ws + WS_ROWGATE);
        const int beg = totL[32 + vcu] + totL[vcu] + totL[8 + vcu], end = totL[32 + vcu] + (((totL[vcu] + totL[8 + vcu] + 255) >> 8) << 8);
        for (int i = beg + tid; i < end; i += NWAVES * 64) { rtk[i] = -1; rgt[i] = 0.f; } }
    __syncthreads();
}

__device__ __forceinline__ void combine_phase(float* out, unsigned char* ws, int G, int vcu, int tid, int lane, int wave) {
    const int* pos01 = (const int*)(ws + WS_POS); const unsigned char* Y = ws + WS_Y; const _Float16* XH = (const _Float16*)(ws + WS_XH);
    const int gw = vcu * NWAVES + wave, NGW = G * NWAVES; const float ys = 1.f / Y_SCALE;
    for (int t0 = gw * 4; t0 < T; t0 += NGW * 4) {
        v4u ya[4], yb[4]; f32x4 o[4][4];
#pragma unroll
        for (int q = 0; q < 4; ++q) { const int t = t0 + q; const int p0 = pos01[t], p1 = pos01[T + t];
            ya[q] = *(const GAS v4u*)(Y + (size_t)p0 * 1024 + 16 * lane); yb[q] = *(const GAS v4u*)(Y + (size_t)p1 * 1024 + 16 * lane);
#pragma unroll
            for (int j = 0; j < 4; ++j) o[q][j] = __builtin_convertvector(*(const GAS pg8::h16x4*)(XH + (size_t)t * 1024 + 16 * lane + 4 * j), f32x4); }
#pragma unroll
        for (int q = 0; q < 4; ++q)
#pragma unroll
            for (int j = 0; j < 4; ++j) { const unsigned a = ya[q][j], c = yb[q][j]; f32x4 x = o[q][j];
                x.x += (float)(((int)(a << 24) >> 24) + ((int)(c << 24) >> 24)) * ys; x.y += (float)(((int)(a << 16) >> 24) + ((int)(c << 16) >> 24)) * ys;
                x.z += (float)(((int)(a << 8) >> 24) + ((int)(c << 8) >> 24)) * ys; x.w += (float)(((int)a >> 24) + ((int)c >> 24)) * ys;
                __builtin_nontemporal_store(x, (GAS f32x4*)(out + (size_t)(t0 + q) * 1024 + 16 * lane + 4 * j)); }
    }
}

constexpr int N_LAUNCHES = MK_N_LAUNCHES;
struct Args { const float* in[26]; float* out; unsigned char* ws; int ph_lo, ph_hi; };
typedef const __attribute__((address_space(4))) unsigned char* kargp_t;
#ifdef PROBE_CLK_PHASE
#define CLK_BEGIN(k) unsigned long long ck0_ = 0, rt0_ = 0; if ((k) == PROBE_CLK_PHASE) { ck0_ = __builtin_amdgcn_s_memtime(); rt0_ = __builtin_amdgcn_s_memrealtime(); }
#define CLK_END(k) if ((k) == PROBE_CLK_PHASE && bx == 0 && tid == 0) { const unsigned long long ck1_ = __builtin_amdgcn_s_memtime(), rt1_ = __builtin_amdgcn_s_memrealtime(); const float qv_ = floorf((float)(ck1_ - ck0_) / (float)(rt1_ - rt0_) + 0.5f); ((float*)(ws + WS_GOFS))[100] = 100.f * qv_ * qv_; }
#else
#define CLK_BEGIN(k)
#define CLK_END(k)
#endif
#define PH_ENTER() kargp_t kp_ = kp0; asm volatile("" : "+s"(kp_)); int tid = tid0; asm volatile("" : "+v"(tid)); const int lane = tid & 63, wave = __builtin_amdgcn_readfirstlane(tid >> 6); \
    unsigned char* ws = *(unsigned char* const __attribute__((address_space(4)))*)(kp_ + 216); float* out = *(float* const __attribute__((address_space(4)))*)(kp_ + 208); (void)lane; (void)wave; (void)out
#define INP(i) (*(const float* const __attribute__((address_space(4)))*)(kp_ + 8 * (i)))
__global__ void __launch_bounds__(NWAVES * 64, 2) mk_fwd(Args args) {
    extern __shared__ __attribute__((aligned(16))) unsigned char lds_raw[];
    LAS unsigned char* lds = (LAS unsigned char*)lds_raw;
    static_assert(sizeof(Args) == 232 && __builtin_offsetof(Args, out) == 208 && __builtin_offsetof(Args, ws) == 216, "Args layout");
    const kargp_t kp0 = (kargp_t)__builtin_amdgcn_kernarg_segment_ptr();
    const int tid0 = threadIdx.x;
    const int G = gridDim.x, bx = blockIdx.x, vcu = (G % 8 == 0) ? (bx % 8) * (G / 8) + bx / 8 : bx;
    for (int u = tid0; u < (XTRA_OFF - LDSCTL_OFF) / 4; u += NWAVES * 64) ((LAS unsigned*)(lds + LDSCTL_OFF))[u] = 0u;
    __syncthreads();
    XcdBarrier bar; bar.bar = (unsigned*)(args.ws + WS_CTL) + CW_BAR; bar.x = 0; bar.st = (volatile LAS unsigned*)(lds + MISC_OFF) + 8;
    if (N_LAUNCHES == 1) bar = xcd_barrier_post((unsigned*)(args.ws + WS_CTL) + CW_BAR, (volatile LAS unsigned*)(lds + MISC_OFF) + 8);
#define GRID_BAR() do { if (N_LAUNCHES == 1) xcd_barrier(bar); } while (0)
    const int lo = args.ph_lo, hi = args.ph_hi;
#ifndef PH_MASK
#define PH_MASK 0xFFFFFFFFu
#endif
#define IN(k) (((PH_MASK >> (k)) & 1u) && lo <= (k) && (k) < hi)
#define BOTH(k) (IN(k) && IN((k) + 1))
#ifndef PROBE_NOEPI
#define PROBE_NOEPI 0
#endif
#ifndef PROBE_REP_MASK
#define PROBE_REP_MASK 0u
#define PROBE_REP_N 1
#endif
#define REPS(k) (((PROBE_REP_MASK >> (k)) & 1u) ? PROBE_REP_N : 1)

    _Pragma("nounroll") for (int rep_ = 0; rep_ < REPS(0); ++rep_) if (IN(0)) { PH_ENTER(); CLK_BEGIN(0); p0_prologue(kp_, ws, lds, G, vcu, tid, lane, wave); __syncthreads(); CLK_END(0); if (BOTH(0)) GRID_BAR(); }
    _Pragma("nounroll") for (int rep_ = 0; rep_ < REPS(1); ++rep_) if (IN(1)) { PH_ENTER(); CLK_BEGIN(1);
        pg8::Gemm g{(const bf16*)(ws + WS_H0), (const bf16*)(ws + WS_WIN), T, 2048, 1024, 0, nullptr, nullptr, nullptr, nullptr, 0}; pg8::StaticOrder S; S.init(T, 2048, G, bx, I8_P1 ? 1024 / 128 : 1024 / 64);
        pg8::EpiGated<0> E{(bf16*)(ws + WS_GLU), 1024, INP(4), 1024, nullptr, I8_P1 ? 1.f / (SA_N * SW_I8) : 1.f, 1.f, {}, -1};
        pg8::gemm_phase<pg8::EpiGated<0>, pg8::StaticOrder, false, I8_P1 ? 2 : 0>(lds + RING_OFF, g, S, E, tid);
        CLK_END(1); if (BOTH(1)) GRID_BAR();
    }
    _Pragma("nounroll") for (int rep_ = 0; rep_ < REPS(2); ++rep_) if (IN(2)) { PH_ENTER(); CLK_BEGIN(2); conv_phase((const bf16*)(ws + WS_GLU), INP(5), INP(6), INP(7), INP(8), (bf16*)(ws + WS_V), lds, G, vcu, tid, lane, wave); CLK_END(2); if (BOTH(2)) GRID_BAR(); }
    _Pragma("nounroll") for (int rep_ = 0; rep_ < REPS(3); ++rep_) if (IN(3)) { PH_ENTER(); CLK_BEGIN(3);
        pg8::Gemm g{(const bf16*)(ws + WS_V), (const bf16*)(ws + WS_WOUT), T, 1024, 1024, 0, nullptr, nullptr, nullptr, nullptr, 0}; pg8::StaticOrder S; S.init(T, 1024, G, bx, I8_P3 ? 1024 / 128 : 1024 / 64);
        pg8::EpiResid<true, true, I8_P4 ? 2 : 0, 0, 1> E{INP(0), (float*)(ws + WS_XH), INP(10), ws + WS_X1B, (float*)(ws + WS_PART1), I8_P3 ? 1.f / (SA_N * SW_I8) : 1.f, I8_P4 ? SA_X : 1.f, (LAS float*)(lds + XTRA_OFF)};
        pg8::gemm_phase<pg8::EpiResid<true, true, I8_P4 ? 2 : 0, 0, 1>, pg8::StaticOrder, false, I8_P3 ? 2 : 0>(lds + RING_OFF, g, S, E, tid);
        CLK_END(3); if (BOTH(3)) GRID_BAR();
    }
    _Pragma("nounroll") for (int rep_ = 0; rep_ < REPS(4); ++rep_) if (IN(4)) { PH_ENTER(); CLK_BEGIN(4);
        pg8::Gemm g{(const bf16*)(ws + WS_X1B), (const bf16*)(ws + WS_WF13), T, 5632, 1024, 0, nullptr, nullptr, nullptr, nullptr, 0}; pg8::StaticOrder S; S.init(T, 5632, G, bx, I8_P4 ? 1024 / 128 : 1024 / 64);
        pg8::EpiGated<1> E{(bf16*)(ws + WS_HB), DFFP, nullptr, 0, (const float*)(ws + WS_PART1), I8_P4 ? 1.f / (SA_X * SW_I8) : 1.f, 1.f, {}, -1};
        if (G == 256) {
            const int slot = vcu % 11;
            S.i1 = slot;
            pg8::gemm_phase<pg8::EpiGated<1>, pg8::StaticOrder, false, I8_P4 ? 2 : 0>(lds + RING_OFF, g, S, E, tid);
            __syncthreads();
            p0_items2(kp_, ws, (LAS float*)(lds + RING_OFF + wave * 16384), wave, NWAVES, vcu * (IT_MOE / 256), (vcu + 1) * (IT_MOE / 256), lane);
            __syncthreads();
            S.i0 = slot; S.i1 = 0x7fffffff;
        }
        pg8::gemm_phase<pg8::EpiGated<1>, pg8::StaticOrder, false, I8_P4 ? 2 : 0>(lds + RING_OFF, g, S, E, tid);
        CLK_END(4); if (BOTH(4)) GRID_BAR();
    }
    _Pragma("nounroll") for (int rep_ = 0; rep_ < REPS(5); ++rep_) if (IN(5)) { PH_ENTER(); CLK_BEGIN(5);
        pg8::Gemm g{(const bf16*)(ws + WS_HB), (const bf16*)(ws + WS_WFD), T, 1024, DFFP, 0, nullptr, nullptr, nullptr, nullptr, 0}; pg8::StaticOrder S; S.init(T, 1024, G, bx, DFFP / 64);
        pg8::EpiResid<false, true, 2, 1, 1> E{(const float*)(ws + WS_XH), (float*)(ws + WS_XH), nullptr, ws + WS_X2B, (float*)(ws + WS_PART2), 1.f, SA_X, (LAS float*)(lds + XTRA_OFF)};
        pg8::gemm_phase<pg8::EpiResid<false, true, 2, 1, 1>, pg8::StaticOrder, false>(lds + RING_OFF, g, S, E, tid);
        CLK_END(5); if (BOTH(5)) GRID_BAR();
    }
    for (int grp = 0; grp < 3; ++grp) {
        _Pragma("nounroll") for (int rep_ = 0; rep_ < REPS(6 + 2 * grp); ++rep_) if (IN(6 + 2 * grp)) { PH_ENTER(); CLK_BEGIN(6 + 2 * grp);
            pg8::Gemm g{(const bf16*)(ws + WS_X2B), (const bf16*)(ws + WS_WQKV + (size_t)grp * 3072 * 1024), T, 3072, 1024, 0, nullptr, nullptr, nullptr, nullptr, 0}; pg8::StaticOrder S; S.init(T, 3072, G, bx, 1024 / 128);
            pg8::EpiQKV E{(bf16*)(ws + WS_KG), (size_t)T * D, (const float*)(ws + WS_PART2), INP(13) + grp * 64, INP(16) + grp * 64, QSCALE, 1.f / (SA_X * SW_I8), {}, -1};
            pg8::gemm_phase<pg8::EpiQKV, pg8::StaticOrder, false, 2>(lds + RING_OFF, g, S, E, tid);
            CLK_END(6 + 2 * grp); if (BOTH(6 + 2 * grp)) GRID_BAR();
        }
        _Pragma("nounroll") for (int rep_ = 0; rep_ < REPS(7 + 2 * grp); ++rep_) if (IN(7 + 2 * grp)) { PH_ENTER(); CLK_BEGIN(7 + 2 * grp);
            attn_phase(lds, grp, (const bf16*)(ws + WS_KG), (const bf16*)(ws + WS_VG), (const bf16*)(ws + WS_QG), (bf16*)(ws + WS_O), ws + WS_O8, (float*)(ws + WS_LSE), INP(1), (unsigned*)(ws + WS_CTL) + CW_AQ + grp * 128, G, vcu, tid, lane, wave);
            CLK_END(7 + 2 * grp); if (BOTH(7 + 2 * grp)) GRID_BAR();
        }
    }
    _Pragma("nounroll") for (int rep_ = 0; rep_ < REPS(12); ++rep_) if (IN(12)) { PH_ENTER(); CLK_BEGIN(12);
        pg8::Gemm g{(const bf16*)(ws + WS_O8), (const bf16*)(ws + WS_WO), T, 1024, 1024, 0, nullptr, nullptr, nullptr, nullptr, 0}; pg8::StaticOrder S; S.init(T, 1024, G, bx, 1024 / 128);
        pg8::EpiResid<false, false, 0, 1, 1> E{(const float*)(ws + WS_XH), (float*)(ws + WS_XH), nullptr, nullptr, nullptr, 1.f / (W8_SCALE * O8_SCALE), 1.f, nullptr};
        pg8::gemm_phase<pg8::EpiResid<false, false, 0, 1, 1>, pg8::StaticOrder, false, 1>(lds + RING_OFF, g, S, E, tid);
        CLK_END(12); if (BOTH(12)) GRID_BAR();
    }
    _Pragma("nounroll") for (int rep_ = 0; rep_ < REPS(13); ++rep_) if (IN(13)) { PH_ENTER(); CLK_BEGIN(13); route_phase((const _Float16*)(ws + WS_XH), INP(18) + 1024, INP(22), ws, lds, G, vcu, tid, lane, wave); CLK_END(13); if (BOTH(13)) GRID_BAR(); }
    _Pragma("nounroll") for (int rep_ = 0; rep_ < REPS(14); ++rep_) if (IN(14)) { PH_ENTER(); CLK_BEGIN(14); pos_phase(ws, lds, G, vcu, tid, lane, wave); CLK_END(14); if (BOTH(14)) GRID_BAR(); }
    _Pragma("nounroll") for (int rep_ = 0; rep_ < REPS(15); ++rep_) if (IN(15)) { PH_ENTER(); CLK_BEGIN(15);
        const int* gofs = (const int*)(ws + WS_GOFS); const int* rowtok = (const int*)(ws + WS_ROWTOK);
        const int ntile = gofs[16];
        pg8::MoeOrder S; S.so.init(ntile * 256, 7168, G, bx, 1024 / 128); S.p0 = 0; S.p1 = 0; S.ppu = 0;
        S.t1 = gofs[32 + 1]; S.t2 = gofs[32 + 2]; S.t3 = gofs[32 + 3]; S.t4 = gofs[32 + 4]; S.t5 = gofs[32 + 5]; S.t6 = gofs[32 + 6]; S.t7 = gofs[32 + 7];
        pg8::Gemm g{(const bf16*)(ws + WS_H3), (const bf16*)(ws + WS_WM13), ntile * 256, 7168, 1024, (size_t)7168 * 1024, rowtok, nullptr, nullptr, nullptr, 0};
        pg8::EpiGated<3> E{(bf16*)(ws + WS_HM), DFFE, nullptr, 0, nullptr, 1.f / (SA_N * SW_I8), HM_SCALE, {}, -1};
        pg8::gemm_phase<pg8::EpiGated<3>, pg8::MoeOrder, true, 2>(lds + RING_OFF, g, S, E, tid);
        CLK_END(15); if (BOTH(15)) GRID_BAR();
    }
    _Pragma("nounroll") for (int rep_ = 0; rep_ < REPS(16); ++rep_) if (IN(16)) { PH_ENTER(); CLK_BEGIN(16);
        const int* gofs = (const int*)(ws + WS_GOFS); const float* rowgate = (const float*)(ws + WS_ROWGATE);
        const int ntile = gofs[16];
        pg8::MoeOrderSK S; S.so.init(ntile * 256, 1024, G, vcu, DFFE / 128); S.plan();
        S.t1 = gofs[32 + 1]; S.t2 = gofs[32 + 2]; S.t3 = gofs[32 + 3]; S.t4 = gofs[32 + 4]; S.t5 = gofs[32 + 5]; S.t6 = gofs[32 + 6]; S.t7 = gofs[32 + 7];
        pg8::Gemm g{(const bf16*)(ws + WS_HM), (const bf16*)(ws + WS_WM2), ntile * 256, 1024, DFFE, (size_t)1024 * DFFE, nullptr, ws + WS_SLAB, (unsigned*)(ws + WS_CTL) + CW_SKFLAG + (rep_ & 1) * 8192, (unsigned*)(ws + WS_CTL) + CW_TMO, 0};
        pg8::EpiMoeDown E{ws + WS_Y, rowgate, Y_SCALE / (W8_SCALE * HM_SCALE)};
        pg8::gemm_phase<pg8::EpiMoeDown, pg8::MoeOrderSK, false, 1>(lds + RING_OFF, g, S, E, tid);
        CLK_END(16); if (BOTH(16)) GRID_BAR();
    }
    _Pragma("nounroll") for (int rep_ = 0; rep_ < REPS(17); ++rep_) if (IN(17)) { PH_ENTER(); CLK_BEGIN(17); combine_phase(out, ws, G, vcu, tid, lane, wave); }
#ifdef PROBE_CLK_PHASE
    if (bx == 0 && tid0 == 0) { asm volatile("s_waitcnt vmcnt(0)" ::: "memory"); args.out[(size_t)T * D - 1] = ((float*)(args.ws + WS_GOFS))[100]; }
#endif
#ifdef PROBE_TCH
    {
        GRID_BAR();
        if (bx == 0 && tid0 == 0) { const unsigned tot = __hip_atomic_load((unsigned*)(args.ws + WS_CTL) + 60000, __ATOMIC_RELAXED, __HIP_MEMORY_SCOPE_AGENT); const unsigned long long wait_ticks = (unsigned long long)(tot / (unsigned)G) * PROBE_TCH;
            const unsigned long long t0_ = __builtin_amdgcn_s_memrealtime(); while (__builtin_amdgcn_s_memrealtime() - t0_ < wait_ticks) __builtin_amdgcn_s_sleep(8); } }
#endif
#undef IN
#undef BOTH
#undef GRID_BAR
}

extern "C" void kernel_launch(void* const* d_in, const int* in_sizes, int n_in, void* d_out, int out_size, void* d_ws, size_t ws_size, hipStream_t stream) {
    static int grid = 0;
    if (grid == 0) {
        if (n_in != 26 || in_sizes[0] != T * D || out_size != T * D || ws_size < WS_END) { fprintf(stderr, "kernel_launch: unexpected shapes: n_in %d in0 %d out %d ws %zu (need >= %zu); nothing launched\n", n_in, n_in > 0 ? in_sizes[0] : -1, out_size, ws_size, (size_t)WS_END); grid = -1; return; }
        int dev = 0, cus = 0;
        if (hipGetDevice(&dev) != hipSuccess || hipDeviceGetAttribute(&cus, hipDeviceAttributeMultiprocessorCount, dev) != hipSuccess) { fprintf(stderr, "kernel_launch: device query failed\n"); grid = -1; return; }
        if (hipFuncSetAttribute((const void*)mk_fwd, hipFuncAttributeMaxDynamicSharedMemorySize, LDS_BYTES) != hipSuccess) { fprintf(stderr, "kernel_launch: hipFuncSetAttribute failed\n"); grid = -1; return; }
        int per_cu = 0;
        if (hipOccupancyMaxActiveBlocksPerMultiprocessor(&per_cu, (const void*)mk_fwd, NWAVES * 64, LDS_BYTES) != hipSuccess || per_cu < 1) fprintf(stderr, "kernel_launch: note: occupancy query reports %d workgroups per CU\n", per_cu);
        (void)hipGetLastError();
        grid = cus;
    }
    if (grid < 0) return;
    if (hipMemsetAsync((char*)d_ws + WS_CTL, 0, CTL_ZERO_BYTES, stream) != hipSuccess) { fprintf(stderr, "kernel_launch: hipMemsetAsync failed\n"); return; }
    Args a{};
    for (int i = 0; i < 26; ++i) a.in[i] = (const float*)d_in[i];
    a.out = (float*)d_out; a.ws = (unsigned char*)d_ws;
    for (int li = 0; li < N_LAUNCHES; ++li) {
        a.ph_lo = (N_LAUNCHES == 1) ? 0 : li; a.ph_hi = (N_LAUNCHES == 1) ? NPHASE : li + 1;
        hipLaunchKernelGGL(mk_fwd, dim3(grid), dim3(NWAVES * 64), LDS_BYTES, stream, a);
        const hipError_t le = hipPeekAtLastError();
        if (le != hipSuccess) { fprintf(stderr, "kernel_launch: launch %d failed: %s\n", li, hipGetErrorName(le)); break; }
    }
}
```

```cpp
#include <hip/hip_runtime.h>
#include <cstdio>
#include <cstdint>
#ifndef MK_N_LAUNCHES
#define MK_N_LAUNCHES 1
#endif
namespace pg8 {
#define PG8_LAS __attribute__((address_space(3)))
#define PG8_GAS __attribute__((address_space(1)))
typedef unsigned short bf16_t;
typedef short bf16x8 __attribute__((ext_vector_type(8)));
typedef float f32x4 __attribute__((ext_vector_type(4)));
typedef float f32x2 __attribute__((ext_vector_type(2)));
typedef unsigned u32x4 __attribute__((ext_vector_type(4)));
typedef unsigned u32x2 __attribute__((ext_vector_type(2)));
typedef int v4i_t __attribute__((ext_vector_type(4)));
typedef int v8i_t __attribute__((ext_vector_type(8)));
constexpr int BM = 256, BK = 64, HALF = 128, HTB = HALF * BK * 2  , STAGE_BYTES = 8 * HTB, NXCD = 8, WGM = 8;

__host__ __device__ __forceinline__ int lds_byte(int r, int c) { const int st = (r >> 4) * 2 + (c >> 5), rr = r & 15, cc = c & 31, ob = rr * 64 + cc * 2; return st * 1024 + (ob ^ (((ob >> 9) & 1) << 5)); }
__host__ __device__ __forceinline__ void stage_rc(int b, int& R, int& C) { const int st = b / 1024, sb = b % 1024, swz = sb ^ (((sb >> 9) & 1) << 5); R = (st >> 1) * 16 + swz / 64; C = (st & 1) * 32 + (swz % 64) / 2; }
__host__ __device__ __forceinline__ int perm32(int rho) { const int n = rho >> 4, i = rho & 15; return 8 * (i >> 2) + 4 * n + (i & 3); }

struct Unit { int pm, pn, be, kt0, nkt, part; };
struct Gemm { const bf16_t* A; const bf16_t* Bt; int M, N, K; size_t bstride; const int* rowtok; unsigned char* slab; unsigned* skflag; unsigned* tmo; int noepi; };

struct StaticOrder {
    static constexpr bool STREAMK = false;
    int nM, nN, nwg, G, c, nt, i0, i1;
    __host__ __device__ __forceinline__ void init(int M, int N, int G_, int c_, int nt_) { nM = M / BM; nN = N / BM; nwg = nM * nN; G = G_; c = c_; nt = nt_; i0 = 0; i1 = 0x7fffffff; }
    __host__ __device__ __forceinline__ int wg() const { return c; }
    __host__ __device__ __forceinline__ bool next(int i, Unit& u) const { const int ii = i + i0; if (ii >= i1) return false; const long L = (long)ii * G + c; if (L >= nwg) return false; map((int)L, u); return true; }
    __host__ __device__ __forceinline__ void map_linear(int wgid, Unit& u) const {
        const int nig = WGM * nN, gid = wgid / nig, fm = gid * WGM, gsz = (nM - fm) < WGM ? (nM - fm) : WGM;
        u.pm = fm + ((wgid % nig) % gsz); u.pn = (wgid % nig) / gsz; u.be = 0; u.kt0 = 0; u.nkt = nt; u.part = 0;
    }
    __host__ __device__ __forceinline__ void map(int L, Unit& u) const {
        int wgid = L; { const int q = nwg / NXCD, r = nwg % NXCD, xcd = wgid % NXCD, off = wgid / NXCD; wgid = (xcd < r ? xcd * (q + 1) : r * (q + 1) + (xcd - r) * q) + off; }
        const int nig = WGM * nN, gid = wgid / nig, fm = gid * WGM, gsz = (nM - fm) < WGM ? (nM - fm) : WGM;
        u.pm = fm + ((wgid % nig) % gsz); u.pn = (wgid % nig) / gsz; u.be = 0; u.kt0 = 0; u.nkt = nt; u.part = 0;
    }
};
template <bool STREAMK_> struct MoeOrderT {
    static constexpr bool STREAMK = STREAMK_;
    StaticOrder so; int t1, t2, t3, t4, t5, t6, t7; int p0, p1, ppu;
    __device__ __forceinline__ int wg() const { return so.c; }
    __device__ __forceinline__ void plan() { ppu = so.nt / 2; const long tot = (long)so.nwg * ppu; p0 = (int)(tot * so.c / so.G); p1 = (int)(tot * (so.c + 1) / so.G); }
    __device__ __forceinline__ bool next(int i, Unit& u) const {
#if defined(PROBE_DOUBLE_KLOOP)
        if (!STREAMK) { if (!so.next(i >> 1, u)) return false; if (!(i & 1)) u.part = 3; }
#else
        if (!STREAMK) { if (!so.next(i, u)) return false; }
#endif
        else { const int first = p0 / ppu, uidx = first + i; const int s = (i == 0) ? (p0 - first * ppu) : 0; const int rem = p1 - uidx * ppu;
            if (rem <= s) return false;
            const int e = rem < ppu ? rem : ppu;
            so.map_linear(uidx, u); u.kt0 = 2 * s; u.nkt = 2 * (e - s); u.part = (s > 0) ? 1 : ((e < ppu) ? 2 : 0); }
        const int q = u.pm; u.be = (q >= t1) + (q >= t2) + (q >= t3) + (q >= t4) + (q >= t5) + (q >= t6) + (q >= t7); return true;
    }
};
typedef MoeOrderT<false> MoeOrder;
typedef MoeOrderT<true> MoeOrderSK;

__device__ __forceinline__ unsigned cvt_pk_bf16(float lo, float hi) { unsigned r; asm volatile("v_cvt_pk_bf16_f32 %0, %1, %2" : "=v"(r) : "v"(lo), "v"(hi)); return r; }
__device__ __forceinline__ float fast_sigmoid(float x) { return __builtin_amdgcn_rcpf(1.0f + __builtin_amdgcn_exp2f(-1.4426950408889634f * x)); }
__device__ __forceinline__ float row_rstd(const float* part, int row) {
    const f32x4 a = *(const f32x4*)(part + (size_t)row * 4);
    return __builtin_amdgcn_rsqf(((a[0] + a[1]) + (a[2] + a[3])) * (1.0f / 1024.0f) + 1e-6f);
}
__device__ __forceinline__ void row_rstd8(const float* part, int row0, float (&r)[2][4]) {
#pragma unroll
    for (int ai = 0; ai < 2; ++ai)
#pragma unroll
        for (int m = 0; m < 4; ++m) r[ai][m] = row_rstd(part, row0 + ai * HALF + m * 16);
}
__device__ __forceinline__ unsigned pk_fp8x4(float a, float b, float c, float d) {
    a = __builtin_amdgcn_fmed3f(a, -448.f, 448.f); b = __builtin_amdgcn_fmed3f(b, -448.f, 448.f); c = __builtin_amdgcn_fmed3f(c, -448.f, 448.f); d = __builtin_amdgcn_fmed3f(d, -448.f, 448.f);
    unsigned w = 0u; w = __builtin_amdgcn_cvt_pk_fp8_f32(a, b, w, false); w = __builtin_amdgcn_cvt_pk_fp8_f32(c, d, w, true); return w;
}
__device__ __forceinline__ unsigned pk_i8x4(float a, float b, float c, float d) {
    const int ia = (int)__builtin_rintf(__builtin_amdgcn_fmed3f(a, -127.f, 127.f)), ib = (int)__builtin_rintf(__builtin_amdgcn_fmed3f(b, -127.f, 127.f));
    const int ic = (int)__builtin_rintf(__builtin_amdgcn_fmed3f(c, -127.f, 127.f)), id = (int)__builtin_rintf(__builtin_amdgcn_fmed3f(d, -127.f, 127.f));
    return ((unsigned)ia & 255u) | (((unsigned)ib & 255u) << 8) | (((unsigned)ic & 255u) << 16) | ((unsigned)id << 24);
}

template <int MODE> struct EpiGated {
    static constexpr bool PERM = true, AFTER_DRAIN = false;
    bf16_t* O; int ldo; const float* bias; int bias_half; const float* part; float descale, out_scale;
    mutable float r8c[2][4]; mutable int pmc;
    __device__ __forceinline__ void operator()(const f32x4 (&acc)[2][2][4][2], const Unit& u, int wr, int wc, int fr, int fq) const {
        const int row0 = u.pm * BM + wr * 64 + fr, col0 = u.pn * 128 + wc * 32 + 8 * fq;
        f32x4 ba[2], bg[2];
#pragma unroll
        for (int n = 0; n < 2; ++n) { if (MODE == 0) { ba[n] = *(const f32x4*)(bias + col0 + 4 * n); bg[n] = *(const f32x4*)(bias + bias_half + col0 + 4 * n); } else { ba[n] = (f32x4){0.f, 0.f, 0.f, 0.f}; bg[n] = ba[n]; } }
        if ((MODE == 1 || MODE == 4) && u.pm != pmc) { row_rstd8(part, row0, r8c); pmc = u.pm; }
#pragma unroll
        for (int ai = 0; ai < 2; ++ai)
#pragma unroll
            for (int m = 0; m < 4; ++m) { const int row = row0 + ai * HALF + m * 16;
                float r = 1.f; if (MODE == 1 || MODE == 4) r = r8c[ai][m];
                f32x4 o[2];
#pragma unroll
                for (int n = 0; n < 2; ++n) { f32x4 a = acc[ai][0][m][n], g = acc[ai][1][m][n];
                    if (MODE == 0) { a = a * descale + ba[n]; g = g * descale + bg[n];
#pragma unroll
                        for (int e = 0; e < 4; ++e) o[n][e] = a[e] * fast_sigmoid(g[e]); }
                    else if (MODE == 3) {
                        const float c1 = -1.4426950408889634f * descale, c2 = descale * descale * out_scale;
#pragma unroll
                        for (int e = 0; e < 4; ++e) o[n][e] = (a[e] * g[e]) * __builtin_amdgcn_rcpf(1.0f + __builtin_amdgcn_exp2f(a[e] * c1)) * c2; }
                    else { if (MODE == 1) { a = a * (r * descale); g = g * (r * descale); } if (MODE == 4) { a = a * (r * descale); g = g * (r * descale * out_scale); }
#pragma unroll
                        for (int e = 0; e < 4; ++e) o[n][e] = a[e] * fast_sigmoid(a[e]) * g[e]; } }
                if (MODE == 3 || MODE == 4) { u32x2 w; w.x = pk_fp8x4(o[0][0], o[0][1], o[0][2], o[0][3]); w.y = pk_fp8x4(o[1][0], o[1][1], o[1][2], o[1][3]); *(u32x2*)((unsigned char*)O + (size_t)row * ldo + col0) = w; }
                else { u32x4 w; w.x = cvt_pk_bf16(o[0][0], o[0][1]); w.y = cvt_pk_bf16(o[0][2], o[0][3]); w.z = cvt_pk_bf16(o[1][0], o[1][1]); w.w = cvt_pk_bf16(o[1][2], o[1][3]);
                *(u32x4*)(O + (size_t)row * ldo + col0) = w; }
                }
    }
};
typedef _Float16 h16x4 __attribute__((ext_vector_type(4)));
template <bool BIAS, bool AUX, int XB8 = 0, int RIN = 0, int ROUT = 0> struct EpiResid {
    static constexpr bool PERM = false, AFTER_DRAIN = false;
    const float* resid; float* out; const float* bias; unsigned char* xb; float* part; float descale, xb_scale; PG8_LAS float* red;
    __device__ __forceinline__ void operator()(const f32x4 (&acc)[2][2][4][2], const Unit& u, int wr, int wc, int fr, int fq) const {
        const int row0 = u.pm * BM + wr * 64 + fr, col0 = u.pn * BM + wc * 32 + 4 * fq;
        f32x4 bv[2][2];
#pragma unroll
        for (int bj = 0; bj < 2; ++bj)
#pragma unroll
            for (int n = 0; n < 2; ++n) bv[bj][n] = BIAS ? *(const f32x4*)(bias + col0 + bj * HALF + n * 16) : (f32x4){0.f, 0.f, 0.f, 0.f};
#pragma unroll
        for (int ai = 0; ai < 2; ++ai)
#pragma unroll
            for (int m = 0; m < 4; ++m) { const int row = row0 + ai * HALF + m * 16; const size_t off = (size_t)row * 1024 + col0; float ss = 0.f;
#pragma unroll
                for (int bj = 0; bj < 2; ++bj)
#pragma unroll
                    for (int n = 0; n < 2; ++n) { const size_t o2 = off + bj * HALF + n * 16;
                        const f32x4 r = RIN ? __builtin_convertvector(*(const h16x4*)((const _Float16*)resid + o2), f32x4) : *(const f32x4*)(resid + o2);
                        const f32x4 x = r + acc[ai][bj][m][n] * descale + bv[bj][n];
                        if (ROUT) *(h16x4*)((_Float16*)out + o2) = __builtin_convertvector(x, h16x4); else *(f32x4*)(out + o2) = x;
                        if (AUX) { ss += (x[0] * x[0] + x[1] * x[1]) + (x[2] * x[2] + x[3] * x[3]); if (XB8 == 1) *(unsigned*)(xb + off + bj * HALF + n * 16) = pk_fp8x4(x[0] * xb_scale, x[1] * xb_scale, x[2] * xb_scale, x[3] * xb_scale);
                            else if (XB8 == 2) *(unsigned*)(xb + off + bj * HALF + n * 16) = pk_i8x4(x[0] * xb_scale, x[1] * xb_scale, x[2] * xb_scale, x[3] * xb_scale);
                            else { u32x2 w; w.x = cvt_pk_bf16(x[0], x[1]); w.y = cvt_pk_bf16(x[2], x[3]); *(u32x2*)((bf16_t*)xb + off + bj * HALF + n * 16) = w; } } }
                if (AUX) { ss += __shfl_xor(ss, 16); ss += __shfl_xor(ss, 32); if (fq == 0) red[(ai * HALF + wr * 64 + m * 16 + fr) * 4 + wc] = ss; }
                if (m == 3) asm volatile("" ::: "memory"); }
        if (AUX) {
            __syncthreads();
            const int t = ((wr * 4 + wc) << 6) | (fq * 16 + fr);
            if (t < BM) { const f32x4 q = *(const PG8_LAS f32x4*)(red + t * 4); part[(size_t)(u.pm * BM + t) * 4 + u.pn] = (q[0] + q[1]) + (q[2] + q[3]); }
            __syncthreads();
        }
    }
};
struct EpiQKV {
    static constexpr bool PERM = true, AFTER_DRAIN = false;
    bf16_t* Kb; size_t kvq_stride; const float* part; const float* kgain; const float* qgain; float qscale, descale;
    mutable float r8c[2][4]; mutable int pmc;
    __device__ __forceinline__ void operator()(const f32x4 (&acc)[2][2][4][2], const Unit& u, int wr, int wc, int fr, int fq) const {
        const int kind = u.pn >> 2, head = (u.pn & 3) * 4 + wc;
        bf16_t* dst = Kb + (size_t)kind * kvq_stride;
        const float* gsrc = kind == 0 ? kgain : qgain; const float gs = kind == 2 ? qscale : 1.f;
        const int row0 = u.pm * BM + wr * 64 + fr, colb = head * 64 + 8 * fq;
        f32x4 gv[2][2];
#pragma unroll
        for (int bj = 0; bj < 2; ++bj)
#pragma unroll
            for (int n = 0; n < 2; ++n) gv[bj][n] = *(const f32x4*)(gsrc + 32 * bj + 8 * fq + 4 * n) * gs;
        if (u.pm != pmc) { row_rstd8(part, row0, r8c); pmc = u.pm; }
#pragma unroll
        for (int ai = 0; ai < 2; ++ai)
#pragma unroll
            for (int m = 0; m < 4; ++m) { const int row = row0 + ai * HALF + m * 16; const float r = r8c[ai][m] * descale;
                f32x4 v[2][2]; float ss = 0.f;
#pragma unroll
                for (int bj = 0; bj < 2; ++bj)
#pragma unroll
                    for (int n = 0; n < 2; ++n) { v[bj][n] = acc[ai][bj][m][n] * r; const f32x4 x = v[bj][n]; ss += (x[0] * x[0] + x[1] * x[1]) + (x[2] * x[2] + x[3] * x[3]); }
                ss += __shfl_xor(ss, 16); ss += __shfl_xor(ss, 32);
                if (kind != 1) { const float inv = __builtin_amdgcn_rsqf(ss * (1.0f / 64.0f) + 1e-6f);
#pragma unroll
                    for (int bj = 0; bj < 2; ++bj)
#pragma unroll
                        for (int n = 0; n < 2; ++n) v[bj][n] = v[bj][n] * gv[bj][n] * inv; }
#pragma unroll
                for (int bj = 0; bj < 2; ++bj) { u32x4 w; w.x = cvt_pk_bf16(v[bj][0][0], v[bj][0][1]); w.y = cvt_pk_bf16(v[bj][0][2], v[bj][0][3]); w.z = cvt_pk_bf16(v[bj][1][0], v[bj][1][1]); w.w = cvt_pk_bf16(v[bj][1][2], v[bj][1][3]);
                    *(u32x4*)(dst + (size_t)row * 1024 + colb + 32 * bj) = w; }
                __builtin_amdgcn_sched_barrier(0); }
    }
};
struct EpiMoeDown {
    static constexpr bool PERM = true, AFTER_DRAIN = false;
    unsigned char* Y; const float* rowgate; float descale;
    template <bool ADD> __device__ __forceinline__ void run(const f32x4 (&acc)[2][2][4][2], const Unit& u, int wr, int wc, int fr, int fq, const PG8_GAS u32x2* sl) const {
        const int rt0 = u.pm * BM + wr * 64 + fr, col0 = u.pn * BM + wc * 32 + 8 * fq;
        float gtv[2][4];
#pragma unroll
        for (int ai = 0; ai < 2; ++ai)
#pragma unroll
            for (int m = 0; m < 4; ++m) gtv[ai][m] = rowgate[rt0 + ai * HALF + m * 16] * descale;
#pragma unroll
        for (int ai = 0; ai < 2; ++ai) {
#pragma unroll
            for (int m = 0; m < 4; ++m) { const float gt = gtv[ai][m]; unsigned char* p = Y + (size_t)(rt0 + ai * HALF + m * 16) * 1024 + col0;
#pragma unroll
                for (int bj = 0; bj < 2; ++bj) { f32x4 s0 = acc[ai][bj][m][0], s1 = acc[ai][bj][m][1];
                    if (ADD) { const u32x2 q0 = sl[bj * 2 + 0], q1 = sl[bj * 2 + 1];
                        s0[0] += __uint_as_float(q0.x << 16); s0[1] += __uint_as_float(q0.x & 0xffff0000u); s0[2] += __uint_as_float(q0.y << 16); s0[3] += __uint_as_float(q0.y & 0xffff0000u);
                        s1[0] += __uint_as_float(q1.x << 16); s1[1] += __uint_as_float(q1.x & 0xffff0000u); s1[2] += __uint_as_float(q1.y << 16); s1[3] += __uint_as_float(q1.y & 0xffff0000u); }
                    s0 = s0 * gt; s1 = s1 * gt;
                    u32x2 w; w.x = pk_i8x4(s0[0], s0[1], s0[2], s0[3]); w.y = pk_i8x4(s1[0], s1[1], s1[2], s1[3]);
                    *(u32x2*)(p + bj * HALF) = w; }
                if (ADD) { sl += 512 * 4; asm volatile("" : "+v"(sl)); } }
            asm volatile("" ::: "memory"); }
    }
    __device__ __forceinline__ void operator()(const f32x4 (&acc)[2][2][4][2], const Unit& u, int wr, int wc, int fr, int fq) const { run<false>(acc, u, wr, wc, fr, fq, nullptr); }
};

template <class Epi, class Sched, bool GATHER, int PREC = 0>
__device__ __forceinline__ void gemm_phase(PG8_LAS unsigned char* lds, const Gemm g, const Sched& S, const Epi& E, const int tid) {
    constexpr bool FP8 = (PREC == 1), I8 = (PREC == 2), BYTE1 = (PREC != 0);
    const int wid = __builtin_amdgcn_readfirstlane(tid >> 6), lane = tid & 63, wr = wid >> 2, wc = wid & 3, fr = lane & 15, fq = lane >> 4;
    const int K = g.K;
    const int rowb = BYTE1 ? K : 2 * K;
    unsigned voffB[2]; unsigned vC0[2], vC1[2], vN0[2], vN1[2]; int Rr[2], Cc[2];
#pragma unroll
    for (int i = 0; i < 2; ++i) { int R, C; stage_rc(tid * 16 + i * 8192, R, C); const int Rb = Epi::PERM ? ((R & ~31) + perm32(R & 31)) : R;
        Rr[i] = R; Cc[i] = C; vC0[i] = (unsigned)(R * rowb + C * 2); vC1[i] = vC0[i]; vN0[i] = vC0[i]; vN1[i] = vC0[i]; voffB[i] = (unsigned)(Rb * rowb + C * 2); }
    const size_t kstep = (size_t)(BK * 2);
    const size_t hstep = (size_t)HALF * rowb;
    const size_t hstepA = GATHER ? 0 : hstep;
    const size_t tstep = 2 * hstep;
    const unsigned ldsw = (unsigned)wid * 1024u;
    const int aoff = lds_byte(wr * 64 + fr, fq * 8), boff = lds_byte(wc * 32 + fr, fq * 8);
#define PG8_SA(b, h) (((b) * 2 + (h)) * HTB)
#define PG8_SB(b, h) ((4 + (b) * 2 + (h)) * HTB)
#define PG8_STAGE(bufoff, gbase, v0, v1) do { \
        __builtin_amdgcn_global_load_lds((const unsigned*)((const char*)(gbase) + (v0)), (PG8_LAS unsigned*)(lds + (bufoff) + ldsw), 16, 0, 0); \
        __builtin_amdgcn_global_load_lds((const unsigned*)((const char*)(gbase) + (v1)), (PG8_LAS unsigned*)(lds + (bufoff) + ldsw + 8192), 16, 0, 0); } while (0)
#define PG8_LD8(addr) __builtin_shufflevector(*(const PG8_LAS v4i_t*)(addr), *(const PG8_LAS v4i_t*)((addr) + 1024), 0, 1, 2, 3, 4, 5, 6, 7)
#define PG8_LDA(dst, b, h) do { if (FP8) { _Pragma("unroll") for (int m = 0; m < 4; ++m) dst##8[m] = PG8_LD8(lds + PG8_SA(b, h) + aoff + m * 2048); } else { \
        _Pragma("unroll") for (int m = 0; m < 4; ++m) _Pragma("unroll") for (int k = 0; k < 2; ++k) dst[m][k] = *(const PG8_LAS bf16x8*)(lds + PG8_SA(b, h) + aoff + m * 2048 + k * 1024); } } while (0)
#define PG8_LDB(dst, b, h) do { if (FP8) { _Pragma("unroll") for (int n = 0; n < 2; ++n) dst##8[n] = PG8_LD8(lds + PG8_SB(b, h) + boff + n * 2048); } else { \
        _Pragma("unroll") for (int n = 0; n < 2; ++n) _Pragma("unroll") for (int k = 0; k < 2; ++k) dst[n][k] = *(const PG8_LAS bf16x8*)(lds + PG8_SB(b, h) + boff + n * 2048 + k * 1024); } } while (0)
#if defined(PROBE_HALF_MFMA)
#define PG8_SKIP(ai) ((ai) == 1 && cur.part == 3)
#else
#define PG8_SKIP(ai) false
#endif
#define PG8_MMA(ai, bj, At, Bt) do { if (PG8_SKIP(ai)) break; __builtin_amdgcn_s_setprio(1); _Pragma("unroll") for (int m = 0; m < 4; ++m) _Pragma("unroll") for (int n = 0; n < 2; ++n) { \
        if (FP8) asm volatile("v_mfma_scale_f32_16x16x128_f8f6f4 %0, %1, %2, %0, %3, %3 op_sel_hi:[0,0,0]" : "+v"(acc[ai][bj][m][n]) : "v"(Bt##8[n]), "v"(At##8[m]), "v"(sc1)); \
        else if (I8) { _Pragma("unroll") for (int k = 0; k < 2; ++k) acc[ai][bj][m][n] = __builtin_bit_cast(f32x4, __builtin_amdgcn_mfma_i32_16x16x64_i8(__builtin_bit_cast(v4i_t, Bt[n][k]), __builtin_bit_cast(v4i_t, At[m][k]), __builtin_bit_cast(v4i_t, acc[ai][bj][m][n]), 0, 0, 0)); } \
        else { _Pragma("unroll") for (int k = 0; k < 2; ++k) acc[ai][bj][m][n] = __builtin_amdgcn_mfma_f32_16x16x32_bf16(Bt[n][k], At[m][k], acc[ai][bj][m][n], 0, 0, 0); } } __builtin_amdgcn_s_setprio(0); } while (0)
#define PG8_WAIT_V(n) asm volatile("s_waitcnt vmcnt(" #n ")" ::: "memory")
#define PG8_WAIT_L(n) asm volatile("s_waitcnt lgkmcnt(" #n ")" ::: "memory")
#define PG8_BAR __builtin_amdgcn_s_barrier()
#define PG8_SCHED __builtin_amdgcn_sched_barrier(0)
#define PG8_TOKOFF(pm_, h_, i_) ({ int t_ = g.rowtok[(pm_) * BM + (h_) * HALF + Rr[i_]]; t_ = t_ < 0 ? 0 : t_; (unsigned)(t_ * rowb + Cc[i_] * 2); })
    unsigned sc1 = 0u; if (FP8) asm volatile("v_mov_b32 %0, 0x7f7f7f7f" : "=v"(sc1));
    Unit cur, nxt; int ui = 0;
    if (!S.next(0, cur)) return;
    f32x4 acc[2][2][4][2];
#pragma unroll
    for (int a = 0; a < 2; ++a)
#pragma unroll
        for (int b = 0; b < 2; ++b)
#pragma unroll
            for (int m = 0; m < 4; ++m)
#pragma unroll
                for (int n = 0; n < 2; ++n) acc[a][b][m][n] = (f32x4){0.f, 0.f, 0.f, 0.f};
    bf16x8 At[4][2], B0[2][2], B1[2][2]; v8i_t At8[4], B08[2], B18[2];
    if (GATHER) {
#pragma unroll
        for (int i = 0; i < 2; ++i) { vC0[i] = PG8_TOKOFF(cur.pm, 0, i); vC1[i] = PG8_TOKOFF(cur.pm, 1, i); }
    }
    const char* cA = (GATHER ? (const char*)g.A : (const char*)g.A + (size_t)cur.pm * tstep) + (size_t)cur.kt0 * kstep;
    const char* cB = (const char*)g.Bt + (size_t)cur.be * g.bstride + (size_t)cur.pn * tstep + (size_t)cur.kt0 * kstep;
    PG8_STAGE(PG8_SB(0, 0), cB, voffB[0], voffB[1]); PG8_STAGE(PG8_SB(0, 1), cB + hstep, voffB[0], voffB[1]); PG8_STAGE(PG8_SA(0, 0), cA, vC0[0], vC0[1]); PG8_STAGE(PG8_SA(0, 1), cA + hstepA, vC1[0], vC1[1]);
    if (wr == 1) PG8_BAR;
    PG8_WAIT_V(2); PG8_BAR;
    PG8_STAGE(PG8_SB(1, 0), cB + kstep, voffB[0], voffB[1]); PG8_STAGE(PG8_SA(1, 0), cA + kstep, vC0[0], vC0[1]); PG8_STAGE(PG8_SB(1, 1), cB + hstep + kstep, voffB[0], voffB[1]);
    PG8_WAIT_V(6); PG8_BAR;
    for (;;) {
        const bool has_next = S.next(ui + 1, nxt);
        const char* nA = has_next ? (GATHER ? (const char*)g.A : (const char*)g.A + (size_t)nxt.pm * tstep) + (size_t)nxt.kt0 * kstep : cA;
        const char* nB = has_next ? (const char*)g.Bt + (size_t)nxt.be * g.bstride + (size_t)nxt.pn * tstep + (size_t)nxt.kt0 * kstep : cB;
        if (GATHER) {
            if (has_next && nxt.pm != cur.pm) {
#pragma unroll
                for (int i = 0; i < 2; ++i) { vN0[i] = PG8_TOKOFF(nxt.pm, 0, i); vN1[i] = PG8_TOKOFF(nxt.pm, 1, i); }
            } else {
#pragma unroll
                for (int i = 0; i < 2; ++i) { vN0[i] = vC0[i]; vN1[i] = vC1[i]; }
            }
        }
        const int nkt = cur.nkt;
        for (int t = 0; t < nkt; t += 2) {
            const bool last = (t == nkt - 2);
            const char* a1 = cA + (size_t)(t + 1) * kstep;
            const char* a2 = last ? nA : cA + (size_t)(t + 2) * kstep; const char* b2 = last ? nB : cB + (size_t)(t + 2) * kstep;
            const char* a3 = a2 + kstep; const char* b3 = b2 + kstep;
            const unsigned x00 = (GATHER && last) ? vN0[0] : vC0[0], x01 = (GATHER && last) ? vN0[1] : vC0[1], x10 = (GATHER && last) ? vN1[0] : vC1[0], x11 = (GATHER && last) ? vN1[1] : vC1[1];
            PG8_LDB(B0, 0, 0); PG8_LDB(B1, 0, 1); PG8_SCHED; PG8_LDA(At, 0, 0); PG8_STAGE(PG8_SA(1, 1), a1 + hstepA, vC1[0], vC1[1]);
            PG8_WAIT_V(8); PG8_WAIT_L(0); PG8_BAR; PG8_MMA(0, 0, At, B0); PG8_MMA(0, 1, At, B1); PG8_BAR; PG8_SCHED;
            PG8_LDA(At, 0, 1); PG8_STAGE(PG8_SB(0, 0), b2, voffB[0], voffB[1]); PG8_STAGE(PG8_SB(0, 1), b2 + hstep, voffB[0], voffB[1]); PG8_STAGE(PG8_SA(0, 0), a2, x00, x01);
            PG8_WAIT_V(8); PG8_WAIT_L(0); PG8_BAR; PG8_MMA(1, 0, At, B0); PG8_MMA(1, 1, At, B1); PG8_BAR; PG8_SCHED;
            PG8_LDB(B0, 1, 0); PG8_LDB(B1, 1, 1); PG8_SCHED; PG8_LDA(At, 1, 0); PG8_STAGE(PG8_SA(0, 1), a2 + hstepA, x10, x11);
            PG8_WAIT_V(8); PG8_WAIT_L(0); PG8_BAR; PG8_MMA(0, 0, At, B0); PG8_MMA(0, 1, At, B1); PG8_BAR; PG8_SCHED;
            PG8_LDA(At, 1, 1); PG8_STAGE(PG8_SB(1, 0), b3, voffB[0], voffB[1]); PG8_STAGE(PG8_SB(1, 1), b3 + hstep, voffB[0], voffB[1]); PG8_STAGE(PG8_SA(1, 0), a3, x00, x01);
            PG8_WAIT_V(8); PG8_WAIT_L(0); PG8_BAR; PG8_MMA(1, 0, At, B0); PG8_MMA(1, 1, At, B1); PG8_BAR; PG8_SCHED;
        }
        if (wr == 0) PG8_BAR;
        if (FP8) { asm volatile("s_nop 15\n\ts_nop 15" ::: "memory");
#pragma unroll
            for (int a = 0; a < 2; ++a)
#pragma unroll
                for (int b = 0; b < 2; ++b)
#pragma unroll
                    for (int m = 0; m < 4; ++m)
#pragma unroll
                        for (int n = 0; n < 2; ++n) asm volatile("" : "+v"(acc[a][b][m][n])); }
        if (I8) {
#pragma unroll
            for (int a = 0; a < 2; ++a)
#pragma unroll
                for (int b = 0; b < 2; ++b)
#pragma unroll
                    for (int m = 0; m < 4; ++m)
#pragma unroll
                        for (int n = 0; n < 2; ++n) { const v4i_t q = __builtin_bit_cast(v4i_t, acc[a][b][m][n]); acc[a][b][m][n] = (f32x4){(float)q[0], (float)q[1], (float)q[2], (float)q[3]}; } }
        if (g.noepi) {} else
        if constexpr (Sched::STREAMK) {
            if (cur.part == 1) {
                PG8_GAS u32x2* sl = (PG8_GAS u32x2*)g.slab + (size_t)S.wg() * (32 * 512) + tid * 4;
#pragma unroll
                for (int a = 0; a < 2; ++a)
#pragma unroll
                    for (int m = 0; m < 4; ++m) {
#pragma unroll
                        for (int b = 0; b < 2; ++b)
#pragma unroll
                            for (int n = 0; n < 2; ++n) { u32x2 w; w.x = cvt_pk_bf16(acc[a][b][m][n][0], acc[a][b][m][n][1]); w.y = cvt_pk_bf16(acc[a][b][m][n][2], acc[a][b][m][n][3]); sl[b * 2 + n] = w; }
                        sl += 512 * 4; asm volatile("" : "+v"(sl)); }
                asm volatile("s_waitcnt vmcnt(0)" ::: "memory");
                __syncthreads();
                if (tid == 0) { __builtin_amdgcn_fence(__ATOMIC_RELEASE, "agent"); asm volatile("s_waitcnt vmcnt(0)" ::: "memory");
                    __hip_atomic_store(g.skflag + 16 * S.wg(), 1u, __ATOMIC_RELAXED, __HIP_MEMORY_SCOPE_AGENT); }
            } else if (cur.part == 2) {
                if (wid == 0) { unsigned sp = 0;
                    while (__hip_atomic_load(g.skflag + 16 * (S.wg() + 1), __ATOMIC_RELAXED, __HIP_MEMORY_SCOPE_AGENT) == 0u) { __builtin_amdgcn_s_sleep(2);
                        if (++sp > (1u << 22)) { if (lane == 0) __hip_atomic_store(g.tmo, 1u, __ATOMIC_RELAXED, __HIP_MEMORY_SCOPE_AGENT); break; } }
                    __builtin_amdgcn_fence(__ATOMIC_ACQUIRE, "agent"); }
                asm volatile("s_waitcnt vmcnt(0)" ::: "memory");
                __syncthreads();
                E.template run<true>(acc, cur, wr, wc, fr, fq, (const PG8_GAS u32x2*)g.slab + (size_t)(S.wg() + 1) * (32 * 512) + tid * 4);
            } else { if (cur.part != 3) E(acc, cur, wr, wc, fr, fq); }
        } else { if (cur.part != 3) E(acc, cur, wr, wc, fr, fq); }
        if (!has_next) break;
#pragma unroll
        for (int a = 0; a < 2; ++a)
#pragma unroll
            for (int b = 0; b < 2; ++b)
#pragma unroll
                for (int m = 0; m < 4; ++m)
#pragma unroll
                    for (int n = 0; n < 2; ++n) acc[a][b][m][n] = (f32x4){0.f, 0.f, 0.f, 0.f};
        cur = nxt; cA = nA; cB = nB; ++ui;
        if (GATHER) {
#pragma unroll
            for (int i = 0; i < 2; ++i) { vC0[i] = vN0[i]; vC1[i] = vN1[i]; }
        }
        if (wr == 1) PG8_BAR;
    }
    PG8_WAIT_V(0);
    PG8_BAR;
#undef PG8_SA
#undef PG8_SB
#undef PG8_STAGE
#undef PG8_LDA
#undef PG8_LDB
#undef PG8_MMA
#undef PG8_LD8
#undef PG8_WAIT_V
#undef PG8_WAIT_L
#undef PG8_BAR
#undef PG8_SCHED
#undef PG8_TOKOFF
}
}
#define GAS __attribute__((address_space(1)))
#define LAS __attribute__((address_space(3)))
typedef unsigned short bf16;
typedef unsigned v4u __attribute__((ext_vector_type(4)));
typedef float f32x4 __attribute__((ext_vector_type(4)));
typedef short bf16x8 __attribute__((ext_vector_type(8)));
typedef GAS unsigned gu32;
typedef GAS unsigned long long gu64;
#define RLX_AGENT __ATOMIC_RELAXED, __HIP_MEMORY_SCOPE_AGENT
#define LDS_WAIT() asm volatile("s_waitcnt lgkmcnt(0)" ::: "memory")
#define VM_WAIT() asm volatile("s_waitcnt vmcnt(0)" ::: "memory")
__device__ __forceinline__ unsigned long long rt() { return __builtin_amdgcn_s_memrealtime(); }
__device__ __forceinline__ unsigned f2bf(float f) { unsigned u = __builtin_bit_cast(unsigned, f); return (u + 0x7fffu + ((u >> 16) & 1u)) >> 16; }
__device__ __forceinline__ unsigned pk2(float lo, float hi) { return f2bf(lo) | (f2bf(hi) << 16); }

#define XB_TMO      128
#define XB_XCNT(j)  (256  + 64 * (j))
#define XB_XSUB(j)  (1280 + 64 * (j))
#define XB_XGEN(j)  (2304 + 64 * (j))
#define XB_TOP      3328
#define XB_TOPGEN   3392
#define XCD_BAR_WORDS 3456
#define XB_SPIN_CAP (1u << 18)

__device__ __forceinline__ unsigned xb_ld(unsigned* p)              { return __hip_atomic_load(p, __ATOMIC_RELAXED, __HIP_MEMORY_SCOPE_AGENT); }
__device__ __forceinline__ unsigned xb_add(unsigned* p, unsigned v) { return __hip_atomic_fetch_add(p, v, __ATOMIC_RELAXED, __HIP_MEMORY_SCOPE_AGENT); }
__device__ __forceinline__ unsigned xb_xcc_id() { return (unsigned)__builtin_amdgcn_s_getreg((3 << 11) | 20) & 0xFu; }
#define XB_SPIN(cond, bar) do { unsigned _sp = 0; while (cond) { __builtin_amdgcn_s_sleep(1); \
    if ((++_sp & 255u) == 0u) { if (xb_ld(&(bar)[XB_TMO])) break; if (_sp > XB_SPIN_CAP) { atomicAdd(&(bar)[XB_TMO], 1u); break; } } } } while (0)

struct XcdBarrier {
    unsigned* bar; unsigned x;
    volatile LAS unsigned* st;
};

__device__ __forceinline__ XcdBarrier xcd_barrier_post(unsigned* bar, volatile LAS unsigned* st) {
    XcdBarrier b; b.bar = bar; b.x = xb_xcc_id(); b.st = st;
    if (threadIdx.x == 0) (void)xb_add(&bar[XB_XCNT(b.x)], 1u);
    return b;
}
__device__ __forceinline__ void xcd_barrier_complete(unsigned* bar, unsigned x, unsigned& nloc, unsigned& nx) {
    const unsigned G = gridDim.x * gridDim.y * gridDim.z;
    unsigned sum, cnt, mine, sp = 0u;
    for (;;) {
        sum = 0u; cnt = 0u; mine = 0u;
#pragma unroll
        for (unsigned j = 0; j < 16; ++j) { const unsigned c = xb_ld(&bar[XB_XCNT(j)]); sum += c; cnt += (c > 0u) ? 1u : 0u; mine = (j == x) ? c : mine; }
        if (sum == G) break;
        __builtin_amdgcn_s_sleep(1);
        if ((++sp & 255u) == 0u) { if (xb_ld(&bar[XB_TMO])) break; if (sp > XB_SPIN_CAP) { atomicAdd(&bar[XB_TMO], 1u); break; } }
    }
    nloc = mine > 0u ? mine : 1u; nx = cnt > 0u ? cnt : 1u;
}

__device__ __forceinline__ void xcd_barrier(const XcdBarrier& b) {
    asm volatile("s_waitcnt vmcnt(0)" ::: "memory");
    __syncthreads();
    if (threadIdx.x == 0) {
        unsigned* bar = b.bar;
        __builtin_amdgcn_s_waitcnt(0);
        unsigned nloc = b.st[0], nx = b.st[1];
        if (nloc == 0u) { xcd_barrier_complete(bar, b.x, nloc, nx); b.st[0] = nloc; b.st[1] = nx; }
        const unsigned old = xb_add(&bar[XB_XSUB(b.x)], 1u);
        const unsigned gen = old / nloc;
        if (old + 1u == (gen + 1u) * nloc) {
            __builtin_amdgcn_fence(__ATOMIC_RELEASE, "agent");
            asm volatile("s_waitcnt vmcnt(0)" ::: "memory");
            const unsigned og = xb_add(&bar[XB_TOP], 1u);
            const unsigned tg = og / nx;
            if (og + 1u == (tg + 1u) * nx) xb_add(&bar[XB_TOPGEN], 1u);
            else XB_SPIN(xb_ld(&bar[XB_TOPGEN]) == tg, bar);
            __builtin_amdgcn_fence(__ATOMIC_ACQUIRE, "agent");
            xb_add(&bar[XB_XGEN(b.x)], 1u);
            asm volatile("s_waitcnt vmcnt(0)" ::: "memory");
        } else {
            XB_SPIN(xb_ld(&bar[XB_XGEN(b.x)]) == gen, bar);
            __builtin_amdgcn_fence(__ATOMIC_ACQUIRE, "agent");
            asm volatile("s_waitcnt vmcnt(0)" ::: "memory");
        }
    }
    __syncthreads();
}

constexpr int NWAVES = 8;
constexpr int T = 32768, D = 1024, SEQ = 4096, NBATCH = 8;
constexpr int DFF = 2752, DFFP = 2816, DFFE = 3584, NEXP = 8;
constexpr int ROWCAP = 67584;
constexpr float EPS = 1e-6f;
constexpr float LOG2E = 1.4426950408889634f;
constexpr float SOFTMAX_OFS = 16.f;
constexpr float QSCALE = 0.125f * LOG2E;
#ifndef I8_P1
#define I8_P1 1
#endif
#ifndef I8_P3
#define I8_P3 0
#endif
#ifndef I8_P4
#define I8_P4 1
#endif
constexpr float SA_N = 127.f / 5.f, SA_X = 127.f / 6.f, SW_I8 = 127.f * 32.f / 4.5f;
constexpr float Y_SCALE = 127.f / 2.5f;
constexpr float W8_SCALE = 64.f, H3_SCALE = 16.f, HM_SCALE = 8.f, X8_SCALE = 16.f, HB_SCALE = 8.f, O8_SCALE = 64.f;
constexpr size_t MiB = 1u << 20;
constexpr size_t WS_CTL = 0, CTL_ZERO_BYTES = 1 * MiB;
constexpr size_t WS_PART1 = 1 * MiB, WS_PART2 = 3 * MiB, WS_LSE = 5 * MiB;
constexpr size_t WS_ROUTE = 7 * MiB, WS_GATE1 = WS_ROUTE + 128 * 1024, WS_GATE2 = WS_ROUTE + 256 * 1024, WS_WAVECNT = WS_ROUTE + 384 * 1024, WS_BLOCKCNT = WS_ROUTE + 448 * 1024, WS_GOFS = WS_ROUTE + 480 * 1024;
constexpr size_t WS_ROWTOK = 8 * MiB, WS_ROWGATE = 8 * MiB + 512 * 1024;
constexpr size_t WS_WIN = 12 * MiB, WS_WOUT = 16 * MiB, WS_WF13 = 18 * MiB, WS_WFD = 29 * MiB, WS_WQKV = 35 * MiB, WS_WO = 53 * MiB;
constexpr size_t WS_WM13 = 56 * MiB, WS_WM2 = 112 * MiB;
constexpr size_t WS_XH = 144 * MiB;
constexpr size_t WS_A0 = 224 * MiB;
constexpr size_t WS_H0 = WS_A0, WS_GLU = WS_A0 + 64 * MiB, WS_V = WS_A0 + 128 * MiB;
constexpr size_t WS_X1B = WS_A0, WS_HB = WS_A0 + 64 * MiB;
constexpr size_t WS_X2B = WS_A0, WS_KG = WS_A0 + 64 * MiB, WS_VG = WS_A0 + 128 * MiB, WS_QG = WS_A0 + 192 * MiB, WS_O = WS_A0 + 256 * MiB, WS_O8 = WS_A0 + 32 * MiB;
constexpr size_t WS_H3 = WS_A0, WS_HM = WS_A0 + 66 * MiB;
constexpr size_t WS_END = 548 * MiB;
static_assert(WS_HB + (size_t)T * DFFP * 2 <= WS_END && WS_O + (size_t)T * D * 2 <= WS_END && WS_HM + (size_t)ROWCAP * DFFE <= WS_END, "arena");
static_assert(WS_WFD + (size_t)D * DFFP * 2 <= WS_WQKV && WS_WO + (size_t)D * D * 2 <= WS_WM13 && WS_WM13 + (size_t)NEXP * 7168 * 1024 <= WS_WM2 && WS_WM2 + (size_t)NEXP * D * DFFE <= WS_XH && WS_XH + (size_t)T * D * 2 <= WS_A0, "weights");
constexpr int CW_AQ = 50000;
constexpr int CW_TMO = 0, CW_CODE = 1, CW_BAR = 4096, CW_SKFLAG = 16384;
constexpr size_t WS_SLAB = 12 * MiB;
constexpr size_t WS_POS = 9 * MiB;
constexpr size_t WS_Y = WS_A0;
static_assert(WS_SLAB + (size_t)256 * 131072 <= 56 * MiB && WS_Y + (size_t)ROWCAP * 1024 <= WS_HM, "slab / Y");

constexpr int RING_OFF = 0, RING_BYTES = 131072;
constexpr int LDSCTL_OFF = RING_BYTES, MISC_OFF = LDSCTL_OFF + 320;
constexpr int XTRA_OFF = RING_BYTES + 512;
constexpr int LDS_BYTES = 147456;

constexpr int NPHASE = 18;

__constant__ unsigned char T5_BUCKET[3][132] = {
 {0,1,2,3,4,5,6,7,8,9,10,11,12,13,14,15,16,16,16,16,16,16,17,17,17,17,17,17,17,17,18,18,18,18,18,18,18,18,18,18,19,19,19,19,19,19,19,19,19,19,19,19,19,19,20,20,20,20,20,20,20,20,20,20,20,20,20,20,20,20,20,20,20,21,21,21,21,21,21,21,21,21,21,21,21,21,21,21,21,21,21,21,21,21,21,21,21,21,21,22,22,22,22,22,22,22,22,22,22,22,22,22,22,22,22,22,22,22,22,22,22,22,22,22,22,22,22,22,22,0,0,0},
 {0,4,8,12,16,16,17,17,18,18,19,19,19,19,20,20,20,20,20,21,21,21,21,21,21,22,22,22,22,22,22,22,22,22,23,23,23,23,23,23,23,23,23,23,23,23,24,24,24,24,24,24,24,24,24,24,24,24,24,24,24,24,25,25,25,25,25,25,25,25,25,25,25,25,25,25,25,25,25,25,25,25,25,26,26,26,26,26,26,26,26,26,26,26,26,26,26,26,26,26,26,26,26,26,26,26,26,26,26,26,26,26,26,27,27,27,27,27,27,27,27,27,27,27,27,27,27,27,27,0,0,0},
 {0,16,18,19,20,21,21,22,22,23,23,23,24,24,24,24,25,25,25,25,25,26,26,26,26,26,26,26,26,27,27,27,27,27,27,27,27,27,27,28,28,28,28,28,28,28,28,28,28,28,28,28,29,29,29,29,29,29,29,29,29,29,29,29,29,29,29,29,29,29,30,30,30,30,30,30,30,30,30,30,30,30,30,30,30,30,30,30,30,30,30,30,30,30,30,31,31,31,31,31,31,31,31,31,31,31,31,31,31,31,31,31,31,31,31,31,31,31,31,31,31,31,31,31,31,31,31,31,31,0,0,0}};

typedef float f32x16 __attribute__((ext_vector_type(16)));
typedef float f32x2v __attribute__((ext_vector_type(2)));
typedef __bf16 bf16x2v __attribute__((ext_vector_type(2)));
typedef short v4i16_t __attribute__((ext_vector_type(4)));
__device__ __forceinline__ unsigned pkbf(float lo, float hi) { f32x2v v = {lo, hi}; bf16x2v b = __builtin_convertvector(v, bf16x2v); return __builtin_bit_cast(unsigned, b); }
__device__ __forceinline__ float bflo(unsigned u) { return __uint_as_float(u << 16); }
__device__ __forceinline__ float bfhi(unsigned u) { return __uint_as_float(u & 0xffff0000u); }
template <int N> __device__ __forceinline__ float dpp_row_ror(float v) { return __builtin_bit_cast(float, __builtin_amdgcn_update_dpp(0, __builtin_bit_cast(int, v), 0x120 + N, 0xf, 0xf, true)); }
__device__ __forceinline__ float wave_sum(float v) {
    v += dpp_row_ror<8>(v); v += dpp_row_ror<4>(v); v += dpp_row_ror<2>(v); v += dpp_row_ror<1>(v);
    const int b = __builtin_bit_cast(int, v);
    return (__builtin_bit_cast(float, __builtin_amdgcn_readlane(b, 0)) + __builtin_bit_cast(float, __builtin_amdgcn_readlane(b, 16))) + (__builtin_bit_cast(float, __builtin_amdgcn_readlane(b, 32)) + __builtin_bit_cast(float, __builtin_amdgcn_readlane(b, 48)));
}
__device__ __forceinline__ int crow(int r, int hi) { return (r & 3) + 8 * (r >> 2) + 4 * hi; }

struct TrDesc { const float* W; const float* gsc; unsigned char* WT; int ldw, Kp, drow0, k0, n0src, is8; float scale; };
__device__ __forceinline__ int hmap_row0(int L) { const int lc = L & 255; return (L & ~255) + 128 * ((lc >> 5) & 1) + 32 * (lc >> 6); }

constexpr int IT_MG = NEXP * 16 * 112, IT_MU = IT_MG, IT_MD = NEXP * 56 * 32, IT_WIN = 16 * 64, IT_WOUT = 16 * 32, IT_FG = 16 * 86, IT_FU = IT_FG, IT_FD = 43 * 32, IT_KV = 16 * 192, IT_Q = 16 * 96, IT_WO = 16 * 32;
constexpr int IT_MOE = IT_MG + IT_MU + IT_MD;
static_assert(IT_MOE == 3 * 256 * 56, "expert-weight items per attention phase and workgroup");
constexpr int IT_TOTAL = IT_MG + IT_MU + IT_MD + IT_WIN + IT_WOUT + IT_FG + IT_FU + IT_FD + IT_KV + IT_Q + IT_WO;
typedef const __attribute__((address_space(4))) unsigned char* kargp0_t;
#define P0IN(i) (*(const float* const __attribute__((address_space(4)))*)(kp + 8 * (i)))
__device__ __forceinline__ void tr_desc(int it, kargp0_t kp, unsigned char* ws, TrDesc& d) {
    int r = it; d.gsc = nullptr; d.is8 = 2; d.scale = SW_I8; d.Kp = 1024;
    if (r < IT_MG) { const int e = r / 1792, rr = r % 1792, j = (rr % 112) * 32; d.W = P0IN(23) + (size_t)e * D * DFFE; d.ldw = DFFE; d.WT = ws + WS_WM13 + (size_t)e * 7168 * 1024; d.drow0 = 256 * (j >> 7) + (j & 127); d.k0 = (rr / 112) * 64; d.n0src = j; return; } r -= IT_MG;
    if (r < IT_MU) { const int e = r / 1792, rr = r % 1792, j = (rr % 112) * 32; d.W = P0IN(24) + (size_t)e * D * DFFE; d.ldw = DFFE; d.WT = ws + WS_WM13 + (size_t)e * 7168 * 1024; d.drow0 = 256 * (j >> 7) + 128 + (j & 127); d.k0 = (rr / 112) * 64; d.n0src = j; return; } r -= IT_MU;
    if (r < IT_MD) { const int e = r / 1792, rr = r % 1792, j = (rr % 32) * 32; d.W = P0IN(25) + (size_t)e * DFFE * D; d.ldw = D; d.WT = ws + WS_WM2 + (size_t)e * 1024 * DFFE; d.Kp = DFFE; d.is8 = 1; d.scale = W8_SCALE; d.drow0 = j; d.k0 = (rr / 32) * 64; d.n0src = j; return; } r -= IT_MD;
    if (r < IT_KV) { const int c = (r % 192) * 32, kvsel = c / 3072, cg = c % 3072, g = cg >> 10, hc = cg & 1023, L = kvsel * 1024 + hc; d.W = P0IN(12); d.ldw = 6144; d.gsc = P0IN(11); d.WT = ws + WS_WQKV + (size_t)g * 3072 * 1024; d.drow0 = hmap_row0(L); d.k0 = (r / 192) * 64; d.n0src = c; return; } r -= IT_KV;
    if (r < IT_Q) { const int c = (r % 96) * 32, g = c >> 10, hc = c & 1023, L = 2048 + hc; d.W = P0IN(15); d.ldw = 3072; d.gsc = P0IN(14); d.WT = ws + WS_WQKV + (size_t)g * 3072 * 1024; d.drow0 = hmap_row0(L); d.k0 = (r / 96) * 64; d.n0src = c; return; } r -= IT_Q;
    if (r < IT_WIN) { const int c = (r % 64) * 32, sel = c >> 10, j = c & 1023; d.W = P0IN(3); d.ldw = 2048; d.WT = ws + WS_WIN; if (!I8_P1) { d.is8 = 0; d.scale = 1.f; } d.drow0 = 256 * (j >> 7) + 128 * sel + (j & 127); d.k0 = (r / 64) * 64; d.n0src = c; return; } r -= IT_WIN;
    if (r < IT_WOUT) { const int j = (r % 32) * 32; d.W = P0IN(9); d.ldw = 1024; d.WT = ws + WS_WOUT; if (!I8_P3) { d.is8 = 0; d.scale = 1.f; } d.drow0 = j; d.k0 = (r / 32) * 64; d.n0src = j; return; } r -= IT_WOUT;
    if (r < IT_FG) { const int j = (r % 86) * 32; d.W = P0IN(19); d.ldw = DFF; d.gsc = P0IN(18); d.WT = ws + WS_WF13; if (!I8_P4) { d.is8 = 0; d.scale = 1.f; } d.drow0 = 256 * (j >> 7) + (j & 127); d.k0 = (r / 86) * 64; d.n0src = j; return; } r -= IT_FG;
    if (r < IT_FU) { const int j = (r % 86) * 32; d.W = P0IN(20); d.ldw = DFF; d.gsc = P0IN(18); d.WT = ws + WS_WF13; if (!I8_P4) { d.is8 = 0; d.scale = 1.f; } d.drow0 = 256 * (j >> 7) + 128 + (j & 127); d.k0 = (r / 86) * 64; d.n0src = j; return; } r -= IT_FU;
    if (r < IT_FD) { const int j = (r % 32) * 32; d.W = P0IN(21); d.ldw = 1024; d.WT = ws + WS_WFD; d.Kp = DFFP; d.is8 = 0; d.scale = 1.f; d.drow0 = j; d.k0 = (r / 32) * 64; d.n0src = j; return; } r -= IT_FD;
    { const int j = (r % 32) * 32; d.W = P0IN(17); d.ldw = 1024; d.WT = ws + WS_WO; d.drow0 = j; d.k0 = (r / 32) * 64; d.n0src = j; d.is8 = 1; d.scale = W8_SCALE; }
}
__device__ __forceinline__ void tr_load(const TrDesc& d, f32x4 (&v)[8], f32x4 (&gv)[2], int lane) {
#pragma unroll
    for (int i = 0; i < 8; ++i) v[i] = __builtin_nontemporal_load((const f32x4*)(d.W + (size_t)(d.k0 + 8 * i + (lane >> 3)) * d.ldw + d.n0src + 4 * (lane & 7)));
    const float* gp = d.gsc ? d.gsc + d.k0 + 8 * (lane & 7) : d.W + (size_t)d.k0 * d.ldw + d.n0src;
    gv[0] = *(const f32x4*)gp; gv[1] = *(const f32x4*)(gp + 4);
}
template <bool NT = false>
__device__ __forceinline__ void tr_store(const TrDesc& d, const f32x4 (&v)[8], const f32x4 (&gv)[2], LAS float* scr, int lane) {
#pragma unroll
    for (int i = 0; i < 8; ++i) { LAS float* w = scr + (8 * i + (lane >> 3)) * 33 + 4 * (lane & 7); w[0] = v[i].x; w[1] = v[i].y; w[2] = v[i].z; w[3] = v[i].w; }
    LDS_WAIT(); asm volatile("" ::: "memory");
    const int c = lane & 7; const float sc = d.scale;
    const f32x4 one4 = {1.f, 1.f, 1.f, 1.f}; const f32x4 gv0 = d.gsc ? gv[0] : one4, gv1 = d.gsc ? gv[1] : one4;
#pragma unroll
    for (int j = 0; j < 4; ++j) { const int n = (lane >> 3) + 8 * j; const LAS float* s = scr + (8 * c) * 33 + n;
        const float x0 = s[0 * 33] * gv0.x * sc, x1 = s[1 * 33] * gv0.y * sc, x2 = s[2 * 33] * gv0.z * sc, x3 = s[3 * 33] * gv0.w * sc, x4 = s[4 * 33] * gv1.x * sc, x5 = s[5 * 33] * gv1.y * sc, x6 = s[6 * 33] * gv1.z * sc, x7 = s[7 * 33] * gv1.w * sc;
        if (d.is8 == 2) { pg8::u32x2 o; o.x = pg8::pk_i8x4(x0, x1, x2, x3); o.y = pg8::pk_i8x4(x4, x5, x6, x7); GAS pg8::u32x2* op = (GAS pg8::u32x2*)(d.WT + (size_t)(d.drow0 + n) * d.Kp + d.k0 + 8 * c); if (NT) __builtin_nontemporal_store(o, op); else *op = o; }
        else if (d.is8) { pg8::u32x2 o; o.x = pg8::pk_fp8x4(x0, x1, x2, x3); o.y = pg8::pk_fp8x4(x4, x5, x6, x7); GAS pg8::u32x2* op = (GAS pg8::u32x2*)(d.WT + (size_t)(d.drow0 + n) * d.Kp + d.k0 + 8 * c); if (NT) __builtin_nontemporal_store(o, op); else *op = o; }
        else { v4u o; o.x = pkbf(x0, x1); o.y = pkbf(x2, x3); o.z = pkbf(x4, x5); o.w = pkbf(x6, x7); *(GAS v4u*)((bf16*)d.WT + (size_t)(d.drow0 + n) * d.Kp + d.k0 + 8 * c) = o; } }
    LDS_WAIT(); asm volatile("" ::: "memory");
}

__device__ __forceinline__ void p0_items(kargp0_t kp, unsigned char* ws, LAS float* scr, int first, int stride, int lo, int hi, int lane) {
    TrDesc da, db, dc; f32x4 va[8], vb[8], vc[8]; f32x4 ga[2], gb[2], gc[2];
    int it = lo + first; const int NGW = stride;
    if (it < hi) { tr_desc(it, kp, ws, da); tr_load(da, va, ga, lane); }
    if (it + NGW < hi) { tr_desc(it + NGW, kp, ws, db); tr_load(db, vb, gb, lane); }
    while (it < hi) {
        if (it + 2 * NGW < hi) { tr_desc(it + 2 * NGW, kp, ws, dc); tr_load(dc, vc, gc, lane); }
        tr_store(da, va, ga, scr, lane);
        if (it + NGW >= hi) break;
        if (it + 3 * NGW < hi) { tr_desc(it + 3 * NGW, kp, ws, da); tr_load(da, va, ga, lane); }
        tr_store(db, vb, gb, scr, lane);
        if (it + 2 * NGW >= hi) break;
        if (it + 4 * NGW < hi) { tr_desc(it + 4 * NGW, kp, ws, db); tr_load(db, vb, gb, lane); }
        tr_store(dc, vc, gc, scr, lane);
        it += 3 * NGW;
    }
}
__device__ __forceinline__ void p0_items2(kargp0_t kp, unsigned char* ws, LAS float* scr, int first, int stride, int lo, int hi, int lane) {
    if (first >= hi - lo) return;
    const int n = (hi - lo - first + stride - 1) / stride, base = lo + first, last = n - 1;
    TrDesc da, db; f32x4 va[8], vb[8]; f32x4 ga[2], gb[2];
#define P0_ITEM(k) (base + ((k) < last ? (k) : last) * stride)
    tr_desc(base, kp, ws, da); tr_load(da, va, ga, lane);
    for (int k = 0; k + 1 < n; k += 2) {
        tr_desc(P0_ITEM(k + 1), kp, ws, db); tr_load(db, vb, gb, lane);
        tr_store<true>(da, va, ga, scr, lane);
        tr_desc(P0_ITEM(k + 2), kp, ws, da); tr_load(da, va, ga, lane);
        tr_store<true>(db, vb, gb, scr, lane);
    }
    if (n & 1) tr_store<true>(da, va, ga, scr, lane);
#undef P0_ITEM
}
__device__ __forceinline__ void p0_prologue(kargp0_t kp, unsigned char* ws, LAS unsigned char* lds, int G, int vcu, int tid, int lane, int wave) {
    LAS float* scr = (LAS float*)(lds + RING_OFF + wave * 16384);
    const int gw = vcu * NWAVES + wave, NGW = G * NWAVES;
    bf16* WF13 = (bf16*)(ws + WS_WF13); bf16* WFD = (bf16*)(ws + WS_WFD);
    p0_items(kp, ws, scr, gw, NGW, (G == 256) ? IT_MOE : 0, IT_TOTAL, lane);
#ifdef PROBE_CONV_NC
    if ((vcu & 31) < PROBE_CONV_NC) p0_items(kp, ws, scr, ((vcu >> 5) * PROBE_CONV_NC + (vcu & 31)) * NWAVES + wave, 8 * PROBE_CONV_NC * NWAVES, 0, IT_MOE, lane);
#endif
    const int gt = vcu * (NWAVES * 64) + tid, NGT = G * NWAVES * 64; const v4u z = {0u, 0u, 0u, 0u};
    { constexpr int RB = I8_P4 ? 1024 : 2048, CH = RB / 16;
      for (int i = gt; i < 2 * 64 * CH; i += NGT) { const int sel = i / (64 * CH), rr = (i / CH) & 63, ch = i % CH; *(GAS v4u*)((unsigned char*)WF13 + (size_t)(256 * 21 + 128 * sel + 64 + rr) * RB + ch * 16) = z; } }
    for (int i = gt; i < 1024 * 8; i += NGT) { const int row = i >> 3, ch = i & 7; *(GAS v4u*)(WFD + (size_t)row * DFFP + DFF + ch * 8) = z; }
    const float* x = P0IN(0); const float* gn = P0IN(2); bf16* H0 = (bf16*)(ws + WS_H0);
    f32x4 gv[4];
#pragma unroll
    for (int j = 0; j < 4; ++j) gv[j] = *(const f32x4*)(gn + 4 * lane + 256 * j);
    for (int m0 = gw * 4; m0 < T; m0 += NGW * 4) {
        f32x4 v[4][4];
#pragma unroll
        for (int q = 0; q < 4; ++q) { const GAS f32x4* xr = (const GAS f32x4*)(x + (size_t)(m0 + q) * D) + lane;
#pragma unroll
            for (int j = 0; j < 4; ++j) v[q][j] = __builtin_nontemporal_load(xr + 64 * j); }
#pragma unroll
        for (int q = 0; q < 4; ++q) { float s = 0.f;
#pragma unroll
            for (int j = 0; j < 4; ++j) s += (v[q][j].x * v[q][j].x + v[q][j].y * v[q][j].y) + (v[q][j].z * v[q][j].z + v[q][j].w * v[q][j].w);
            const float rstd = 1.f / sqrtf(wave_sum(s) * (1.f / D) + EPS);
            if (I8_P1) { GAS unsigned* o4 = (GAS unsigned*)((unsigned char*)H0 + (size_t)(m0 + q) * D) + lane;
#pragma unroll
                for (int j = 0; j < 4; ++j) { const f32x4 y = v[q][j] * (rstd * SA_N) * gv[j]; o4[64 * j] = pg8::pk_i8x4(y.x, y.y, y.z, y.w); } }
            else { GAS unsigned long long* o8 = (GAS unsigned long long*)(H0 + (size_t)(m0 + q) * D) + lane;
#pragma unroll
                for (int j = 0; j < 4; ++j) { const f32x4 y = v[q][j] * rstd * gv[j]; o8[64 * j] = (unsigned long long)pkbf(y.x, y.y) | ((unsigned long long)pkbf(y.z, y.w) << 32); } } }
    }
}

__device__ __forceinline__ void conv_phase(const bf16* glu, const float* dw_w, const float* dw_b, const float* ln_g, const float* ln_b, bf16* vout, LAS unsigned char* lds, int G, int vcu, int tid, int lane, int wave) {
    LAS float* ybuf = (LAS float*)(lds + RING_OFF);
    const int c0 = 2 * tid;
    float w0[31], w1[31];
#pragma unroll
    for (int k = 0; k < 31; ++k) { const f32x2v w = *(const f32x2v*)(dw_w + k * 1024 + c0); w0[k] = w.x; w1[k] = w.y; }
    const f32x2v dbv = *(const f32x2v*)(dw_b + c0);
    LAS float* lnp = (LAS float*)(lds + XTRA_OFF);
    for (int i = tid; i < 1024; i += NWAVES * 64) { lnp[i] = ln_g[i]; lnp[1024 + i] = ln_b[i]; }
    __syncthreads();
    for (int item = vcu; item < T / 128; item += G) {
        const int b = item >> 5, s0 = (item & 31) * 128;
        const bf16* ub = glu + (size_t)b * SEQ * D + c0;
        float r0[32], r1[32];
        r0[0] = 0.f; r1[0] = 0.f; r0[1] = 0.f; r1[1] = 0.f;
#pragma unroll
        for (int i = 0; i < 30; ++i) { const int s = s0 - 30 + i; unsigned v = 0u; if (s >= 0) v = *(const unsigned*)(ub + (size_t)s * D); r0[i + 2] = bflo(v); r1[i + 2] = bfhi(v); }
        for (int base = 0; base < 128; base += 32) {
            unsigned nu[32];
#pragma unroll
            for (int j = 0; j < 32; ++j) nu[j] = *(const unsigned*)(ub + (size_t)(s0 + base + j) * D);
#pragma unroll
            for (int j = 0; j < 32; ++j) {
                r0[j] = bflo(nu[j]); r1[j] = bfhi(nu[j]);
                float y0 = dbv.x, y1 = dbv.y;
#pragma unroll
                for (int k = 0; k < 31; ++k) { const int idx = (j + 2 + k) & 31; y0 += r0[idx] * w0[k]; y1 += r1[idx] * w1[k]; }
                *(LAS f32x2v*)(ybuf + j * 1024 + c0) = (f32x2v){y0, y1};
            }
            __syncthreads();
            const int ntok = 32;
            for (int j = wave; j < ntok; j += NWAVES) {
                f32x4 y[4]; float s = 0.f;
#pragma unroll
                for (int i = 0; i < 4; ++i) { y[i] = *(const LAS f32x4*)(ybuf + j * 1024 + 4 * lane + 256 * i); s += (y[i].x + y[i].y) + (y[i].z + y[i].w); }
                const float mean = wave_sum(s) * (1.f / D); float q = 0.f;
#pragma unroll
                for (int i = 0; i < 4; ++i) { y[i] = y[i] - mean; q += (y[i].x * y[i].x + y[i].y * y[i].y) + (y[i].z * y[i].z + y[i].w * y[i].w); }
                const float rstd = 1.f / sqrtf(wave_sum(q) * (1.f / D) + EPS);
                GAS unsigned* o4 = (GAS unsigned*)((unsigned char*)vout + ((size_t)b * SEQ + s0 + base + j) * D) + lane;
                GAS unsigned long long* o8 = (GAS unsigned long long*)(vout + ((size_t)b * SEQ + s0 + base + j) * D) + lane;
#pragma unroll
                for (int i = 0; i < 4; ++i) { const f32x4 lgv = *(const LAS f32x4*)(lnp + 4 * lane + 256 * i), lbv = *(const LAS f32x4*)(lnp + 1024 + 4 * lane + 256 * i); f32x4 z = y[i] * rstd * lgv + lbv;
                    z.x *= pg8::fast_sigmoid(z.x); z.y *= pg8::fast_sigmoid(z.y); z.z *= pg8::fast_sigmoid(z.z); z.w *= pg8::fast_sigmoid(z.w);
                    if (I8_P3) o4[64 * i] = pg8::pk_i8x4(z.x * SA_N, z.y * SA_N, z.z * SA_N, z.w * SA_N);
                    else o8[64 * i] = (unsigned long long)pkbf(z.x, z.y) | ((unsigned long long)pkbf(z.z, z.w) << 32); }
            }
            __syncthreads();
        }
    }
}

__device__ __forceinline__ void attn_phase(LAS unsigned char* lds, int grp, const bf16* Kb, const bf16* Vb, const bf16* Qb, bf16* Ob, unsigned char* O8, float* lse, const float* rel_bias, unsigned* qheads, int G, int vcu, int tid, int lane, int wave) {
    const int dsh = 2 * grp, dil = 1 << dsh;
    LAS unsigned char* Kl = lds + RING_OFF;
    LAS unsigned char* Vl = lds + RING_OFF + 55296;
    LAS float* btab_all = (LAS float*)(lds + XTRA_OFF);
    for (int i = tid; i < 16 * 192; i += NWAVES * 64) { const int hh = i / 192, j = i % 192, dist = 159 - j;
        btab_all[i] = (dist >= 0 && dist <= 128) ? rel_bias[(int)T5_BUCKET[grp][dist] * 48 + grp * 16 + hh] * LOG2E - SOFTMAX_OFS : -1.0e30f; }
    const int lq = lane & 31, hi = lane >> 5;
    v4u kvp[6], vvp[6];
#define ATT_DECODE(IDX, b_, h_, res_, n0_) const int bh_##b_ = (IDX) >> 4, w16_##b_ = (IDX) & 15, b_ = bh_##b_ >> 4, h_ = bh_##b_ & 15, res_ = w16_##b_ & (dil - 1), n0_ = (w16_##b_ >> dsh) * 256
#define ATT_LOAD(IDX) do { ATT_DECODE(IDX, pb, ph, pres, pn0); \
        _Pragma("unroll") for (int i = 0; i < 6; ++i) { const int cidx = tid + 512 * i, j = cidx >> 3, c16 = cidx & 7, sub = pn0 - 128 + j; \
            kvp[i] = (v4u){0u, 0u, 0u, 0u}; vvp[i] = kvp[i]; \
            if (sub >= 0) { const size_t off = ((size_t)pb * SEQ + ((size_t)sub << dsh) + pres) * D + ph * 64 + c16 * 8; kvp[i] = *(const GAS v4u*)(Kb + off); vvp[i] = *(const GAS v4u*)(Vb + off); } } } while (0)
    pg8::bf16x8 qnext[4];
#define ATT_LOADQ(IDX) do { ATT_DECODE(IDX, qb_, qh_, qres_, qn0_); const size_t qrow_ = (size_t)qb_ * SEQ + ((size_t)(qn0_ + 32 * wave + lq) << dsh) + qres_; \
        _Pragma("unroll") for (int c = 0; c < 4; ++c) qnext[c] = *(const pg8::bf16x8*)(Qb + qrow_ * D + qh_ * 64 + 16 * c + 8 * hi); } while (0)
    const bool dyn = (G == 256);
    const int xq = vcu >> 5;
    LAS int* qL = (LAS int*)(lds + XTRA_OFF + 12288 + 64);
    int idx = vcu;
    if (idx < 2048) { ATT_LOAD(idx); ATT_LOADQ(idx); }
    __syncthreads();
    while (idx < 2048) {
        int claimed = 0;
        if (dyn && tid == 0) claimed = (int)__hip_atomic_fetch_add(qheads + 16 * xq, 1u, __ATOMIC_RELAXED, __HIP_MEMORY_SCOPE_AGENT);
        ATT_DECODE(idx, b, h, res, n0);
        const int ql = 32 * wave + lq;
        const size_t qrow = (size_t)b * SEQ + ((size_t)(n0 + ql) << dsh) + res;
        pg8::bf16x8 qr[4];
#pragma unroll
        for (int c = 0; c < 4; ++c) qr[c] = qnext[c];
        __syncthreads();
#pragma unroll
        for (int i = 0; i < 6; ++i) { const int cidx = tid + 512 * i, j = cidx >> 3, c16 = cidx & 7;
            *(LAS v4u*)(Kl + j * 144 + c16 * 16) = kvp[i]; *(LAS v4u*)(Vl + (c16 >> 2) * 24576 + j * 64 + (c16 & 3) * 16) = vvp[i]; }
        if (dyn && tid == 0) qL[0] = 32 + claimed;
        __syncthreads();
        int nidx = idx + G;
        if (dyn) { const int jn = qL[0]; nidx = jn < 256 ? ((jn >> 5) << 8) + (xq << 5) + (jn & 31) : 2048; }
        if (nidx < 2048) ATT_LOAD(nidx);
        float sv[5][16]; float m = -3.0e38f;
        const int kofs = n0 - 128 + 32 * wave;
        const LAS float* brow = btab_all + h * 192 + (31 - lq + 4 * hi);
#pragma unroll
        for (int kt = 0; kt < 5; ++kt) {
            f32x16 S = (f32x16){0.f, 0.f, 0.f, 0.f, 0.f, 0.f, 0.f, 0.f, 0.f, 0.f, 0.f, 0.f, 0.f, 0.f, 0.f, 0.f};
#pragma unroll
            for (int c = 0; c < 4; ++c) { const pg8::bf16x8 a = *(const LAS pg8::bf16x8*)(Kl + (32 * wave + 32 * kt + lq) * 144 + (16 * c + 8 * hi) * 2);
                S = __builtin_amdgcn_mfma_f32_32x32x16_bf16(a, qr[c], S, 0, 0, 0); }
#pragma unroll
            for (int r = 0; r < 16; ++r) { const float s = S[r] + brow[32 * kt + (r & 3) + 8 * (r >> 2)]; sv[kt][r] = s; }
            __builtin_amdgcn_sched_barrier(0);
        }
        if (kofs < 0) {
#pragma unroll
            for (int kt = 0; kt < 5; ++kt)
#pragma unroll
                for (int r = 0; r < 16; ++r) { const int kk = 32 * kt + crow(r, hi); if (kofs + kk < 0) sv[kt][r] = -1.0e30f; }
        }
        m = SOFTMAX_OFS;
        float l = 0.f; unsigned pw[5][8];
#pragma unroll
        for (int kt = 0; kt < 5; ++kt) {
#pragma unroll
            for (int r = 0; r < 16; r += 2) { const float p0 = __builtin_amdgcn_exp2f(sv[kt][r]), p1 = __builtin_amdgcn_exp2f(sv[kt][r + 1]); l += p0 + p1; pw[kt][r >> 1] = pkbf(p0, p1); }
            __builtin_amdgcn_sched_barrier(0);
        }
        l += __shfl_xor(l, 32);
        f32x16 O0 = (f32x16){0.f, 0.f, 0.f, 0.f, 0.f, 0.f, 0.f, 0.f, 0.f, 0.f, 0.f, 0.f, 0.f, 0.f, 0.f, 0.f}, O1 = O0;
        const int vlane = ((lane & 15) >> 2) * 64 + ((lane >> 4) & 1) * 32 + (lane & 3) * 8;
#pragma unroll
        for (int kt = 0; kt < 5; ++kt)
#pragma unroll
            for (int s2 = 0; s2 < 2; ++s2) {
                v4u pq; pq.x = pw[kt][4 * s2 + 0]; pq.y = pw[kt][4 * s2 + 1]; pq.z = pw[kt][4 * s2 + 2]; pq.w = pw[kt][4 * s2 + 3];
                const pg8::bf16x8 pf = __builtin_bit_cast(pg8::bf16x8, pq);
                const int vrow = 32 * wave + 32 * kt + 16 * s2 + 4 * hi;
                LAS unsigned char* vp = Vl + vrow * 64 + vlane;
                const v4i16_t a0 = __builtin_amdgcn_ds_read_tr16_b64_v4i16((LAS v4i16_t*)(vp)), a1 = __builtin_amdgcn_ds_read_tr16_b64_v4i16((LAS v4i16_t*)(vp + 512));
                const v4i16_t b0 = __builtin_amdgcn_ds_read_tr16_b64_v4i16((LAS v4i16_t*)(vp + 24576)), b1 = __builtin_amdgcn_ds_read_tr16_b64_v4i16((LAS v4i16_t*)(vp + 24576 + 512));
                const pg8::bf16x8 vf0 = (pg8::bf16x8){a0[0], a0[1], a0[2], a0[3], a1[0], a1[1], a1[2], a1[3]};
                const pg8::bf16x8 vf1 = (pg8::bf16x8){b0[0], b0[1], b0[2], b0[3], b1[0], b1[1], b1[2], b1[3]};
                O0 = __builtin_amdgcn_mfma_f32_32x32x16_bf16(vf0, pf, O0, 0, 0, 0);
                O1 = __builtin_amdgcn_mfma_f32_32x32x16_bf16(vf1, pf, O1, 0, 0, 0);
                __builtin_amdgcn_sched_barrier(0);
            }
        if (nidx < 2048) ATT_LOADQ(nidx);
        const float inv_l = 1.f / l, lse2 = m + __builtin_amdgcn_logf(l);
        const size_t orow = qrow;
        v4u oldv[4];
        if (grp != 0) {
#pragma unroll
            for (int i = 0; i < 4; ++i) { const int ch = lane + 64 * i, qq = ch >> 3, c8 = ch & 7; oldv[i] = *(const GAS v4u*)(Ob + ((size_t)b * SEQ + ((size_t)(n0 + 32 * wave + qq) << dsh) + res) * D + h * 64 + c8 * 8); } }
        float co = 0.f, cg = inv_l, lnew = lse2;
        if (grp != 0) { const float lo_ = lse[orow * 16 + h]; const float M = fmaxf(lo_, lse2); const float wo = __builtin_amdgcn_exp2f(lo_ - M), wg = __builtin_amdgcn_exp2f(lse2 - M), den = wo + wg;
            co = wo / den; cg = wg / den * inv_l; lnew = M + __builtin_amdgcn_logf(den); }
        __syncthreads();
        LAS unsigned char* stg = Kl + wave * 4608;
        LAS float* cot = (LAS float*)(Kl + 8 * 4608) + wave * 32;
#pragma unroll
        for (int rg = 0; rg < 4; ++rg) {
            pg8::u32x2 wa, wb; wa.x = pkbf(O0[4 * rg] * cg, O0[4 * rg + 1] * cg); wa.y = pkbf(O0[4 * rg + 2] * cg, O0[4 * rg + 3] * cg);
            wb.x = pkbf(O1[4 * rg] * cg, O1[4 * rg + 1] * cg); wb.y = pkbf(O1[4 * rg + 2] * cg, O1[4 * rg + 3] * cg);
            *(LAS pg8::u32x2*)(stg + lq * 144 + (8 * rg + 4 * hi) * 2) = wa; *(LAS pg8::u32x2*)(stg + lq * 144 + (32 + 8 * rg + 4 * hi) * 2) = wb; }
        if (hi == 0) cot[lq] = co;
        if (hi == 0) lse[orow * 16 + h] = lnew;
#pragma unroll
        for (int i = 0; i < 4; ++i) { const int ch = lane + 64 * i, qq = ch >> 3, c8 = ch & 7;
            const v4u sv4 = *(const LAS v4u*)(stg + qq * 144 + c8 * 16);
            bf16* op = Ob + ((size_t)b * SEQ + ((size_t)(n0 + 32 * wave + qq) << dsh) + res) * D + h * 64 + c8 * 8;
            v4u ov = sv4;
            if (grp != 0) { const float cq = cot[qq]; const v4u old = oldv[i];
                ov.x = pkbf(bflo(sv4.x) + cq * bflo(old.x), bfhi(sv4.x) + cq * bfhi(old.x)); ov.y = pkbf(bflo(sv4.y) + cq * bflo(old.y), bfhi(sv4.y) + cq * bfhi(old.y));
                ov.z = pkbf(bflo(sv4.z) + cq * bflo(old.z), bfhi(sv4.z) + cq * bfhi(old.z)); ov.w = pkbf(bflo(sv4.w) + cq * bflo(old.w), bfhi(sv4.w) + cq * bfhi(old.w)); }
            if (grp == 2) { unsigned char* o8 = O8 + ((size_t)b * SEQ + ((size_t)(n0 + 32 * wave + qq) << dsh) + res) * D + h * 64 + c8 * 8;
                pg8::u32x2 w8; w8.x = pg8::pk_fp8x4(bflo(ov.x) * O8_SCALE, bfhi(ov.x) * O8_SCALE, bflo(ov.y) * O8_SCALE, bfhi(ov.y) * O8_SCALE); w8.y = pg8::pk_fp8x4(bflo(ov.z) * O8_SCALE, bfhi(ov.z) * O8_SCALE, bflo(ov.w) * O8_SCALE, bfhi(ov.w) * O8_SCALE);
                *(GAS pg8::u32x2*)o8 = w8; }
            else *(GAS v4u*)op = ov; }
        idx = nidx;
    }
    __syncthreads();
#undef ATT_DECODE
#undef ATT_LOAD
#undef ATT_LOADQ
}

__device__ __forceinline__ void route_phase(const _Float16* x3, const float* gnorm, const float* wr, unsigned char* ws, LAS unsigned char* lds, int G, int vcu, int tid, int lane, int wave) {
    LAS float* WrT = (LAS float*)(lds + RING_OFF);
    LAS unsigned* wcL = (LAS unsigned*)(lds + RING_OFF + 32768);
    for (int i = tid; i < 8192; i += NWAVES * 64) { const int e = i >> 10, k = i & 1023; WrT[i] = wr[k * 8 + e] * gnorm[k]; }
    __syncthreads();
    unsigned* route = (unsigned*)(ws + WS_ROUTE); float* gate1 = (float*)(ws + WS_GATE1); float* gate2 = (float*)(ws + WS_GATE2);
    unsigned* wavecnt = (unsigned*)(ws + WS_WAVECNT); int* blockcnt = (int*)(ws + WS_BLOCKCNT); unsigned char* H3 = ws + WS_H3;
    const int gw = vcu * NWAVES + wave, NGW = G * NWAVES, tpw = (T + NGW - 1) / NGW;
    const int t0 = gw * tpw, t1 = (t0 + tpw) < T ? (t0 + tpw) : T;
    f32x4 gv[4];
#pragma unroll
    for (int j = 0; j < 4; ++j) gv[j] = *(const f32x4*)(gnorm + 4 * lane + 256 * j);
    unsigned long long cnt0 = 0ull, cnt1 = 0ull;
    f32x4 vn[4];
    if (t0 < t1) { const GAS pg8::h16x4* xr = (const GAS pg8::h16x4*)(x3 + (size_t)t0 * D) + lane;
#pragma unroll
        for (int j = 0; j < 4; ++j) vn[j] = __builtin_convertvector(xr[64 * j], f32x4); }
    for (int t = t0; t < t1; ++t) {
        f32x4 v[4]; float ss = 0.f;
#pragma unroll
        for (int j = 0; j < 4; ++j) { v[j] = vn[j]; ss += (v[j].x * v[j].x + v[j].y * v[j].y) + (v[j].z * v[j].z + v[j].w * v[j].w); }
        if (t + 1 < t1) { const GAS pg8::h16x4* xr = (const GAS pg8::h16x4*)(x3 + (size_t)(t + 1) * D) + lane;
#pragma unroll
            for (int j = 0; j < 4; ++j) vn[j] = __builtin_convertvector(xr[64 * j], f32x4); }
        float dt[8];
#pragma unroll
        for (int e = 0; e < 8; ++e) { float a = 0.f;
#pragma unroll
            for (int j = 0; j < 4; ++j) { const f32x4 w = *(const LAS f32x4*)(WrT + e * 1024 + 4 * lane + 256 * j); a += (v[j].x * w.x + v[j].y * w.y) + (v[j].z * w.z + v[j].w * w.w); }
            dt[e] = a; }
        ss = wave_sum(ss);
#pragma unroll
        for (int e = 0; e < 8; ++e) dt[e] = wave_sum(dt[e]);
        const float rstd = 1.f / sqrtf(ss * (1.f / D) + EPS);
        GAS unsigned* o4 = (GAS unsigned*)(H3 + (size_t)t * D) + lane;
#pragma unroll
        for (int j = 0; j < 4; ++j) { const f32x4 y = v[j] * (rstd * SA_N) * gv[j]; o4[64 * j] = pg8::pk_i8x4(y.x, y.y, y.z, y.w); }
        int e1 = 0; float v1 = dt[0] * rstd;
#pragma unroll
        for (int e = 1; e < 8; ++e) { const float x = dt[e] * rstd; if (x > v1) { v1 = x; e1 = e; } }
        int e2 = -1; float v2 = -3.0e38f;
#pragma unroll
        for (int e = 0; e < 8; ++e) { const float x = dt[e] * rstd; if (e != e1 && x > v2) { v2 = x; e2 = e; } }
        const float g2 = 1.f / (1.f + __expf(v1 - v2)), g1 = 1.f - g2;
        cnt0 += 1ull << (8 * e1); cnt1 += 1ull << (8 * e2);
        if (lane == 0) { route[t] = (unsigned)e1 | ((unsigned)e2 << 8); gate1[t] = g1; gate2[t] = g2; }
    }
    if (lane == 0) { v4u c; c.x = (unsigned)cnt0; c.y = (unsigned)(cnt0 >> 32); c.z = (unsigned)cnt1; c.w = (unsigned)(cnt1 >> 32);
        *(GAS v4u*)(wavecnt + (size_t)gw * 4) = c; wcL[wave * 4 + 0] = c.x; wcL[wave * 4 + 1] = c.y; wcL[wave * 4 + 2] = c.z; wcL[wave * 4 + 3] = c.w; }
    __syncthreads();
    if (tid < 16) { const int slot = tid >> 3, e = tid & 7; int s = 0;
#pragma unroll
        for (int w = 0; w < NWAVES; ++w) s += (int)((wcL[w * 4 + slot * 2 + (e >> 2)] >> (8 * (e & 3))) & 255u);
        blockcnt[vcu * 16 + tid] = s; }
    __syncthreads();
}

__device__ __forceinline__ void pos_phase(unsigned char* ws, LAS unsigned char* lds, int G, int vcu, int tid, int lane, int wave) {
    LAS int* cntL = (LAS int*)(lds + RING_OFF);
    LAS int* pAll = (LAS int*)(lds + RING_OFF + 65536);
    LAS int* pBef = pAll + 512;
    LAS int* totL = pBef + 512;
    const int* blockcnt = (const int*)(ws + WS_BLOCKCNT); const unsigned* wavecnt = (const unsigned*)(ws + WS_WAVECNT);
    const unsigned* route = (const unsigned*)(ws + WS_ROUTE); const float* gate1 = (const float*)(ws + WS_GATE1); const float* gate2 = (const float*)(ws + WS_GATE2);
    int* gofs = (int*)(ws + WS_GOFS);
    for (int i = tid; i < G * 16; i += NWAVES * 64) cntL[i] = blockcnt[i];
    __syncthreads();
    { const int c = tid & 15, part = tid >> 4, bpp = (G + 31) / 32; int sa = 0, sb = 0;
      for (int bb = part * bpp; bb < (part + 1) * bpp && bb < G; ++bb) { const int v = cntL[bb * 16 + c]; sa += v; if (bb < vcu) sb += v; }
      pAll[part * 16 + c] = sa; pBef[part * 16 + c] = sb; }
    __syncthreads();
    if (tid < 16) { int sa = 0, sb = 0;
        for (int p = 0; p < 32; ++p) { sa += pAll[p * 16 + tid]; sb += pBef[p * 16 + tid]; }
        totL[tid] = sa; totL[16 + tid] = sb; }
    __syncthreads();
    if (tid == 0) { int off = 0;
        for (int e = 0; e < 8; ++e) { totL[32 + e] = off; totL[32 + 8 + e] = off + totL[e]; if (vcu == 0) { gofs[e] = off; gofs[8 + e] = off + totL[e]; gofs[32 + e] = off >> 8; } off += ((totL[e] + totL[8 + e] + 255) >> 8) << 8; }
        if (vcu == 0) gofs[16] = off >> 8; }
    __syncthreads();
    const int gw = vcu * NWAVES + wave, NGW = G * NWAVES, tpw = (T + NGW - 1) / NGW;
    const int t0 = gw * tpw, t1 = (t0 + tpw) < T ? (t0 + tpw) : T;
    int mypos = 0;
    if (lane < 16) { mypos = totL[32 + lane] + totL[16 + lane];
        for (int w = 0; w < wave; ++w) mypos += (int)((wavecnt[(size_t)(vcu * NWAVES + w) * 4 + (lane >> 3) * 2 + ((lane & 7) >> 2)] >> (8 * (lane & 3))) & 255u); }
    int* pos01 = (int*)(ws + WS_POS);
    int* rowtok0 = (int*)(ws + WS_ROWTOK); int* rowtok1 = rowtok0; float* rowgate0 = (float*)(ws + WS_ROWGATE); float* rowgate1 = rowgate0;
    for (int t = t0; t < t1; ++t) {
        const unsigned rt = route[t]; const int e1 = (int)(rt & 255u), e2 = (int)((rt >> 8) & 255u);
        const int p1 = __shfl(mypos, e1), p2 = __shfl(mypos, 8 + e2);
        if (lane == e1 || lane == 8 + e2) mypos += 1;
        if (lane == 0) { rowtok0[p1] = t; rowgate0[p1] = gate1[t]; rowtok1[p2] = t; rowgate1[p2] = gate2[t]; pos01[t] = p1; pos01[T + t] = p2; }
    }
    if (vcu < 8) { int* rtk = (int*)(ws + WS_ROWTOK); float* rgt = (float*)(ws + WS_ROWGATE);
        const int beg = totL[32 + vcu] + totL[vcu] + totL[8 + vcu], end = totL[32 + vcu] + (((totL[vcu] + totL[8 + vcu] + 255) >> 8) << 8);
        for (int i = beg + tid; i < end; i += NWAVES * 64) { rtk[i] = -1; rgt[i] = 0.f; } }
    __syncthreads();
}

__device__ __forceinline__ void combine_phase(float* out, unsigned char* ws, int G, int vcu, int tid, int lane, int wave) {
    const int* pos01 = (const int*)(ws + WS_POS); const unsigned char* Y = ws + WS_Y; const _Float16* XH = (const _Float16*)(ws + WS_XH);
    const int gw = vcu * NWAVES + wave, NGW = G * NWAVES; const float ys = 1.f / Y_SCALE;
    for (int t0 = gw * 4; t0 < T; t0 += NGW * 4) {
        v4u ya[4], yb[4]; f32x4 o[4][4];
#pragma unroll
        for (int q = 0; q < 4; ++q) { const int t = t0 + q; const int p0 = pos01[t], p1 = pos01[T + t];
            ya[q] = *(const GAS v4u*)(Y + (size_t)p0 * 1024 + 16 * lane); yb[q] = *(const GAS v4u*)(Y + (size_t)p1 * 1024 + 16 * lane);
#pragma unroll
            for (int j = 0; j < 4; ++j) o[q][j] = __builtin_convertvector(*(const GAS pg8::h16x4*)(XH + (size_t)t * 1024 + 16 * lane + 4 * j), f32x4); }
#pragma unroll
        for (int q = 0; q < 4; ++q)
#pragma unroll
            for (int j = 0; j < 4; ++j) { const unsigned a = ya[q][j], c = yb[q][j]; f32x4 x = o[q][j];
                x.x += (float)(((int)(a << 24) >> 24) + ((int)(c << 24) >> 24)) * ys; x.y += (float)(((int)(a << 16) >> 24) + ((int)(c << 16) >> 24)) * ys;
                x.z += (float)(((int)(a << 8) >> 24) + ((int)(c << 8) >> 24)) * ys; x.w += (float)(((int)a >> 24) + ((int)c >> 24)) * ys;
                __builtin_nontemporal_store(x, (GAS f32x4*)(out + (size_t)(t0 + q) * 1024 + 16 * lane + 4 * j)); }
    }
}

constexpr int N_LAUNCHES = MK_N_LAUNCHES;
struct Args { const float* in[26]; float* out; unsigned char* ws; int ph_lo, ph_hi; };
typedef const __attribute__((address_space(4))) unsigned char* kargp_t;
#ifdef PROBE_CLK_PHASE
#define CLK_BEGIN(k) unsigned long long ck0_ = 0, rt0_ = 0; if ((k) == PROBE_CLK_PHASE) { ck0_ = __builtin_amdgcn_s_memtime(); rt0_ = __builtin_amdgcn_s_memrealtime(); }
#define CLK_END(k) if ((k) == PROBE_CLK_PHASE && bx == 0 && tid == 0) { const unsigned long long ck1_ = __builtin_amdgcn_s_memtime(), rt1_ = __builtin_amdgcn_s_memrealtime(); const float qv_ = floorf((float)(ck1_ - ck0_) / (float)(rt1_ - rt0_) + 0.5f); ((float*)(ws + WS_GOFS))[100] = 100.f * qv_ * qv_; }
#else
#define CLK_BEGIN(k)
#define CLK_END(k)
#endif
#define PH_ENTER() kargp_t kp_ = kp0; asm volatile("" : "+s"(kp_)); int tid = tid0; asm volatile("" : "+v"(tid)); const int lane = tid & 63, wave = __builtin_amdgcn_readfirstlane(tid >> 6); \
    unsigned char* ws = *(unsigned char* const __attribute__((address_space(4)))*)(kp_ + 216); float* out = *(float* const __attribute__((address_space(4)))*)(kp_ + 208); (void)lane; (void)wave; (void)out
#define INP(i) (*(const float* const __attribute__((address_space(4)))*)(kp_ + 8 * (i)))
__global__ void __launch_bounds__(NWAVES * 64, 2) mk_fwd(Args args) {
    extern __shared__ __attribute__((aligned(16))) unsigned char lds_raw[];
    LAS unsigned char* lds = (LAS unsigned char*)lds_raw;
    static_assert(sizeof(Args) == 232 && __builtin_offsetof(Args, out) == 208 && __builtin_offsetof(Args, ws) == 216, "Args layout");
    const kargp_t kp0 = (kargp_t)__builtin_amdgcn_kernarg_segment_ptr();
    const int tid0 = threadIdx.x;
    const int G = gridDim.x, bx = blockIdx.x, vcu = (G % 8 == 0) ? (bx % 8) * (G / 8) + bx / 8 : bx;
    for (int u = tid0; u < (XTRA_OFF - LDSCTL_OFF) / 4; u += NWAVES * 64) ((LAS unsigned*)(lds + LDSCTL_OFF))[u] = 0u;
    __syncthreads();
    XcdBarrier bar; bar.bar = (unsigned*)(args.ws + WS_CTL) + CW_BAR; bar.x = 0; bar.st = (volatile LAS unsigned*)(lds + MISC_OFF) + 8;
    if (N_LAUNCHES == 1) bar = xcd_barrier_post((unsigned*)(args.ws + WS_CTL) + CW_BAR, (volatile LAS unsigned*)(lds + MISC_OFF) + 8);
#define GRID_BAR() do { if (N_LAUNCHES == 1) xcd_barrier(bar); } while (0)
    const int lo = args.ph_lo, hi = args.ph_hi;
#ifndef PH_MASK
#define PH_MASK 0xFFFFFFFFu
#endif
#define IN(k) (((PH_MASK >> (k)) & 1u) && lo <= (k) && (k) < hi)
#define BOTH(k) (IN(k) && IN((k) + 1))
#ifndef PROBE_NOEPI
#define PROBE_NOEPI 0
#endif
#ifndef PROBE_REP_MASK
#define PROBE_REP_MASK 0u
#define PROBE_REP_N 1
#endif
#define REPS(k) (((PROBE_REP_MASK >> (k)) & 1u) ? PROBE_REP_N : 1)

    _Pragma("nounroll") for (int rep_ = 0; rep_ < REPS(0); ++rep_) if (IN(0)) { PH_ENTER(); CLK_BEGIN(0); p0_prologue(kp_, ws, lds, G, vcu, tid, lane, wave); __syncthreads(); CLK_END(0); if (BOTH(0)) GRID_BAR(); }
    _Pragma("nounroll") for (int rep_ = 0; rep_ < REPS(1); ++rep_) if (IN(1)) { PH_ENTER(); CLK_BEGIN(1);
        pg8::Gemm g{(const bf16*)(ws + WS_H0), (const bf16*)(ws + WS_WIN), T, 2048, 1024, 0, nullptr, nullptr, nullptr, nullptr, 0}; pg8::StaticOrder S; S.init(T, 2048, G, bx, I8_P1 ? 1024 / 128 : 1024 / 64);
        pg8::EpiGated<0> E{(bf16*)(ws + WS_GLU), 1024, INP(4), 1024, nullptr, I8_P1 ? 1.f / (SA_N * SW_I8) : 1.f, 1.f, {}, -1};
        pg8::gemm_phase<pg8::EpiGated<0>, pg8::StaticOrder, false, I8_P1 ? 2 : 0>(lds + RING_OFF, g, S, E, tid);
        CLK_END(1); if (BOTH(1)) GRID_BAR();
    }
    _Pragma("nounroll") for (int rep_ = 0; rep_ < REPS(2); ++rep_) if (IN(2)) { PH_ENTER(); CLK_BEGIN(2); conv_phase((const bf16*)(ws + WS_GLU), INP(5), INP(6), INP(7), INP(8), (bf16*)(ws + WS_V), lds, G, vcu, tid, lane, wave); CLK_END(2); if (BOTH(2)) GRID_BAR(); }
    _Pragma("nounroll") for (int rep_ = 0; rep_ < REPS(3); ++rep_) if (IN(3)) { PH_ENTER(); CLK_BEGIN(3);
        pg8::Gemm g{(const bf16*)(ws + WS_V), (const bf16*)(ws + WS_WOUT), T, 1024, 1024, 0, nullptr, nullptr, nullptr, nullptr, 0}; pg8::StaticOrder S; S.init(T, 1024, G, bx, I8_P3 ? 1024 / 128 : 1024 / 64);
        pg8::EpiResid<true, true, I8_P4 ? 2 : 0, 0, 1> E{INP(0), (float*)(ws + WS_XH), INP(10), ws + WS_X1B, (float*)(ws + WS_PART1), I8_P3 ? 1.f / (SA_N * SW_I8) : 1.f, I8_P4 ? SA_X : 1.f, (LAS float*)(lds + XTRA_OFF)};
        pg8::gemm_phase<pg8::EpiResid<true, true, I8_P4 ? 2 : 0, 0, 1>, pg8::StaticOrder, false, I8_P3 ? 2 : 0>(lds + RING_OFF, g, S, E, tid);
        CLK_END(3); if (BOTH(3)) GRID_BAR();
    }
    _Pragma("nounroll") for (int rep_ = 0; rep_ < REPS(4); ++rep_) if (IN(4)) { PH_ENTER(); CLK_BEGIN(4);
        pg8::Gemm g{(const bf16*)(ws + WS_X1B), (const bf16*)(ws + WS_WF13), T, 5632, 1024, 0, nullptr, nullptr, nullptr, nullptr, 0}; pg8::StaticOrder S; S.init(T, 5632, G, bx, I8_P4 ? 1024 / 128 : 1024 / 64);
        pg8::EpiGated<1> E{(bf16*)(ws + WS_HB), DFFP, nullptr, 0, (const float*)(ws + WS_PART1), I8_P4 ? 1.f / (SA_X * SW_I8) : 1.f, 1.f, {}, -1};
        if (G == 256) {
            const int slot = vcu % 11;
            S.i1 = slot;
            pg8::gemm_phase<pg8::EpiGated<1>, pg8::StaticOrder, false, I8_P4 ? 2 : 0>(lds + RING_OFF, g, S, E, tid);
            __syncthreads();
            p0_items2(kp_, ws, (LAS float*)(lds + RING_OFF + wave * 16384), wave, NWAVES, vcu * (IT_MOE / 256), (vcu + 1) * (IT_MOE / 256), lane);
            __syncthreads();
            S.i0 = slot; S.i1 = 0x7fffffff;
        }
        pg8::gemm_phase<pg8::EpiGated<1>, pg8::StaticOrder, false, I8_P4 ? 2 : 0>(lds + RING_OFF, g, S, E, tid);
        CLK_END(4); if (BOTH(4)) GRID_BAR();
    }
    _Pragma("nounroll") for (int rep_ = 0; rep_ < REPS(5); ++rep_) if (IN(5)) { PH_ENTER(); CLK_BEGIN(5);
        pg8::Gemm g{(const bf16*)(ws + WS_HB), (const bf16*)(ws + WS_WFD), T, 1024, DFFP, 0, nullptr, nullptr, nullptr, nullptr, 0}; pg8::StaticOrder S; S.init(T, 1024, G, bx, DFFP / 64);
        pg8::EpiResid<false, true, 2, 1, 1> E{(const float*)(ws + WS_XH), (float*)(ws + WS_XH), nullptr, ws + WS_X2B, (float*)(ws + WS_PART2), 1.f, SA_X, (LAS float*)(lds + XTRA_OFF)};
        pg8::gemm_phase<pg8::EpiResid<false, true, 2, 1, 1>, pg8::StaticOrder, false>(lds + RING_OFF, g, S, E, tid);
        CLK_END(5); if (BOTH(5)) GRID_BAR();
    }
    for (int grp = 0; grp < 3; ++grp) {
        _Pragma("nounroll") for (int rep_ = 0; rep_ < REPS(6 + 2 * grp); ++rep_) if (IN(6 + 2 * grp)) { PH_ENTER(); CLK_BEGIN(6 + 2 * grp);
            pg8::Gemm g{(const bf16*)(ws + WS_X2B), (const bf16*)(ws + WS_WQKV + (size_t)grp * 3072 * 1024), T, 3072, 1024, 0, nullptr, nullptr, nullptr, nullptr, 0}; pg8::StaticOrder S; S.init(T, 3072, G, bx, 1024 / 128);
            pg8::EpiQKV E{(bf16*)(ws + WS_KG), (size_t)T * D, (const float*)(ws + WS_PART2), INP(13) + grp * 64, INP(16) + grp * 64, QSCALE, 1.f / (SA_X * SW_I8), {}, -1};
            pg8::gemm_phase<pg8::EpiQKV, pg8::StaticOrder, false, 2>(lds + RING_OFF, g, S, E, tid);
            CLK_END(6 + 2 * grp); if (BOTH(6 + 2 * grp)) GRID_BAR();
        }
        _Pragma("nounroll") for (int rep_ = 0; rep_ < REPS(7 + 2 * grp); ++rep_) if (IN(7 + 2 * grp)) { PH_ENTER(); CLK_BEGIN(7 + 2 * grp);
            attn_phase(lds, grp, (const bf16*)(ws + WS_KG), (const bf16*)(ws + WS_VG), (const bf16*)(ws + WS_QG), (bf16*)(ws + WS_O), ws + WS_O8, (float*)(ws + WS_LSE), INP(1), (unsigned*)(ws + WS_CTL) + CW_AQ + grp * 128, G, vcu, tid, lane, wave);
            CLK_END(7 + 2 * grp); if (BOTH(7 + 2 * grp)) GRID_BAR();
        }
    }
    _Pragma("nounroll") for (int rep_ = 0; rep_ < REPS(12); ++rep_) if (IN(12)) { PH_ENTER(); CLK_BEGIN(12);
        pg8::Gemm g{(const bf16*)(ws + WS_O8), (const bf16*)(ws + WS_WO), T, 1024, 1024, 0, nullptr, nullptr, nullptr, nullptr, 0}; pg8::StaticOrder S; S.init(T, 1024, G, bx, 1024 / 128);
        pg8::EpiResid<false, false, 0, 1, 1> E{(const float*)(ws + WS_XH), (float*)(ws + WS_XH), nullptr, nullptr, nullptr, 1.f / (W8_SCALE * O8_SCALE), 1.f, nullptr};
        pg8::gemm_phase<pg8::EpiResid<false, false, 0, 1, 1>, pg8::StaticOrder, false, 1>(lds + RING_OFF, g, S, E, tid);
        CLK_END(12); if (BOTH(12)) GRID_BAR();
    }
    _Pragma("nounroll") for (int rep_ = 0; rep_ < REPS(13); ++rep_) if (IN(13)) { PH_ENTER(); CLK_BEGIN(13); route_phase((const _Float16*)(ws + WS_XH), INP(18) + 1024, INP(22), ws, lds, G, vcu, tid, lane, wave); CLK_END(13); if (BOTH(13)) GRID_BAR(); }
    _Pragma("nounroll") for (int rep_ = 0; rep_ < REPS(14); ++rep_) if (IN(14)) { PH_ENTER(); CLK_BEGIN(14); pos_phase(ws, lds, G, vcu, tid, lane, wave); CLK_END(14); if (BOTH(14)) GRID_BAR(); }
    _Pragma("nounroll") for (int rep_ = 0; rep_ < REPS(15); ++rep_) if (IN(15)) { PH_ENTER(); CLK_BEGIN(15);
        const int* gofs = (const int*)(ws + WS_GOFS); const int* rowtok = (const int*)(ws + WS_ROWTOK);
        const int ntile = gofs[16];
        pg8::MoeOrder S; S.so.init(ntile * 256, 7168, G, bx, 1024 / 128); S.p0 = 0; S.p1 = 0; S.ppu = 0;
        S.t1 = gofs[32 + 1]; S.t2 = gofs[32 + 2]; S.t3 = gofs[32 + 3]; S.t4 = gofs[32 + 4]; S.t5 = gofs[32 + 5]; S.t6 = gofs[32 + 6]; S.t7 = gofs[32 + 7];
        pg8::Gemm g{(const bf16*)(ws + WS_H3), (const bf16*)(ws + WS_WM13), ntile * 256, 7168, 1024, (size_t)7168 * 1024, rowtok, nullptr, nullptr, nullptr, 0};
        pg8::EpiGated<3> E{(bf16*)(ws + WS_HM), DFFE, nullptr, 0, nullptr, 1.f / (SA_N * SW_I8), HM_SCALE, {}, -1};
        pg8::gemm_phase<pg8::EpiGated<3>, pg8::MoeOrder, true, 2>(lds + RING_OFF, g, S, E, tid);
        CLK_END(15); if (BOTH(15)) GRID_BAR();
    }
    _Pragma("nounroll") for (int rep_ = 0; rep_ < REPS(16); ++rep_) if (IN(16)) { PH_ENTER(); CLK_BEGIN(16);
        const int* gofs = (const int*)(ws + WS_GOFS); const float* rowgate = (const float*)(ws + WS_ROWGATE);
        const int ntile = gofs[16];
        pg8::MoeOrderSK S; S.so.init(ntile * 256, 1024, G, vcu, DFFE / 128); S.plan();
        S.t1 = gofs[32 + 1]; S.t2 = gofs[32 + 2]; S.t3 = gofs[32 + 3]; S.t4 = gofs[32 + 4]; S.t5 = gofs[32 + 5]; S.t6 = gofs[32 + 6]; S.t7 = gofs[32 + 7];
        pg8::Gemm g{(const bf16*)(ws + WS_HM), (const bf16*)(ws + WS_WM2), ntile * 256, 1024, DFFE, (size_t)1024 * DFFE, nullptr, ws + WS_SLAB, (unsigned*)(ws + WS_CTL) + CW_SKFLAG + (rep_ & 1) * 8192, (unsigned*)(ws + WS_CTL) + CW_TMO, 0};
        pg8::EpiMoeDown E{ws + WS_Y, rowgate, Y_SCALE / (W8_SCALE * HM_SCALE)};
        pg8::gemm_phase<pg8::EpiMoeDown, pg8::MoeOrderSK, false, 1>(lds + RING_OFF, g, S, E, tid);
        CLK_END(16); if (BOTH(16)) GRID_BAR();
    }
    _Pragma("nounroll") for (int rep_ = 0; rep_ < REPS(17); ++rep_) if (IN(17)) { PH_ENTER(); CLK_BEGIN(17); combine_phase(out, ws, G, vcu, tid, lane, wave); }
#ifdef PROBE_CLK_PHASE
    if (bx == 0 && tid0 == 0) { asm volatile("s_waitcnt vmcnt(0)" ::: "memory"); args.out[(size_t)T * D - 1] = ((float*)(args.ws + WS_GOFS))[100]; }
#endif
#ifdef PROBE_TCH
    {
        GRID_BAR();
        if (bx == 0 && tid0 == 0) { const unsigned tot = __hip_atomic_load((unsigned*)(args.ws + WS_CTL) + 60000, __ATOMIC_RELAXED, __HIP_MEMORY_SCOPE_AGENT); const unsigned long long wait_ticks = (unsigned long long)(tot / (unsigned)G) * PROBE_TCH;
            const unsigned long long t0_ = __builtin_amdgcn_s_memrealtime(); while (__builtin_amdgcn_s_memrealtime() - t0_ < wait_ticks) __builtin_amdgcn_s_sleep(8); } }
#endif
#undef IN
#undef BOTH
#undef GRID_BAR
}

extern "C" void kernel_launch(void* const* d_in, const int* in_sizes, int n_in, void* d_out, int out_size, void* d_ws, size_t ws_size, hipStream_t stream) {
    static int grid = 0;
    if (grid == 0) {
        if (n_in != 26 || in_sizes[0] != T * D || out_size != T * D || ws_size < WS_END) { fprintf(stderr, "kernel_launch: unexpected shapes: n_in %d in0 %d out %d ws %zu (need >= %zu); nothing launched\n", n_in, n_in > 0 ? in_sizes[0] : -1, out_size, ws_size, (size_t)WS_END); grid = -1; return; }
        int dev = 0, cus = 0;
        if (hipGetDevice(&dev) != hipSuccess || hipDeviceGetAttribute(&cus, hipDeviceAttributeMultiprocessorCount, dev) != hipSuccess) { fprintf(stderr, "kernel_launch: device query failed\n"); grid = -1; return; }
        if (hipFuncSetAttribute((const void*)mk_fwd, hipFuncAttributeMaxDynamicSharedMemorySize, LDS_BYTES) != hipSuccess) { fprintf(stderr, "kernel_launch: hipFuncSetAttribute failed\n"); grid = -1; return; }
        int per_cu = 0;
        if (hipOccupancyMaxActiveBlocksPerMultiprocessor(&per_cu, (const void*)mk_fwd, NWAVES * 64, LDS_BYTES) != hipSuccess || per_cu < 1) fprintf(stderr, "kernel_launch: note: occupancy query reports %d workgroups per CU\n", per_cu);
        (void)hipGetLastError();
        grid = cus;
    }
    if (grid < 0) return;
    if (hipMemsetAsync((char*)d_ws + WS_CTL, 0, CTL_ZERO_BYTES, stream) != hipSuccess) { fprintf(stderr, "kernel_launch: hipMemsetAsync failed\n"); return; }
    Args a{};
    for (int i = 0; i < 26; ++i) a.in[i] = (const float*)d_in[i];
    a.out = (float*)d_out; a.ws = (unsigned char*)d_ws;
    for (int li = 0; li < N_LAUNCHES; ++li) {
        a.ph_lo = (N_LAUNCHES == 1) ? 0 : li; a.ph_hi = (N_LAUNCHES == 1) ? NPHASE : li + 1;
        hipLaunchKernelGGL(mk_fwd, dim3(grid), dim3(NWAVES * 64), LDS_BYTES, stream, a);
        const hipError_t le = hipPeekAtLastError();
        if (le != hipSuccess) { fprintf(stderr, "kernel_launch: launch %d failed: %s\n", li, hipGetErrorName(le)); break; }
    }
}
```

```cpp
#include <hip/hip_runtime.h>
#include <cstdio>
#include <cstdint>
#ifndef MK_N_LAUNCHES
#define MK_N_LAUNCHES 1
#endif
namespace pg8 {
#define PG8_LAS __attribute__((address_space(3)))
#define PG8_GAS __attribute__((address_space(1)))
typedef unsigned short bf16_t;
typedef short bf16x8 __attribute__((ext_vector_type(8)));
typedef float f32x4 __attribute__((ext_vector_type(4)));
typedef float f32x2 __attribute__((ext_vector_type(2)));
typedef unsigned u32x4 __attribute__((ext_vector_type(4)));
typedef unsigned u32x2 __attribute__((ext_vector_type(2)));
typedef int v4i_t __attribute__((ext_vector_type(4)));
typedef int v8i_t __attribute__((ext_vector_type(8)));
constexpr int BM = 256, BK = 64, HALF = 128, HTB = HALF * BK * 2  , STAGE_BYTES = 8 * HTB, NXCD = 8, WGM = 8;

__host__ __device__ __forceinline__ int lds_byte(int r, int c) { const int st = (r >> 4) * 2 + (c >> 5), rr = r & 15, cc = c & 31, ob = rr * 64 + cc * 2; return st * 1024 + (ob ^ (((ob >> 9) & 1) << 5)); }
__host__ __device__ __forceinline__ void stage_rc(int b, int& R, int& C) { const int st = b / 1024, sb = b % 1024, swz = sb ^ (((sb >> 9) & 1) << 5); R = (st >> 1) * 16 + swz / 64; C = (st & 1) * 32 + (swz % 64) / 2; }
__host__ __device__ __forceinline__ int perm32(int rho) { const int n = rho >> 4, i = rho & 15; return 8 * (i >> 2) + 4 * n + (i & 3); }

struct Unit { int pm, pn, be, kt0, nkt, part; };
struct Gemm { const bf16_t* A; const bf16_t* Bt; int M, N, K; size_t bstride; const int* rowtok; unsigned char* slab; unsigned* skflag; unsigned* tmo; int noepi; };

struct StaticOrder {
    static constexpr bool STREAMK = false;
    int nM, nN, nwg, G, c, nt, i0, i1;
    __host__ __device__ __forceinline__ void init(int M, int N, int G_, int c_, int nt_) { nM = M / BM; nN = N / BM; nwg = nM * nN; G = G_; c = c_; nt = nt_; i0 = 0; i1 = 0x7fffffff; }
    __host__ __device__ __forceinline__ int wg() const { return c; }
    __host__ __device__ __forceinline__ bool next(int i, Unit& u) const { const int ii = i + i0; if (ii >= i1) return false; const long L = (long)ii * G + c; if (L >= nwg) return false; map((int)L, u); return true; }
    __host__ __device__ __forceinline__ void map_linear(int wgid, Unit& u) const {
        const int nig = WGM * nN, gid = wgid / nig, fm = gid * WGM, gsz = (nM - fm) < WGM ? (nM - fm) : WGM;
        u.pm = fm + ((wgid % nig) % gsz); u.pn = (wgid % nig) / gsz; u.be = 0; u.kt0 = 0; u.nkt = nt; u.part = 0;
    }
    __host__ __device__ __forceinline__ void map(int L, Unit& u) const {
        int wgid = L; { const int q = nwg / NXCD, r = nwg % NXCD, xcd = wgid % NXCD, off = wgid / NXCD; wgid = (xcd < r ? xcd * (q + 1) : r * (q + 1) + (xcd - r) * q) + off; }
        const int nig = WGM * nN, gid = wgid / nig, fm = gid * WGM, gsz = (nM - fm) < WGM ? (nM - fm) : WGM;
        u.pm = fm + ((wgid % nig) % gsz); u.pn = (wgid % nig) / gsz; u.be = 0; u.kt0 = 0; u.nkt = nt; u.part = 0;
    }
};
template <bool STREAMK_> struct MoeOrderT {
    static constexpr bool STREAMK = STREAMK_;
    StaticOrder so; int t1, t2, t3, t4, t5, t6, t7; int p0, p1, ppu;
    __device__ __forceinline__ int wg() const { return so.c; }
    __device__ __forceinline__ void plan() { ppu = so.nt / 2; const long tot = (long)so.nwg * ppu; p0 = (int)(tot * so.c / so.G); p1 = (int)(tot * (so.c + 1) / so.G); }
    __device__ __forceinline__ bool next(int i, Unit& u) const {
#if defined(PROBE_DOUBLE_KLOOP)
        if (!STREAMK) { if (!so.next(i >> 1, u)) return false; if (!(i & 1)) u.part = 3; }
#else
        if (!STREAMK) { if (!so.next(i, u)) return false; }
#endif
        else { const int first = p0 / ppu, uidx = first + i; const int s = (i == 0) ? (p0 - first * ppu) : 0; const int rem = p1 - uidx * ppu;
            if (rem <= s) return false;
            const int e = rem < ppu ? rem : ppu;
            so.map_linear(uidx, u); u.kt0 = 2 * s; u.nkt = 2 * (e - s); u.part = (s > 0) ? 1 : ((e < ppu) ? 2 : 0); }
        const int q = u.pm; u.be = (q >= t1) + (q >= t2) + (q >= t3) + (q >= t4) + (q >= t5) + (q >= t6) + (q >= t7); return true;
    }
};
typedef MoeOrderT<false> MoeOrder;
typedef MoeOrderT<true> MoeOrderSK;

__device__ __forceinline__ unsigned cvt_pk_bf16(float lo, float hi) { unsigned r; asm volatile("v_cvt_pk_bf16_f32 %0, %1, %2" : "=v"(r) : "v"(lo), "v"(hi)); return r; }
__device__ __forceinline__ float fast_sigmoid(float x) { return __builtin_amdgcn_rcpf(1.0f + __builtin_amdgcn_exp2f(-1.4426950408889634f * x)); }
__device__ __forceinline__ float row_rstd(const float* part, int row) {
    const f32x4 a = *(const f32x4*)(part + (size_t)row * 4);
    return __builtin_amdgcn_rsqf(((a[0] + a[1]) + (a[2] + a[3])) * (1.0f / 1024.0f) + 1e-6f);
}
__device__ __forceinline__ void row_rstd8(const float* part, int row0, float (&r)[2][4]) {
#pragma unroll
    for (int ai = 0; ai < 2; ++ai)
#pragma unroll
        for (int m = 0; m < 4; ++m) r[ai][m] = row_rstd(part, row0 + ai * HALF + m * 16);
}
__device__ __forceinline__ unsigned pk_fp8x4(float a, float b, float c, float d) {
    a = __builtin_amdgcn_fmed3f(a, -448.f, 448.f); b = __builtin_amdgcn_fmed3f(b, -448.f, 448.f); c = __builtin_amdgcn_fmed3f(c, -448.f, 448.f); d = __builtin_amdgcn_fmed3f(d, -448.f, 448.f);
    unsigned w = 0u; w = __builtin_amdgcn_cvt_pk_fp8_f32(a, b, w, false); w = __builtin_amdgcn_cvt_pk_fp8_f32(c, d, w, true); return w;
}
__device__ __forceinline__ unsigned pk_i8x4(float a, float b, float c, float d) {
    const int ia = (int)__builtin_rintf(__builtin_amdgcn_fmed3f(a, -127.f, 127.f)), ib = (int)__builtin_rintf(__builtin_amdgcn_fmed3f(b, -127.f, 127.f));
    const int ic = (int)__builtin_rintf(__builtin_amdgcn_fmed3f(c, -127.f, 127.f)), id = (int)__builtin_rintf(__builtin_amdgcn_fmed3f(d, -127.f, 127.f));
    return ((unsigned)ia & 255u) | (((unsigned)ib & 255u) << 8) | (((unsigned)ic & 255u) << 16) | ((unsigned)id << 24);
}

template <int MODE> struct EpiGated {
    static constexpr bool PERM = true, AFTER_DRAIN = false;
    bf16_t* O; int ldo; const float* bias; int bias_half; const float* part; float descale, out_scale;
    mutable float r8c[2][4]; mutable int pmc;
    __device__ __forceinline__ void operator()(const f32x4 (&acc)[2][2][4][2], const Unit& u, int wr, int wc, int fr, int fq) const {
        const int row0 = u.pm * BM + wr * 64 + fr, col0 = u.pn * 128 + wc * 32 + 8 * fq;
        f32x4 ba[2], bg[2];
#pragma unroll
        for (int n = 0; n < 2; ++n) { if (MODE == 0) { ba[n] = *(const f32x4*)(bias + col0 + 4 * n); bg[n] = *(const f32x4*)(bias + bias_half + col0 + 4 * n); } else { ba[n] = (f32x4){0.f, 0.f, 0.f, 0.f}; bg[n] = ba[n]; } }
        if ((MODE == 1 || MODE == 4) && u.pm != pmc) { row_rstd8(part, row0, r8c); pmc = u.pm; }
#pragma unroll
        for (int ai = 0; ai < 2; ++ai)
#pragma unroll
            for (int m = 0; m < 4; ++m) { const int row = row0 + ai * HALF + m * 16;
                float r = 1.f; if (MODE == 1 || MODE == 4) r = r8c[ai][m];
                f32x4 o[2];
#pragma unroll
                for (int n = 0; n < 2; ++n) { f32x4 a = acc[ai][0][m][n], g = acc[ai][1][m][n];
                    if (MODE == 0) { a = a * descale + ba[n]; g = g * descale + bg[n];
#pragma unroll
                        for (int e = 0; e < 4; ++e) o[n][e] = a[e] * fast_sigmoid(g[e]); }
                    else if (MODE == 3) {
                        const float c1 = -1.4426950408889634f * descale, c2 = descale * descale * out_scale;
#pragma unroll
                        for (int e = 0; e < 4; ++e) o[n][e] = (a[e] * g[e]) * __builtin_amdgcn_rcpf(1.0f + __builtin_amdgcn_exp2f(a[e] * c1)) * c2; }
                    else { if (MODE == 1) { a = a * (r * descale); g = g * (r * descale); } if (MODE == 4) { a = a * (r * descale); g = g * (r * descale * out_scale); }
#pragma unroll
                        for (int e = 0; e < 4; ++e) o[n][e] = a[e] * fast_sigmoid(a[e]) * g[e]; } }
                if (MODE == 3 || MODE == 4) { u32x2 w; w.x = pk_fp8x4(o[0][0], o[0][1], o[0][2], o[0][3]); w.y = pk_fp8x4(o[1][0], o[1][1], o[1][2], o[1][3]); *(u32x2*)((unsigned char*)O + (size_t)row * ldo + col0) = w; }
                else { u32x4 w; w.x = cvt_pk_bf16(o[0][0], o[0][1]); w.y = cvt_pk_bf16(o[0][2], o[0][3]); w.z = cvt_pk_bf16(o[1][0], o[1][1]); w.w = cvt_pk_bf16(o[1][2], o[1][3]);
                *(u32x4*)(O + (size_t)row * ldo + col0) = w; }
                }
    }
};
typedef _Float16 h16x4 __attribute__((ext_vector_type(4)));
typedef _Float16 h16x8 __attribute__((ext_vector_type(8)));
typedef float f32x8 __attribute__((ext_vector_type(8)));
template <bool BIAS, bool AUX, int XB8 = 0, int RIN = 0, int ROUT = 0> struct EpiResid {
    static constexpr bool PERM = true, AFTER_DRAIN = false;
    const float* resid; float* out; const float* bias; unsigned char* xb; float* part; float descale, xb_scale; PG8_LAS float* red;
    __device__ __forceinline__ void operator()(const f32x4 (&acc)[2][2][4][2], const Unit& u, int wr, int wc, int fr, int fq) const {
        const int row0 = u.pm * BM + wr * 64 + fr, col0 = u.pn * BM + wc * 32 + 8 * fq;
        f32x4 bv[2][2];
#pragma unroll
        for (int bj = 0; bj < 2; ++bj)
#pragma unroll
            for (int n = 0; n < 2; ++n) bv[bj][n] = BIAS ? *(const f32x4*)(bias + col0 + bj * HALF + n * 4) : (f32x4){0.f, 0.f, 0.f, 0.f};
#pragma unroll
        for (int ai = 0; ai < 2; ++ai)
#pragma unroll
            for (int m = 0; m < 4; ++m) { const int row = row0 + ai * HALF + m * 16; const size_t off = (size_t)row * 1024 + col0; float ss = 0.f;
#pragma unroll
                for (int bj = 0; bj < 2; ++bj) { const size_t o2 = off + bj * HALF;
                    f32x4 r0, r1;
                    if (RIN) { const f32x8 r8 = __builtin_convertvector(*(const h16x8*)((const _Float16*)resid + o2), f32x8); r0 = (f32x4){r8[0], r8[1], r8[2], r8[3]}; r1 = (f32x4){r8[4], r8[5], r8[6], r8[7]}; }
                    else { r0 = *(const f32x4*)(resid + o2); r1 = *(const f32x4*)(resid + o2 + 4); }
                    const f32x4 x0 = r0 + acc[ai][bj][m][0] * descale + bv[bj][0], x1 = r1 + acc[ai][bj][m][1] * descale + bv[bj][1];
                    if (ROUT) { const f32x8 x8 = {x0[0], x0[1], x0[2], x0[3], x1[0], x1[1], x1[2], x1[3]}; *(h16x8*)((_Float16*)out + o2) = __builtin_convertvector(x8, h16x8); }
                    else { *(f32x4*)(out + o2) = x0; *(f32x4*)(out + o2 + 4) = x1; }
                    if (AUX) { ss += ((x0[0] * x0[0] + x0[1] * x0[1]) + (x0[2] * x0[2] + x0[3] * x0[3])) + ((x1[0] * x1[0] + x1[1] * x1[1]) + (x1[2] * x1[2] + x1[3] * x1[3]));
                        if (XB8 == 1) { u32x2 w; w.x = pk_fp8x4(x0[0] * xb_scale, x0[1] * xb_scale, x0[2] * xb_scale, x0[3] * xb_scale); w.y = pk_fp8x4(x1[0] * xb_scale, x1[1] * xb_scale, x1[2] * xb_scale, x1[3] * xb_scale); *(u32x2*)(xb + o2) = w; }
                        else if (XB8 == 2) { u32x2 w; w.x = pk_i8x4(x0[0] * xb_scale, x0[1] * xb_scale, x0[2] * xb_scale, x0[3] * xb_scale); w.y = pk_i8x4(x1[0] * xb_scale, x1[1] * xb_scale, x1[2] * xb_scale, x1[3] * xb_scale); *(u32x2*)(xb + o2) = w; }
                        else { u32x4 w; w.x = cvt_pk_bf16(x0[0], x0[1]); w.y = cvt_pk_bf16(x0[2], x0[3]); w.z = cvt_pk_bf16(x1[0], x1[1]); w.w = cvt_pk_bf16(x1[2], x1[3]); *(u32x4*)((bf16_t*)xb + o2) = w; } } }
                if (AUX) { ss += __shfl_xor(ss, 16); ss += __shfl_xor(ss, 32); if (fq == 0) red[(ai * HALF + wr * 64 + m * 16 + fr) * 4 + wc] = ss; }
                if (m == 3) asm volatile("" ::: "memory"); }
        if (AUX) {
            __syncthreads();
            const int t = ((wr * 4 + wc) << 6) | (fq * 16 + fr);
            if (t < BM) { const f32x4 q = *(const PG8_LAS f32x4*)(red + t * 4); part[(size_t)(u.pm * BM + t) * 4 + u.pn] = (q[0] + q[1]) + (q[2] + q[3]); }
            __syncthreads();
        }
    }
};
struct EpiQKV {
    static constexpr bool PERM = true, AFTER_DRAIN = false;
    bf16_t* Kb; size_t kvq_stride; const float* part; const float* kgain; const float* qgain; float qscale, descale;
    mutable float r8c[2][4]; mutable int pmc; PG8_LAS unsigned char* stg;
    __device__ __forceinline__ void operator()(const f32x4 (&acc)[2][2][4][2], const Unit& u, int wr, int wc, int fr, int fq) const {
        const int kind = u.pn >> 2, head = (u.pn & 3) * 4 + wc;
        bf16_t* dst = Kb + (size_t)kind * kvq_stride;
        const float* gsrc = kind == 0 ? kgain : qgain; const float gs = kind == 2 ? qscale : 1.f;
        const int row0 = u.pm * BM + wr * 64 + fr, colb = head * 64 + 8 * fq; (void)colb;
        PG8_LAS unsigned char* ws_ = stg + (wr * 4 + wc) * 2304;
        f32x4 gv[2][2];
#pragma unroll
        for (int bj = 0; bj < 2; ++bj)
#pragma unroll
            for (int n = 0; n < 2; ++n) gv[bj][n] = *(const f32x4*)(gsrc + 32 * bj + 8 * fq + 4 * n) * gs;
        if (u.pm != pmc) { row_rstd8(part, row0, r8c); pmc = u.pm; }
#pragma unroll
        for (int ai = 0; ai < 2; ++ai)
#pragma unroll
            for (int m = 0; m < 4; ++m) { const int row = row0 + ai * HALF + m * 16; const float r = r8c[ai][m] * descale;
                f32x4 v[2][2]; float ss = 0.f;
#pragma unroll
                for (int bj = 0; bj < 2; ++bj)
#pragma unroll
                    for (int n = 0; n < 2; ++n) { v[bj][n] = acc[ai][bj][m][n] * r; const f32x4 x = v[bj][n]; ss += (x[0] * x[0] + x[1] * x[1]) + (x[2] * x[2] + x[3] * x[3]); }
                ss += __shfl_xor(ss, 16); ss += __shfl_xor(ss, 32);
                if (kind != 1) { const float inv = __builtin_amdgcn_rsqf(ss * (1.0f / 64.0f) + 1e-6f);
#pragma unroll
                    for (int bj = 0; bj < 2; ++bj)
#pragma unroll
                        for (int n = 0; n < 2; ++n) v[bj][n] = v[bj][n] * gv[bj][n] * inv; }
#pragma unroll
                for (int bj = 0; bj < 2; ++bj) { u32x4 w; w.x = cvt_pk_bf16(v[bj][0][0], v[bj][0][1]); w.y = cvt_pk_bf16(v[bj][0][2], v[bj][0][3]); w.z = cvt_pk_bf16(v[bj][1][0], v[bj][1][1]); w.w = cvt_pk_bf16(v[bj][1][2], v[bj][1][3]);
                    *(PG8_LAS u32x4*)(ws_ + fr * 144 + bj * 64 + fq * 16) = w; }
                { const int l = fq * 16 + fr, rr = l >> 3, cc = l & 7; const int rowb = row - fr;
                  const u32x4 o0 = *(const PG8_LAS u32x4*)(ws_ + rr * 144 + cc * 16), o1 = *(const PG8_LAS u32x4*)(ws_ + (rr + 8) * 144 + cc * 16);
                  *(u32x4*)(dst + (size_t)(rowb + rr) * 1024 + head * 64 + cc * 8) = o0; *(u32x4*)(dst + (size_t)(rowb + rr + 8) * 1024 + head * 64 + cc * 8) = o1; }
                __builtin_amdgcn_sched_barrier(0); }
    }
};
struct EpiMoeDown {
    static constexpr bool PERM = true, AFTER_DRAIN = false;
    unsigned char* Y; const float* rowgate; float descale;
    template <bool ADD> __device__ __forceinline__ void run(const f32x4 (&acc)[2][2][4][2], const Unit& u, int wr, int wc, int fr, int fq, const PG8_GAS u32x2* sl) const {
        const int rt0 = u.pm * BM + wr * 64 + fr, col0 = u.pn * BM + wc * 32 + 8 * fq;
        float gtv[2][4];
#pragma unroll
        for (int ai = 0; ai < 2; ++ai)
#pragma unroll
            for (int m = 0; m < 4; ++m) gtv[ai][m] = rowgate[rt0 + ai * HALF + m * 16] * descale;
#pragma unroll
        for (int ai = 0; ai < 2; ++ai) {
#pragma unroll
            for (int m = 0; m < 4; ++m) { const float gt = gtv[ai][m]; unsigned char* p = Y + (size_t)(rt0 + ai * HALF + m * 16) * 1024 + col0;
#pragma unroll
                for (int bj = 0; bj < 2; ++bj) { f32x4 s0 = acc[ai][bj][m][0], s1 = acc[ai][bj][m][1];
                    if (ADD) { const u32x2 q0 = sl[bj * 2 + 0], q1 = sl[bj * 2 + 1];
                        s0[0] += __uint_as_float(q0.x << 16); s0[1] += __uint_as_float(q0.x & 0xffff0000u); s0[2] += __uint_as_float(q0.y << 16); s0[3] += __uint_as_float(q0.y & 0xffff0000u);
                        s1[0] += __uint_as_float(q1.x << 16); s1[1] += __uint_as_float(q1.x & 0xffff0000u); s1[2] += __uint_as_float(q1.y << 16); s1[3] += __uint_as_float(q1.y & 0xffff0000u); }
                    s0 = s0 * gt; s1 = s1 * gt;
                    u32x2 w; w.x = pk_i8x4(s0[0], s0[1], s0[2], s0[3]); w.y = pk_i8x4(s1[0], s1[1], s1[2], s1[3]);
                    *(u32x2*)(p + bj * HALF) = w; }
                if (ADD) { sl += 512 * 4; asm volatile("" : "+v"(sl)); } }
            asm volatile("" ::: "memory"); }
    }
    __device__ __forceinline__ void operator()(const f32x4 (&acc)[2][2][4][2], const Unit& u, int wr, int wc, int fr, int fq) const { run<false>(acc, u, wr, wc, fr, fq, nullptr); }
};

template <class Epi, class Sched, bool GATHER, int PREC = 0>
__device__ __forceinline__ void gemm_phase(PG8_LAS unsigned char* lds, const Gemm g, const Sched& S, const Epi& E, const int tid) {
    constexpr bool FP8 = (PREC == 1), I8 = (PREC == 2), BYTE1 = (PREC != 0);
    const int wid = __builtin_amdgcn_readfirstlane(tid >> 6), lane = tid & 63, wr = wid >> 2, wc = wid & 3, fr = lane & 15, fq = lane >> 4;
    const int K = g.K;
    const int rowb = BYTE1 ? K : 2 * K;
    unsigned voffB[2]; unsigned vC0[2], vC1[2], vN0[2], vN1[2]; int Rr[2], Cc[2];
#pragma unroll
    for (int i = 0; i < 2; ++i) { int R, C; stage_rc(tid * 16 + i * 8192, R, C); const int Rb = Epi::PERM ? ((R & ~31) + perm32(R & 31)) : R;
        Rr[i] = R; Cc[i] = C; vC0[i] = (unsigned)(R * rowb + C * 2); vC1[i] = vC0[i]; vN0[i] = vC0[i]; vN1[i] = vC0[i]; voffB[i] = (unsigned)(Rb * rowb + C * 2); }
    const size_t kstep = (size_t)(BK * 2);
    const size_t hstep = (size_t)HALF * rowb;
    const size_t hstepA = GATHER ? 0 : hstep;
    const size_t tstep = 2 * hstep;
    const unsigned ldsw = (unsigned)wid * 1024u;
    const int aoff = lds_byte(wr * 64 + fr, fq * 8), boff = lds_byte(wc * 32 + fr, fq * 8);
#define PG8_SA(b, h) (((b) * 2 + (h)) * HTB)
#define PG8_SB(b, h) ((4 + (b) * 2 + (h)) * HTB)
#define PG8_STAGE(bufoff, gbase, v0, v1) do { \
        __builtin_amdgcn_global_load_lds((const unsigned*)((const char*)(gbase) + (v0)), (PG8_LAS unsigned*)(lds + (bufoff) + ldsw), 16, 0, 0); \
        __builtin_amdgcn_global_load_lds((const unsigned*)((const char*)(gbase) + (v1)), (PG8_LAS unsigned*)(lds + (bufoff) + ldsw + 8192), 16, 0, 0); } while (0)
#define PG8_LD8(addr) __builtin_shufflevector(*(const PG8_LAS v4i_t*)(addr), *(const PG8_LAS v4i_t*)((addr) + 1024), 0, 1, 2, 3, 4, 5, 6, 7)
#define PG8_LDA(dst, b, h) do { if (FP8) { _Pragma("unroll") for (int m = 0; m < 4; ++m) dst##8[m] = PG8_LD8(lds + PG8_SA(b, h) + aoff + m * 2048); } else { \
        _Pragma("unroll") for (int m = 0; m < 4; ++m) _Pragma("unroll") for (int k = 0; k < 2; ++k) dst[m][k] = *(const PG8_LAS bf16x8*)(lds + PG8_SA(b, h) + aoff + m * 2048 + k * 1024); } } while (0)
#define PG8_LDB(dst, b, h) do { if (FP8) { _Pragma("unroll") for (int n = 0; n < 2; ++n) dst##8[n] = PG8_LD8(lds + PG8_SB(b, h) + boff + n * 2048); } else { \
        _Pragma("unroll") for (int n = 0; n < 2; ++n) _Pragma("unroll") for (int k = 0; k < 2; ++k) dst[n][k] = *(const PG8_LAS bf16x8*)(lds + PG8_SB(b, h) + boff + n * 2048 + k * 1024); } } while (0)
#if defined(PROBE_HALF_MFMA)
#define PG8_SKIP(ai) ((ai) == 1 && cur.part == 3)
#else
#define PG8_SKIP(ai) false
#endif
#define PG8_MMA(ai, bj, At, Bt) do { if (PG8_SKIP(ai)) break; __builtin_amdgcn_s_setprio(1); _Pragma("unroll") for (int m = 0; m < 4; ++m) _Pragma("unroll") for (int n = 0; n < 2; ++n) { \
        if (FP8) asm volatile("v_mfma_scale_f32_16x16x128_f8f6f4 %0, %1, %2, %0, %3, %3 op_sel_hi:[0,0,0]" : "+v"(acc[ai][bj][m][n]) : "v"(Bt##8[n]), "v"(At##8[m]), "v"(sc1)); \
        else if (I8) { _Pragma("unroll") for (int k = 0; k < 2; ++k) acc[ai][bj][m][n] = __builtin_bit_cast(f32x4, __builtin_amdgcn_mfma_i32_16x16x64_i8(__builtin_bit_cast(v4i_t, Bt[n][k]), __builtin_bit_cast(v4i_t, At[m][k]), __builtin_bit_cast(v4i_t, acc[ai][bj][m][n]), 0, 0, 0)); } \
        else { _Pragma("unroll") for (int k = 0; k < 2; ++k) acc[ai][bj][m][n] = __builtin_amdgcn_mfma_f32_16x16x32_bf16(Bt[n][k], At[m][k], acc[ai][bj][m][n], 0, 0, 0); } } __builtin_amdgcn_s_setprio(0); } while (0)
#define PG8_WAIT_V(n) asm volatile("s_waitcnt vmcnt(" #n ")" ::: "memory")
#define PG8_WAIT_L(n) asm volatile("s_waitcnt lgkmcnt(" #n ")" ::: "memory")
#define PG8_BAR __builtin_amdgcn_s_barrier()
#define PG8_SCHED __builtin_amdgcn_sched_barrier(0)
#define PG8_TOKOFF(pm_, h_, i_) ({ int t_ = g.rowtok[(pm_) * BM + (h_) * HALF + Rr[i_]]; t_ = t_ < 0 ? 0 : t_; (unsigned)(t_ * rowb + Cc[i_] * 2); })
    unsigned sc1 = 0u; if (FP8) asm volatile("v_mov_b32 %0, 0x7f7f7f7f" : "=v"(sc1));
    Unit cur, nxt; int ui = 0;
    if (!S.next(0, cur)) return;
    f32x4 acc[2][2][4][2];
#pragma unroll
    for (int a = 0; a < 2; ++a)
#pragma unroll
        for (int b = 0; b < 2; ++b)
#pragma unroll
            for (int m = 0; m < 4; ++m)
#pragma unroll
                for (int n = 0; n < 2; ++n) acc[a][b][m][n] = (f32x4){0.f, 0.f, 0.f, 0.f};
    bf16x8 At[4][2], B0[2][2], B1[2][2]; v8i_t At8[4], B08[2], B18[2];
    if (GATHER) {
#pragma unroll
        for (int i = 0; i < 2; ++i) { vC0[i] = PG8_TOKOFF(cur.pm, 0, i); vC1[i] = PG8_TOKOFF(cur.pm, 1, i); }
    }
    const char* cA = (GATHER ? (const char*)g.A : (const char*)g.A + (size_t)cur.pm * tstep) + (size_t)cur.kt0 * kstep;
    const char* cB = (const char*)g.Bt + (size_t)cur.be * g.bstride + (size_t)cur.pn * tstep + (size_t)cur.kt0 * kstep;
    PG8_STAGE(PG8_SB(0, 0), cB, voffB[0], voffB[1]); PG8_STAGE(PG8_SB(0, 1), cB + hstep, voffB[0], voffB[1]); PG8_STAGE(PG8_SA(0, 0), cA, vC0[0], vC0[1]); PG8_STAGE(PG8_SA(0, 1), cA + hstepA, vC1[0], vC1[1]);
    if (wr == 1) PG8_BAR;
    PG8_WAIT_V(2); PG8_BAR;
    PG8_STAGE(PG8_SB(1, 0), cB + kstep, voffB[0], voffB[1]); PG8_STAGE(PG8_SA(1, 0), cA + kstep, vC0[0], vC0[1]); PG8_STAGE(PG8_SB(1, 1), cB + hstep + kstep, voffB[0], voffB[1]);
    PG8_WAIT_V(6); PG8_BAR;
    for (;;) {
        const bool has_next = S.next(ui + 1, nxt);
        const char* nA = has_next ? (GATHER ? (const char*)g.A : (const char*)g.A + (size_t)nxt.pm * tstep) + (size_t)nxt.kt0 * kstep : cA;
        const char* nB = has_next ? (const char*)g.Bt + (size_t)nxt.be * g.bstride + (size_t)nxt.pn * tstep + (size_t)nxt.kt0 * kstep : cB;
        if (GATHER) {
            if (has_next && nxt.pm != cur.pm) {
#pragma unroll
                for (int i = 0; i < 2; ++i) { vN0[i] = PG8_TOKOFF(nxt.pm, 0, i); vN1[i] = PG8_TOKOFF(nxt.pm, 1, i); }
            } else {
#pragma unroll
                for (int i = 0; i < 2; ++i) { vN0[i] = vC0[i]; vN1[i] = vC1[i]; }
            }
        }
        const int nkt = cur.nkt;
        for (int t = 0; t < nkt; t += 2) {
            const bool last = (t == nkt - 2);
            const char* a1 = cA + (size_t)(t + 1) * kstep;
            const char* a2 = last ? nA : cA + (size_t)(t + 2) * kstep; const char* b2 = last ? nB : cB + (size_t)(t + 2) * kstep;
            const char* a3 = a2 + kstep; const char* b3 = b2 + kstep;
            const unsigned x00 = (GATHER && last) ? vN0[0] : vC0[0], x01 = (GATHER && last) ? vN0[1] : vC0[1], x10 = (GATHER && last) ? vN1[0] : vC1[0], x11 = (GATHER && last) ? vN1[1] : vC1[1];
            PG8_LDB(B0, 0, 0); PG8_LDB(B1, 0, 1); PG8_SCHED; PG8_LDA(At, 0, 0); PG8_STAGE(PG8_SA(1, 1), a1 + hstepA, vC1[0], vC1[1]);
            PG8_WAIT_V(8); PG8_WAIT_L(0); PG8_BAR; PG8_MMA(0, 0, At, B0); PG8_MMA(0, 1, At, B1); PG8_BAR; PG8_SCHED;
            PG8_LDA(At, 0, 1); PG8_STAGE(PG8_SB(0, 0), b2, voffB[0], voffB[1]); PG8_STAGE(PG8_SB(0, 1), b2 + hstep, voffB[0], voffB[1]); PG8_STAGE(PG8_SA(0, 0), a2, x00, x01);
            PG8_WAIT_V(8); PG8_WAIT_L(0); PG8_BAR; PG8_MMA(1, 0, At, B0); PG8_MMA(1, 1, At, B1); PG8_BAR; PG8_SCHED;
            PG8_LDB(B0, 1, 0); PG8_LDB(B1, 1, 1); PG8_SCHED; PG8_LDA(At, 1, 0); PG8_STAGE(PG8_SA(0, 1), a2 + hstepA, x10, x11);
            PG8_WAIT_V(8); PG8_WAIT_L(0); PG8_BAR; PG8_MMA(0, 0, At, B0); PG8_MMA(0, 1, At, B1); PG8_BAR; PG8_SCHED;
            PG8_LDA(At, 1, 1); PG8_STAGE(PG8_SB(1, 0), b3, voffB[0], voffB[1]); PG8_STAGE(PG8_SB(1, 1), b3 + hstep, voffB[0], voffB[1]); PG8_STAGE(PG8_SA(1, 0), a3, x00, x01);
            PG8_WAIT_V(8); PG8_WAIT_L(0); PG8_BAR; PG8_MMA(1, 0, At, B0); PG8_MMA(1, 1, At, B1); PG8_BAR; PG8_SCHED;
        }
        if (wr == 0) PG8_BAR;
        if (FP8) { asm volatile("s_nop 15\n\ts_nop 15" ::: "memory");
#pragma unroll
            for (int a = 0; a < 2; ++a)
#pragma unroll
                for (int b = 0; b < 2; ++b)
#pragma unroll
                    for (int m = 0; m < 4; ++m)
#pragma unroll
                        for (int n = 0; n < 2; ++n) asm volatile("" : "+v"(acc[a][b][m][n])); }
        if (I8) {
#pragma unroll
            for (int a = 0; a < 2; ++a)
#pragma unroll
                for (int b = 0; b < 2; ++b)
#pragma unroll
                    for (int m = 0; m < 4; ++m)
#pragma unroll
                        for (int n = 0; n < 2; ++n) { const v4i_t q = __builtin_bit_cast(v4i_t, acc[a][b][m][n]); acc[a][b][m][n] = (f32x4){(float)q[0], (float)q[1], (float)q[2], (float)q[3]}; } }
        if (g.noepi) {} else
        if constexpr (Sched::STREAMK) {
            if (cur.part == 1) {
                PG8_GAS u32x2* sl = (PG8_GAS u32x2*)g.slab + (size_t)S.wg() * (32 * 512) + tid * 4;
#pragma unroll
                for (int a = 0; a < 2; ++a)
#pragma unroll
                    for (int m = 0; m < 4; ++m) {
#pragma unroll
                        for (int b = 0; b < 2; ++b)
#pragma unroll
                            for (int n = 0; n < 2; ++n) { u32x2 w; w.x = cvt_pk_bf16(acc[a][b][m][n][0], acc[a][b][m][n][1]); w.y = cvt_pk_bf16(acc[a][b][m][n][2], acc[a][b][m][n][3]); sl[b * 2 + n] = w; }
                        sl += 512 * 4; asm volatile("" : "+v"(sl)); }
                asm volatile("s_waitcnt vmcnt(0)" ::: "memory");
                __syncthreads();
                if (tid == 0) { __builtin_amdgcn_fence(__ATOMIC_RELEASE, "agent"); asm volatile("s_waitcnt vmcnt(0)" ::: "memory");
                    __hip_atomic_store(g.skflag + 16 * S.wg(), 1u, __ATOMIC_RELAXED, __HIP_MEMORY_SCOPE_AGENT); }
            } else if (cur.part == 2) {
                if (wid == 0) { unsigned sp = 0;
                    while (__hip_atomic_load(g.skflag + 16 * (S.wg() + 1), __ATOMIC_RELAXED, __HIP_MEMORY_SCOPE_AGENT) == 0u) { __builtin_amdgcn_s_sleep(2);
                        if (++sp > (1u << 22)) { if (lane == 0) __hip_atomic_store(g.tmo, 1u, __ATOMIC_RELAXED, __HIP_MEMORY_SCOPE_AGENT); break; } }
                    __builtin_amdgcn_fence(__ATOMIC_ACQUIRE, "agent"); }
                asm volatile("s_waitcnt vmcnt(0)" ::: "memory");
                __syncthreads();
                E.template run<true>(acc, cur, wr, wc, fr, fq, (const PG8_GAS u32x2*)g.slab + (size_t)(S.wg() + 1) * (32 * 512) + tid * 4);
            } else { if (cur.part != 3) E(acc, cur, wr, wc, fr, fq); }
        } else { if (cur.part != 3) E(acc, cur, wr, wc, fr, fq); }
        if (!has_next) break;
#pragma unroll
        for (int a = 0; a < 2; ++a)
#pragma unroll
            for (int b = 0; b < 2; ++b)
#pragma unroll
                for (int m = 0; m < 4; ++m)
#pragma unroll
                    for (int n = 0; n < 2; ++n) acc[a][b][m][n] = (f32x4){0.f, 0.f, 0.f, 0.f};
        cur = nxt; cA = nA; cB = nB; ++ui;
        if (GATHER) {
#pragma unroll
            for (int i = 0; i < 2; ++i) { vC0[i] = vN0[i]; vC1[i] = vN1[i]; }
        }
        if (wr == 1) PG8_BAR;
    }
    PG8_WAIT_V(0);
    PG8_BAR;
#undef PG8_SA
#undef PG8_SB
#undef PG8_STAGE
#undef PG8_LDA
#undef PG8_LDB
#undef PG8_MMA
#undef PG8_LD8
#undef PG8_WAIT_V
#undef PG8_WAIT_L
#undef PG8_BAR
#undef PG8_SCHED
#undef PG8_TOKOFF
}
}
#define GAS __attribute__((address_space(1)))
#define LAS __attribute__((address_space(3)))
typedef unsigned short bf16;
typedef unsigned v4u __attribute__((ext_vector_type(4)));
typedef float f32x4 __attribute__((ext_vector_type(4)));
typedef short bf16x8 __attribute__((ext_vector_type(8)));
typedef GAS unsigned gu32;
typedef GAS unsigned long long gu64;
#define RLX_AGENT __ATOMIC_RELAXED, __HIP_MEMORY_SCOPE_AGENT
#define LDS_WAIT() asm volatile("s_waitcnt lgkmcnt(0)" ::: "memory")
#define VM_WAIT() asm volatile("s_waitcnt vmcnt(0)" ::: "memory")
__device__ __forceinline__ unsigned long long rt() { return __builtin_amdgcn_s_memrealtime(); }
__device__ __forceinline__ unsigned f2bf(float f) { unsigned u = __builtin_bit_cast(unsigned, f); return (u + 0x7fffu + ((u >> 16) & 1u)) >> 16; }
__device__ __forceinline__ unsigned pk2(float lo, float hi) { return f2bf(lo) | (f2bf(hi) << 16); }

#define XB_TMO      128
#define XB_XCNT(j)  (256  + 64 * (j))
#define XB_XSUB(j)  (1280 + 64 * (j))
#define XB_XGEN(j)  (2304 + 64 * (j))
#define XB_TOP      3328
#define XB_TOPGEN   3392
#define XCD_BAR_WORDS 3456
#define XB_SPIN_CAP (1u << 18)

__device__ __forceinline__ unsigned xb_ld(unsigned* p)              { return __hip_atomic_load(p, __ATOMIC_RELAXED, __HIP_MEMORY_SCOPE_AGENT); }
__device__ __forceinline__ unsigned xb_add(unsigned* p, unsigned v) { return __hip_atomic_fetch_add(p, v, __ATOMIC_RELAXED, __HIP_MEMORY_SCOPE_AGENT); }
__device__ __forceinline__ unsigned xb_xcc_id() { return (unsigned)__builtin_amdgcn_s_getreg((3 << 11) | 20) & 0xFu; }
#define XB_SPIN(cond, bar) do { unsigned _sp = 0; while (cond) { __builtin_amdgcn_s_sleep(1); \
    if ((++_sp & 255u) == 0u) { if (xb_ld(&(bar)[XB_TMO])) break; if (_sp > XB_SPIN_CAP) { atomicAdd(&(bar)[XB_TMO], 1u); break; } } } } while (0)

struct XcdBarrier {
    unsigned* bar; unsigned x;
    volatile LAS unsigned* st;
};

__device__ __forceinline__ XcdBarrier xcd_barrier_post(unsigned* bar, volatile LAS unsigned* st) {
    XcdBarrier b; b.bar = bar; b.x = xb_xcc_id(); b.st = st;
    if (threadIdx.x == 0) (void)xb_add(&bar[XB_XCNT(b.x)], 1u);
    return b;
}
__device__ __forceinline__ void xcd_barrier_complete(unsigned* bar, unsigned x, unsigned& nloc, unsigned& nx) {
    const unsigned G = gridDim.x * gridDim.y * gridDim.z;
    unsigned sum, cnt, mine, sp = 0u;
    for (;;) {
        sum = 0u; cnt = 0u; mine = 0u;
#pragma unroll
        for (unsigned j = 0; j < 16; ++j) { const unsigned c = xb_ld(&bar[XB_XCNT(j)]); sum += c; cnt += (c > 0u) ? 1u : 0u; mine = (j == x) ? c : mine; }
        if (sum == G) break;
        __builtin_amdgcn_s_sleep(1);
        if ((++sp & 255u) == 0u) { if (xb_ld(&bar[XB_TMO])) break; if (sp > XB_SPIN_CAP) { atomicAdd(&bar[XB_TMO], 1u); break; } }
    }
    nloc = mine > 0u ? mine : 1u; nx = cnt > 0u ? cnt : 1u;
}

__device__ __forceinline__ void xcd_barrier(const XcdBarrier& b) {
    asm volatile("s_waitcnt vmcnt(0)" ::: "memory");
    __syncthreads();
    if (threadIdx.x == 0) {
        unsigned* bar = b.bar;
        __builtin_amdgcn_s_waitcnt(0);
        unsigned nloc = b.st[0], nx = b.st[1];
        if (nloc == 0u) { xcd_barrier_complete(bar, b.x, nloc, nx); b.st[0] = nloc; b.st[1] = nx; }
        const unsigned old = xb_add(&bar[XB_XSUB(b.x)], 1u);
        const unsigned gen = old / nloc;
        if (old + 1u == (gen + 1u) * nloc) {
            __builtin_amdgcn_fence(__ATOMIC_RELEASE, "agent");
            asm volatile("s_waitcnt vmcnt(0)" ::: "memory");
            const unsigned og = xb_add(&bar[XB_TOP], 1u);
            const unsigned tg = og / nx;
            if (og + 1u == (tg + 1u) * nx) xb_add(&bar[XB_TOPGEN], 1u);
            else XB_SPIN(xb_ld(&bar[XB_TOPGEN]) == tg, bar);
            __builtin_amdgcn_fence(__ATOMIC_ACQUIRE, "agent");
            xb_add(&bar[XB_XGEN(b.x)], 1u);
            asm volatile("s_waitcnt vmcnt(0)" ::: "memory");
        } else {
            XB_SPIN(xb_ld(&bar[XB_XGEN(b.x)]) == gen, bar);
            __builtin_amdgcn_fence(__ATOMIC_ACQUIRE, "agent");
            asm volatile("s_waitcnt vmcnt(0)" ::: "memory");
        }
    }
    __syncthreads();
}

constexpr int NWAVES = 8;
constexpr int T = 32768, D = 1024, SEQ = 4096, NBATCH = 8;
constexpr int DFF = 2752, DFFP = 2816, DFFE = 3584, NEXP = 8;
constexpr int ROWCAP = 67584;
constexpr float EPS = 1e-6f;
constexpr float LOG2E = 1.4426950408889634f;
constexpr float SOFTMAX_OFS = 16.f;
constexpr float QSCALE = 0.125f * LOG2E;
#ifndef I8_P1
#define I8_P1 1
#endif
#ifndef I8_P3
#define I8_P3 0
#endif
#ifndef I8_P4
#define I8_P4 1
#endif
constexpr float SA_N = 127.f / 5.f, SA_X = 127.f / 6.f, SW_I8 = 127.f * 32.f / 4.5f;
constexpr float Y_SCALE = 127.f / 2.5f;
constexpr float W8_SCALE = 64.f, H3_SCALE = 16.f, HM_SCALE = 8.f, X8_SCALE = 16.f, HB_SCALE = 8.f, O8_SCALE = 64.f;
constexpr size_t MiB = 1u << 20;
constexpr size_t WS_CTL = 0, CTL_ZERO_BYTES = 1 * MiB;
constexpr size_t WS_PART1 = 1 * MiB, WS_PART2 = 3 * MiB, WS_LSE = 5 * MiB;
constexpr size_t WS_ROUTE = 7 * MiB, WS_GATE1 = WS_ROUTE + 128 * 1024, WS_GATE2 = WS_ROUTE + 256 * 1024, WS_WAVECNT = WS_ROUTE + 384 * 1024, WS_BLOCKCNT = WS_ROUTE + 448 * 1024, WS_GOFS = WS_ROUTE + 480 * 1024;
constexpr size_t WS_ROWTOK = 8 * MiB, WS_ROWGATE = 8 * MiB + 512 * 1024;
constexpr size_t WS_WIN = 12 * MiB, WS_WOUT = 16 * MiB, WS_WF13 = 18 * MiB, WS_WFD = 29 * MiB, WS_WQKV = 35 * MiB, WS_WO = 53 * MiB;
constexpr size_t WS_WM13 = 56 * MiB, WS_WM2 = 112 * MiB;
constexpr size_t WS_XH = 144 * MiB;
constexpr size_t WS_A0 = 224 * MiB;
constexpr size_t WS_H0 = WS_A0, WS_GLU = WS_A0 + 64 * MiB, WS_V = WS_A0 + 128 * MiB;
constexpr size_t WS_X1B = WS_A0, WS_HB = WS_A0 + 64 * MiB;
constexpr size_t WS_X2B = WS_A0, WS_KG = WS_A0 + 64 * MiB, WS_VG = WS_A0 + 128 * MiB, WS_QG = WS_A0 + 192 * MiB, WS_O = WS_A0 + 256 * MiB, WS_O8 = WS_A0 + 32 * MiB;
constexpr size_t WS_H3 = WS_A0, WS_HM = WS_A0 + 66 * MiB;
constexpr size_t WS_END = 548 * MiB;
static_assert(WS_HB + (size_t)T * DFFP * 2 <= WS_END && WS_O + (size_t)T * D * 2 <= WS_END && WS_HM + (size_t)ROWCAP * DFFE <= WS_END, "arena");
static_assert(WS_WFD + (size_t)D * DFFP * 2 <= WS_WQKV && WS_WO + (size_t)D * D * 2 <= WS_WM13 && WS_WM13 + (size_t)NEXP * 7168 * 1024 <= WS_WM2 && WS_WM2 + (size_t)NEXP * D * DFFE <= WS_XH && WS_XH + (size_t)T * D * 2 <= WS_A0, "weights");
constexpr int CW_AQ = 50000;
constexpr int CW_TMO = 0, CW_CODE = 1, CW_BAR = 4096, CW_SKFLAG = 16384;
constexpr size_t WS_SLAB = 12 * MiB;
constexpr size_t WS_POS = 9 * MiB;
constexpr size_t WS_Y = WS_A0;
static_assert(WS_SLAB + (size_t)256 * 131072 <= 56 * MiB && WS_Y + (size_t)ROWCAP * 1024 <= WS_HM, "slab / Y");

constexpr int RING_OFF = 0, RING_BYTES = 131072;
constexpr int LDSCTL_OFF = RING_BYTES, MISC_OFF = LDSCTL_OFF + 320;
constexpr int XTRA_OFF = RING_BYTES + 512;
constexpr int LDS_BYTES = 155648;

constexpr int NPHASE = 18;

__constant__ unsigned char T5_BUCKET[3][132] = {
 {0,1,2,3,4,5,6,7,8,9,10,11,12,13,14,15,16,16,16,16,16,16,17,17,17,17,17,17,17,17,18,18,18,18,18,18,18,18,18,18,19,19,19,19,19,19,19,19,19,19,19,19,19,19,20,20,20,20,20,20,20,20,20,20,20,20,20,20,20,20,20,20,20,21,21,21,21,21,21,21,21,21,21,21,21,21,21,21,21,21,21,21,21,21,21,21,21,21,21,22,22,22,22,22,22,22,22,22,22,22,22,22,22,22,22,22,22,22,22,22,22,22,22,22,22,22,22,22,22,0,0,0},
 {0,4,8,12,16,16,17,17,18,18,19,19,19,19,20,20,20,20,20,21,21,21,21,21,21,22,22,22,22,22,22,22,22,22,23,23,23,23,23,23,23,23,23,23,23,23,24,24,24,24,24,24,24,24,24,24,24,24,24,24,24,24,25,25,25,25,25,25,25,25,25,25,25,25,25,25,25,25,25,25,25,25,25,26,26,26,26,26,26,26,26,26,26,26,26,26,26,26,26,26,26,26,26,26,26,26,26,26,26,26,26,26,26,27,27,27,27,27,27,27,27,27,27,27,27,27,27,27,27,0,0,0},
 {0,16,18,19,20,21,21,22,22,23,23,23,24,24,24,24,25,25,25,25,25,26,26,26,26,26,26,26,26,27,27,27,27,27,27,27,27,27,27,28,28,28,28,28,28,28,28,28,28,28,28,28,29,29,29,29,29,29,29,29,29,29,29,29,29,29,29,29,29,29,30,30,30,30,30,30,30,30,30,30,30,30,30,30,30,30,30,30,30,30,30,30,30,30,30,31,31,31,31,31,31,31,31,31,31,31,31,31,31,31,31,31,31,31,31,31,31,31,31,31,31,31,31,31,31,31,31,31,31,0,0,0}};

typedef float f32x16 __attribute__((ext_vector_type(16)));
typedef float f32x2v __attribute__((ext_vector_type(2)));
typedef __bf16 bf16x2v __attribute__((ext_vector_type(2)));
typedef short v4i16_t __attribute__((ext_vector_type(4)));
__device__ __forceinline__ unsigned pkbf(float lo, float hi) { f32x2v v = {lo, hi}; bf16x2v b = __builtin_convertvector(v, bf16x2v); return __builtin_bit_cast(unsigned, b); }
__device__ __forceinline__ float bflo(unsigned u) { return __uint_as_float(u << 16); }
__device__ __forceinline__ float bfhi(unsigned u) { return __uint_as_float(u & 0xffff0000u); }
template <int N> __device__ __forceinline__ float dpp_row_ror(float v) { return __builtin_bit_cast(float, __builtin_amdgcn_update_dpp(0, __builtin_bit_cast(int, v), 0x120 + N, 0xf, 0xf, true)); }
__device__ __forceinline__ float wave_sum(float v) {
    v += dpp_row_ror<8>(v); v += dpp_row_ror<4>(v); v += dpp_row_ror<2>(v); v += dpp_row_ror<1>(v);
    const int b = __builtin_bit_cast(int, v);
    return (__builtin_bit_cast(float, __builtin_amdgcn_readlane(b, 0)) + __builtin_bit_cast(float, __builtin_amdgcn_readlane(b, 16))) + (__builtin_bit_cast(float, __builtin_amdgcn_readlane(b, 32)) + __builtin_bit_cast(float, __builtin_amdgcn_readlane(b, 48)));
}
__device__ __forceinline__ int crow(int r, int hi) { return (r & 3) + 8 * (r >> 2) + 4 * hi; }

struct TrDesc { const float* W; const float* gsc; unsigned char* WT; int ldw, Kp, drow0, k0, n0src, is8; float scale; };
__device__ __forceinline__ int hmap_row0(int L) { const int lc = L & 255; return (L & ~255) + 128 * ((lc >> 5) & 1) + 32 * (lc >> 6); }

constexpr int IT_MG = NEXP * 16 * 112, IT_MU = IT_MG, IT_MD = NEXP * 56 * 32, IT_WIN = 16 * 64, IT_WOUT = 16 * 32, IT_FG = 16 * 86, IT_FU = IT_FG, IT_FD = 43 * 32, IT_KV = 16 * 192, IT_Q = 16 * 96, IT_WO = 16 * 32;
constexpr int IT_MOE = IT_MG + IT_MU + IT_MD;
static_assert(IT_MOE == 3 * 256 * 56, "expert-weight items per attention phase and workgroup");
constexpr int IT_TOTAL = IT_MG + IT_MU + IT_MD + IT_WIN + IT_WOUT + IT_FG + IT_FU + IT_FD + IT_KV + IT_Q + IT_WO;
typedef const __attribute__((address_space(4))) unsigned char* kargp0_t;
#define P0IN(i) (*(const float* const __attribute__((address_space(4)))*)(kp + 8 * (i)))
__device__ __forceinline__ void tr_desc(int it, kargp0_t kp, unsigned char* ws, TrDesc& d) {
    int r = it; d.gsc = nullptr; d.is8 = 2; d.scale = SW_I8; d.Kp = 1024;
    if (r < IT_MG) { const int e = r / 1792, rr = r % 1792, j = (rr % 112) * 32; d.W = P0IN(23) + (size_t)e * D * DFFE; d.ldw = DFFE; d.WT = ws + WS_WM13 + (size_t)e * 7168 * 1024; d.drow0 = 256 * (j >> 7) + (j & 127); d.k0 = (rr / 112) * 64; d.n0src = j; return; } r -= IT_MG;
    if (r < IT_MU) { const int e = r / 1792, rr = r % 1792, j = (rr % 112) * 32; d.W = P0IN(24) + (size_t)e * D * DFFE; d.ldw = DFFE; d.WT = ws + WS_WM13 + (size_t)e * 7168 * 1024; d.drow0 = 256 * (j >> 7) + 128 + (j & 127); d.k0 = (rr / 112) * 64; d.n0src = j; return; } r -= IT_MU;
    if (r < IT_MD) { const int e = r / 1792, rr = r % 1792, j = (rr % 32) * 32; d.W = P0IN(25) + (size_t)e * DFFE * D; d.ldw = D; d.WT = ws + WS_WM2 + (size_t)e * 1024 * DFFE; d.Kp = DFFE; d.is8 = 1; d.scale = W8_SCALE; d.drow0 = j; d.k0 = (rr / 32) * 64; d.n0src = j; return; } r -= IT_MD;
    if (r < IT_KV) { const int c = (r % 192) * 32, kvsel = c / 3072, cg = c % 3072, g = cg >> 10, hc = cg & 1023, L = kvsel * 1024 + hc; d.W = P0IN(12); d.ldw = 6144; d.gsc = P0IN(11); d.WT = ws + WS_WQKV + (size_t)g * 3072 * 1024; d.drow0 = hmap_row0(L); d.k0 = (r / 192) * 64; d.n0src = c; return; } r -= IT_KV;
    if (r < IT_Q) { const int c = (r % 96) * 32, g = c >> 10, hc = c & 1023, L = 2048 + hc; d.W = P0IN(15); d.ldw = 3072; d.gsc = P0IN(14); d.WT = ws + WS_WQKV + (size_t)g * 3072 * 1024; d.drow0 = hmap_row0(L); d.k0 = (r / 96) * 64; d.n0src = c; return; } r -= IT_Q;
    if (r < IT_WIN) { const int c = (r % 64) * 32, sel = c >> 10, j = c & 1023; d.W = P0IN(3); d.ldw = 2048; d.WT = ws + WS_WIN; if (!I8_P1) { d.is8 = 0; d.scale = 1.f; } d.drow0 = 256 * (j >> 7) + 128 * sel + (j & 127); d.k0 = (r / 64) * 64; d.n0src = c; return; } r -= IT_WIN;
    if (r < IT_WOUT) { const int j = (r % 32) * 32; d.W = P0IN(9); d.ldw = 1024; d.WT = ws + WS_WOUT; if (!I8_P3) { d.is8 = 0; d.scale = 1.f; } d.drow0 = j; d.k0 = (r / 32) * 64; d.n0src = j; return; } r -= IT_WOUT;
    if (r < IT_FG) { const int j = (r % 86) * 32; d.W = P0IN(19); d.ldw = DFF; d.gsc = P0IN(18); d.WT = ws + WS_WF13; if (!I8_P4) { d.is8 = 0; d.scale = 1.f; } d.drow0 = 256 * (j >> 7) + (j & 127); d.k0 = (r / 86) * 64; d.n0src = j; return; } r -= IT_FG;
    if (r < IT_FU) { const int j = (r % 86) * 32; d.W = P0IN(20); d.ldw = DFF; d.gsc = P0IN(18); d.WT = ws + WS_WF13; if (!I8_P4) { d.is8 = 0; d.scale = 1.f; } d.drow0 = 256 * (j >> 7) + 128 + (j & 127); d.k0 = (r / 86) * 64; d.n0src = j; return; } r -= IT_FU;
    if (r < IT_FD) { const int j = (r % 32) * 32; d.W = P0IN(21); d.ldw = 1024; d.WT = ws + WS_WFD; d.Kp = DFFP; d.is8 = 0; d.scale = 1.f; d.drow0 = j; d.k0 = (r / 32) * 64; d.n0src = j; return; } r -= IT_FD;
    { const int j = (r % 32) * 32; d.W = P0IN(17); d.ldw = 1024; d.WT = ws + WS_WO; d.drow0 = j; d.k0 = (r / 32) * 64; d.n0src = j; d.is8 = 1; d.scale = W8_SCALE; }
}
__device__ __forceinline__ void tr_load(const TrDesc& d, f32x4 (&v)[8], f32x4 (&gv)[2], int lane) {
#pragma unroll
    for (int i = 0; i < 8; ++i) v[i] = __builtin_nontemporal_load((const f32x4*)(d.W + (size_t)(d.k0 + 8 * i + (lane >> 3)) * d.ldw + d.n0src + 4 * (lane & 7)));
    const float* gp = d.gsc ? d.gsc + d.k0 + 8 * (lane & 7) : d.W + (size_t)d.k0 * d.ldw + d.n0src;
    gv[0] = *(const f32x4*)gp; gv[1] = *(const f32x4*)(gp + 4);
}
template <bool NT = false>
__device__ __forceinline__ void tr_store(const TrDesc& d, const f32x4 (&v)[8], const f32x4 (&gv)[2], LAS float* scr, int lane) {
#pragma unroll
    for (int i = 0; i < 8; ++i) { LAS float* w = scr + (8 * i + (lane >> 3)) * 33 + 4 * (lane & 7); w[0] = v[i].x; w[1] = v[i].y; w[2] = v[i].z; w[3] = v[i].w; }
    LDS_WAIT(); asm volatile("" ::: "memory");
    const int c = lane & 7; const float sc = d.scale;
    const f32x4 one4 = {1.f, 1.f, 1.f, 1.f}; const f32x4 gv0 = d.gsc ? gv[0] : one4, gv1 = d.gsc ? gv[1] : one4;
#pragma unroll
    for (int j = 0; j < 4; ++j) { const int n = (lane >> 3) + 8 * j; const LAS float* s = scr + (8 * c) * 33 + n;
        const float x0 = s[0 * 33] * gv0.x * sc, x1 = s[1 * 33] * gv0.y * sc, x2 = s[2 * 33] * gv0.z * sc, x3 = s[3 * 33] * gv0.w * sc, x4 = s[4 * 33] * gv1.x * sc, x5 = s[5 * 33] * gv1.y * sc, x6 = s[6 * 33] * gv1.z * sc, x7 = s[7 * 33] * gv1.w * sc;
        if (d.is8 == 2) { pg8::u32x2 o; o.x = pg8::pk_i8x4(x0, x1, x2, x3); o.y = pg8::pk_i8x4(x4, x5, x6, x7); GAS pg8::u32x2* op = (GAS pg8::u32x2*)(d.WT + (size_t)(d.drow0 + n) * d.Kp + d.k0 + 8 * c); if (NT) __builtin_nontemporal_store(o, op); else *op = o; }
        else if (d.is8) { pg8::u32x2 o; o.x = pg8::pk_fp8x4(x0, x1, x2, x3); o.y = pg8::pk_fp8x4(x4, x5, x6, x7); GAS pg8::u32x2* op = (GAS pg8::u32x2*)(d.WT + (size_t)(d.drow0 + n) * d.Kp + d.k0 + 8 * c); if (NT) __builtin_nontemporal_store(o, op); else *op = o; }
        else { v4u o; o.x = pkbf(x0, x1); o.y = pkbf(x2, x3); o.z = pkbf(x4, x5); o.w = pkbf(x6, x7); *(GAS v4u*)((bf16*)d.WT + (size_t)(d.drow0 + n) * d.Kp + d.k0 + 8 * c) = o; } }
    LDS_WAIT(); asm volatile("" ::: "memory");
}

__device__ __forceinline__ void p0_items(kargp0_t kp, unsigned char* ws, LAS float* scr, int first, int stride, int lo, int hi, int lane) {
    TrDesc da, db, dc; f32x4 va[8], vb[8], vc[8]; f32x4 ga[2], gb[2], gc[2];
    int it = lo + first; const int NGW = stride;
    if (it < hi) { tr_desc(it, kp, ws, da); tr_load(da, va, ga, lane); }
    if (it + NGW < hi) { tr_desc(it + NGW, kp, ws, db); tr_load(db, vb, gb, lane); }
    while (it < hi) {
        if (it + 2 * NGW < hi) { tr_desc(it + 2 * NGW, kp, ws, dc); tr_load(dc, vc, gc, lane); }
        tr_store(da, va, ga, scr, lane);
        if (it + NGW >= hi) break;
        if (it + 3 * NGW < hi) { tr_desc(it + 3 * NGW, kp, ws, da); tr_load(da, va, ga, lane); }
        tr_store(db, vb, gb, scr, lane);
        if (it + 2 * NGW >= hi) break;
        if (it + 4 * NGW < hi) { tr_desc(it + 4 * NGW, kp, ws, db); tr_load(db, vb, gb, lane); }
        tr_store(dc, vc, gc, scr, lane);
        it += 3 * NGW;
    }
}
__device__ __forceinline__ void p0_items2(kargp0_t kp, unsigned char* ws, LAS float* scr, int first, int stride, int lo, int hi, int lane) {
    if (first >= hi - lo) return;
    const int n = (hi - lo - first + stride - 1) / stride, base = lo + first, last = n - 1;
    TrDesc da, db; f32x4 va[8], vb[8]; f32x4 ga[2], gb[2];
#define P0_ITEM(k) (base + ((k) < last ? (k) : last) * stride)
    tr_desc(base, kp, ws, da); tr_load(da, va, ga, lane);
    for (int k = 0; k + 1 < n; k += 2) {
        tr_desc(P0_ITEM(k + 1), kp, ws, db); tr_load(db, vb, gb, lane);
        tr_store<true>(da, va, ga, scr, lane);
        tr_desc(P0_ITEM(k + 2), kp, ws, da); tr_load(da, va, ga, lane);
        tr_store<true>(db, vb, gb, scr, lane);
    }
    if (n & 1) tr_store<true>(da, va, ga, scr, lane);
#undef P0_ITEM
}
__device__ __forceinline__ void p0_prologue(kargp0_t kp, unsigned char* ws, LAS unsigned char* lds, int G, int vcu, int tid, int lane, int wave) {
    LAS float* scr = (LAS float*)(lds + RING_OFF + wave * 16384);
    const int gw = vcu * NWAVES + wave, NGW = G * NWAVES;
    bf16* WF13 = (bf16*)(ws + WS_WF13); bf16* WFD = (bf16*)(ws + WS_WFD);
    p0_items(kp, ws, scr, gw, NGW, (G == 256) ? IT_MOE : 0, IT_TOTAL, lane);
#ifdef PROBE_CONV_NC
    if ((vcu & 31) < PROBE_CONV_NC) p0_items(kp, ws, scr, ((vcu >> 5) * PROBE_CONV_NC + (vcu & 31)) * NWAVES + wave, 8 * PROBE_CONV_NC * NWAVES, 0, IT_MOE, lane);
#endif
    const int gt = vcu * (NWAVES * 64) + tid, NGT = G * NWAVES * 64; const v4u z = {0u, 0u, 0u, 0u};
    { constexpr int RB = I8_P4 ? 1024 : 2048, CH = RB / 16;
      for (int i = gt; i < 2 * 64 * CH; i += NGT) { const int sel = i / (64 * CH), rr = (i / CH) & 63, ch = i % CH; *(GAS v4u*)((unsigned char*)WF13 + (size_t)(256 * 21 + 128 * sel + 64 + rr) * RB + ch * 16) = z; } }
    for (int i = gt; i < 1024 * 8; i += NGT) { const int row = i >> 3, ch = i & 7; *(GAS v4u*)(WFD + (size_t)row * DFFP + DFF + ch * 8) = z; }
    const float* x = P0IN(0); const float* gn = P0IN(2); bf16* H0 = (bf16*)(ws + WS_H0);
    f32x4 gv[4];
#pragma unroll
    for (int j = 0; j < 4; ++j) gv[j] = *(const f32x4*)(gn + 4 * lane + 256 * j);
    for (int m0 = gw * 4; m0 < T; m0 += NGW * 4) {
        f32x4 v[4][4];
#pragma unroll
        for (int q = 0; q < 4; ++q) { const GAS f32x4* xr = (const GAS f32x4*)(x + (size_t)(m0 + q) * D) + lane;
#pragma unroll
            for (int j = 0; j < 4; ++j) v[q][j] = __builtin_nontemporal_load(xr + 64 * j); }
#pragma unroll
        for (int q = 0; q < 4; ++q) { float s = 0.f;
#pragma unroll
            for (int j = 0; j < 4; ++j) s += (v[q][j].x * v[q][j].x + v[q][j].y * v[q][j].y) + (v[q][j].z * v[q][j].z + v[q][j].w * v[q][j].w);
            const float rstd = 1.f / sqrtf(wave_sum(s) * (1.f / D) + EPS);
            if (I8_P1) { GAS unsigned* o4 = (GAS unsigned*)((unsigned char*)H0 + (size_t)(m0 + q) * D) + lane;
#pragma unroll
                for (int j = 0; j < 4; ++j) { const f32x4 y = v[q][j] * (rstd * SA_N) * gv[j]; o4[64 * j] = pg8::pk_i8x4(y.x, y.y, y.z, y.w); } }
            else { GAS unsigned long long* o8 = (GAS unsigned long long*)(H0 + (size_t)(m0 + q) * D) + lane;
#pragma unroll
                for (int j = 0; j < 4; ++j) { const f32x4 y = v[q][j] * rstd * gv[j]; o8[64 * j] = (unsigned long long)pkbf(y.x, y.y) | ((unsigned long long)pkbf(y.z, y.w) << 32); } } }
    }
}

__device__ __forceinline__ void conv_phase(const bf16* glu, const float* dw_w, const float* dw_b, const float* ln_g, const float* ln_b, bf16* vout, LAS unsigned char* lds, int G, int vcu, int tid, int lane, int wave) {
    LAS float* ybuf = (LAS float*)(lds + RING_OFF);
    const int c0 = 2 * tid;
    float w0[31], w1[31];
#pragma unroll
    for (int k = 0; k < 31; ++k) { const f32x2v w = *(const f32x2v*)(dw_w + k * 1024 + c0); w0[k] = w.x; w1[k] = w.y; }
    const f32x2v dbv = *(const f32x2v*)(dw_b + c0);
    LAS float* lnp = (LAS float*)(lds + XTRA_OFF);
    for (int i = tid; i < 1024; i += NWAVES * 64) { lnp[i] = ln_g[i]; lnp[1024 + i] = ln_b[i]; }
    __syncthreads();
    for (int item = vcu; item < T / 128; item += G) {
        const int b = item >> 5, s0 = (item & 31) * 128;
        const bf16* ub = glu + (size_t)b * SEQ * D + c0;
        float r0[32], r1[32];
        r0[0] = 0.f; r1[0] = 0.f; r0[1] = 0.f; r1[1] = 0.f;
#pragma unroll
        for (int i = 0; i < 30; ++i) { const int s = s0 - 30 + i; unsigned v = 0u; if (s >= 0) v = *(const unsigned*)(ub + (size_t)s * D); r0[i + 2] = bflo(v); r1[i + 2] = bfhi(v); }
        for (int base = 0; base < 128; base += 32) {
            unsigned nu[32];
#pragma unroll
            for (int j = 0; j < 32; ++j) nu[j] = *(const unsigned*)(ub + (size_t)(s0 + base + j) * D);
#pragma unroll
            for (int j = 0; j < 32; ++j) {
                r0[j] = bflo(nu[j]); r1[j] = bfhi(nu[j]);
                float y0 = dbv.x, y1 = dbv.y;
#pragma unroll
                for (int k = 0; k < 31; ++k) { const int idx = (j + 2 + k) & 31; y0 += r0[idx] * w0[k]; y1 += r1[idx] * w1[k]; }
                *(LAS f32x2v*)(ybuf + j * 1024 + c0) = (f32x2v){y0, y1};
            }
            __syncthreads();
            const int ntok = 32;
            for (int j = wave; j < ntok; j += NWAVES) {
                f32x4 y[4]; float s = 0.f;
#pragma unroll
                for (int i = 0; i < 4; ++i) { y[i] = *(const LAS f32x4*)(ybuf + j * 1024 + 4 * lane + 256 * i); s += (y[i].x + y[i].y) + (y[i].z + y[i].w); }
                const float mean = wave_sum(s) * (1.f / D); float q = 0.f;
#pragma unroll
                for (int i = 0; i < 4; ++i) { y[i] = y[i] - mean; q += (y[i].x * y[i].x + y[i].y * y[i].y) + (y[i].z * y[i].z + y[i].w * y[i].w); }
                const float rstd = 1.f / sqrtf(wave_sum(q) * (1.f / D) + EPS);
                GAS unsigned* o4 = (GAS unsigned*)((unsigned char*)vout + ((size_t)b * SEQ + s0 + base + j) * D) + lane;
                GAS unsigned long long* o8 = (GAS unsigned long long*)(vout + ((size_t)b * SEQ + s0 + base + j) * D) + lane;
#pragma unroll
                for (int i = 0; i < 4; ++i) { const f32x4 lgv = *(const LAS f32x4*)(lnp + 4 * lane + 256 * i), lbv = *(const LAS f32x4*)(lnp + 1024 + 4 * lane + 256 * i); f32x4 z = y[i] * rstd * lgv + lbv;
                    z.x *= pg8::fast_sigmoid(z.x); z.y *= pg8::fast_sigmoid(z.y); z.z *= pg8::fast_sigmoid(z.z); z.w *= pg8::fast_sigmoid(z.w);
                    if (I8_P3) o4[64 * i] = pg8::pk_i8x4(z.x * SA_N, z.y * SA_N, z.z * SA_N, z.w * SA_N);
                    else o8[64 * i] = (unsigned long long)pkbf(z.x, z.y) | ((unsigned long long)pkbf(z.z, z.w) << 32); }
            }
            __syncthreads();
        }
    }
}

__device__ __forceinline__ void attn_phase(LAS unsigned char* lds, int grp, const bf16* Kb, const bf16* Vb, const bf16* Qb, bf16* Ob, unsigned char* O8, float* lse, const float* rel_bias, unsigned* qheads, int G, int vcu, int tid, int lane, int wave) {
    const int dsh = 2 * grp, dil = 1 << dsh;
    LAS unsigned char* Kl = lds + RING_OFF;
    LAS unsigned char* Vl = lds + RING_OFF + 55296;
    LAS float* btab_all = (LAS float*)(lds + XTRA_OFF);
    for (int i = tid; i < 16 * 192; i += NWAVES * 64) { const int hh = i / 192, j = i % 192, dist = 159 - j;
        btab_all[i] = (dist >= 0 && dist <= 128) ? rel_bias[(int)T5_BUCKET[grp][dist] * 48 + grp * 16 + hh] * LOG2E - SOFTMAX_OFS : -1.0e30f; }
    const int lq = lane & 31, hi = lane >> 5;
    v4u kvp[6], vvp[6];
#define ATT_DECODE(IDX, b_, h_, res_, n0_) const int bh_##b_ = (IDX) >> 4, w16_##b_ = (IDX) & 15, b_ = bh_##b_ >> 4, h_ = bh_##b_ & 15, res_ = w16_##b_ & (dil - 1), n0_ = (w16_##b_ >> dsh) * 256
#define ATT_LOAD(IDX) do { ATT_DECODE(IDX, pb, ph, pres, pn0); \
        _Pragma("unroll") for (int i = 0; i < 6; ++i) { const int cidx = tid + 512 * i, j = cidx >> 3, c16 = cidx & 7, sub = pn0 - 128 + j; \
            kvp[i] = (v4u){0u, 0u, 0u, 0u}; vvp[i] = kvp[i]; \
            if (sub >= 0) { const size_t off = ((size_t)pb * SEQ + ((size_t)sub << dsh) + pres) * D + ph * 64 + c16 * 8; kvp[i] = *(const GAS v4u*)(Kb + off); vvp[i] = *(const GAS v4u*)(Vb + off); } } } while (0)
    pg8::bf16x8 qnext[4];
#define ATT_LOADQ(IDX) do { ATT_DECODE(IDX, qb_, qh_, qres_, qn0_); const size_t qrow_ = (size_t)qb_ * SEQ + ((size_t)(qn0_ + 32 * wave + lq) << dsh) + qres_; \
        _Pragma("unroll") for (int c = 0; c < 4; ++c) qnext[c] = *(const pg8::bf16x8*)(Qb + qrow_ * D + qh_ * 64 + 16 * c + 8 * hi); } while (0)
    const bool dyn = (G == 256);
    const int xq = vcu >> 5;
    LAS int* qL = (LAS int*)(lds + XTRA_OFF + 12288 + 64);
    int idx = vcu;
    if (idx < 2048) { ATT_LOAD(idx); ATT_LOADQ(idx); }
    __syncthreads();
    while (idx < 2048) {
        int claimed = 0;
        if (dyn && tid == 0) claimed = (int)__hip_atomic_fetch_add(qheads + 16 * xq, 1u, __ATOMIC_RELAXED, __HIP_MEMORY_SCOPE_AGENT);
        ATT_DECODE(idx, b, h, res, n0);
        const int ql = 32 * wave + lq;
        const size_t qrow = (size_t)b * SEQ + ((size_t)(n0 + ql) << dsh) + res;
        pg8::bf16x8 qr[4];
#pragma unroll
        for (int c = 0; c < 4; ++c) qr[c] = qnext[c];
        __syncthreads();
#pragma unroll
        for (int i = 0; i < 6; ++i) { const int cidx = tid + 512 * i, j = cidx >> 3, c16 = cidx & 7;
            *(LAS v4u*)(Kl + j * 144 + c16 * 16) = kvp[i]; *(LAS v4u*)(Vl + (c16 >> 2) * 24576 + j * 64 + (c16 & 3) * 16) = vvp[i]; }
        if (dyn && tid == 0) qL[0] = 32 + claimed;
        __syncthreads();
        int nidx = idx + G;
        if (dyn) { const int jn = qL[0]; nidx = jn < 256 ? ((jn >> 5) << 8) + (xq << 5) + (jn & 31) : 2048; }
        if (nidx < 2048) ATT_LOAD(nidx);
        float sv[5][16]; float m = -3.0e38f;
        const int kofs = n0 - 128 + 32 * wave;
        const LAS float* brow = btab_all + h * 192 + (31 - lq + 4 * hi);
#pragma unroll
        for (int kt = 0; kt < 5; ++kt) {
            f32x16 S = (f32x16){0.f, 0.f, 0.f, 0.f, 0.f, 0.f, 0.f, 0.f, 0.f, 0.f, 0.f, 0.f, 0.f, 0.f, 0.f, 0.f};
#pragma unroll
            for (int c = 0; c < 4; ++c) { const pg8::bf16x8 a = *(const LAS pg8::bf16x8*)(Kl + (32 * wave + 32 * kt + lq) * 144 + (16 * c + 8 * hi) * 2);
                S = __builtin_amdgcn_mfma_f32_32x32x16_bf16(a, qr[c], S, 0, 0, 0); }
#pragma unroll
            for (int r = 0; r < 16; ++r) { const float s = S[r] + brow[32 * kt + (r & 3) + 8 * (r >> 2)]; sv[kt][r] = s; }
            __builtin_amdgcn_sched_barrier(0);
        }
        if (kofs < 0) {
#pragma unroll
            for (int kt = 0; kt < 5; ++kt)
#pragma unroll
                for (int r = 0; r < 16; ++r) { const int kk = 32 * kt + crow(r, hi); if (kofs + kk < 0) sv[kt][r] = -1.0e30f; }
        }
        m = SOFTMAX_OFS;
        float l = 0.f; unsigned pw[5][8];
#pragma unroll
        for (int kt = 0; kt < 5; ++kt) {
#pragma unroll
            for (int r = 0; r < 16; r += 2) { const float p0 = __builtin_amdgcn_exp2f(sv[kt][r]), p1 = __builtin_amdgcn_exp2f(sv[kt][r + 1]); l += p0 + p1; pw[kt][r >> 1] = pkbf(p0, p1); }
            __builtin_amdgcn_sched_barrier(0);
        }
        l += __shfl_xor(l, 32);
        f32x16 O0 = (f32x16){0.f, 0.f, 0.f, 0.f, 0.f, 0.f, 0.f, 0.f, 0.f, 0.f, 0.f, 0.f, 0.f, 0.f, 0.f, 0.f}, O1 = O0;
        const int vlane = ((lane & 15) >> 2) * 64 + ((lane >> 4) & 1) * 32 + (lane & 3) * 8;
#pragma unroll
        for (int kt = 0; kt < 5; ++kt)
#pragma unroll
            for (int s2 = 0; s2 < 2; ++s2) {
                v4u pq; pq.x = pw[kt][4 * s2 + 0]; pq.y = pw[kt][4 * s2 + 1]; pq.z = pw[kt][4 * s2 + 2]; pq.w = pw[kt][4 * s2 + 3];
                const pg8::bf16x8 pf = __builtin_bit_cast(pg8::bf16x8, pq);
                const int vrow = 32 * wave + 32 * kt + 16 * s2 + 4 * hi;
                LAS unsigned char* vp = Vl + vrow * 64 + vlane;
                const v4i16_t a0 = __builtin_amdgcn_ds_read_tr16_b64_v4i16((LAS v4i16_t*)(vp)), a1 = __builtin_amdgcn_ds_read_tr16_b64_v4i16((LAS v4i16_t*)(vp + 512));
                const v4i16_t b0 = __builtin_amdgcn_ds_read_tr16_b64_v4i16((LAS v4i16_t*)(vp + 24576)), b1 = __builtin_amdgcn_ds_read_tr16_b64_v4i16((LAS v4i16_t*)(vp + 24576 + 512));
                const pg8::bf16x8 vf0 = (pg8::bf16x8){a0[0], a0[1], a0[2], a0[3], a1[0], a1[1], a1[2], a1[3]};
                const pg8::bf16x8 vf1 = (pg8::bf16x8){b0[0], b0[1], b0[2], b0[3], b1[0], b1[1], b1[2], b1[3]};
                O0 = __builtin_amdgcn_mfma_f32_32x32x16_bf16(vf0, pf, O0, 0, 0, 0);
                O1 = __builtin_amdgcn_mfma_f32_32x32x16_bf16(vf1, pf, O1, 0, 0, 0);
                __builtin_amdgcn_sched_barrier(0);
            }
        if (nidx < 2048) ATT_LOADQ(nidx);
        const float inv_l = 1.f / l, lse2 = m + __builtin_amdgcn_logf(l);
        const size_t orow = qrow;
        v4u oldv[4];
        if (grp != 0) {
#pragma unroll
            for (int i = 0; i < 4; ++i) { const int ch = lane + 64 * i, qq = ch >> 3, c8 = ch & 7; oldv[i] = *(const GAS v4u*)(Ob + ((size_t)b * SEQ + ((size_t)(n0 + 32 * wave + qq) << dsh) + res) * D + h * 64 + c8 * 8); } }
        float co = 0.f, cg = inv_l, lnew = lse2;
        if (grp != 0) { const float lo_ = lse[orow * 16 + h]; const float M = fmaxf(lo_, lse2); const float wo = __builtin_amdgcn_exp2f(lo_ - M), wg = __builtin_amdgcn_exp2f(lse2 - M), den = wo + wg;
            co = wo / den; cg = wg / den * inv_l; lnew = M + __builtin_amdgcn_logf(den); }
        __syncthreads();
        LAS unsigned char* stg = Kl + wave * 4608;
        LAS float* cot = (LAS float*)(Kl + 8 * 4608) + wave * 32;
#pragma unroll
        for (int rg = 0; rg < 4; ++rg) {
            pg8::u32x2 wa, wb; wa.x = pkbf(O0[4 * rg] * cg, O0[4 * rg + 1] * cg); wa.y = pkbf(O0[4 * rg + 2] * cg, O0[4 * rg + 3] * cg);
            wb.x = pkbf(O1[4 * rg] * cg, O1[4 * rg + 1] * cg); wb.y = pkbf(O1[4 * rg + 2] * cg, O1[4 * rg + 3] * cg);
            *(LAS pg8::u32x2*)(stg + lq * 144 + (8 * rg + 4 * hi) * 2) = wa; *(LAS pg8::u32x2*)(stg + lq * 144 + (32 + 8 * rg + 4 * hi) * 2) = wb; }
        if (hi == 0) cot[lq] = co;
        if (hi == 0) lse[orow * 16 + h] = lnew;
#pragma unroll
        for (int i = 0; i < 4; ++i) { const int ch = lane + 64 * i, qq = ch >> 3, c8 = ch & 7;
            const v4u sv4 = *(const LAS v4u*)(stg + qq * 144 + c8 * 16);
            bf16* op = Ob + ((size_t)b * SEQ + ((size_t)(n0 + 32 * wave + qq) << dsh) + res) * D + h * 64 + c8 * 8;
            v4u ov = sv4;
            if (grp != 0) { const float cq = cot[qq]; const v4u old = oldv[i];
                ov.x = pkbf(bflo(sv4.x) + cq * bflo(old.x), bfhi(sv4.x) + cq * bfhi(old.x)); ov.y = pkbf(bflo(sv4.y) + cq * bflo(old.y), bfhi(sv4.y) + cq * bfhi(old.y));
                ov.z = pkbf(bflo(sv4.z) + cq * bflo(old.z), bfhi(sv4.z) + cq * bfhi(old.z)); ov.w = pkbf(bflo(sv4.w) + cq * bflo(old.w), bfhi(sv4.w) + cq * bfhi(old.w)); }
            if (grp == 2) { unsigned char* o8 = O8 + ((size_t)b * SEQ + ((size_t)(n0 + 32 * wave + qq) << dsh) + res) * D + h * 64 + c8 * 8;
                pg8::u32x2 w8; w8.x = pg8::pk_fp8x4(bflo(ov.x) * O8_SCALE, bfhi(ov.x) * O8_SCALE, bflo(ov.y) * O8_SCALE, bfhi(ov.y) * O8_SCALE); w8.y = pg8::pk_fp8x4(bflo(ov.z) * O8_SCALE, bfhi(ov.z) * O8_SCALE, bflo(ov.w) * O8_SCALE, bfhi(ov.w) * O8_SCALE);
                *(GAS pg8::u32x2*)o8 = w8; }
            else *(GAS v4u*)op = ov; }
        idx = nidx;
    }
    __syncthreads();
#undef ATT_DECODE
#undef ATT_LOAD
#undef ATT_LOADQ
}

__device__ __forceinline__ void route_phase(const _Float16* x3, const float* gnorm, const float* wr, unsigned char* ws, LAS unsigned char* lds, int G, int vcu, int tid, int lane, int wave) {
    LAS float* WrT = (LAS float*)(lds + RING_OFF);
    LAS unsigned* wcL = (LAS unsigned*)(lds + RING_OFF + 32768);
    for (int i = tid; i < 8192; i += NWAVES * 64) { const int e = i >> 10, k = i & 1023; WrT[i] = wr[k * 8 + e] * gnorm[k]; }
    __syncthreads();
    unsigned* route = (unsigned*)(ws + WS_ROUTE); float* gate1 = (float*)(ws + WS_GATE1); float* gate2 = (float*)(ws + WS_GATE2);
    unsigned* wavecnt = (unsigned*)(ws + WS_WAVECNT); int* blockcnt = (int*)(ws + WS_BLOCKCNT); unsigned char* H3 = ws + WS_H3;
    const int gw = vcu * NWAVES + wave, NGW = G * NWAVES, tpw = (T + NGW - 1) / NGW;
    const int t0 = gw * tpw, t1 = (t0 + tpw) < T ? (t0 + tpw) : T;
    f32x4 gv[4];
#pragma unroll
    for (int j = 0; j < 4; ++j) gv[j] = *(const f32x4*)(gnorm + 4 * lane + 256 * j);
    unsigned long long cnt0 = 0ull, cnt1 = 0ull;
    f32x4 vn[4];
    if (t0 < t1) { const GAS pg8::h16x4* xr = (const GAS pg8::h16x4*)(x3 + (size_t)t0 * D) + lane;
#pragma unroll
        for (int j = 0; j < 4; ++j) vn[j] = __builtin_convertvector(xr[64 * j], f32x4); }
    for (int t = t0; t < t1; ++t) {
        f32x4 v[4]; float ss = 0.f;
#pragma unroll
        for (int j = 0; j < 4; ++j) { v[j] = vn[j]; ss += (v[j].x * v[j].x + v[j].y * v[j].y) + (v[j].z * v[j].z + v[j].w * v[j].w); }
        if (t + 1 < t1) { const GAS pg8::h16x4* xr = (const GAS pg8::h16x4*)(x3 + (size_t)(t + 1) * D) + lane;
#pragma unroll
            for (int j = 0; j < 4; ++j) vn[j] = __builtin_convertvector(xr[64 * j], f32x4); }
        float dt[8];
#pragma unroll
        for (int e = 0; e < 8; ++e) { float a = 0.f;
#pragma unroll
            for (int j = 0; j < 4; ++j) { const f32x4 w = *(const LAS f32x4*)(WrT + e * 1024 + 4 * lane + 256 * j); a += (v[j].x * w.x + v[j].y * w.y) + (v[j].z * w.z + v[j].w * w.w); }
            dt[e] = a; }
        ss = wave_sum(ss);
#pragma unroll
        for (int e = 0; e < 8; ++e) dt[e] = wave_sum(dt[e]);
        const float rstd = 1.f / sqrtf(ss * (1.f / D) + EPS);
        GAS unsigned* o4 = (GAS unsigned*)(H3 + (size_t)t * D) + lane;
#pragma unroll
        for (int j = 0; j < 4; ++j) { const f32x4 y = v[j] * (rstd * SA_N) * gv[j]; o4[64 * j] = pg8::pk_i8x4(y.x, y.y, y.z, y.w); }
        int e1 = 0; float v1 = dt[0] * rstd;
#pragma unroll
        for (int e = 1; e < 8; ++e) { const float x = dt[e] * rstd; if (x > v1) { v1 = x; e1 = e; } }
        int e2 = -1; float v2 = -3.0e38f;
#pragma unroll
        for (int e = 0; e < 8; ++e) { const float x = dt[e] * rstd; if (e != e1 && x > v2) { v2 = x; e2 = e; } }
        const float g2 = 1.f / (1.f + __expf(v1 - v2)), g1 = 1.f - g2;
        cnt0 += 1ull << (8 * e1); cnt1 += 1ull << (8 * e2);
        if (lane == 0) { route[t] = (unsigned)e1 | ((unsigned)e2 << 8); gate1[t] = g1; gate2[t] = g2; }
    }
    if (lane == 0) { v4u c; c.x = (unsigned)cnt0; c.y = (unsigned)(cnt0 >> 32); c.z = (unsigned)cnt1; c.w = (unsigned)(cnt1 >> 32);
        *(GAS v4u*)(wavecnt + (size_t)gw * 4) = c; wcL[wave * 4 + 0] = c.x; wcL[wave * 4 + 1] = c.y; wcL[wave * 4 + 2] = c.z; wcL[wave * 4 + 3] = c.w; }
    __syncthreads();
    if (tid < 16) { const int slot = tid >> 3, e = tid & 7; int s = 0;
#pragma unroll
        for (int w = 0; w < NWAVES; ++w) s += (int)((wcL[w * 4 + slot * 2 + (e >> 2)] >> (8 * (e & 3))) & 255u);
        blockcnt[vcu * 16 + tid] = s; }
    __syncthreads();
}

__device__ __forceinline__ void pos_phase(unsigned char* ws, LAS unsigned char* lds, int G, int vcu, int tid, int lane, int wave) {
    LAS int* cntL = (LAS int*)(lds + RING_OFF);
    LAS int* pAll = (LAS int*)(lds + RING_OFF + 65536);
    LAS int* pBef = pAll + 512;
    LAS int* totL = pBef + 512;
    const int* blockcnt = (const int*)(ws + WS_BLOCKCNT); const unsigned* wavecnt = (const unsigned*)(ws + WS_WAVECNT);
    const unsigned* route = (const unsigned*)(ws + WS_ROUTE); const float* gate1 = (const float*)(ws + WS_GATE1); const float* gate2 = (const float*)(ws + WS_GATE2);
    int* gofs = (int*)(ws + WS_GOFS);
    for (int i = tid; i < G * 16; i += NWAVES * 64) cntL[i] = blockcnt[i];
    __syncthreads();
    { const int c = tid & 15, part = tid >> 4, bpp = (G + 31) / 32; int sa = 0, sb = 0;
      for (int bb = part * bpp; bb < (part + 1) * bpp && bb < G; ++bb) { const int v = cntL[bb * 16 + c]; sa += v; if (bb < vcu) sb += v; }
      pAll[part * 16 + c] = sa; pBef[part * 16 + c] = sb; }
    __syncthreads();
    if (tid < 16) { int sa = 0, sb = 0;
        for (int p = 0; p < 32; ++p) { sa += pAll[p * 16 + tid]; sb += pBef[p * 16 + tid]; }
        totL[tid] = sa; totL[16 + tid] = sb; }
    __syncthreads();
    if (tid == 0) { int off = 0;
        for (int e = 0; e < 8; ++e) { totL[32 + e] = off; totL[32 + 8 + e] = off + totL[e]; if (vcu == 0) { gofs[e] = off; gofs[8 + e] = off + totL[e]; gofs[32 + e] = off >> 8; } off += ((totL[e] + totL[8 + e] + 255) >> 8) << 8; }
        if (vcu == 0) gofs[16] = off >> 8; }
    __syncthreads();
    const int gw = vcu * NWAVES + wave, NGW = G * NWAVES, tpw = (T + NGW - 1) / NGW;
    const int t0 = gw * tpw, t1 = (t0 + tpw) < T ? (t0 + tpw) : T;
    int mypos = 0;
    if (lane < 16) { mypos = totL[32 + lane] + totL[16 + lane];
        for (int w = 0; w < wave; ++w) mypos += (int)((wavecnt[(size_t)(vcu * NWAVES + w) * 4 + (lane >> 3) * 2 + ((lane & 7) >> 2)] >> (8 * (lane & 3))) & 255u); }
    int* pos01 = (int*)(ws + WS_POS);
    int* rowtok0 = (int*)(ws + WS_ROWTOK); int* rowtok1 = rowtok0; float* rowgate0 = (float*)(ws + WS_ROWGATE); float* rowgate1 = rowgate0;
    for (int t = t0; t < t1; ++t) {
        const unsigned rt = route[t]; const int e1 = (int)(rt & 255u), e2 = (int)((rt >> 8) & 255u);
        const int p1 = __shfl(mypos, e1), p2 = __shfl(mypos, 8 + e2);
        if (lane == e1 || lane == 8 + e2) mypos += 1;
        if (lane == 0) { rowtok0[p1] = t; rowgate0[p1] = gate1[t]; rowtok1[p2] = t; rowgate1[p2] = gate2[t]; pos01[t] = p1; pos01[T + t] = p2; }
    }
    if (vcu < 8) { int* rtk = (int*)(ws + WS_ROWTOK); float* rgt = (float*)(ws + WS_ROWGATE);
        const int beg = totL[32 + vcu] + totL[vcu] + totL[8 + vcu], end = totL[32 + vcu] + (((totL[vcu] + totL[8 + vcu] + 255) >> 8) << 8);
        for (int i = beg + tid; i < end; i += NWAVES * 64) { rtk[i] = -1; rgt[i] = 0.f; } }
    __syncthreads();
}

__device__ __forceinline__ void combine_phase(float* out, unsigned char* ws, int G, int vcu, int tid, int lane, int wave) {
    const int* pos01 = (const int*)(ws + WS_POS); const unsigned char* Y = ws + WS_Y; const _Float16* XH = (const _Float16*)(ws + WS_XH);
    const int gw = vcu * NWAVES + wave, NGW = G * NWAVES; const float ys = 1.f / Y_SCALE;
    for (int t0 = gw * 4; t0 < T; t0 += NGW * 4) {
        v4u ya[4], yb[4]; f32x4 o[4][4];
#pragma unroll
        for (int q = 0; q < 4; ++q) { const int t = t0 + q; const int p0 = pos01[t], p1 = pos01[T + t];
            ya[q] = *(const GAS v4u*)(Y + (size_t)p0 * 1024 + 16 * lane); yb[q] = *(const GAS v4u*)(Y + (size_t)p1 * 1024 + 16 * lane);
#pragma unroll
            for (int j = 0; j < 4; ++j) o[q][j] = __builtin_convertvector(*(const GAS pg8::h16x4*)(XH + (size_t)t * 1024 + 16 * lane + 4 * j), f32x4); }
#pragma unroll
        for (int q = 0; q < 4; ++q)
#pragma unroll
            for (int j = 0; j < 4; ++j) { const unsigned a = ya[q][j], c = yb[q][j]; f32x4 x = o[q][j];
                x.x += (float)(((int)(a << 24) >> 24) + ((int)(c << 24) >> 24)) * ys; x.y += (float)(((int)(a << 16) >> 24) + ((int)(c << 16) >> 24)) * ys;
                x.z += (float)(((int)(a << 8) >> 24) + ((int)(c << 8) >> 24)) * ys; x.w += (float)(((int)a >> 24) + ((int)c >> 24)) * ys;
                __builtin_nontemporal_store(x, (GAS f32x4*)(out + (size_t)(t0 + q) * 1024 + 16 * lane + 4 * j)); }
    }
}

constexpr int N_LAUNCHES = MK_N_LAUNCHES;
struct Args { const float* in[26]; float* out; unsigned char* ws; int ph_lo, ph_hi; };
typedef const __attribute__((address_space(4))) unsigned char* kargp_t;
#ifdef PROBE_CLK_PHASE
#define CLK_BEGIN(k) unsigned long long ck0_ = 0, rt0_ = 0; if ((k) == PROBE_CLK_PHASE) { ck0_ = __builtin_amdgcn_s_memtime(); rt0_ = __builtin_amdgcn_s_memrealtime(); }
#define CLK_END(k) if ((k) == PROBE_CLK_PHASE && bx == 0 && tid == 0) { const unsigned long long ck1_ = __builtin_amdgcn_s_memtime(), rt1_ = __builtin_amdgcn_s_memrealtime(); const float qv_ = floorf((float)(ck1_ - ck0_) / (float)(rt1_ - rt0_) + 0.5f); ((float*)(ws + WS_GOFS))[100] = 100.f * qv_ * qv_; }
#else
#define CLK_BEGIN(k)
#define CLK_END(k)
#endif
#define PH_ENTER() kargp_t kp_ = kp0; asm volatile("" : "+s"(kp_)); int tid = tid0; asm volatile("" : "+v"(tid)); const int lane = tid & 63, wave = __builtin_amdgcn_readfirstlane(tid >> 6); \
    unsigned char* ws = *(unsigned char* const __attribute__((address_space(4)))*)(kp_ + 216); float* out = *(float* const __attribute__((address_space(4)))*)(kp_ + 208); (void)lane; (void)wave; (void)out
#define INP(i) (*(const float* const __attribute__((address_space(4)))*)(kp_ + 8 * (i)))
__global__ void __launch_bounds__(NWAVES * 64, 2) mk_fwd(Args args) {
    extern __shared__ __attribute__((aligned(16))) unsigned char lds_raw[];
    LAS unsigned char* lds = (LAS unsigned char*)lds_raw;
    static_assert(sizeof(Args) == 232 && __builtin_offsetof(Args, out) == 208 && __builtin_offsetof(Args, ws) == 216, "Args layout");
    const kargp_t kp0 = (kargp_t)__builtin_amdgcn_kernarg_segment_ptr();
    const int tid0 = threadIdx.x;
    const int G = gridDim.x, bx = blockIdx.x, vcu = (G % 8 == 0) ? (bx % 8) * (G / 8) + bx / 8 : bx;
    for (int u = tid0; u < (XTRA_OFF - LDSCTL_OFF) / 4; u += NWAVES * 64) ((LAS unsigned*)(lds + LDSCTL_OFF))[u] = 0u;
    __syncthreads();
    XcdBarrier bar; bar.bar = (unsigned*)(args.ws + WS_CTL) + CW_BAR; bar.x = 0; bar.st = (volatile LAS unsigned*)(lds + MISC_OFF) + 8;
    if (N_LAUNCHES == 1) bar = xcd_barrier_post((unsigned*)(args.ws + WS_CTL) + CW_BAR, (volatile LAS unsigned*)(lds + MISC_OFF) + 8);
#define GRID_BAR() do { if (N_LAUNCHES == 1) xcd_barrier(bar); } while (0)
    const int lo = args.ph_lo, hi = args.ph_hi;
#ifndef PH_MASK
#define PH_MASK 0xFFFFFFFFu
#endif
#define IN(k) (((PH_MASK >> (k)) & 1u) && lo <= (k) && (k) < hi)
#define BOTH(k) (IN(k) && IN((k) + 1))
#ifndef PROBE_NOEPI
#define PROBE_NOEPI 0
#endif
#ifndef PROBE_REP_MASK
#define PROBE_REP_MASK 0u
#define PROBE_REP_N 1
#endif
#define REPS(k) (((PROBE_REP_MASK >> (k)) & 1u) ? PROBE_REP_N : 1)

    _Pragma("nounroll") for (int rep_ = 0; rep_ < REPS(0); ++rep_) if (IN(0)) { PH_ENTER(); CLK_BEGIN(0); p0_prologue(kp_, ws, lds, G, vcu, tid, lane, wave); __syncthreads(); CLK_END(0); if (BOTH(0)) GRID_BAR(); }
    _Pragma("nounroll") for (int rep_ = 0; rep_ < REPS(1); ++rep_) if (IN(1)) { PH_ENTER(); CLK_BEGIN(1);
        pg8::Gemm g{(const bf16*)(ws + WS_H0), (const bf16*)(ws + WS_WIN), T, 2048, 1024, 0, nullptr, nullptr, nullptr, nullptr, 0}; pg8::StaticOrder S; S.init(T, 2048, G, bx, I8_P1 ? 1024 / 128 : 1024 / 64);
        pg8::EpiGated<0> E{(bf16*)(ws + WS_GLU), 1024, INP(4), 1024, nullptr, I8_P1 ? 1.f / (SA_N * SW_I8) : 1.f, 1.f, {}, -1};
        pg8::gemm_phase<pg8::EpiGated<0>, pg8::StaticOrder, false, I8_P1 ? 2 : 0>(lds + RING_OFF, g, S, E, tid);
        CLK_END(1); if (BOTH(1)) GRID_BAR();
    }
    _Pragma("nounroll") for (int rep_ = 0; rep_ < REPS(2); ++rep_) if (IN(2)) { PH_ENTER(); CLK_BEGIN(2); conv_phase((const bf16*)(ws + WS_GLU), INP(5), INP(6), INP(7), INP(8), (bf16*)(ws + WS_V), lds, G, vcu, tid, lane, wave); CLK_END(2); if (BOTH(2)) GRID_BAR(); }
    _Pragma("nounroll") for (int rep_ = 0; rep_ < REPS(3); ++rep_) if (IN(3)) { PH_ENTER(); CLK_BEGIN(3);
        pg8::Gemm g{(const bf16*)(ws + WS_V), (const bf16*)(ws + WS_WOUT), T, 1024, 1024, 0, nullptr, nullptr, nullptr, nullptr, 0}; pg8::StaticOrder S; S.init(T, 1024, G, bx, I8_P3 ? 1024 / 128 : 1024 / 64);
        pg8::EpiResid<true, true, I8_P4 ? 2 : 0, 0, 1> E{INP(0), (float*)(ws + WS_XH), INP(10), ws + WS_X1B, (float*)(ws + WS_PART1), I8_P3 ? 1.f / (SA_N * SW_I8) : 1.f, I8_P4 ? SA_X : 1.f, (LAS float*)(lds + XTRA_OFF)};
        pg8::gemm_phase<pg8::EpiResid<true, true, I8_P4 ? 2 : 0, 0, 1>, pg8::StaticOrder, false, I8_P3 ? 2 : 0>(lds + RING_OFF, g, S, E, tid);
        CLK_END(3); if (BOTH(3)) GRID_BAR();
    }
    _Pragma("nounroll") for (int rep_ = 0; rep_ < REPS(4); ++rep_) if (IN(4)) { PH_ENTER(); CLK_BEGIN(4);
        pg8::Gemm g{(const bf16*)(ws + WS_X1B), (const bf16*)(ws + WS_WF13), T, 5632, 1024, 0, nullptr, nullptr, nullptr, nullptr, 0}; pg8::StaticOrder S; S.init(T, 5632, G, bx, I8_P4 ? 1024 / 128 : 1024 / 64);
        pg8::EpiGated<1> E{(bf16*)(ws + WS_HB), DFFP, nullptr, 0, (const float*)(ws + WS_PART1), I8_P4 ? 1.f / (SA_X * SW_I8) : 1.f, 1.f, {}, -1};
        if (G == 256) {
            const int slot = vcu % 11;
            S.i1 = slot;
            pg8::gemm_phase<pg8::EpiGated<1>, pg8::StaticOrder, false, I8_P4 ? 2 : 0>(lds + RING_OFF, g, S, E, tid);
            __syncthreads();
            p0_items2(kp_, ws, (LAS float*)(lds + RING_OFF + wave * 16384), wave, NWAVES, vcu * (IT_MOE / 256), (vcu + 1) * (IT_MOE / 256), lane);
            __syncthreads();
            S.i0 = slot; S.i1 = 0x7fffffff;
        }
        pg8::gemm_phase<pg8::EpiGated<1>, pg8::StaticOrder, false, I8_P4 ? 2 : 0>(lds + RING_OFF, g, S, E, tid);
        CLK_END(4); if (BOTH(4)) GRID_BAR();
    }
    _Pragma("nounroll") for (int rep_ = 0; rep_ < REPS(5); ++rep_) if (IN(5)) { PH_ENTER(); CLK_BEGIN(5);
        pg8::Gemm g{(const bf16*)(ws + WS_HB), (const bf16*)(ws + WS_WFD), T, 1024, DFFP, 0, nullptr, nullptr, nullptr, nullptr, 0}; pg8::StaticOrder S; S.init(T, 1024, G, bx, DFFP / 64);
        pg8::EpiResid<false, true, 2, 1, 1> E{(const float*)(ws + WS_XH), (float*)(ws + WS_XH), nullptr, ws + WS_X2B, (float*)(ws + WS_PART2), 1.f, SA_X, (LAS float*)(lds + XTRA_OFF)};
        pg8::gemm_phase<pg8::EpiResid<false, true, 2, 1, 1>, pg8::StaticOrder, false>(lds + RING_OFF, g, S, E, tid);
        CLK_END(5); if (BOTH(5)) GRID_BAR();
    }
    for (int grp = 0; grp < 3; ++grp) {
        _Pragma("nounroll") for (int rep_ = 0; rep_ < REPS(6 + 2 * grp); ++rep_) if (IN(6 + 2 * grp)) { PH_ENTER(); CLK_BEGIN(6 + 2 * grp);
            pg8::Gemm g{(const bf16*)(ws + WS_X2B), (const bf16*)(ws + WS_WQKV + (size_t)grp * 3072 * 1024), T, 3072, 1024, 0, nullptr, nullptr, nullptr, nullptr, 0}; pg8::StaticOrder S; S.init(T, 3072, G, bx, 1024 / 128);
            pg8::EpiQKV E{(bf16*)(ws + WS_KG), (size_t)T * D, (const float*)(ws + WS_PART2), INP(13) + grp * 64, INP(16) + grp * 64, QSCALE, 1.f / (SA_X * SW_I8), {}, -1, lds + XTRA_OFF};
            pg8::gemm_phase<pg8::EpiQKV, pg8::StaticOrder, false, 2>(lds + RING_OFF, g, S, E, tid);
            CLK_END(6 + 2 * grp); if (BOTH(6 + 2 * grp)) GRID_BAR();
        }
        _Pragma("nounroll") for (int rep_ = 0; rep_ < REPS(7 + 2 * grp); ++rep_) if (IN(7 + 2 * grp)) { PH_ENTER(); CLK_BEGIN(7 + 2 * grp);
            attn_phase(lds, grp, (const bf16*)(ws + WS_KG), (const bf16*)(ws + WS_VG), (const bf16*)(ws + WS_QG), (bf16*)(ws + WS_O), ws + WS_O8, (float*)(ws + WS_LSE), INP(1), (unsigned*)(ws + WS_CTL) + CW_AQ + grp * 128, G, vcu, tid, lane, wave);
            CLK_END(7 + 2 * grp); if (BOTH(7 + 2 * grp)) GRID_BAR();
        }
    }
    _Pragma("nounroll") for (int rep_ = 0; rep_ < REPS(12); ++rep_) if (IN(12)) { PH_ENTER(); CLK_BEGIN(12);
        pg8::Gemm g{(const bf16*)(ws + WS_O8), (const bf16*)(ws + WS_WO), T, 1024, 1024, 0, nullptr, nullptr, nullptr, nullptr, 0}; pg8::StaticOrder S; S.init(T, 1024, G, bx, 1024 / 128);
        pg8::EpiResid<false, false, 0, 1, 1> E{(const float*)(ws + WS_XH), (float*)(ws + WS_XH), nullptr, nullptr, nullptr, 1.f / (W8_SCALE * O8_SCALE), 1.f, nullptr};
        pg8::gemm_phase<pg8::EpiResid<false, false, 0, 1, 1>, pg8::StaticOrder, false, 1>(lds + RING_OFF, g, S, E, tid);
        CLK_END(12); if (BOTH(12)) GRID_BAR();
    }
    _Pragma("nounroll") for (int rep_ = 0; rep_ < REPS(13); ++rep_) if (IN(13)) { PH_ENTER(); CLK_BEGIN(13); route_phase((const _Float16*)(ws + WS_XH), INP(18) + 1024, INP(22), ws, lds, G, vcu, tid, lane, wave); CLK_END(13); if (BOTH(13)) GRID_BAR(); }
    _Pragma("nounroll") for (int rep_ = 0; rep_ < REPS(14); ++rep_) if (IN(14)) { PH_ENTER(); CLK_BEGIN(14); pos_phase(ws, lds, G, vcu, tid, lane, wave); CLK_END(14); if (BOTH(14)) GRID_BAR(); }
    _Pragma("nounroll") for (int rep_ = 0; rep_ < REPS(15); ++rep_) if (IN(15)) { PH_ENTER(); CLK_BEGIN(15);
        const int* gofs = (const int*)(ws + WS_GOFS); const int* rowtok = (const int*)(ws + WS_ROWTOK);
        const int ntile = gofs[16];
        pg8::MoeOrder S; S.so.init(ntile * 256, 7168, G, bx, 1024 / 128); S.p0 = 0; S.p1 = 0; S.ppu = 0;
        S.t1 = gofs[32 + 1]; S.t2 = gofs[32 + 2]; S.t3 = gofs[32 + 3]; S.t4 = gofs[32 + 4]; S.t5 = gofs[32 + 5]; S.t6 = gofs[32 + 6]; S.t7 = gofs[32 + 7];
        pg8::Gemm g{(const bf16*)(ws + WS_H3), (const bf16*)(ws + WS_WM13), ntile * 256, 7168, 1024, (size_t)7168 * 1024, rowtok, nullptr, nullptr, nullptr, 0};
        pg8::EpiGated<3> E{(bf16*)(ws + WS_HM), DFFE, nullptr, 0, nullptr, 1.f / (SA_N * SW_I8), HM_SCALE, {}, -1};
        pg8::gemm_phase<pg8::EpiGated<3>, pg8::MoeOrder, true, 2>(lds + RING_OFF, g, S, E, tid);
        CLK_END(15); if (BOTH(15)) GRID_BAR();
    }
    _Pragma("nounroll") for (int rep_ = 0; rep_ < REPS(16); ++rep_) if (IN(16)) { PH_ENTER(); CLK_BEGIN(16);
        const int* gofs = (const int*)(ws + WS_GOFS); const float* rowgate = (const float*)(ws + WS_ROWGATE);
        const int ntile = gofs[16];
        pg8::MoeOrderSK S; S.so.init(ntile * 256, 1024, G, vcu, DFFE / 128); S.plan();
        S.t1 = gofs[32 + 1]; S.t2 = gofs[32 + 2]; S.t3 = gofs[32 + 3]; S.t4 = gofs[32 + 4]; S.t5 = gofs[32 + 5]; S.t6 = gofs[32 + 6]; S.t7 = gofs[32 + 7];
        pg8::Gemm g{(const bf16*)(ws + WS_HM), (const bf16*)(ws + WS_WM2), ntile * 256, 1024, DFFE, (size_t)1024 * DFFE, nullptr, ws + WS_SLAB, (unsigned*)(ws + WS_CTL) + CW_SKFLAG + (rep_ & 1) * 8192, (unsigned*)(ws + WS_CTL) + CW_TMO, 0};
        pg8::EpiMoeDown E{ws + WS_Y, rowgate, Y_SCALE / (W8_SCALE * HM_SCALE)};
        pg8::gemm_phase<pg8::EpiMoeDown, pg8::MoeOrderSK, false, 1>(lds + RING_OFF, g, S, E, tid);
        CLK_END(16); if (BOTH(16)) GRID_BAR();
    }
    _Pragma("nounroll") for (int rep_ = 0; rep_ < REPS(17); ++rep_) if (IN(17)) { PH_ENTER(); CLK_BEGIN(17); combine_phase(out, ws, G, vcu, tid, lane, wave); }
#ifdef PROBE_CLK_PHASE
    if (bx == 0 && tid0 == 0) { asm volatile("s_waitcnt vmcnt(0)" ::: "memory"); args.out[(size_t)T * D - 1] = ((float*)(args.ws + WS_GOFS))[100]; }
#endif
#ifdef PROBE_TCH
    {
        GRID_BAR();
        if (bx == 0 && tid0 == 0) { const unsigned tot = __hip_atomic_load((unsigned*)(args.ws + WS_CTL) + 60000, __ATOMIC_RELAXED, __HIP_MEMORY_SCOPE_AGENT); const unsigned long long wait_ticks = (unsigned long long)(tot / (unsigned)G) * PROBE_TCH;
            const unsigned long long t0_ = __builtin_amdgcn_s_memrealtime(); while (__builtin_amdgcn_s_memrealtime() - t0_ < wait_ticks) __builtin_amdgcn_s_sleep(8); } }
#endif
#undef IN
#undef BOTH
#undef GRID_BAR
}

extern "C" void kernel_launch(void* const* d_in, const int* in_sizes, int n_in, void* d_out, int out_size, void* d_ws, size_t ws_size, hipStream_t stream) {
    static int grid = 0;
    if (grid == 0) {
        if (n_in != 26 || in_sizes[0] != T * D || out_size != T * D || ws_size < WS_END) { fprintf(stderr, "kernel_launch: unexpected shapes: n_in %d in0 %d out %d ws %zu (need >= %zu); nothing launched\n", n_in, n_in > 0 ? in_sizes[0] : -1, out_size, ws_size, (size_t)WS_END); grid = -1; return; }
        int dev = 0, cus = 0;
        if (hipGetDevice(&dev) != hipSuccess || hipDeviceGetAttribute(&cus, hipDeviceAttributeMultiprocessorCount, dev) != hipSuccess) { fprintf(stderr, "kernel_launch: device query failed\n"); grid = -1; return; }
        if (hipFuncSetAttribute((const void*)mk_fwd, hipFuncAttributeMaxDynamicSharedMemorySize, LDS_BYTES) != hipSuccess) { fprintf(stderr, "kernel_launch: hipFuncSetAttribute failed\n"); grid = -1; return; }
        int per_cu = 0;
        if (hipOccupancyMaxActiveBlocksPerMultiprocessor(&per_cu, (const void*)mk_fwd, NWAVES * 64, LDS_BYTES) != hipSuccess || per_cu < 1) fprintf(stderr, "kernel_launch: note: occupancy query reports %d workgroups per CU\n", per_cu);
        (void)hipGetLastError();
        grid = cus;
    }
    if (grid < 0) return;
    if (hipMemsetAsync((char*)d_ws + WS_CTL, 0, CTL_ZERO_BYTES, stream) != hipSuccess) { fprintf(stderr, "kernel_launch: hipMemsetAsync failed\n"); return; }
    Args a{};
    for (int i = 0; i < 26; ++i) a.in[i] = (const float*)d_in[i];
    a.out = (float*)d_out; a.ws = (unsigned char*)d_ws;
    for (int li = 0; li < N_LAUNCHES; ++li) {
        a.ph_lo = (N_LAUNCHES == 1) ? 0 : li; a.ph_hi = (N_LAUNCHES == 1) ? NPHASE : li + 1;
        hipLaunchKernelGGL(mk_fwd, dim3(grid), dim3(NWAVES * 64), LDS_BYTES, stream, a);
        const hipError_t le = hipPeekAtLastError();
        if (le != hipSuccess) { fprintf(stderr, "kernel_launch: launch %d failed: %s\n", li, hipGetErrorName(le)); break; }
    }
}
```

```cpp
#include <hip/hip_runtime.h>
#include <cstdio>
#include <cstdint>
#ifndef MK_N_LAUNCHES
#define MK_N_LAUNCHES 1
#endif
namespace pg8 {
#define PG8_LAS __attribute__((address_space(3)))
#define PG8_GAS __attribute__((address_space(1)))
typedef unsigned short bf16_t;
typedef short bf16x8 __attribute__((ext_vector_type(8)));
typedef float f32x4 __attribute__((ext_vector_type(4)));
typedef float f32x2 __attribute__((ext_vector_type(2)));
typedef unsigned u32x4 __attribute__((ext_vector_type(4)));
typedef unsigned u32x2 __attribute__((ext_vector_type(2)));
typedef int v4i_t __attribute__((ext_vector_type(4)));
typedef int v8i_t __attribute__((ext_vector_type(8)));
constexpr int BM = 256, BK = 64, HALF = 128, HTB = HALF * BK * 2  , STAGE_BYTES = 8 * HTB, NXCD = 8, WGM = 8;

__host__ __device__ __forceinline__ int lds_byte(int r, int c) { const int st = (r >> 4) * 2 + (c >> 5), rr = r & 15, cc = c & 31, ob = rr * 64 + cc * 2; return st * 1024 + (ob ^ (((ob >> 9) & 1) << 5)); }
__host__ __device__ __forceinline__ void stage_rc(int b, int& R, int& C) { const int st = b / 1024, sb = b % 1024, swz = sb ^ (((sb >> 9) & 1) << 5); R = (st >> 1) * 16 + swz / 64; C = (st & 1) * 32 + (swz % 64) / 2; }
__host__ __device__ __forceinline__ int perm32(int rho) { const int n = rho >> 4, i = rho & 15; return 8 * (i >> 2) + 4 * n + (i & 3); }

struct Unit { int pm, pn, be, kt0, nkt, part; };
struct Gemm { const bf16_t* A; const bf16_t* Bt; int M, N, K; size_t bstride; const int* rowtok; unsigned char* slab; unsigned* skflag; unsigned* tmo; int noepi; };

struct StaticOrder {
    static constexpr bool STREAMK = false;
    int nM, nN, nwg, G, c, nt, i0, i1;
    __host__ __device__ __forceinline__ void init(int M, int N, int G_, int c_, int nt_) { nM = M / BM; nN = N / BM; nwg = nM * nN; G = G_; c = c_; nt = nt_; i0 = 0; i1 = 0x7fffffff; }
    __host__ __device__ __forceinline__ int wg() const { return c; }
    __host__ __device__ __forceinline__ bool next(int i, Unit& u) const { const int ii = i + i0; if (ii >= i1) return false; const long L = (long)ii * G + c; if (L >= nwg) return false; map((int)L, u); return true; }
    __host__ __device__ __forceinline__ void map_linear(int wgid, Unit& u) const {
        const int nig = WGM * nN, gid = wgid / nig, fm = gid * WGM, gsz = (nM - fm) < WGM ? (nM - fm) : WGM;
        u.pm = fm + ((wgid % nig) % gsz); u.pn = (wgid % nig) / gsz; u.be = 0; u.kt0 = 0; u.nkt = nt; u.part = 0;
    }
    __host__ __device__ __forceinline__ void map(int L, Unit& u) const {
        int wgid = L; { const int q = nwg / NXCD, r = nwg % NXCD, xcd = wgid % NXCD, off = wgid / NXCD; wgid = (xcd < r ? xcd * (q + 1) : r * (q + 1) + (xcd - r) * q) + off; }
        const int nig = WGM * nN, gid = wgid / nig, fm = gid * WGM, gsz = (nM - fm) < WGM ? (nM - fm) : WGM;
        u.pm = fm + ((wgid % nig) % gsz); u.pn = (wgid % nig) / gsz; u.be = 0; u.kt0 = 0; u.nkt = nt; u.part = 0;
    }
};
template <bool STREAMK_> struct MoeOrderT {
    static constexpr bool STREAMK = STREAMK_;
    StaticOrder so; int t1, t2, t3, t4, t5, t6, t7; int p0, p1, ppu;
    __device__ __forceinline__ int wg() const { return so.c; }
    __device__ __forceinline__ void plan() { ppu = so.nt / 2; const long tot = (long)so.nwg * ppu; p0 = (int)(tot * so.c / so.G); p1 = (int)(tot * (so.c + 1) / so.G); }
    __device__ __forceinline__ bool next(int i, Unit& u) const {
#if defined(PROBE_DOUBLE_KLOOP)
        if (!STREAMK) { if (!so.next(i >> 1, u)) return false; if (!(i & 1)) u.part = 3; }
#else
        if (!STREAMK) { if (!so.next(i, u)) return false; }
#endif
        else { const int first = p0 / ppu, uidx = first + i; const int s = (i == 0) ? (p0 - first * ppu) : 0; const int rem = p1 - uidx * ppu;
            if (rem <= s) return false;
            const int e = rem < ppu ? rem : ppu;
            so.map_linear(uidx, u); u.kt0 = 2 * s; u.nkt = 2 * (e - s); u.part = (s > 0) ? 1 : ((e < ppu) ? 2 : 0); }
        const int q = u.pm; u.be = (q >= t1) + (q >= t2) + (q >= t3) + (q >= t4) + (q >= t5) + (q >= t6) + (q >= t7); return true;
    }
};
typedef MoeOrderT<false> MoeOrder;
typedef MoeOrderT<true> MoeOrderSK;

__device__ __forceinline__ unsigned cvt_pk_bf16(float lo, float hi) { unsigned r; asm volatile("v_cvt_pk_bf16_f32 %0, %1, %2" : "=v"(r) : "v"(lo), "v"(hi)); return r; }
__device__ __forceinline__ float fast_sigmoid(float x) { return __builtin_amdgcn_rcpf(1.0f + __builtin_amdgcn_exp2f(-1.4426950408889634f * x)); }
__device__ __forceinline__ float row_rstd(const float* part, int row) {
    const f32x4 a = *(const f32x4*)(part + (size_t)row * 4);
    return __builtin_amdgcn_rsqf(((a[0] + a[1]) + (a[2] + a[3])) * (1.0f / 1024.0f) + 1e-6f);
}
__device__ __forceinline__ void row_rstd8(const float* part, int row0, float (&r)[2][4]) {
#pragma unroll
    for (int ai = 0; ai < 2; ++ai)
#pragma unroll
        for (int m = 0; m < 4; ++m) r[ai][m] = row_rstd(part, row0 + ai * HALF + m * 16);
}
__device__ __forceinline__ unsigned pk_fp8x4(float a, float b, float c, float d) {
    a = __builtin_amdgcn_fmed3f(a, -448.f, 448.f); b = __builtin_amdgcn_fmed3f(b, -448.f, 448.f); c = __builtin_amdgcn_fmed3f(c, -448.f, 448.f); d = __builtin_amdgcn_fmed3f(d, -448.f, 448.f);
    unsigned w = 0u; w = __builtin_amdgcn_cvt_pk_fp8_f32(a, b, w, false); w = __builtin_amdgcn_cvt_pk_fp8_f32(c, d, w, true); return w;
}
__device__ __forceinline__ unsigned pk_i8x4(float a, float b, float c, float d) {
    const int ia = (int)__builtin_rintf(__builtin_amdgcn_fmed3f(a, -127.f, 127.f)), ib = (int)__builtin_rintf(__builtin_amdgcn_fmed3f(b, -127.f, 127.f));
    const int ic = (int)__builtin_rintf(__builtin_amdgcn_fmed3f(c, -127.f, 127.f)), id = (int)__builtin_rintf(__builtin_amdgcn_fmed3f(d, -127.f, 127.f));
    return ((unsigned)ia & 255u) | (((unsigned)ib & 255u) << 8) | (((unsigned)ic & 255u) << 16) | ((unsigned)id << 24);
}

template <int MODE> struct EpiGated {
    static constexpr bool PERM = true, AFTER_DRAIN = false;
    bf16_t* O; int ldo; const float* bias; int bias_half; const float* part; float descale, out_scale;
    mutable float r8c[2][4]; mutable int pmc; PG8_LAS unsigned char* stg;
    __device__ __forceinline__ void operator()(const f32x4 (&acc)[2][2][4][2], const Unit& u, int wr, int wc, int fr, int fq) const {
        const int row0 = u.pm * BM + wr * 64 + fr, col0 = u.pn * 128 + wc * 32 + 8 * fq;
        const int lane = fq * 16 + fr, colw = u.pn * 128 + wc * 32; PG8_LAS unsigned char* W = stg + (wr * 4 + wc) * 1536;
        f32x4 ba[2], bg[2];
#pragma unroll
        for (int n = 0; n < 2; ++n) { if (MODE == 0) { ba[n] = *(const f32x4*)(bias + col0 + 4 * n); bg[n] = *(const f32x4*)(bias + bias_half + col0 + 4 * n); } else { ba[n] = (f32x4){0.f, 0.f, 0.f, 0.f}; bg[n] = ba[n]; } }
        if ((MODE == 1 || MODE == 4) && u.pm != pmc) { row_rstd8(part, row0, r8c); pmc = u.pm; }
#pragma unroll
        for (int ai = 0; ai < 2; ++ai)
#pragma unroll
            for (int m = 0; m < 4; ++m) { const int row = row0 + ai * HALF + m * 16;
                float r = 1.f; if (MODE == 1 || MODE == 4) r = r8c[ai][m];
                f32x4 o[2];
#pragma unroll
                for (int n = 0; n < 2; ++n) { f32x4 a = acc[ai][0][m][n], g = acc[ai][1][m][n];
                    if (MODE == 0) { a = a * descale + ba[n]; g = g * descale + bg[n];
#pragma unroll
                        for (int e = 0; e < 4; ++e) o[n][e] = a[e] * fast_sigmoid(g[e]); }
                    else if (MODE == 3) {
                        const float c1 = -1.4426950408889634f * descale, c2 = descale * descale * out_scale;
#pragma unroll
                        for (int e = 0; e < 4; ++e) o[n][e] = (a[e] * g[e]) * __builtin_amdgcn_rcpf(1.0f + __builtin_amdgcn_exp2f(a[e] * c1)) * c2; }
                    else { if (MODE == 1) { a = a * (r * descale); g = g * (r * descale); } if (MODE == 4) { a = a * (r * descale); g = g * (r * descale * out_scale); }
#pragma unroll
                        for (int e = 0; e < 4; ++e) o[n][e] = a[e] * fast_sigmoid(a[e]) * g[e]; } }
                if (MODE == 3 || MODE == 4) { u32x2 w; w.x = pk_fp8x4(o[0][0], o[0][1], o[0][2], o[0][3]); w.y = pk_fp8x4(o[1][0], o[1][1], o[1][2], o[1][3]);
                    *(PG8_LAS u32x2*)(W + ((m & 1) * 16 + fr) * 48 + fq * 8) = w;
                    if (m & 1) { __builtin_amdgcn_wave_barrier();
                        const int rr = lane >> 1, pp = lane & 1; const u32x4 ov = *(const PG8_LAS u32x4*)(W + rr * 48 + pp * 16);
                        *(u32x4*)((unsigned char*)O + (size_t)(row - fr - 16 + rr) * ldo + colw + pp * 16) = ov;
                        __builtin_amdgcn_wave_barrier(); } }
                else { u32x4 w; w.x = cvt_pk_bf16(o[0][0], o[0][1]); w.y = cvt_pk_bf16(o[0][2], o[0][3]); w.z = cvt_pk_bf16(o[1][0], o[1][1]); w.w = cvt_pk_bf16(o[1][2], o[1][3]);
                    *(PG8_LAS u32x4*)(W + fr * 80 + fq * 16) = w;
                    __builtin_amdgcn_wave_barrier();
                    const int rr = lane >> 2, pp = lane & 3; const u32x4 ov = *(const PG8_LAS u32x4*)(W + rr * 80 + pp * 16);
                    *(u32x4*)(O + (size_t)(row - fr + rr) * ldo + colw + pp * 8) = ov;
                    __builtin_amdgcn_wave_barrier(); }
                }
    }
};
typedef _Float16 h16x4 __attribute__((ext_vector_type(4)));
typedef _Float16 h16x8 __attribute__((ext_vector_type(8)));
typedef float f32x8 __attribute__((ext_vector_type(8)));
template <bool BIAS, bool AUX, int XB8 = 0, int RIN = 0, int ROUT = 0> struct EpiResid {
    static constexpr bool PERM = true, AFTER_DRAIN = false;
    static_assert(ROUT == 1 && (!AUX || XB8 != 0), "the staged epilogue writes fp16 rows and 1-byte copies");
    const float* resid; float* out; const float* bias; unsigned char* xb; float* part; float descale, xb_scale; PG8_LAS float* red; PG8_LAS unsigned char* stg;
    __device__ __forceinline__ void operator()(const f32x4 (&acc)[2][2][4][2], const Unit& u, int wr, int wc, int fr, int fq) const {
        const int colw = u.pn * BM + wc * 32, col0 = colw + 8 * fq, lane = fq * 16 + fr;
        const int s4 = lane >> 2, p4 = lane & 3, s8 = lane >> 3, p8 = lane & 7;
        PG8_LAS unsigned char* W = stg + (wr * 4 + wc) * 2304;
        f32x4 bv[2][2];
#pragma unroll
        for (int bj = 0; bj < 2; ++bj)
#pragma unroll
            for (int n = 0; n < 2; ++n) bv[bj][n] = BIAS ? *(const f32x4*)(bias + col0 + bj * HALF + n * 4) : (f32x4){0.f, 0.f, 0.f, 0.f};
#pragma unroll
        for (int ai = 0; ai < 2; ++ai) {
            const int rowh = u.pm * BM + wr * 64 + ai * HALF;
            u32x4 rl[4][RIN ? 2 : 4];
#pragma unroll
            for (int m = 0; m < 4; ++m)
#pragma unroll
                for (int bj = 0; bj < 2; ++bj) {
                    if (RIN) rl[m][bj] = *(const u32x4*)((const _Float16*)resid + (size_t)(rowh + m * 16 + s4) * 1024 + colw + bj * HALF + p4 * 8);
                    else { rl[m][bj * 2] = *(const u32x4*)(resid + (size_t)(rowh + m * 16 + s8) * 1024 + colw + bj * HALF + p8 * 4); rl[m][bj * 2 + 1] = *(const u32x4*)(resid + (size_t)(rowh + m * 16 + s8 + 8) * 1024 + colw + bj * HALF + p8 * 4); } }
#pragma unroll
            for (int m = 0; m < 4; ++m) { const int rowg = rowh + m * 16; float ss = 0.f;
                f32x4 r[2][2];
                if (RIN) {
                    *(PG8_LAS u32x4*)(W + s4 * 144 + p4 * 16) = rl[m][0]; *(PG8_LAS u32x4*)(W + s4 * 144 + 64 + p4 * 16) = rl[m][1];
                    __builtin_amdgcn_wave_barrier();
#pragma unroll
                    for (int bj = 0; bj < 2; ++bj) { const f32x8 r8 = __builtin_convertvector(*(const PG8_LAS h16x8*)(W + fr * 144 + bj * 64 + fq * 16), f32x8); r[bj][0] = (f32x4){r8[0], r8[1], r8[2], r8[3]}; r[bj][1] = (f32x4){r8[4], r8[5], r8[6], r8[7]}; }
                    __builtin_amdgcn_wave_barrier();
                } else {
#pragma unroll
                    for (int bj = 0; bj < 2; ++bj) {
                        *(PG8_LAS u32x4*)(W + s8 * 144 + p8 * 16) = rl[m][bj * 2]; *(PG8_LAS u32x4*)(W + (s8 + 8) * 144 + p8 * 16) = rl[m][bj * 2 + 1];
                        __builtin_amdgcn_wave_barrier();
                        r[bj][0] = *(const PG8_LAS f32x4*)(W + fr * 144 + fq * 32); r[bj][1] = *(const PG8_LAS f32x4*)(W + fr * 144 + fq * 32 + 16);
                        __builtin_amdgcn_wave_barrier(); }
                }
                f32x4 x[2][2];
#pragma unroll
                for (int bj = 0; bj < 2; ++bj)
#pragma unroll
                    for (int n = 0; n < 2; ++n) { x[bj][n] = r[bj][n] + acc[ai][bj][m][n] * descale + bv[bj][n]; const f32x4 q = x[bj][n]; ss += (q[0] * q[0] + q[1] * q[1]) + (q[2] * q[2] + q[3] * q[3]); }
#pragma unroll
                for (int bj = 0; bj < 2; ++bj) { const f32x8 x8 = {x[bj][0][0], x[bj][0][1], x[bj][0][2], x[bj][0][3], x[bj][1][0], x[bj][1][1], x[bj][1][2], x[bj][1][3]}; *(PG8_LAS h16x8*)(W + fr * 144 + bj * 64 + fq * 16) = __builtin_convertvector(x8, h16x8); }
                __builtin_amdgcn_wave_barrier();
#pragma unroll
                for (int bj = 0; bj < 2; ++bj) *(u32x4*)((_Float16*)out + (size_t)(rowg + s4) * 1024 + colw + bj * HALF + p4 * 8) = *(const PG8_LAS u32x4*)(W + s4 * 144 + bj * 64 + p4 * 16);
                __builtin_amdgcn_wave_barrier();
                if (AUX) {
#pragma unroll
                    for (int bj = 0; bj < 2; ++bj) { u32x2 w;
                        if (XB8 == 1) { w.x = pk_fp8x4(x[bj][0][0] * xb_scale, x[bj][0][1] * xb_scale, x[bj][0][2] * xb_scale, x[bj][0][3] * xb_scale); w.y = pk_fp8x4(x[bj][1][0] * xb_scale, x[bj][1][1] * xb_scale, x[bj][1][2] * xb_scale, x[bj][1][3] * xb_scale); }
                        else { w.x = pk_i8x4(x[bj][0][0] * xb_scale, x[bj][0][1] * xb_scale, x[bj][0][2] * xb_scale, x[bj][0][3] * xb_scale); w.y = pk_i8x4(x[bj][1][0] * xb_scale, x[bj][1][1] * xb_scale, x[bj][1][2] * xb_scale, x[bj][1][3] * xb_scale); }
                        *(PG8_LAS u32x2*)(W + fr * 80 + bj * 32 + fq * 8) = w; }
                    __builtin_amdgcn_wave_barrier();
                    *(u32x4*)(xb + (size_t)(rowg + s4) * 1024 + colw + (p4 >> 1) * HALF + (p4 & 1) * 16) = *(const PG8_LAS u32x4*)(W + s4 * 80 + (p4 >> 1) * 32 + (p4 & 1) * 16);
                    __builtin_amdgcn_wave_barrier();
                    ss += __shfl_xor(ss, 16); ss += __shfl_xor(ss, 32); if (fq == 0) red[(ai * HALF + wr * 64 + m * 16 + fr) * 4 + wc] = ss; }
            }
        }
        if (AUX) {
            __syncthreads();
            const int t = ((wr * 4 + wc) << 6) | (fq * 16 + fr);
            if (t < BM) { const f32x4 q = *(const PG8_LAS f32x4*)(red + t * 4); part[(size_t)(u.pm * BM + t) * 4 + u.pn] = (q[0] + q[1]) + (q[2] + q[3]); }
            __syncthreads();
        }
    }
};
struct EpiQKV {
    static constexpr bool PERM = true, AFTER_DRAIN = false;
    bf16_t* Kb; size_t kvq_stride; const float* part; const float* kgain; const float* qgain; float qscale, descale;
    mutable float r8c[2][4]; mutable int pmc; PG8_LAS unsigned char* stg;
    __device__ __forceinline__ void operator()(const f32x4 (&acc)[2][2][4][2], const Unit& u, int wr, int wc, int fr, int fq) const {
        const int kind = u.pn >> 2, head = (u.pn & 3) * 4 + wc;
        bf16_t* dst = Kb + (size_t)kind * kvq_stride;
        const float* gsrc = kind == 0 ? kgain : qgain; const float gs = kind == 2 ? qscale : 1.f;
        const int row0 = u.pm * BM + wr * 64 + fr, colb = head * 64 + 8 * fq; (void)colb;
        PG8_LAS unsigned char* ws_ = stg + (wr * 4 + wc) * 2304;
        f32x4 gv[2][2];
#pragma unroll
        for (int bj = 0; bj < 2; ++bj)
#pragma unroll
            for (int n = 0; n < 2; ++n) gv[bj][n] = *(const f32x4*)(gsrc + 32 * bj + 8 * fq + 4 * n) * gs;
        if (u.pm != pmc) { row_rstd8(part, row0, r8c); pmc = u.pm; }
#pragma unroll
        for (int ai = 0; ai < 2; ++ai)
#pragma unroll
            for (int m = 0; m < 4; ++m) { const int row = row0 + ai * HALF + m * 16; const float r = r8c[ai][m] * descale;
                f32x4 v[2][2]; float ss = 0.f;
#pragma unroll
                for (int bj = 0; bj < 2; ++bj)
#pragma unroll
                    for (int n = 0; n < 2; ++n) { v[bj][n] = acc[ai][bj][m][n] * r; const f32x4 x = v[bj][n]; ss += (x[0] * x[0] + x[1] * x[1]) + (x[2] * x[2] + x[3] * x[3]); }
                ss += __shfl_xor(ss, 16); ss += __shfl_xor(ss, 32);
                if (kind != 1) { const float inv = __builtin_amdgcn_rsqf(ss * (1.0f / 64.0f) + 1e-6f);
#pragma unroll
                    for (int bj = 0; bj < 2; ++bj)
#pragma unroll
                        for (int n = 0; n < 2; ++n) v[bj][n] = v[bj][n] * gv[bj][n] * inv; }
#pragma unroll
                for (int bj = 0; bj < 2; ++bj) { u32x4 w; w.x = cvt_pk_bf16(v[bj][0][0], v[bj][0][1]); w.y = cvt_pk_bf16(v[bj][0][2], v[bj][0][3]); w.z = cvt_pk_bf16(v[bj][1][0], v[bj][1][1]); w.w = cvt_pk_bf16(v[bj][1][2], v[bj][1][3]);
                    *(PG8_LAS u32x4*)(ws_ + fr * 144 + bj * 64 + fq * 16) = w; }
                { const int l = fq * 16 + fr, rr = l >> 3, cc = l & 7; const int rowb = row - fr;
                  const u32x4 o0 = *(const PG8_LAS u32x4*)(ws_ + rr * 144 + cc * 16), o1 = *(const PG8_LAS u32x4*)(ws_ + (rr + 8) * 144 + cc * 16);
                  *(u32x4*)(dst + (size_t)(rowb + rr) * 1024 + head * 64 + cc * 8) = o0; *(u32x4*)(dst + (size_t)(rowb + rr + 8) * 1024 + head * 64 + cc * 8) = o1; }
                __builtin_amdgcn_sched_barrier(0); }
    }
};
struct EpiMoeDown {
    static constexpr bool PERM = true, AFTER_DRAIN = false;
    unsigned char* Y; const float* rowgate; float descale;
    template <bool ADD> __device__ __forceinline__ void run(const f32x4 (&acc)[2][2][4][2], const Unit& u, int wr, int wc, int fr, int fq, const PG8_GAS u32x2* sl) const {
        const int rt0 = u.pm * BM + wr * 64 + fr, col0 = u.pn * BM + wc * 32 + 8 * fq;
        float gtv[2][4];
#pragma unroll
        for (int ai = 0; ai < 2; ++ai)
#pragma unroll
            for (int m = 0; m < 4; ++m) gtv[ai][m] = rowgate[rt0 + ai * HALF + m * 16] * descale;
#pragma unroll
        for (int ai = 0; ai < 2; ++ai) {
#pragma unroll
            for (int m = 0; m < 4; ++m) { const float gt = gtv[ai][m]; unsigned char* p = Y + (size_t)(rt0 + ai * HALF + m * 16) * 1024 + col0;
#pragma unroll
                for (int bj = 0; bj < 2; ++bj) { f32x4 s0 = acc[ai][bj][m][0], s1 = acc[ai][bj][m][1];
                    if (ADD) { const u32x2 q0 = sl[bj * 2 + 0], q1 = sl[bj * 2 + 1];
                        s0[0] += __uint_as_float(q0.x << 16); s0[1] += __uint_as_float(q0.x & 0xffff0000u); s0[2] += __uint_as_float(q0.y << 16); s0[3] += __uint_as_float(q0.y & 0xffff0000u);
                        s1[0] += __uint_as_float(q1.x << 16); s1[1] += __uint_as_float(q1.x & 0xffff0000u); s1[2] += __uint_as_float(q1.y << 16); s1[3] += __uint_as_float(q1.y & 0xffff0000u); }
                    s0 = s0 * gt; s1 = s1 * gt;
                    u32x2 w; w.x = pk_i8x4(s0[0], s0[1], s0[2], s0[3]); w.y = pk_i8x4(s1[0], s1[1], s1[2], s1[3]);
                    *(u32x2*)(p + bj * HALF) = w; }
                if (ADD) { sl += 512 * 4; asm volatile("" : "+v"(sl)); } }
            asm volatile("" ::: "memory"); }
    }
    __device__ __forceinline__ void operator()(const f32x4 (&acc)[2][2][4][2], const Unit& u, int wr, int wc, int fr, int fq) const { run<false>(acc, u, wr, wc, fr, fq, nullptr); }
};

template <class Epi, class Sched, bool GATHER, int PREC = 0>
__device__ __forceinline__ void gemm_phase(PG8_LAS unsigned char* lds, const Gemm g, const Sched& S, const Epi& E, const int tid) {
    constexpr bool FP8 = (PREC == 1), I8 = (PREC == 2), BYTE1 = (PREC != 0);
    const int wid = __builtin_amdgcn_readfirstlane(tid >> 6), lane = tid & 63, wr = wid >> 2, wc = wid & 3, fr = lane & 15, fq = lane >> 4;
    const int K = g.K;
    const int rowb = BYTE1 ? K : 2 * K;
    unsigned voffB[2]; unsigned vC0[2], vC1[2], vN0[2], vN1[2]; int Rr[2], Cc[2];
#pragma unroll
    for (int i = 0; i < 2; ++i) { int R, C; stage_rc(tid * 16 + i * 8192, R, C); const int Rb = Epi::PERM ? ((R & ~31) + perm32(R & 31)) : R;
        Rr[i] = R; Cc[i] = C; vC0[i] = (unsigned)(R * rowb + C * 2); vC1[i] = vC0[i]; vN0[i] = vC0[i]; vN1[i] = vC0[i]; voffB[i] = (unsigned)(Rb * rowb + C * 2); }
    const size_t kstep = (size_t)(BK * 2);
    const size_t hstep = (size_t)HALF * rowb;
    const size_t hstepA = GATHER ? 0 : hstep;
    const size_t tstep = 2 * hstep;
    const unsigned ldsw = (unsigned)wid * 1024u;
    const int aoff = lds_byte(wr * 64 + fr, fq * 8), boff = lds_byte(wc * 32 + fr, fq * 8);
#define PG8_SA(b, h) (((b) * 2 + (h)) * HTB)
#define PG8_SB(b, h) ((4 + (b) * 2 + (h)) * HTB)
#define PG8_STAGE(bufoff, gbase, v0, v1) do { \
        __builtin_amdgcn_global_load_lds((const unsigned*)((const char*)(gbase) + (v0)), (PG8_LAS unsigned*)(lds + (bufoff) + ldsw), 16, 0, 0); \
        __builtin_amdgcn_global_load_lds((const unsigned*)((const char*)(gbase) + (v1)), (PG8_LAS unsigned*)(lds + (bufoff) + ldsw + 8192), 16, 0, 0); } while (0)
#define PG8_LD8(addr) __builtin_shufflevector(*(const PG8_LAS v4i_t*)(addr), *(const PG8_LAS v4i_t*)((addr) + 1024), 0, 1, 2, 3, 4, 5, 6, 7)
#define PG8_LDA(dst, b, h) do { if (FP8) { _Pragma("unroll") for (int m = 0; m < 4; ++m) dst##8[m] = PG8_LD8(lds + PG8_SA(b, h) + aoff + m * 2048); } else { \
        _Pragma("unroll") for (int m = 0; m < 4; ++m) _Pragma("unroll") for (int k = 0; k < 2; ++k) dst[m][k] = *(const PG8_LAS bf16x8*)(lds + PG8_SA(b, h) + aoff + m * 2048 + k * 1024); } } while (0)
#define PG8_LDB(dst, b, h) do { if (FP8) { _Pragma("unroll") for (int n = 0; n < 2; ++n) dst##8[n] = PG8_LD8(lds + PG8_SB(b, h) + boff + n * 2048); } else { \
        _Pragma("unroll") for (int n = 0; n < 2; ++n) _Pragma("unroll") for (int k = 0; k < 2; ++k) dst[n][k] = *(const PG8_LAS bf16x8*)(lds + PG8_SB(b, h) + boff + n * 2048 + k * 1024); } } while (0)
#if defined(PROBE_HALF_MFMA)
#define PG8_SKIP(ai) ((ai) == 1 && cur.part == 3)
#else
#define PG8_SKIP(ai) false
#endif
#define PG8_MMA(ai, bj, At, Bt) do { if (PG8_SKIP(ai)) break; __builtin_amdgcn_s_setprio(1); _Pragma("unroll") for (int m = 0; m < 4; ++m) _Pragma("unroll") for (int n = 0; n < 2; ++n) { \
        if (FP8) asm volatile("v_mfma_scale_f32_16x16x128_f8f6f4 %0, %1, %2, %0, %3, %3 op_sel_hi:[0,0,0]" : "+v"(acc[ai][bj][m][n]) : "v"(Bt##8[n]), "v"(At##8[m]), "v"(sc1)); \
        else if (I8) { _Pragma("unroll") for (int k = 0; k < 2; ++k) acc[ai][bj][m][n] = __builtin_bit_cast(f32x4, __builtin_amdgcn_mfma_i32_16x16x64_i8(__builtin_bit_cast(v4i_t, Bt[n][k]), __builtin_bit_cast(v4i_t, At[m][k]), __builtin_bit_cast(v4i_t, acc[ai][bj][m][n]), 0, 0, 0)); } \
        else { _Pragma("unroll") for (int k = 0; k < 2; ++k) acc[ai][bj][m][n] = __builtin_amdgcn_mfma_f32_16x16x32_bf16(Bt[n][k], At[m][k], acc[ai][bj][m][n], 0, 0, 0); } } __builtin_amdgcn_s_setprio(0); } while (0)
#define PG8_WAIT_V(n) asm volatile("s_waitcnt vmcnt(" #n ")" ::: "memory")
#define PG8_WAIT_L(n) asm volatile("s_waitcnt lgkmcnt(" #n ")" ::: "memory")
#define PG8_BAR __builtin_amdgcn_s_barrier()
#define PG8_SCHED __builtin_amdgcn_sched_barrier(0)
#define PG8_TOKOFF(pm_, h_, i_) ({ int t_ = g.rowtok[(pm_) * BM + (h_) * HALF + Rr[i_]]; t_ = t_ < 0 ? 0 : t_; (unsigned)(t_ * rowb + Cc[i_] * 2); })
    unsigned sc1 = 0u; if (FP8) asm volatile("v_mov_b32 %0, 0x7f7f7f7f" : "=v"(sc1));
    Unit cur, nxt; int ui = 0;
    if (!S.next(0, cur)) return;
    f32x4 acc[2][2][4][2];
#pragma unroll
    for (int a = 0; a < 2; ++a)
#pragma unroll
        for (int b = 0; b < 2; ++b)
#pragma unroll
            for (int m = 0; m < 4; ++m)
#pragma unroll
                for (int n = 0; n < 2; ++n) acc[a][b][m][n] = (f32x4){0.f, 0.f, 0.f, 0.f};
    bf16x8 At[4][2], B0[2][2], B1[2][2]; v8i_t At8[4], B08[2], B18[2];
    if (GATHER) {
#pragma unroll
        for (int i = 0; i < 2; ++i) { vC0[i] = PG8_TOKOFF(cur.pm, 0, i); vC1[i] = PG8_TOKOFF(cur.pm, 1, i); }
    }
    const char* cA = (GATHER ? (const char*)g.A : (const char*)g.A + (size_t)cur.pm * tstep) + (size_t)cur.kt0 * kstep;
    const char* cB = (const char*)g.Bt + (size_t)cur.be * g.bstride + (size_t)cur.pn * tstep + (size_t)cur.kt0 * kstep;
    PG8_STAGE(PG8_SB(0, 0), cB, voffB[0], voffB[1]); PG8_STAGE(PG8_SB(0, 1), cB + hstep, voffB[0], voffB[1]); PG8_STAGE(PG8_SA(0, 0), cA, vC0[0], vC0[1]); PG8_STAGE(PG8_SA(0, 1), cA + hstepA, vC1[0], vC1[1]);
    if (wr == 1) PG8_BAR;
    PG8_WAIT_V(2); PG8_BAR;
    PG8_STAGE(PG8_SB(1, 0), cB + kstep, voffB[0], voffB[1]); PG8_STAGE(PG8_SA(1, 0), cA + kstep, vC0[0], vC0[1]); PG8_STAGE(PG8_SB(1, 1), cB + hstep + kstep, voffB[0], voffB[1]);
    PG8_WAIT_V(6); PG8_BAR;
    for (;;) {
        const bool has_next = S.next(ui + 1, nxt);
        const char* nA = has_next ? (GATHER ? (const char*)g.A : (const char*)g.A + (size_t)nxt.pm * tstep) + (size_t)nxt.kt0 * kstep : cA;
        const char* nB = has_next ? (const char*)g.Bt + (size_t)nxt.be * g.bstride + (size_t)nxt.pn * tstep + (size_t)nxt.kt0 * kstep : cB;
        if (GATHER) {
            if (has_next && nxt.pm != cur.pm) {
#pragma unroll
                for (int i = 0; i < 2; ++i) { vN0[i] = PG8_TOKOFF(nxt.pm, 0, i); vN1[i] = PG8_TOKOFF(nxt.pm, 1, i); }
            } else {
#pragma unroll
                for (int i = 0; i < 2; ++i) { vN0[i] = vC0[i]; vN1[i] = vC1[i]; }
            }
        }
        const int nkt = cur.nkt;
        for (int t = 0; t < nkt; t += 2) {
            const bool last = (t == nkt - 2);
            const char* a1 = cA + (size_t)(t + 1) * kstep;
            const char* a2 = last ? nA : cA + (size_t)(t + 2) * kstep; const char* b2 = last ? nB : cB + (size_t)(t + 2) * kstep;
            const char* a3 = a2 + kstep; const char* b3 = b2 + kstep;
            const unsigned x00 = (GATHER && last) ? vN0[0] : vC0[0], x01 = (GATHER && last) ? vN0[1] : vC0[1], x10 = (GATHER && last) ? vN1[0] : vC1[0], x11 = (GATHER && last) ? vN1[1] : vC1[1];
            PG8_LDB(B0, 0, 0); PG8_LDB(B1, 0, 1); PG8_SCHED; PG8_LDA(At, 0, 0); PG8_STAGE(PG8_SA(1, 1), a1 + hstepA, vC1[0], vC1[1]);
            PG8_WAIT_V(8); PG8_WAIT_L(0); PG8_BAR; PG8_MMA(0, 0, At, B0); PG8_MMA(0, 1, At, B1); PG8_BAR; PG8_SCHED;
            PG8_LDA(At, 0, 1); PG8_STAGE(PG8_SB(0, 0), b2, voffB[0], voffB[1]); PG8_STAGE(PG8_SB(0, 1), b2 + hstep, voffB[0], voffB[1]); PG8_STAGE(PG8_SA(0, 0), a2, x00, x01);
            PG8_WAIT_V(8); PG8_WAIT_L(0); PG8_BAR; PG8_MMA(1, 0, At, B0); PG8_MMA(1, 1, At, B1); PG8_BAR; PG8_SCHED;
            PG8_LDB(B0, 1, 0); PG8_LDB(B1, 1, 1); PG8_SCHED; PG8_LDA(At, 1, 0); PG8_STAGE(PG8_SA(0, 1), a2 + hstepA, x10, x11);
            PG8_WAIT_V(8); PG8_WAIT_L(0); PG8_BAR; PG8_MMA(0, 0, At, B0); PG8_MMA(0, 1, At, B1); PG8_BAR; PG8_SCHED;
            PG8_LDA(At, 1, 1); PG8_STAGE(PG8_SB(1, 0), b3, voffB[0], voffB[1]); PG8_STAGE(PG8_SB(1, 1), b3 + hstep, voffB[0], voffB[1]); PG8_STAGE(PG8_SA(1, 0), a3, x00, x01);
            PG8_WAIT_V(8); PG8_WAIT_L(0); PG8_BAR; PG8_MMA(1, 0, At, B0); PG8_MMA(1, 1, At, B1); PG8_BAR; PG8_SCHED;
        }
        if (wr == 0) PG8_BAR;
        if (FP8) { asm volatile("s_nop 15\n\ts_nop 15" ::: "memory");
#pragma unroll
            for (int a = 0; a < 2; ++a)
#pragma unroll
                for (int b = 0; b < 2; ++b)
#pragma unroll
                    for (int m = 0; m < 4; ++m)
#pragma unroll
                        for (int n = 0; n < 2; ++n) asm volatile("" : "+v"(acc[a][b][m][n])); }
        if (I8) {
#pragma unroll
            for (int a = 0; a < 2; ++a)
#pragma unroll
                for (int b = 0; b < 2; ++b)
#pragma unroll
                    for (int m = 0; m < 4; ++m)
#pragma unroll
                        for (int n = 0; n < 2; ++n) { const v4i_t q = __builtin_bit_cast(v4i_t, acc[a][b][m][n]); acc[a][b][m][n] = (f32x4){(float)q[0], (float)q[1], (float)q[2], (float)q[3]}; } }
        if (g.noepi) {} else
        if constexpr (Sched::STREAMK) {
            if (cur.part == 1) {
                PG8_GAS u32x2* sl = (PG8_GAS u32x2*)g.slab + (size_t)S.wg() * (32 * 512) + tid * 4;
#pragma unroll
                for (int a = 0; a < 2; ++a)
#pragma unroll
                    for (int m = 0; m < 4; ++m) {
#pragma unroll
                        for (int b = 0; b < 2; ++b)
#pragma unroll
                            for (int n = 0; n < 2; ++n) { u32x2 w; w.x = cvt_pk_bf16(acc[a][b][m][n][0], acc[a][b][m][n][1]); w.y = cvt_pk_bf16(acc[a][b][m][n][2], acc[a][b][m][n][3]); sl[b * 2 + n] = w; }
                        sl += 512 * 4; asm volatile("" : "+v"(sl)); }
                asm volatile("s_waitcnt vmcnt(0)" ::: "memory");
                __syncthreads();
                if (tid == 0) { __builtin_amdgcn_fence(__ATOMIC_RELEASE, "agent"); asm volatile("s_waitcnt vmcnt(0)" ::: "memory");
                    __hip_atomic_store(g.skflag + 16 * S.wg(), 1u, __ATOMIC_RELAXED, __HIP_MEMORY_SCOPE_AGENT); }
            } else if (cur.part == 2) {
                if (wid == 0) { unsigned sp = 0;
                    while (__hip_atomic_load(g.skflag + 16 * (S.wg() + 1), __ATOMIC_RELAXED, __HIP_MEMORY_SCOPE_AGENT) == 0u) { __builtin_amdgcn_s_sleep(2);
                        if (++sp > (1u << 22)) { if (lane == 0) __hip_atomic_store(g.tmo, 1u, __ATOMIC_RELAXED, __HIP_MEMORY_SCOPE_AGENT); break; } }
                    __builtin_amdgcn_fence(__ATOMIC_ACQUIRE, "agent"); }
                asm volatile("s_waitcnt vmcnt(0)" ::: "memory");
                __syncthreads();
                E.template run<true>(acc, cur, wr, wc, fr, fq, (const PG8_GAS u32x2*)g.slab + (size_t)(S.wg() + 1) * (32 * 512) + tid * 4);
            } else { if (cur.part != 3) E(acc, cur, wr, wc, fr, fq); }
        } else { if (cur.part != 3) E(acc, cur, wr, wc, fr, fq); }
        if (!has_next) break;
#pragma unroll
        for (int a = 0; a < 2; ++a)
#pragma unroll
            for (int b = 0; b < 2; ++b)
#pragma unroll
                for (int m = 0; m < 4; ++m)
#pragma unroll
                    for (int n = 0; n < 2; ++n) acc[a][b][m][n] = (f32x4){0.f, 0.f, 0.f, 0.f};
        cur = nxt; cA = nA; cB = nB; ++ui;
        if (GATHER) {
#pragma unroll
            for (int i = 0; i < 2; ++i) { vC0[i] = vN0[i]; vC1[i] = vN1[i]; }
        }
        if (wr == 1) PG8_BAR;
    }
    PG8_WAIT_V(0);
    PG8_BAR;
#undef PG8_SA
#undef PG8_SB
#undef PG8_STAGE
#undef PG8_LDA
#undef PG8_LDB
#undef PG8_MMA
#undef PG8_LD8
#undef PG8_WAIT_V
#undef PG8_WAIT_L
#undef PG8_BAR
#undef PG8_SCHED
#undef PG8_TOKOFF
}
}
#define GAS __attribute__((address_space(1)))
#define LAS __attribute__((address_space(3)))
typedef unsigned short bf16;
typedef unsigned v4u __attribute__((ext_vector_type(4)));
typedef float f32x4 __attribute__((ext_vector_type(4)));
typedef short bf16x8 __attribute__((ext_vector_type(8)));
typedef GAS unsigned gu32;
typedef GAS unsigned long long gu64;
#define RLX_AGENT __ATOMIC_RELAXED, __HIP_MEMORY_SCOPE_AGENT
#define LDS_WAIT() asm volatile("s_waitcnt lgkmcnt(0)" ::: "memory")
#define VM_WAIT() asm volatile("s_waitcnt vmcnt(0)" ::: "memory")
__device__ __forceinline__ unsigned long long rt() { return __builtin_amdgcn_s_memrealtime(); }
__device__ __forceinline__ unsigned f2bf(float f) { unsigned u = __builtin_bit_cast(unsigned, f); return (u + 0x7fffu + ((u >> 16) & 1u)) >> 16; }
__device__ __forceinline__ unsigned pk2(float lo, float hi) { return f2bf(lo) | (f2bf(hi) << 16); }

#define XB_TMO      128
#define XB_XCNT(j)  (256  + 64 * (j))
#define XB_XSUB(j)  (1280 + 64 * (j))
#define XB_XGEN(j)  (2304 + 64 * (j))
#define XB_TOP      3328
#define XB_TOPGEN   3392
#define XCD_BAR_WORDS 3456
#define XB_SPIN_CAP (1u << 18)

__device__ __forceinline__ unsigned xb_ld(unsigned* p)              { return __hip_atomic_load(p, __ATOMIC_RELAXED, __HIP_MEMORY_SCOPE_AGENT); }
__device__ __forceinline__ unsigned xb_add(unsigned* p, unsigned v) { return __hip_atomic_fetch_add(p, v, __ATOMIC_RELAXED, __HIP_MEMORY_SCOPE_AGENT); }
__device__ __forceinline__ unsigned xb_xcc_id() { return (unsigned)__builtin_amdgcn_s_getreg((3 << 11) | 20) & 0xFu; }
#define XB_SPIN(cond, bar) do { unsigned _sp = 0; while (cond) { __builtin_amdgcn_s_sleep(1); \
    if ((++_sp & 255u) == 0u) { if (xb_ld(&(bar)[XB_TMO])) break; if (_sp > XB_SPIN_CAP) { atomicAdd(&(bar)[XB_TMO], 1u); break; } } } } while (0)

struct XcdBarrier {
    unsigned* bar; unsigned x;
    volatile LAS unsigned* st;
};

__device__ __forceinline__ XcdBarrier xcd_barrier_post(unsigned* bar, volatile LAS unsigned* st) {
    XcdBarrier b; b.bar = bar; b.x = xb_xcc_id(); b.st = st;
    if (threadIdx.x == 0) (void)xb_add(&bar[XB_XCNT(b.x)], 1u);
    return b;
}
__device__ __forceinline__ void xcd_barrier_complete(unsigned* bar, unsigned x, unsigned& nloc, unsigned& nx) {
    const unsigned G = gridDim.x * gridDim.y * gridDim.z;
    unsigned sum, cnt, mine, sp = 0u;
    for (;;) {
        sum = 0u; cnt = 0u; mine = 0u;
#pragma unroll
        for (unsigned j = 0; j < 16; ++j) { const unsigned c = xb_ld(&bar[XB_XCNT(j)]); sum += c; cnt += (c > 0u) ? 1u : 0u; mine = (j == x) ? c : mine; }
        if (sum == G) break;
        __builtin_amdgcn_s_sleep(1);
        if ((++sp & 255u) == 0u) { if (xb_ld(&bar[XB_TMO])) break; if (sp > XB_SPIN_CAP) { atomicAdd(&bar[XB_TMO], 1u); break; } }
    }
    nloc = mine > 0u ? mine : 1u; nx = cnt > 0u ? cnt : 1u;
}

__device__ __forceinline__ void xcd_barrier(const XcdBarrier& b) {
    asm volatile("s_waitcnt vmcnt(0)" ::: "memory");
    __syncthreads();
    if (threadIdx.x == 0) {
        unsigned* bar = b.bar;
        __builtin_amdgcn_s_waitcnt(0);
        unsigned nloc = b.st[0], nx = b.st[1];
        if (nloc == 0u) { xcd_barrier_complete(bar, b.x, nloc, nx); b.st[0] = nloc; b.st[1] = nx; }
        const unsigned old = xb_add(&bar[XB_XSUB(b.x)], 1u);
        const unsigned gen = old / nloc;
        if (old + 1u == (gen + 1u) * nloc) {
            __builtin_amdgcn_fence(__ATOMIC_RELEASE, "agent");
            asm volatile("s_waitcnt vmcnt(0)" ::: "memory");
            const unsigned og = xb_add(&bar[XB_TOP], 1u);
            const unsigned tg = og / nx;
            if (og + 1u == (tg + 1u) * nx) xb_add(&bar[XB_TOPGEN], 1u);
            else XB_SPIN(xb_ld(&bar[XB_TOPGEN]) == tg, bar);
            __builtin_amdgcn_fence(__ATOMIC_ACQUIRE, "agent");
            xb_add(&bar[XB_XGEN(b.x)], 1u);
            asm volatile("s_waitcnt vmcnt(0)" ::: "memory");
        } else {
            XB_SPIN(xb_ld(&bar[XB_XGEN(b.x)]) == gen, bar);
            __builtin_amdgcn_fence(__ATOMIC_ACQUIRE, "agent");
            asm volatile("s_waitcnt vmcnt(0)" ::: "memory");
        }
    }
    __syncthreads();
}

constexpr int NWAVES = 8;
constexpr int T = 32768, D = 1024, SEQ = 4096, NBATCH = 8;
constexpr int DFF = 2752, DFFP = 2816, DFFE = 3584, NEXP = 8;
constexpr int ROWCAP = 67584;
constexpr float EPS = 1e-6f;
constexpr float LOG2E = 1.4426950408889634f;
constexpr float SOFTMAX_OFS = 16.f;
constexpr float QSCALE = 0.125f * LOG2E;
#ifndef I8_P1
#define I8_P1 1
#endif
#ifndef I8_P3
#define I8_P3 0
#endif
#ifndef I8_P4
#define I8_P4 1
#endif
constexpr float SA_N = 127.f / 5.f, SA_X = 127.f / 6.f, SW_I8 = 127.f * 32.f / 4.5f;
constexpr float Y_SCALE = 127.f / 2.5f;
constexpr float W8_SCALE = 64.f, H3_SCALE = 16.f, HM_SCALE = 8.f, X8_SCALE = 16.f, HB_SCALE = 8.f, O8_SCALE = 64.f;
constexpr size_t MiB = 1u << 20;
constexpr size_t WS_CTL = 0, CTL_ZERO_BYTES = 1 * MiB;
constexpr size_t WS_PART1 = 1 * MiB, WS_PART2 = 3 * MiB, WS_LSE = 5 * MiB;
constexpr size_t WS_ROUTE = 7 * MiB, WS_GATE1 = WS_ROUTE + 128 * 1024, WS_GATE2 = WS_ROUTE + 256 * 1024, WS_WAVECNT = WS_ROUTE + 384 * 1024, WS_BLOCKCNT = WS_ROUTE + 448 * 1024, WS_GOFS = WS_ROUTE + 480 * 1024;
constexpr size_t WS_ROWTOK = 8 * MiB, WS_ROWGATE = 8 * MiB + 512 * 1024;
constexpr size_t WS_WIN = 12 * MiB, WS_WOUT = 16 * MiB, WS_WF13 = 18 * MiB, WS_WFD = 29 * MiB, WS_WQKV = 35 * MiB, WS_WO = 53 * MiB;
constexpr size_t WS_WM13 = 56 * MiB, WS_WM2 = 112 * MiB;
constexpr size_t WS_XH = 144 * MiB;
constexpr size_t WS_A0 = 224 * MiB;
constexpr size_t WS_H0 = WS_A0, WS_GLU = WS_A0 + 64 * MiB, WS_V = WS_A0 + 128 * MiB;
constexpr size_t WS_X1B = WS_A0, WS_HB = WS_A0 + 64 * MiB;
constexpr size_t WS_X2B = WS_A0, WS_KG = WS_A0 + 64 * MiB, WS_VG = WS_A0 + 128 * MiB, WS_QG = WS_A0 + 192 * MiB, WS_O = WS_A0 + 256 * MiB, WS_O8 = WS_A0 + 32 * MiB;
constexpr size_t WS_H3 = WS_A0, WS_HM = WS_A0 + 66 * MiB;
constexpr size_t WS_END = 548 * MiB;
static_assert(WS_HB + (size_t)T * DFFP * 2 <= WS_END && WS_O + (size_t)T * D * 2 <= WS_END && WS_HM + (size_t)ROWCAP * DFFE <= WS_END, "arena");
static_assert(WS_WFD + (size_t)D * DFFP * 2 <= WS_WQKV && WS_WO + (size_t)D * D * 2 <= WS_WM13 && WS_WM13 + (size_t)NEXP * 7168 * 1024 <= WS_WM2 && WS_WM2 + (size_t)NEXP * D * DFFE <= WS_XH && WS_XH + (size_t)T * D * 2 <= WS_A0, "weights");
constexpr int CW_AQ = 50000;
constexpr int CW_TMO = 0, CW_CODE = 1, CW_BAR = 4096, CW_SKFLAG = 16384;
constexpr size_t WS_SLAB = 12 * MiB;
constexpr size_t WS_POS = 9 * MiB;
constexpr size_t WS_Y = WS_A0;
static_assert(WS_SLAB + (size_t)256 * 131072 <= 56 * MiB && WS_Y + (size_t)ROWCAP * 1024 <= WS_HM, "slab / Y");

constexpr int RING_OFF = 0, RING_BYTES = 131072;
constexpr int LDSCTL_OFF = RING_BYTES, MISC_OFF = LDSCTL_OFF + 320;
constexpr int XTRA_OFF = RING_BYTES + 512;
constexpr int LDS_BYTES = 155648;

constexpr int NPHASE = 18;

__constant__ unsigned char T5_BUCKET[3][132] = {
 {0,1,2,3,4,5,6,7,8,9,10,11,12,13,14,15,16,16,16,16,16,16,17,17,17,17,17,17,17,17,18,18,18,18,18,18,18,18,18,18,19,19,19,19,19,19,19,19,19,19,19,19,19,19,20,20,20,20,20,20,20,20,20,20,20,20,20,20,20,20,20,20,20,21,21,21,21,21,21,21,21,21,21,21,21,21,21,21,21,21,21,21,21,21,21,21,21,21,21,22,22,22,22,22,22,22,22,22,22,22,22,22,22,22,22,22,22,22,22,22,22,22,22,22,22,22,22,22,22,0,0,0},
 {0,4,8,12,16,16,17,17,18,18,19,19,19,19,20,20,20,20,20,21,21,21,21,21,21,22,22,22,22,22,22,22,22,22,23,23,23,23,23,23,23,23,23,23,23,23,24,24,24,24,24,24,24,24,24,24,24,24,24,24,24,24,25,25,25,25,25,25,25,25,25,25,25,25,25,25,25,25,25,25,25,25,25,26,26,26,26,26,26,26,26,26,26,26,26,26,26,26,26,26,26,26,26,26,26,26,26,26,26,26,26,26,26,27,27,27,27,27,27,27,27,27,27,27,27,27,27,27,27,0,0,0},
 {0,16,18,19,20,21,21,22,22,23,23,23,24,24,24,24,25,25,25,25,25,26,26,26,26,26,26,26,26,27,27,27,27,27,27,27,27,27,27,28,28,28,28,28,28,28,28,28,28,28,28,28,29,29,29,29,29,29,29,29,29,29,29,29,29,29,29,29,29,29,30,30,30,30,30,30,30,30,30,30,30,30,30,30,30,30,30,30,30,30,30,30,30,30,30,31,31,31,31,31,31,31,31,31,31,31,31,31,31,31,31,31,31,31,31,31,31,31,31,31,31,31,31,31,31,31,31,31,31,0,0,0}};

typedef float f32x16 __attribute__((ext_vector_type(16)));
typedef float f32x2v __attribute__((ext_vector_type(2)));
typedef __bf16 bf16x2v __attribute__((ext_vector_type(2)));
typedef short v4i16_t __attribute__((ext_vector_type(4)));
__device__ __forceinline__ unsigned pkbf(float lo, float hi) { f32x2v v = {lo, hi}; bf16x2v b = __builtin_convertvector(v, bf16x2v); return __builtin_bit_cast(unsigned, b); }
__device__ __forceinline__ float bflo(unsigned u) { return __uint_as_float(u << 16); }
__device__ __forceinline__ float bfhi(unsigned u) { return __uint_as_float(u & 0xffff0000u); }
template <int N> __device__ __forceinline__ float dpp_row_ror(float v) { return __builtin_bit_cast(float, __builtin_amdgcn_update_dpp(0, __builtin_bit_cast(int, v), 0x120 + N, 0xf, 0xf, true)); }
__device__ __forceinline__ float wave_sum(float v) {
    v += dpp_row_ror<8>(v); v += dpp_row_ror<4>(v); v += dpp_row_ror<2>(v); v += dpp_row_ror<1>(v);
    const int b = __builtin_bit_cast(int, v);
    return (__builtin_bit_cast(float, __builtin_amdgcn_readlane(b, 0)) + __builtin_bit_cast(float, __builtin_amdgcn_readlane(b, 16))) + (__builtin_bit_cast(float, __builtin_amdgcn_readlane(b, 32)) + __builtin_bit_cast(float, __builtin_amdgcn_readlane(b, 48)));
}
__device__ __forceinline__ int crow(int r, int hi) { return (r & 3) + 8 * (r >> 2) + 4 * hi; }

struct TrDesc { const float* W; const float* gsc; unsigned char* WT; int ldw, Kp, drow0, k0, n0src, is8; float scale; };
__device__ __forceinline__ int hmap_row0(int L) { const int lc = L & 255; return (L & ~255) + 128 * ((lc >> 5) & 1) + 32 * (lc >> 6); }

constexpr int IT_MG = NEXP * 16 * 112, IT_MU = IT_MG, IT_MD = NEXP * 56 * 32, IT_WIN = 16 * 64, IT_WOUT = 16 * 32, IT_FG = 16 * 86, IT_FU = IT_FG, IT_FD = 43 * 32, IT_KV = 16 * 192, IT_Q = 16 * 96, IT_WO = 16 * 32;
constexpr int IT_MOE = IT_MG + IT_MU + IT_MD;
static_assert(IT_MOE == 3 * 256 * 56, "expert-weight items per attention phase and workgroup");
constexpr int IT_TOTAL = IT_MG + IT_MU + IT_MD + IT_WIN + IT_WOUT + IT_FG + IT_FU + IT_FD + IT_KV + IT_Q + IT_WO;
typedef const __attribute__((address_space(4))) unsigned char* kargp0_t;
#define P0IN(i) (*(const float* const __attribute__((address_space(4)))*)(kp + 8 * (i)))
__device__ __forceinline__ void tr_desc(int it, kargp0_t kp, unsigned char* ws, TrDesc& d) {
    int r = it; d.gsc = nullptr; d.is8 = 2; d.scale = SW_I8; d.Kp = 1024;
    if (r < IT_MG) { const int e = r / 1792, rr = r % 1792, j = (rr % 112) * 32; d.W = P0IN(23) + (size_t)e * D * DFFE; d.ldw = DFFE; d.WT = ws + WS_WM13 + (size_t)e * 7168 * 1024; d.drow0 = 256 * (j >> 7) + (j & 127); d.k0 = (rr / 112) * 64; d.n0src = j; return; } r -= IT_MG;
    if (r < IT_MU) { const int e = r / 1792, rr = r % 1792, j = (rr % 112) * 32; d.W = P0IN(24) + (size_t)e * D * DFFE; d.ldw = DFFE; d.WT = ws + WS_WM13 + (size_t)e * 7168 * 1024; d.drow0 = 256 * (j >> 7) + 128 + (j & 127); d.k0 = (rr / 112) * 64; d.n0src = j; return; } r -= IT_MU;
    if (r < IT_MD) { const int e = r / 1792, rr = r % 1792, j = (rr % 32) * 32; d.W = P0IN(25) + (size_t)e * DFFE * D; d.ldw = D; d.WT = ws + WS_WM2 + (size_t)e * 1024 * DFFE; d.Kp = DFFE; d.is8 = 1; d.scale = W8_SCALE; d.drow0 = j; d.k0 = (rr / 32) * 64; d.n0src = j; return; } r -= IT_MD;
    if (r < IT_KV) { const int c = (r % 192) * 32, kvsel = c / 3072, cg = c % 3072, g = cg >> 10, hc = cg & 1023, L = kvsel * 1024 + hc; d.W = P0IN(12); d.ldw = 6144; d.gsc = P0IN(11); d.WT = ws + WS_WQKV + (size_t)g * 3072 * 1024; d.drow0 = hmap_row0(L); d.k0 = (r / 192) * 64; d.n0src = c; return; } r -= IT_KV;
    if (r < IT_Q) { const int c = (r % 96) * 32, g = c >> 10, hc = c & 1023, L = 2048 + hc; d.W = P0IN(15); d.ldw = 3072; d.gsc = P0IN(14); d.WT = ws + WS_WQKV + (size_t)g * 3072 * 1024; d.drow0 = hmap_row0(L); d.k0 = (r / 96) * 64; d.n0src = c; return; } r -= IT_Q;
    if (r < IT_WIN) { const int c = (r % 64) * 32, sel = c >> 10, j = c & 1023; d.W = P0IN(3); d.ldw = 2048; d.WT = ws + WS_WIN; if (!I8_P1) { d.is8 = 0; d.scale = 1.f; } d.drow0 = 256 * (j >> 7) + 128 * sel + (j & 127); d.k0 = (r / 64) * 64; d.n0src = c; return; } r -= IT_WIN;
    if (r < IT_WOUT) { const int j = (r % 32) * 32; d.W = P0IN(9); d.ldw = 1024; d.WT = ws + WS_WOUT; if (!I8_P3) { d.is8 = 0; d.scale = 1.f; } d.drow0 = j; d.k0 = (r / 32) * 64; d.n0src = j; return; } r -= IT_WOUT;
    if (r < IT_FG) { const int j = (r % 86) * 32; d.W = P0IN(19); d.ldw = DFF; d.gsc = P0IN(18); d.WT = ws + WS_WF13; if (!I8_P4) { d.is8 = 0; d.scale = 1.f; } d.drow0 = 256 * (j >> 7) + (j & 127); d.k0 = (r / 86) * 64; d.n0src = j; return; } r -= IT_FG;
    if (r < IT_FU) { const int j = (r % 86) * 32; d.W = P0IN(20); d.ldw = DFF; d.gsc = P0IN(18); d.WT = ws + WS_WF13; if (!I8_P4) { d.is8 = 0; d.scale = 1.f; } d.drow0 = 256 * (j >> 7) + 128 + (j & 127); d.k0 = (r / 86) * 64; d.n0src = j; return; } r -= IT_FU;
    if (r < IT_FD) { const int j = (r % 32) * 32; d.W = P0IN(21); d.ldw = 1024; d.WT = ws + WS_WFD; d.Kp = DFFP; d.is8 = 0; d.scale = 1.f; d.drow0 = j; d.k0 = (r / 32) * 64; d.n0src = j; return; } r -= IT_FD;
    { const int j = (r % 32) * 32; d.W = P0IN(17); d.ldw = 1024; d.WT = ws + WS_WO; d.drow0 = j; d.k0 = (r / 32) * 64; d.n0src = j; d.is8 = 1; d.scale = W8_SCALE; }
}
__device__ __forceinline__ void tr_load(const TrDesc& d, f32x4 (&v)[8], f32x4 (&gv)[2], int lane) {
#pragma unroll
    for (int i = 0; i < 8; ++i) v[i] = __builtin_nontemporal_load((const f32x4*)(d.W + (size_t)(d.k0 + 8 * i + (lane >> 3)) * d.ldw + d.n0src + 4 * (lane & 7)));
    const float* gp = d.gsc ? d.gsc + d.k0 + 8 * (lane & 7) : d.W + (size_t)d.k0 * d.ldw + d.n0src;
    gv[0] = *(const f32x4*)gp; gv[1] = *(const f32x4*)(gp + 4);
}
template <bool NT = false>
__device__ __forceinline__ void tr_store(const TrDesc& d, const f32x4 (&v)[8], const f32x4 (&gv)[2], LAS float* scr, int lane) {
#pragma unroll
    for (int i = 0; i < 8; ++i) { LAS float* w = scr + (8 * i + (lane >> 3)) * 33 + 4 * (lane & 7); w[0] = v[i].x; w[1] = v[i].y; w[2] = v[i].z; w[3] = v[i].w; }
    LDS_WAIT(); asm volatile("" ::: "memory");
    const int c = lane & 7; const float sc = d.scale;
    const f32x4 one4 = {1.f, 1.f, 1.f, 1.f}; const f32x4 gv0 = d.gsc ? gv[0] : one4, gv1 = d.gsc ? gv[1] : one4;
#pragma unroll
    for (int j = 0; j < 4; ++j) { const int n = (lane >> 3) + 8 * j; const LAS float* s = scr + (8 * c) * 33 + n;
        const float x0 = s[0 * 33] * gv0.x * sc, x1 = s[1 * 33] * gv0.y * sc, x2 = s[2 * 33] * gv0.z * sc, x3 = s[3 * 33] * gv0.w * sc, x4 = s[4 * 33] * gv1.x * sc, x5 = s[5 * 33] * gv1.y * sc, x6 = s[6 * 33] * gv1.z * sc, x7 = s[7 * 33] * gv1.w * sc;
        if (d.is8 == 2) { pg8::u32x2 o; o.x = pg8::pk_i8x4(x0, x1, x2, x3); o.y = pg8::pk_i8x4(x4, x5, x6, x7); GAS pg8::u32x2* op = (GAS pg8::u32x2*)(d.WT + (size_t)(d.drow0 + n) * d.Kp + d.k0 + 8 * c); if (NT) __builtin_nontemporal_store(o, op); else *op = o; }
        else if (d.is8) { pg8::u32x2 o; o.x = pg8::pk_fp8x4(x0, x1, x2, x3); o.y = pg8::pk_fp8x4(x4, x5, x6, x7); GAS pg8::u32x2* op = (GAS pg8::u32x2*)(d.WT + (size_t)(d.drow0 + n) * d.Kp + d.k0 + 8 * c); if (NT) __builtin_nontemporal_store(o, op); else *op = o; }
        else { v4u o; o.x = pkbf(x0, x1); o.y = pkbf(x2, x3); o.z = pkbf(x4, x5); o.w = pkbf(x6, x7); *(GAS v4u*)((bf16*)d.WT + (size_t)(d.drow0 + n) * d.Kp + d.k0 + 8 * c) = o; } }
    LDS_WAIT(); asm volatile("" ::: "memory");
}

__device__ __forceinline__ void p0_items(kargp0_t kp, unsigned char* ws, LAS float* scr, int first, int stride, int lo, int hi, int lane) {
    TrDesc da, db, dc; f32x4 va[8], vb[8], vc[8]; f32x4 ga[2], gb[2], gc[2];
    int it = lo + first; const int NGW = stride;
    if (it < hi) { tr_desc(it, kp, ws, da); tr_load(da, va, ga, lane); }
    if (it + NGW < hi) { tr_desc(it + NGW, kp, ws, db); tr_load(db, vb, gb, lane); }
    while (it < hi) {
        if (it + 2 * NGW < hi) { tr_desc(it + 2 * NGW, kp, ws, dc); tr_load(dc, vc, gc, lane); }
        tr_store(da, va, ga, scr, lane);
        if (it + NGW >= hi) break;
        if (it + 3 * NGW < hi) { tr_desc(it + 3 * NGW, kp, ws, da); tr_load(da, va, ga, lane); }
        tr_store(db, vb, gb, scr, lane);
        if (it + 2 * NGW >= hi) break;
        if (it + 4 * NGW < hi) { tr_desc(it + 4 * NGW, kp, ws, db); tr_load(db, vb, gb, lane); }
        tr_store(dc, vc, gc, scr, lane);
        it += 3 * NGW;
    }
}
__device__ __forceinline__ void p0_items2(kargp0_t kp, unsigned char* ws, LAS float* scr, int first, int stride, int lo, int hi, int lane) {
    if (first >= hi - lo) return;
    const int n = (hi - lo - first + stride - 1) / stride, base = lo + first, last = n - 1;
    TrDesc da, db; f32x4 va[8], vb[8]; f32x4 ga[2], gb[2];
#define P0_ITEM(k) (base + ((k) < last ? (k) : last) * stride)
    tr_desc(base, kp, ws, da); tr_load(da, va, ga, lane);
    for (int k = 0; k + 1 < n; k += 2) {
        tr_desc(P0_ITEM(k + 1), kp, ws, db); tr_load(db, vb, gb, lane);
        tr_store<true>(da, va, ga, scr, lane);
        tr_desc(P0_ITEM(k + 2), kp, ws, da); tr_load(da, va, ga, lane);
        tr_store<true>(db, vb, gb, scr, lane);
    }
    if (n & 1) tr_store<true>(da, va, ga, scr, lane);
#undef P0_ITEM
}
__device__ __forceinline__ void p0_prologue(kargp0_t kp, unsigned char* ws, LAS unsigned char* lds, int G, int vcu, int tid, int lane, int wave) {
    LAS float* scr = (LAS float*)(lds + RING_OFF + wave * 16384);
    const int gw = vcu * NWAVES + wave, NGW = G * NWAVES;
    bf16* WF13 = (bf16*)(ws + WS_WF13); bf16* WFD = (bf16*)(ws + WS_WFD);
    p0_items(kp, ws, scr, gw, NGW, (G == 256) ? IT_MOE : 0, IT_TOTAL, lane);
#ifdef PROBE_CONV_NC
    if ((vcu & 31) < PROBE_CONV_NC) p0_items(kp, ws, scr, ((vcu >> 5) * PROBE_CONV_NC + (vcu & 31)) * NWAVES + wave, 8 * PROBE_CONV_NC * NWAVES, 0, IT_MOE, lane);
#endif
    const int gt = vcu * (NWAVES * 64) + tid, NGT = G * NWAVES * 64; const v4u z = {0u, 0u, 0u, 0u};
    { constexpr int RB = I8_P4 ? 1024 : 2048, CH = RB / 16;
      for (int i = gt; i < 2 * 64 * CH; i += NGT) { const int sel = i / (64 * CH), rr = (i / CH) & 63, ch = i % CH; *(GAS v4u*)((unsigned char*)WF13 + (size_t)(256 * 21 + 128 * sel + 64 + rr) * RB + ch * 16) = z; } }
    for (int i = gt; i < 1024 * 8; i += NGT) { const int row = i >> 3, ch = i & 7; *(GAS v4u*)(WFD + (size_t)row * DFFP + DFF + ch * 8) = z; }
    const float* x = P0IN(0); const float* gn = P0IN(2); bf16* H0 = (bf16*)(ws + WS_H0);
    f32x4 gv[4];
#pragma unroll
    for (int j = 0; j < 4; ++j) gv[j] = *(const f32x4*)(gn + 4 * lane + 256 * j);
    for (int m0 = gw * 4; m0 < T; m0 += NGW * 4) {
        f32x4 v[4][4];
#pragma unroll
        for (int q = 0; q < 4; ++q) { const GAS f32x4* xr = (const GAS f32x4*)(x + (size_t)(m0 + q) * D) + lane;
#pragma unroll
            for (int j = 0; j < 4; ++j) v[q][j] = __builtin_nontemporal_load(xr + 64 * j); }
#pragma unroll
        for (int q = 0; q < 4; ++q) { float s = 0.f;
#pragma unroll
            for (int j = 0; j < 4; ++j) s += (v[q][j].x * v[q][j].x + v[q][j].y * v[q][j].y) + (v[q][j].z * v[q][j].z + v[q][j].w * v[q][j].w);
            const float rstd = 1.f / sqrtf(wave_sum(s) * (1.f / D) + EPS);
            if (I8_P1) { GAS unsigned* o4 = (GAS unsigned*)((unsigned char*)H0 + (size_t)(m0 + q) * D) + lane;
#pragma unroll
                for (int j = 0; j < 4; ++j) { const f32x4 y = v[q][j] * (rstd * SA_N) * gv[j]; o4[64 * j] = pg8::pk_i8x4(y.x, y.y, y.z, y.w); } }
            else { GAS unsigned long long* o8 = (GAS unsigned long long*)(H0 + (size_t)(m0 + q) * D) + lane;
#pragma unroll
                for (int j = 0; j < 4; ++j) { const f32x4 y = v[q][j] * rstd * gv[j]; o8[64 * j] = (unsigned long long)pkbf(y.x, y.y) | ((unsigned long long)pkbf(y.z, y.w) << 32); } } }
    }
}

__device__ __forceinline__ void conv_phase(const bf16* glu, const float* dw_w, const float* dw_b, const float* ln_g, const float* ln_b, bf16* vout, LAS unsigned char* lds, int G, int vcu, int tid, int lane, int wave) {
    LAS float* ybuf = (LAS float*)(lds + RING_OFF);
    const int c0 = 2 * tid;
    float w0[31], w1[31];
#pragma unroll
    for (int k = 0; k < 31; ++k) { const f32x2v w = *(const f32x2v*)(dw_w + k * 1024 + c0); w0[k] = w.x; w1[k] = w.y; }
    const f32x2v dbv = *(const f32x2v*)(dw_b + c0);
    LAS float* lnp = (LAS float*)(lds + XTRA_OFF);
    for (int i = tid; i < 1024; i += NWAVES * 64) { lnp[i] = ln_g[i]; lnp[1024 + i] = ln_b[i]; }
    __syncthreads();
    for (int item = vcu; item < T / 128; item += G) {
        const int b = item >> 5, s0 = (item & 31) * 128;
        const bf16* ub = glu + (size_t)b * SEQ * D + c0;
        float r0[32], r1[32];
        r0[0] = 0.f; r1[0] = 0.f; r0[1] = 0.f; r1[1] = 0.f;
#pragma unroll
        for (int i = 0; i < 30; ++i) { const int s = s0 - 30 + i; unsigned v = 0u; if (s >= 0) v = *(const unsigned*)(ub + (size_t)s * D); r0[i + 2] = bflo(v); r1[i + 2] = bfhi(v); }
        for (int base = 0; base < 128; base += 32) {
            unsigned nu[32];
#pragma unroll
            for (int j = 0; j < 32; ++j) nu[j] = *(const unsigned*)(ub + (size_t)(s0 + base + j) * D);
#pragma unroll
            for (int j = 0; j < 32; ++j) {
                r0[j] = bflo(nu[j]); r1[j] = bfhi(nu[j]);
                float y0 = dbv.x, y1 = dbv.y;
#pragma unroll
                for (int k = 0; k < 31; ++k) { const int idx = (j + 2 + k) & 31; y0 += r0[idx] * w0[k]; y1 += r1[idx] * w1[k]; }
                *(LAS f32x2v*)(ybuf + j * 1024 + c0) = (f32x2v){y0, y1};
            }
            __syncthreads();
            const int ntok = 32;
            for (int j = wave; j < ntok; j += NWAVES) {
                f32x4 y[4]; float s = 0.f;
#pragma unroll
                for (int i = 0; i < 4; ++i) { y[i] = *(const LAS f32x4*)(ybuf + j * 1024 + 4 * lane + 256 * i); s += (y[i].x + y[i].y) + (y[i].z + y[i].w); }
                const float mean = wave_sum(s) * (1.f / D); float q = 0.f;
#pragma unroll
                for (int i = 0; i < 4; ++i) { y[i] = y[i] - mean; q += (y[i].x * y[i].x + y[i].y * y[i].y) + (y[i].z * y[i].z + y[i].w * y[i].w); }
                const float rstd = 1.f / sqrtf(wave_sum(q) * (1.f / D) + EPS);
                GAS unsigned* o4 = (GAS unsigned*)((unsigned char*)vout + ((size_t)b * SEQ + s0 + base + j) * D) + lane;
                GAS unsigned long long* o8 = (GAS unsigned long long*)(vout + ((size_t)b * SEQ + s0 + base + j) * D) + lane;
#pragma unroll
                for (int i = 0; i < 4; ++i) { const f32x4 lgv = *(const LAS f32x4*)(lnp + 4 * lane + 256 * i), lbv = *(const LAS f32x4*)(lnp + 1024 + 4 * lane + 256 * i); f32x4 z = y[i] * rstd * lgv + lbv;
                    z.x *= pg8::fast_sigmoid(z.x); z.y *= pg8::fast_sigmoid(z.y); z.z *= pg8::fast_sigmoid(z.z); z.w *= pg8::fast_sigmoid(z.w);
                    if (I8_P3) o4[64 * i] = pg8::pk_i8x4(z.x * SA_N, z.y * SA_N, z.z * SA_N, z.w * SA_N);
                    else o8[64 * i] = (unsigned long long)pkbf(z.x, z.y) | ((unsigned long long)pkbf(z.z, z.w) << 32); }
            }
            __syncthreads();
        }
    }
}

__device__ __forceinline__ void attn_phase(LAS unsigned char* lds, int grp, const bf16* Kb, const bf16* Vb, const bf16* Qb, bf16* Ob, unsigned char* O8, float* lse, const float* rel_bias, unsigned* qheads, int G, int vcu, int tid, int lane, int wave) {
    const int dsh = 2 * grp, dil = 1 << dsh;
    LAS unsigned char* Kl = lds + RING_OFF;
    LAS unsigned char* Vl = lds + RING_OFF + 55296;
    LAS float* btab_all = (LAS float*)(lds + XTRA_OFF);
    for (int i = tid; i < 16 * 192; i += NWAVES * 64) { const int hh = i / 192, j = i % 192, dist = 159 - j;
        btab_all[i] = (dist >= 0 && dist <= 128) ? rel_bias[(int)T5_BUCKET[grp][dist] * 48 + grp * 16 + hh] * LOG2E - SOFTMAX_OFS : -1.0e30f; }
    const int lq = lane & 31, hi = lane >> 5;
    v4u kvp[6], vvp[6];
#define ATT_DECODE(IDX, b_, h_, res_, n0_) const int bh_##b_ = (IDX) >> 4, w16_##b_ = (IDX) & 15, b_ = bh_##b_ >> 4, h_ = bh_##b_ & 15, res_ = w16_##b_ & (dil - 1), n0_ = (w16_##b_ >> dsh) * 256
#define ATT_LOAD(IDX) do { ATT_DECODE(IDX, pb, ph, pres, pn0); \
        _Pragma("unroll") for (int i = 0; i < 6; ++i) { const int cidx = tid + 512 * i, j = cidx >> 3, c16 = cidx & 7, sub = pn0 - 128 + j; \
            kvp[i] = (v4u){0u, 0u, 0u, 0u}; vvp[i] = kvp[i]; \
            if (sub >= 0) { const size_t off = ((size_t)pb * SEQ + ((size_t)sub << dsh) + pres) * D + ph * 64 + c16 * 8; kvp[i] = *(const GAS v4u*)(Kb + off); vvp[i] = *(const GAS v4u*)(Vb + off); } } } while (0)
    pg8::bf16x8 qnext[4];
#define ATT_LOADQ(IDX) do { ATT_DECODE(IDX, qb_, qh_, qres_, qn0_); const size_t qrow_ = (size_t)qb_ * SEQ + ((size_t)(qn0_ + 32 * wave + lq) << dsh) + qres_; \
        _Pragma("unroll") for (int c = 0; c < 4; ++c) qnext[c] = *(const pg8::bf16x8*)(Qb + qrow_ * D + qh_ * 64 + 16 * c + 8 * hi); } while (0)
    const bool dyn = (G == 256);
    const int xq = vcu >> 5;
    LAS int* qL = (LAS int*)(lds + XTRA_OFF + 12288 + 64);
    int idx = vcu;
    if (idx < 2048) { ATT_LOAD(idx); ATT_LOADQ(idx); }
    __syncthreads();
    while (idx < 2048) {
        int claimed = 0;
        if (dyn && tid == 0) claimed = (int)__hip_atomic_fetch_add(qheads + 16 * xq, 1u, __ATOMIC_RELAXED, __HIP_MEMORY_SCOPE_AGENT);
        ATT_DECODE(idx, b, h, res, n0);
        const int ql = 32 * wave + lq;
        const size_t qrow = (size_t)b * SEQ + ((size_t)(n0 + ql) << dsh) + res;
        pg8::bf16x8 qr[4];
#pragma unroll
        for (int c = 0; c < 4; ++c) qr[c] = qnext[c];
        __syncthreads();
#pragma unroll
        for (int i = 0; i < 6; ++i) { const int cidx = tid + 512 * i, j = cidx >> 3, c16 = cidx & 7;
            *(LAS v4u*)(Kl + j * 144 + c16 * 16) = kvp[i]; *(LAS v4u*)(Vl + (c16 >> 2) * 24576 + j * 64 + (c16 & 3) * 16) = vvp[i]; }
        if (dyn && tid == 0) qL[0] = 32 + claimed;
        __syncthreads();
        int nidx = idx + G;
        if (dyn) { const int jn = qL[0]; nidx = jn < 256 ? ((jn >> 5) << 8) + (xq << 5) + (jn & 31) : 2048; }
        if (nidx < 2048) ATT_LOAD(nidx);
        float sv[5][16]; float m = -3.0e38f;
        const int kofs = n0 - 128 + 32 * wave;
        const LAS float* brow = btab_all + h * 192 + (31 - lq + 4 * hi);
#pragma unroll
        for (int kt = 0; kt < 5; ++kt) {
            f32x16 S = (f32x16){0.f, 0.f, 0.f, 0.f, 0.f, 0.f, 0.f, 0.f, 0.f, 0.f, 0.f, 0.f, 0.f, 0.f, 0.f, 0.f};
#pragma unroll
            for (int c = 0; c < 4; ++c) { const pg8::bf16x8 a = *(const LAS pg8::bf16x8*)(Kl + (32 * wave + 32 * kt + lq) * 144 + (16 * c + 8 * hi) * 2);
                S = __builtin_amdgcn_mfma_f32_32x32x16_bf16(a, qr[c], S, 0, 0, 0); }
#pragma unroll
            for (int r = 0; r < 16; ++r) { const float s = S[r] + brow[32 * kt + (r & 3) + 8 * (r >> 2)]; sv[kt][r] = s; }
            __builtin_amdgcn_sched_barrier(0);
        }
        if (kofs < 0) {
#pragma unroll
            for (int kt = 0; kt < 5; ++kt)
#pragma unroll
                for (int r = 0; r < 16; ++r) { const int kk = 32 * kt + crow(r, hi); if (kofs + kk < 0) sv[kt][r] = -1.0e30f; }
        }
        m = SOFTMAX_OFS;
        float l = 0.f; unsigned pw[5][8];
#pragma unroll
        for (int kt = 0; kt < 5; ++kt) {
#pragma unroll
            for (int r = 0; r < 16; r += 2) { const float p0 = __builtin_amdgcn_exp2f(sv[kt][r]), p1 = __builtin_amdgcn_exp2f(sv[kt][r + 1]); l += p0 + p1; pw[kt][r >> 1] = pkbf(p0, p1); }
            __builtin_amdgcn_sched_barrier(0);
        }
        l += __shfl_xor(l, 32);
        f32x16 O0 = (f32x16){0.f, 0.f, 0.f, 0.f, 0.f, 0.f, 0.f, 0.f, 0.f, 0.f, 0.f, 0.f, 0.f, 0.f, 0.f, 0.f}, O1 = O0;
        const int vlane = ((lane & 15) >> 2) * 64 + ((lane >> 4) & 1) * 32 + (lane & 3) * 8;
#pragma unroll
        for (int kt = 0; kt < 5; ++kt)
#pragma unroll
            for (int s2 = 0; s2 < 2; ++s2) {
                v4u pq; pq.x = pw[kt][4 * s2 + 0]; pq.y = pw[kt][4 * s2 + 1]; pq.z = pw[kt][4 * s2 + 2]; pq.w = pw[kt][4 * s2 + 3];
                const pg8::bf16x8 pf = __builtin_bit_cast(pg8::bf16x8, pq);
                const int vrow = 32 * wave + 32 * kt + 16 * s2 + 4 * hi;
                LAS unsigned char* vp = Vl + vrow * 64 + vlane;
                const v4i16_t a0 = __builtin_amdgcn_ds_read_tr16_b64_v4i16((LAS v4i16_t*)(vp)), a1 = __builtin_amdgcn_ds_read_tr16_b64_v4i16((LAS v4i16_t*)(vp + 512));
                const v4i16_t b0 = __builtin_amdgcn_ds_read_tr16_b64_v4i16((LAS v4i16_t*)(vp + 24576)), b1 = __builtin_amdgcn_ds_read_tr16_b64_v4i16((LAS v4i16_t*)(vp + 24576 + 512));
                const pg8::bf16x8 vf0 = (pg8::bf16x8){a0[0], a0[1], a0[2], a0[3], a1[0], a1[1], a1[2], a1[3]};
                const pg8::bf16x8 vf1 = (pg8::bf16x8){b0[0], b0[1], b0[2], b0[3], b1[0], b1[1], b1[2], b1[3]};
                O0 = __builtin_amdgcn_mfma_f32_32x32x16_bf16(vf0, pf, O0, 0, 0, 0);
                O1 = __builtin_amdgcn_mfma_f32_32x32x16_bf16(vf1, pf, O1, 0, 0, 0);
                __builtin_amdgcn_sched_barrier(0);
            }
        if (nidx < 2048) ATT_LOADQ(nidx);
        const float inv_l = 1.f / l, lse2 = m + __builtin_amdgcn_logf(l);
        const size_t orow = qrow;
        v4u oldv[4];
        if (grp != 0) {
#pragma unroll
            for (int i = 0; i < 4; ++i) { const int ch = lane + 64 * i, qq = ch >> 3, c8 = ch & 7; oldv[i] = *(const GAS v4u*)(Ob + ((size_t)b * SEQ + ((size_t)(n0 + 32 * wave + qq) << dsh) + res) * D + h * 64 + c8 * 8); } }
        float co = 0.f, cg = inv_l, lnew = lse2;
        if (grp != 0) { const float lo_ = lse[orow * 16 + h]; const float M = fmaxf(lo_, lse2); const float wo = __builtin_amdgcn_exp2f(lo_ - M), wg = __builtin_amdgcn_exp2f(lse2 - M), den = wo + wg;
            co = wo / den; cg = wg / den * inv_l; lnew = M + __builtin_amdgcn_logf(den); }
        __syncthreads();
        LAS unsigned char* stg = Kl + wave * 4608;
        LAS float* cot = (LAS float*)(Kl + 8 * 4608) + wave * 32;
#pragma unroll
        for (int rg = 0; rg < 4; ++rg) {
            pg8::u32x2 wa, wb; wa.x = pkbf(O0[4 * rg] * cg, O0[4 * rg + 1] * cg); wa.y = pkbf(O0[4 * rg + 2] * cg, O0[4 * rg + 3] * cg);
            wb.x = pkbf(O1[4 * rg] * cg, O1[4 * rg + 1] * cg); wb.y = pkbf(O1[4 * rg + 2] * cg, O1[4 * rg + 3] * cg);
            *(LAS pg8::u32x2*)(stg + lq * 144 + (8 * rg + 4 * hi) * 2) = wa; *(LAS pg8::u32x2*)(stg + lq * 144 + (32 + 8 * rg + 4 * hi) * 2) = wb; }
        if (hi == 0) cot[lq] = co;
        if (hi == 0) lse[orow * 16 + h] = lnew;
#pragma unroll
        for (int i = 0; i < 4; ++i) { const int ch = lane + 64 * i, qq = ch >> 3, c8 = ch & 7;
            const v4u sv4 = *(const LAS v4u*)(stg + qq * 144 + c8 * 16);
            bf16* op = Ob + ((size_t)b * SEQ + ((size_t)(n0 + 32 * wave + qq) << dsh) + res) * D + h * 64 + c8 * 8;
            v4u ov = sv4;
            if (grp != 0) { const float cq = cot[qq]; const v4u old = oldv[i];
                ov.x = pkbf(bflo(sv4.x) + cq * bflo(old.x), bfhi(sv4.x) + cq * bfhi(old.x)); ov.y = pkbf(bflo(sv4.y) + cq * bflo(old.y), bfhi(sv4.y) + cq * bfhi(old.y));
                ov.z = pkbf(bflo(sv4.z) + cq * bflo(old.z), bfhi(sv4.z) + cq * bfhi(old.z)); ov.w = pkbf(bflo(sv4.w) + cq * bflo(old.w), bfhi(sv4.w) + cq * bfhi(old.w)); }
            if (grp == 2) { unsigned char* o8 = O8 + ((size_t)b * SEQ + ((size_t)(n0 + 32 * wave + qq) << dsh) + res) * D + h * 64 + c8 * 8;
                pg8::u32x2 w8; w8.x = pg8::pk_fp8x4(bflo(ov.x) * O8_SCALE, bfhi(ov.x) * O8_SCALE, bflo(ov.y) * O8_SCALE, bfhi(ov.y) * O8_SCALE); w8.y = pg8::pk_fp8x4(bflo(ov.z) * O8_SCALE, bfhi(ov.z) * O8_SCALE, bflo(ov.w) * O8_SCALE, bfhi(ov.w) * O8_SCALE);
                *(GAS pg8::u32x2*)o8 = w8; }
            else *(GAS v4u*)op = ov; }
        idx = nidx;
    }
    __syncthreads();
#undef ATT_DECODE
#undef ATT_LOAD
#undef ATT_LOADQ
}

__device__ __forceinline__ void route_phase(const _Float16* x3, const float* gnorm, const float* wr, unsigned char* ws, LAS unsigned char* lds, int G, int vcu, int tid, int lane, int wave) {
    LAS float* WrT = (LAS float*)(lds + RING_OFF);
    LAS unsigned* wcL = (LAS unsigned*)(lds + RING_OFF + 32768);
    for (int i = tid; i < 8192; i += NWAVES * 64) { const int e = i >> 10, k = i & 1023; WrT[i] = wr[k * 8 + e] * gnorm[k]; }
    __syncthreads();
    unsigned* route = (unsigned*)(ws + WS_ROUTE); float* gate1 = (float*)(ws + WS_GATE1); float* gate2 = (float*)(ws + WS_GATE2);
    unsigned* wavecnt = (unsigned*)(ws + WS_WAVECNT); int* blockcnt = (int*)(ws + WS_BLOCKCNT); unsigned char* H3 = ws + WS_H3;
    const int gw = vcu * NWAVES + wave, NGW = G * NWAVES, tpw = (T + NGW - 1) / NGW;
    const int t0 = gw * tpw, t1 = (t0 + tpw) < T ? (t0 + tpw) : T;
    f32x4 gv[4];
#pragma unroll
    for (int j = 0; j < 4; ++j) gv[j] = *(const f32x4*)(gnorm + 4 * lane + 256 * j);
    unsigned long long cnt0 = 0ull, cnt1 = 0ull;
    f32x4 vn[4];
    if (t0 < t1) { const GAS pg8::h16x4* xr = (const GAS pg8::h16x4*)(x3 + (size_t)t0 * D) + lane;
#pragma unroll
        for (int j = 0; j < 4; ++j) vn[j] = __builtin_convertvector(xr[64 * j], f32x4); }
    for (int t = t0; t < t1; ++t) {
        f32x4 v[4]; float ss = 0.f;
#pragma unroll
        for (int j = 0; j < 4; ++j) { v[j] = vn[j]; ss += (v[j].x * v[j].x + v[j].y * v[j].y) + (v[j].z * v[j].z + v[j].w * v[j].w); }
        if (t + 1 < t1) { const GAS pg8::h16x4* xr = (const GAS pg8::h16x4*)(x3 + (size_t)(t + 1) * D) + lane;
#pragma unroll
            for (int j = 0; j < 4; ++j) vn[j] = __builtin_convertvector(xr[64 * j], f32x4); }
        float dt[8];
#pragma unroll
        for (int e = 0; e < 8; ++e) { float a = 0.f;
#pragma unroll
            for (int j = 0; j < 4; ++j) { const f32x4 w = *(const LAS f32x4*)(WrT + e * 1024 + 4 * lane + 256 * j); a += (v[j].x * w.x + v[j].y * w.y) + (v[j].z * w.z + v[j].w * w.w); }
            dt[e] = a; }
        ss = wave_sum(ss);
#pragma unroll
        for (int e = 0; e < 8; ++e) dt[e] = wave_sum(dt[e]);
        const float rstd = 1.f / sqrtf(ss * (1.f / D) + EPS);
        GAS unsigned* o4 = (GAS unsigned*)(H3 + (size_t)t * D) + lane;
#pragma unroll
        for (int j = 0; j < 4; ++j) { const f32x4 y = v[j] * (rstd * SA_N) * gv[j]; o4[64 * j] = pg8::pk_i8x4(y.x, y.y, y.z, y.w); }
        int e1 = 0; float v1 = dt[0] * rstd;
#pragma unroll
        for (int e = 1; e < 8; ++e) { const float x = dt[e] * rstd; if (x > v1) { v1 = x; e1 = e; } }
        int e2 = -1; float v2 = -3.0e38f;
#pragma unroll
        for (int e = 0; e < 8; ++e) { const float x = dt[e] * rstd; if (e != e1 && x > v2) { v2 = x; e2 = e; } }
        const float g2 = 1.f / (1.f + __expf(v1 - v2)), g1 = 1.f - g2;
        cnt0 += 1ull << (8 * e1); cnt1 += 1ull << (8 * e2);
        if (lane == 0) { route[t] = (unsigned)e1 | ((unsigned)e2 << 8); gate1[t] = g1; gate2[t] = g2; }
    }
    if (lane == 0) { v4u c; c.x = (unsigned)cnt0; c.y = (unsigned)(cnt0 >> 32); c.z = (unsigned)cnt1; c.w = (unsigned)(cnt1 >> 32);
        *(GAS v4u*)(wavecnt + (size_t)gw * 4) = c; wcL[wave * 4 + 0] = c.x; wcL[wave * 4 + 1] = c.y; wcL[wave * 4 + 2] = c.z; wcL[wave * 4 + 3] = c.w; }
    __syncthreads();
    if (tid < 16) { const int slot = tid >> 3, e = tid & 7; int s = 0;
#pragma unroll
        for (int w = 0; w < NWAVES; ++w) s += (int)((wcL[w * 4 + slot * 2 + (e >> 2)] >> (8 * (e & 3))) & 255u);
        blockcnt[vcu * 16 + tid] = s; }
    __syncthreads();
}

__device__ __forceinline__ void pos_phase(unsigned char* ws, LAS unsigned char* lds, int G, int vcu, int tid, int lane, int wave) {
    LAS int* cntL = (LAS int*)(lds + RING_OFF);
    LAS int* pAll = (LAS int*)(lds + RING_OFF + 65536);
    LAS int* pBef = pAll + 512;
    LAS int* totL = pBef + 512;
    const int* blockcnt = (const int*)(ws + WS_BLOCKCNT); const unsigned* wavecnt = (const unsigned*)(ws + WS_WAVECNT);
    const unsigned* route = (const unsigned*)(ws + WS_ROUTE); const float* gate1 = (const float*)(ws + WS_GATE1); const float* gate2 = (const float*)(ws + WS_GATE2);
    int* gofs = (int*)(ws + WS_GOFS);
    for (int i = tid; i < G * 16; i += NWAVES * 64) cntL[i] = blockcnt[i];
    __syncthreads();
    { const int c = tid & 15, part = tid >> 4, bpp = (G + 31) / 32; int sa = 0, sb = 0;
      for (int bb = part * bpp; bb < (part + 1) * bpp && bb < G; ++bb) { const int v = cntL[bb * 16 + c]; sa += v; if (bb < vcu) sb += v; }
      pAll[part * 16 + c] = sa; pBef[part * 16 + c] = sb; }
    __syncthreads();
    if (tid < 16) { int sa = 0, sb = 0;
        for (int p = 0; p < 32; ++p) { sa += pAll[p * 16 + tid]; sb += pBef[p * 16 + tid]; }
        totL[tid] = sa; totL[16 + tid] = sb; }
    __syncthreads();
    if (tid == 0) { int off = 0;
        for (int e = 0; e < 8; ++e) { totL[32 + e] = off; totL[32 + 8 + e] = off + totL[e]; if (vcu == 0) { gofs[e] = off; gofs[8 + e] = off + totL[e]; gofs[32 + e] = off >> 8; } off += ((totL[e] + totL[8 + e] + 255) >> 8) << 8; }
        if (vcu == 0) gofs[16] = off >> 8; }
    __syncthreads();
    const int gw = vcu * NWAVES + wave, NGW = G * NWAVES, tpw = (T + NGW - 1) / NGW;
    const int t0 = gw * tpw, t1 = (t0 + tpw) < T ? (t0 + tpw) : T;
    int mypos = 0;
    if (lane < 16) { mypos = totL[32 + lane] + totL[16 + lane];
        for (int w = 0; w < wave; ++w) mypos += (int)((wavecnt[(size_t)(vcu * NWAVES + w) * 4 + (lane >> 3) * 2 + ((lane & 7) >> 2)] >> (8 * (lane & 3))) & 255u); }
    int* pos01 = (int*)(ws + WS_POS);
    int* rowtok0 = (int*)(ws + WS_ROWTOK); int* rowtok1 = rowtok0; float* rowgate0 = (float*)(ws + WS_ROWGATE); float* rowgate1 = rowgate0;
    for (int t = t0; t < t1; ++t) {
        const unsigned rt = route[t]; const int e1 = (int)(rt & 255u), e2 = (int)((rt >> 8) & 255u);
        const int p1 = __shfl(mypos, e1), p2 = __shfl(mypos, 8 + e2);
        if (lane == e1 || lane == 8 + e2) mypos += 1;
        if (lane == 0) { rowtok0[p1] = t; rowgate0[p1] = gate1[t]; rowtok1[p2] = t; rowgate1[p2] = gate2[t]; pos01[t] = p1; pos01[T + t] = p2; }
    }
    if (vcu < 8) { int* rtk = (int*)(ws + WS_ROWTOK); float* rgt = (float*)(ws + WS_ROWGATE);
        const int beg = totL[32 + vcu] + totL[vcu] + totL[8 + vcu], end = totL[32 + vcu] + (((totL[vcu] + totL[8 + vcu] + 255) >> 8) << 8);
        for (int i = beg + tid; i < end; i += NWAVES * 64) { rtk[i] = -1; rgt[i] = 0.f; } }
    __syncthreads();
}

__device__ __forceinline__ void combine_phase(float* out, unsigned char* ws, int G, int vcu, int tid, int lane, int wave) {
    const int* pos01 = (const int*)(ws + WS_POS); const unsigned char* Y = ws + WS_Y; const _Float16* XH = (const _Float16*)(ws + WS_XH);
    const int gw = vcu * NWAVES + wave, NGW = G * NWAVES; const float ys = 1.f / Y_SCALE;
    for (int t0 = gw * 4; t0 < T; t0 += NGW * 4) {
        v4u ya[4], yb[4]; f32x4 o[4][4];
#pragma unroll
        for (int q = 0; q < 4; ++q) { const int t = t0 + q; const int p0 = pos01[t], p1 = pos01[T + t];
            ya[q] = *(const GAS v4u*)(Y + (size_t)p0 * 1024 + 16 * lane); yb[q] = *(const GAS v4u*)(Y + (size_t)p1 * 1024 + 16 * lane);
#pragma unroll
            for (int j = 0; j < 4; ++j) o[q][j] = __builtin_convertvector(*(const GAS pg8::h16x4*)(XH + (size_t)t * 1024 + 16 * lane + 4 * j), f32x4); }
#pragma unroll
        for (int q = 0; q < 4; ++q)
#pragma unroll
            for (int j = 0; j < 4; ++j) { const unsigned a = ya[q][j], c = yb[q][j]; f32x4 x = o[q][j];
                x.x += (float)(((int)(a << 24) >> 24) + ((int)(c << 24) >> 24)) * ys; x.y += (float)(((int)(a << 16) >> 24) + ((int)(c << 16) >> 24)) * ys;
                x.z += (float)(((int)(a << 8) >> 24) + ((int)(c << 8) >> 24)) * ys; x.w += (float)(((int)a >> 24) + ((int)c >> 24)) * ys;
                __builtin_nontemporal_store(x, (GAS f32x4*)(out + (size_t)(t0 + q) * 1024 + 16 * lane + 4 * j)); }
    }
}

constexpr int N_LAUNCHES = MK_N_LAUNCHES;
struct Args { const float* in[26]; float* out; unsigned char* ws; int ph_lo, ph_hi; };
typedef const __attribute__((address_space(4))) unsigned char* kargp_t;
#ifdef PROBE_CLK_PHASE
#define CLK_BEGIN(k) unsigned long long ck0_ = 0, rt0_ = 0; if ((k) == PROBE_CLK_PHASE) { ck0_ = __builtin_amdgcn_s_memtime(); rt0_ = __builtin_amdgcn_s_memrealtime(); }
#define CLK_END(k) if ((k) == PROBE_CLK_PHASE && bx == 0 && tid == 0) { const unsigned long long ck1_ = __builtin_amdgcn_s_memtime(), rt1_ = __builtin_amdgcn_s_memrealtime(); const float qv_ = floorf((float)(ck1_ - ck0_) / (float)(rt1_ - rt0_) + 0.5f); ((float*)(ws + WS_GOFS))[100] = 100.f * qv_ * qv_; }
#else
#define CLK_BEGIN(k)
#define CLK_END(k)
#endif
#define PH_ENTER() kargp_t kp_ = kp0; asm volatile("" : "+s"(kp_)); int tid = tid0; asm volatile("" : "+v"(tid)); const int lane = tid & 63, wave = __builtin_amdgcn_readfirstlane(tid >> 6); \
    unsigned char* ws = *(unsigned char* const __attribute__((address_space(4)))*)(kp_ + 216); float* out = *(float* const __attribute__((address_space(4)))*)(kp_ + 208); (void)lane; (void)wave; (void)out
#define INP(i) (*(const float* const __attribute__((address_space(4)))*)(kp_ + 8 * (i)))
__global__ void __launch_bounds__(NWAVES * 64, 2) mk_fwd(Args args) {
    extern __shared__ __attribute__((aligned(16))) unsigned char lds_raw[];
    LAS unsigned char* lds = (LAS unsigned char*)lds_raw;
    static_assert(sizeof(Args) == 232 && __builtin_offsetof(Args, out) == 208 && __builtin_offsetof(Args, ws) == 216, "Args layout");
    const kargp_t kp0 = (kargp_t)__builtin_amdgcn_kernarg_segment_ptr();
    const int tid0 = threadIdx.x;
    const int G = gridDim.x, bx = blockIdx.x, vcu = (G % 8 == 0) ? (bx % 8) * (G / 8) + bx / 8 : bx;
    for (int u = tid0; u < (XTRA_OFF - LDSCTL_OFF) / 4; u += NWAVES * 64) ((LAS unsigned*)(lds + LDSCTL_OFF))[u] = 0u;
    __syncthreads();
    XcdBarrier bar; bar.bar = (unsigned*)(args.ws + WS_CTL) + CW_BAR; bar.x = 0; bar.st = (volatile LAS unsigned*)(lds + MISC_OFF) + 8;
    if (N_LAUNCHES == 1) bar = xcd_barrier_post((unsigned*)(args.ws + WS_CTL) + CW_BAR, (volatile LAS unsigned*)(lds + MISC_OFF) + 8);
#define GRID_BAR() do { if (N_LAUNCHES == 1) xcd_barrier(bar); } while (0)
    const int lo = args.ph_lo, hi = args.ph_hi;
#ifndef PH_MASK
#define PH_MASK 0xFFFFFFFFu
#endif
#define IN(k) (((PH_MASK >> (k)) & 1u) && lo <= (k) && (k) < hi)
#define BOTH(k) (IN(k) && IN((k) + 1))
#ifndef PROBE_NOEPI
#define PROBE_NOEPI 0
#endif
#ifndef PROBE_REP_MASK
#define PROBE_REP_MASK 0u
#define PROBE_REP_N 1
#endif
#define REPS(k) (((PROBE_REP_MASK >> (k)) & 1u) ? PROBE_REP_N : 1)

    _Pragma("nounroll") for (int rep_ = 0; rep_ < REPS(0); ++rep_) if (IN(0)) { PH_ENTER(); CLK_BEGIN(0); p0_prologue(kp_, ws, lds, G, vcu, tid, lane, wave); __syncthreads(); CLK_END(0); if (BOTH(0)) GRID_BAR(); }
    _Pragma("nounroll") for (int rep_ = 0; rep_ < REPS(1); ++rep_) if (IN(1)) { PH_ENTER(); CLK_BEGIN(1);
        pg8::Gemm g{(const bf16*)(ws + WS_H0), (const bf16*)(ws + WS_WIN), T, 2048, 1024, 0, nullptr, nullptr, nullptr, nullptr, 0}; pg8::StaticOrder S; S.init(T, 2048, G, bx, I8_P1 ? 1024 / 128 : 1024 / 64);
        pg8::EpiGated<0> E{(bf16*)(ws + WS_GLU), 1024, INP(4), 1024, nullptr, I8_P1 ? 1.f / (SA_N * SW_I8) : 1.f, 1.f, {}, -1, lds + XTRA_OFF};
        pg8::gemm_phase<pg8::EpiGated<0>, pg8::StaticOrder, false, I8_P1 ? 2 : 0>(lds + RING_OFF, g, S, E, tid);
        CLK_END(1); if (BOTH(1)) GRID_BAR();
    }
    _Pragma("nounroll") for (int rep_ = 0; rep_ < REPS(2); ++rep_) if (IN(2)) { PH_ENTER(); CLK_BEGIN(2); conv_phase((const bf16*)(ws + WS_GLU), INP(5), INP(6), INP(7), INP(8), (bf16*)(ws + WS_V), lds, G, vcu, tid, lane, wave); CLK_END(2); if (BOTH(2)) GRID_BAR(); }
    _Pragma("nounroll") for (int rep_ = 0; rep_ < REPS(3); ++rep_) if (IN(3)) { PH_ENTER(); CLK_BEGIN(3);
        pg8::Gemm g{(const bf16*)(ws + WS_V), (const bf16*)(ws + WS_WOUT), T, 1024, 1024, 0, nullptr, nullptr, nullptr, nullptr, 0}; pg8::StaticOrder S; S.init(T, 1024, G, bx, I8_P3 ? 1024 / 128 : 1024 / 64);
        pg8::EpiResid<true, true, I8_P4 ? 2 : 0, 0, 1> E{INP(0), (float*)(ws + WS_XH), INP(10), ws + WS_X1B, (float*)(ws + WS_PART1), I8_P3 ? 1.f / (SA_N * SW_I8) : 1.f, I8_P4 ? SA_X : 1.f, (LAS float*)(lds + XTRA_OFF), lds + XTRA_OFF + 4096};
        pg8::gemm_phase<pg8::EpiResid<true, true, I8_P4 ? 2 : 0, 0, 1>, pg8::StaticOrder, false, I8_P3 ? 2 : 0>(lds + RING_OFF, g, S, E, tid);
        CLK_END(3); if (BOTH(3)) GRID_BAR();
    }
    _Pragma("nounroll") for (int rep_ = 0; rep_ < REPS(4); ++rep_) if (IN(4)) { PH_ENTER(); CLK_BEGIN(4);
        pg8::Gemm g{(const bf16*)(ws + WS_X1B), (const bf16*)(ws + WS_WF13), T, 5632, 1024, 0, nullptr, nullptr, nullptr, nullptr, 0}; pg8::StaticOrder S; S.init(T, 5632, G, bx, I8_P4 ? 1024 / 128 : 1024 / 64);
        pg8::EpiGated<1> E{(bf16*)(ws + WS_HB), DFFP, nullptr, 0, (const float*)(ws + WS_PART1), I8_P4 ? 1.f / (SA_X * SW_I8) : 1.f, 1.f, {}, -1, lds + XTRA_OFF};
        if (G == 256) {
            const int slot = vcu % 11;
            S.i1 = slot;
            pg8::gemm_phase<pg8::EpiGated<1>, pg8::StaticOrder, false, I8_P4 ? 2 : 0>(lds + RING_OFF, g, S, E, tid);
            __syncthreads();
            p0_items2(kp_, ws, (LAS float*)(lds + RING_OFF + wave * 16384), wave, NWAVES, vcu * (IT_MOE / 256), (vcu + 1) * (IT_MOE / 256), lane);
            __syncthreads();
            S.i0 = slot; S.i1 = 0x7fffffff;
        }
        pg8::gemm_phase<pg8::EpiGated<1>, pg8::StaticOrder, false, I8_P4 ? 2 : 0>(lds + RING_OFF, g, S, E, tid);
        CLK_END(4); if (BOTH(4)) GRID_BAR();
    }
    _Pragma("nounroll") for (int rep_ = 0; rep_ < REPS(5); ++rep_) if (IN(5)) { PH_ENTER(); CLK_BEGIN(5);
        pg8::Gemm g{(const bf16*)(ws + WS_HB), (const bf16*)(ws + WS_WFD), T, 1024, DFFP, 0, nullptr, nullptr, nullptr, nullptr, 0}; pg8::StaticOrder S; S.init(T, 1024, G, bx, DFFP / 64);
        pg8::EpiResid<false, true, 2, 1, 1> E{(const float*)(ws + WS_XH), (float*)(ws + WS_XH), nullptr, ws + WS_X2B, (float*)(ws + WS_PART2), 1.f, SA_X, (LAS float*)(lds + XTRA_OFF), lds + XTRA_OFF + 4096};
        pg8::gemm_phase<pg8::EpiResid<false, true, 2, 1, 1>, pg8::StaticOrder, false>(lds + RING_OFF, g, S, E, tid);
        CLK_END(5); if (BOTH(5)) GRID_BAR();
    }
    for (int grp = 0; grp < 3; ++grp) {
        _Pragma("nounroll") for (int rep_ = 0; rep_ < REPS(6 + 2 * grp); ++rep_) if (IN(6 + 2 * grp)) { PH_ENTER(); CLK_BEGIN(6 + 2 * grp);
            pg8::Gemm g{(const bf16*)(ws + WS_X2B), (const bf16*)(ws + WS_WQKV + (size_t)grp * 3072 * 1024), T, 3072, 1024, 0, nullptr, nullptr, nullptr, nullptr, 0}; pg8::StaticOrder S; S.init(T, 3072, G, bx, 1024 / 128);
            pg8::EpiQKV E{(bf16*)(ws + WS_KG), (size_t)T * D, (const float*)(ws + WS_PART2), INP(13) + grp * 64, INP(16) + grp * 64, QSCALE, 1.f / (SA_X * SW_I8), {}, -1, lds + XTRA_OFF};
            pg8::gemm_phase<pg8::EpiQKV, pg8::StaticOrder, false, 2>(lds + RING_OFF, g, S, E, tid);
            CLK_END(6 + 2 * grp); if (BOTH(6 + 2 * grp)) GRID_BAR();
        }
        _Pragma("nounroll") for (int rep_ = 0; rep_ < REPS(7 + 2 * grp); ++rep_) if (IN(7 + 2 * grp)) { PH_ENTER(); CLK_BEGIN(7 + 2 * grp);
            attn_phase(lds, grp, (const bf16*)(ws + WS_KG), (const bf16*)(ws + WS_VG), (const bf16*)(ws + WS_QG), (bf16*)(ws + WS_O), ws + WS_O8, (float*)(ws + WS_LSE), INP(1), (unsigned*)(ws + WS_CTL) + CW_AQ + grp * 128, G, vcu, tid, lane, wave);
            CLK_END(7 + 2 * grp); if (BOTH(7 + 2 * grp)) GRID_BAR();
        }
    }
    _Pragma("nounroll") for (int rep_ = 0; rep_ < REPS(12); ++rep_) if (IN(12)) { PH_ENTER(); CLK_BEGIN(12);
        pg8::Gemm g{(const bf16*)(ws + WS_O8), (const bf16*)(ws + WS_WO), T, 1024, 1024, 0, nullptr, nullptr, nullptr, nullptr, 0}; pg8::StaticOrder S; S.init(T, 1024, G, bx, 1024 / 128);
        pg8::EpiResid<false, false, 0, 1, 1> E{(const float*)(ws + WS_XH), (float*)(ws + WS_XH), nullptr, nullptr, nullptr, 1.f / (W8_SCALE * O8_SCALE), 1.f, nullptr, lds + XTRA_OFF + 4096};
        pg8::gemm_phase<pg8::EpiResid<false, false, 0, 1, 1>, pg8::StaticOrder, false, 1>(lds + RING_OFF, g, S, E, tid);
        CLK_END(12); if (BOTH(12)) GRID_BAR();
    }
    _Pragma("nounroll") for (int rep_ = 0; rep_ < REPS(13); ++rep_) if (IN(13)) { PH_ENTER(); CLK_BEGIN(13); route_phase((const _Float16*)(ws + WS_XH), INP(18) + 1024, INP(22), ws, lds, G, vcu, tid, lane, wave); CLK_END(13); if (BOTH(13)) GRID_BAR(); }
    _Pragma("nounroll") for (int rep_ = 0; rep_ < REPS(14); ++rep_) if (IN(14)) { PH_ENTER(); CLK_BEGIN(14); pos_phase(ws, lds, G, vcu, tid, lane, wave); CLK_END(14); if (BOTH(14)) GRID_BAR(); }
    _Pragma("nounroll") for (int rep_ = 0; rep_ < REPS(15); ++rep_) if (IN(15)) { PH_ENTER(); CLK_BEGIN(15);
        const int* gofs = (const int*)(ws + WS_GOFS); const int* rowtok = (const int*)(ws + WS_ROWTOK);
        const int ntile = gofs[16];
        pg8::MoeOrder S; S.so.init(ntile * 256, 7168, G, bx, 1024 / 128); S.p0 = 0; S.p1 = 0; S.ppu = 0;
        S.t1 = gofs[32 + 1]; S.t2 = gofs[32 + 2]; S.t3 = gofs[32 + 3]; S.t4 = gofs[32 + 4]; S.t5 = gofs[32 + 5]; S.t6 = gofs[32 + 6]; S.t7 = gofs[32 + 7];
        pg8::Gemm g{(const bf16*)(ws + WS_H3), (const bf16*)(ws + WS_WM13), ntile * 256, 7168, 1024, (size_t)7168 * 1024, rowtok, nullptr, nullptr, nullptr, 0};
        pg8::EpiGated<3> E{(bf16*)(ws + WS_HM), DFFE, nullptr, 0, nullptr, 1.f / (SA_N * SW_I8), HM_SCALE, {}, -1, lds + XTRA_OFF};
        pg8::gemm_phase<pg8::EpiGated<3>, pg8::MoeOrder, true, 2>(lds + RING_OFF, g, S, E, tid);
        CLK_END(15); if (BOTH(15)) GRID_BAR();
    }
    _Pragma("nounroll") for (int rep_ = 0; rep_ < REPS(16); ++rep_) if (IN(16)) { PH_ENTER(); CLK_BEGIN(16);
        const int* gofs = (const int*)(ws + WS_GOFS); const float* rowgate = (const float*)(ws + WS_ROWGATE);
        const int ntile = gofs[16];
        pg8::MoeOrderSK S; S.so.init(ntile * 256, 1024, G, vcu, DFFE / 128); S.plan();
        S.t1 = gofs[32 + 1]; S.t2 = gofs[32 + 2]; S.t3 = gofs[32 + 3]; S.t4 = gofs[32 + 4]; S.t5 = gofs[32 + 5]; S.t6 = gofs[32 + 6]; S.t7 = gofs[32 + 7];
        pg8::Gemm g{(const bf16*)(ws + WS_HM), (const bf16*)(ws + WS_WM2), ntile * 256, 1024, DFFE, (size_t)1024 * DFFE, nullptr, ws + WS_SLAB, (unsigned*)(ws + WS_CTL) + CW_SKFLAG + (rep_ & 1) * 8192, (unsigned*)(ws + WS_CTL) + CW_TMO, 0};
        pg8::EpiMoeDown E{ws + WS_Y, rowgate, Y_SCALE / (W8_SCALE * HM_SCALE)};
        pg8::gemm_phase<pg8::EpiMoeDown, pg8::MoeOrderSK, false, 1>(lds + RING_OFF, g, S, E, tid);
        CLK_END(16); if (BOTH(16)) GRID_BAR();
    }
    _Pragma("nounroll") for (int rep_ = 0; rep_ < REPS(17); ++rep_) if (IN(17)) { PH_ENTER(); CLK_BEGIN(17); combine_phase(out, ws, G, vcu, tid, lane, wave); }
#ifdef PROBE_CLK_PHASE
    if (bx == 0 && tid0 == 0) { asm volatile("s_waitcnt vmcnt(0)" ::: "memory"); args.out[(size_t)T * D - 1] = ((float*)(args.ws + WS_GOFS))[100]; }
#endif
#ifdef PROBE_TCH
    {
        GRID_BAR();
        if (bx == 0 && tid0 == 0) { const unsigned tot = __hip_atomic_load((unsigned*)(args.ws + WS_CTL) + 60000, __ATOMIC_RELAXED, __HIP_MEMORY_SCOPE_AGENT); const unsigned long long wait_ticks = (unsigned long long)(tot / (unsigned)G) * PROBE_TCH;
            const unsigned long long t0_ = __builtin_amdgcn_s_memrealtime(); while (__builtin_amdgcn_s_memrealtime() - t0_ < wait_ticks) __builtin_amdgcn_s_sleep(8); } }
#endif
#undef IN
#undef BOTH
#undef GRID_BAR
}

extern "C" void kernel_launch(void* const* d_in, const int* in_sizes, int n_in, void* d_out, int out_size, void* d_ws, size_t ws_size, hipStream_t stream) {
    static int grid = 0;
    if (grid == 0) {
        if (n_in != 26 || in_sizes[0] != T * D || out_size != T * D || ws_size < WS_END) { fprintf(stderr, "kernel_launch: unexpected shapes: n_in %d in0 %d out %d ws %zu (need >= %zu); nothing launched\n", n_in, n_in > 0 ? in_sizes[0] : -1, out_size, ws_size, (size_t)WS_END); grid = -1; return; }
        int dev = 0, cus = 0;
        if (hipGetDevice(&dev) != hipSuccess || hipDeviceGetAttribute(&cus, hipDeviceAttributeMultiprocessorCount, dev) != hipSuccess) { fprintf(stderr, "kernel_launch: device query failed\n"); grid = -1; return; }
        if (hipFuncSetAttribute((const void*)mk_fwd, hipFuncAttributeMaxDynamicSharedMemorySize, LDS_BYTES) != hipSuccess) { fprintf(stderr, "kernel_launch: hipFuncSetAttribute failed\n"); grid = -1; return; }
        int per_cu = 0;
        if (hipOccupancyMaxActiveBlocksPerMultiprocessor(&per_cu, (const void*)mk_fwd, NWAVES * 64, LDS_BYTES) != hipSuccess || per_cu < 1) fprintf(stderr, "kernel_launch: note: occupancy query reports %d workgroups per CU\n", per_cu);
        (void)hipGetLastError();
        grid = cus;
    }
    if (grid < 0) return;
    if (hipMemsetAsync((char*)d_ws + WS_CTL, 0, CTL_ZERO_BYTES, stream) != hipSuccess) { fprintf(stderr, "kernel_launch: hipMemsetAsync failed\n"); return; }
    Args a{};
    for (int i = 0; i < 26; ++i) a.in[i] = (const float*)d_in[i];
    a.out = (float*)d_out; a.ws = (unsigned char*)d_ws;
    for (int li = 0; li < N_LAUNCHES; ++li) {
        a.ph_lo = (N_LAUNCHES == 1) ? 0 : li; a.ph_hi = (N_LAUNCHES == 1) ? NPHASE : li + 1;
        hipLaunchKernelGGL(mk_fwd, dim3(grid), dim3(NWAVES * 64), LDS_BYTES, stream, a);
        const hipError_t le = hipPeekAtLastError();
        if (le != hipSuccess) { fprintf(stderr, "kernel_launch: launch %d failed: %s\n", li, hipGetErrorName(le)); break; }
    }
}
```

```cpp
#include <hip/hip_runtime.h>
#include <cstdio>
#include <cstdint>
#ifndef MK_N_LAUNCHES
#define MK_N_LAUNCHES 1
#endif
namespace pg8 {
#define PG8_LAS __attribute__((address_space(3)))
#define PG8_GAS __attribute__((address_space(1)))
typedef unsigned short bf16_t;
typedef short bf16x8 __attribute__((ext_vector_type(8)));
typedef float f32x4 __attribute__((ext_vector_type(4)));
typedef float f32x2 __attribute__((ext_vector_type(2)));
typedef unsigned u32x4 __attribute__((ext_vector_type(4)));
typedef unsigned u32x2 __attribute__((ext_vector_type(2)));
typedef int v4i_t __attribute__((ext_vector_type(4)));
typedef int v8i_t __attribute__((ext_vector_type(8)));
constexpr int BM = 256, BK = 64, HALF = 128, HTB = HALF * BK * 2  , STAGE_BYTES = 8 * HTB, NXCD = 8, WGM = 8;

__host__ __device__ __forceinline__ int lds_byte(int r, int c) { return r * 128 + ((((c >> 3) ^ r) & 7) << 4) + (c & 7) * 2; }
__host__ __device__ __forceinline__ void stage_rc(int b, int& R, int& C) { R = b >> 7; C = ((((b >> 4) ^ R) & 7) << 3) + ((b & 15) >> 1); }
__host__ __device__ __forceinline__ int perm32(int rho) { const int n = rho >> 4, i = rho & 15; return 8 * (i >> 2) + 4 * n + (i & 3); }

struct Unit { int pm, pn, be, kt0, nkt, part; };
struct Gemm { const bf16_t* A; const bf16_t* Bt; int M, N, K; size_t bstride; const int* rowtok; unsigned char* slab; unsigned* skflag; unsigned* tmo; int noepi; };

struct StaticOrder {
    static constexpr bool STREAMK = false;
    int nM, nN, nwg, G, c, nt, i0, i1;
    __host__ __device__ __forceinline__ void init(int M, int N, int G_, int c_, int nt_) { nM = M / BM; nN = N / BM; nwg = nM * nN; G = G_; c = c_; nt = nt_; i0 = 0; i1 = 0x7fffffff; }
    __host__ __device__ __forceinline__ int wg() const { return c; }
    __host__ __device__ __forceinline__ bool next(int i, Unit& u) const { const int ii = i + i0; if (ii >= i1) return false; const long L = (long)ii * G + c; if (L >= nwg) return false; map((int)L, u); return true; }
    __host__ __device__ __forceinline__ void map_linear(int wgid, Unit& u) const {
        const int nig = WGM * nN, gid = wgid / nig, fm = gid * WGM, gsz = (nM - fm) < WGM ? (nM - fm) : WGM;
        u.pm = fm + ((wgid % nig) % gsz); u.pn = (wgid % nig) / gsz; u.be = 0; u.kt0 = 0; u.nkt = nt; u.part = 0;
    }
    __host__ __device__ __forceinline__ void map(int L, Unit& u) const {
        int wgid = L; { const int q = nwg / NXCD, r = nwg % NXCD, xcd = wgid % NXCD, off = wgid / NXCD; wgid = (xcd < r ? xcd * (q + 1) : r * (q + 1) + (xcd - r) * q) + off; }
        const int nig = WGM * nN, gid = wgid / nig, fm = gid * WGM, gsz = (nM - fm) < WGM ? (nM - fm) : WGM;
        u.pm = fm + ((wgid % nig) % gsz); u.pn = (wgid % nig) / gsz; u.be = 0; u.kt0 = 0; u.nkt = nt; u.part = 0;
    }
};
template <bool STREAMK_> struct MoeOrderT {
    static constexpr bool STREAMK = STREAMK_;
    StaticOrder so; int t1, t2, t3, t4, t5, t6, t7; int p0, p1, ppu;
    __device__ __forceinline__ int wg() const { return so.c; }
    __device__ __forceinline__ void plan() { ppu = so.nt / 2; const long tot = (long)so.nwg * ppu; p0 = (int)(tot * so.c / so.G); p1 = (int)(tot * (so.c + 1) / so.G); }
    __device__ __forceinline__ bool next(int i, Unit& u) const {
#if defined(PROBE_DOUBLE_KLOOP)
        if (!STREAMK) { if (!so.next(i >> 1, u)) return false; if (!(i & 1)) u.part = 3; }
#else
        if (!STREAMK) { if (!so.next(i, u)) return false; }
#endif
        else { const int first = p0 / ppu, uidx = first + i; const int s = (i == 0) ? (p0 - first * ppu) : 0; const int rem = p1 - uidx * ppu;
            if (rem <= s) return false;
            const int e = rem < ppu ? rem : ppu;
            so.map_linear(uidx, u); u.kt0 = 2 * s; u.nkt = 2 * (e - s); u.part = (s > 0) ? 1 : ((e < ppu) ? 2 : 0); }
        const int q = u.pm; u.be = (q >= t1) + (q >= t2) + (q >= t3) + (q >= t4) + (q >= t5) + (q >= t6) + (q >= t7); return true;
    }
};
typedef MoeOrderT<false> MoeOrder;
typedef MoeOrderT<true> MoeOrderSK;

__device__ __forceinline__ unsigned cvt_pk_bf16(float lo, float hi) { unsigned r; asm volatile("v_cvt_pk_bf16_f32 %0, %1, %2" : "=v"(r) : "v"(lo), "v"(hi)); return r; }
__device__ __forceinline__ float fast_sigmoid(float x) { return __builtin_amdgcn_rcpf(1.0f + __builtin_amdgcn_exp2f(-1.4426950408889634f * x)); }
__device__ __forceinline__ float row_rstd(const float* part, int row) {
    const f32x4 a = *(const f32x4*)(part + (size_t)row * 4);
    return __builtin_amdgcn_rsqf(((a[0] + a[1]) + (a[2] + a[3])) * (1.0f / 1024.0f) + 1e-6f);
}
__device__ __forceinline__ void row_rstd8(const float* part, int row0, float (&r)[2][4]) {
#pragma unroll
    for (int ai = 0; ai < 2; ++ai)
#pragma unroll
        for (int m = 0; m < 4; ++m) r[ai][m] = row_rstd(part, row0 + ai * HALF + m * 16);
}
__device__ __forceinline__ unsigned pk_fp8x4(float a, float b, float c, float d) {
    a = __builtin_amdgcn_fmed3f(a, -448.f, 448.f); b = __builtin_amdgcn_fmed3f(b, -448.f, 448.f); c = __builtin_amdgcn_fmed3f(c, -448.f, 448.f); d = __builtin_amdgcn_fmed3f(d, -448.f, 448.f);
    unsigned w = 0u; w = __builtin_amdgcn_cvt_pk_fp8_f32(a, b, w, false); w = __builtin_amdgcn_cvt_pk_fp8_f32(c, d, w, true); return w;
}
__device__ __forceinline__ unsigned pk_i8x4(float a, float b, float c, float d) {
    const int ia = (int)__builtin_rintf(__builtin_amdgcn_fmed3f(a, -127.f, 127.f)), ib = (int)__builtin_rintf(__builtin_amdgcn_fmed3f(b, -127.f, 127.f));
    const int ic = (int)__builtin_rintf(__builtin_amdgcn_fmed3f(c, -127.f, 127.f)), id = (int)__builtin_rintf(__builtin_amdgcn_fmed3f(d, -127.f, 127.f));
    return ((unsigned)ia & 255u) | (((unsigned)ib & 255u) << 8) | (((unsigned)ic & 255u) << 16) | ((unsigned)id << 24);
}

template <int MODE> struct EpiGated {
    static constexpr bool PERM = true, AFTER_DRAIN = false;
    bf16_t* O; int ldo; const float* bias; int bias_half; const float* part; float descale, out_scale;
    mutable float r8c[2][4]; mutable int pmc; PG8_LAS unsigned char* stg;
    __device__ __forceinline__ void operator()(const f32x4 (&acc)[2][2][4][2], const Unit& u, int wr, int wc, int fr, int fq) const {
        const int row0 = u.pm * BM + wr * 64 + fr, col0 = u.pn * 128 + wc * 32 + 8 * fq;
        const int lane = fq * 16 + fr, colw = u.pn * 128 + wc * 32; PG8_LAS unsigned char* W = stg + (wr * 4 + wc) * 1536;
        f32x4 ba[2], bg[2];
#pragma unroll
        for (int n = 0; n < 2; ++n) { if (MODE == 0) { ba[n] = *(const f32x4*)(bias + col0 + 4 * n); bg[n] = *(const f32x4*)(bias + bias_half + col0 + 4 * n); } else { ba[n] = (f32x4){0.f, 0.f, 0.f, 0.f}; bg[n] = ba[n]; } }
        if ((MODE == 1 || MODE == 4) && u.pm != pmc) { row_rstd8(part, row0, r8c); pmc = u.pm; }
#pragma unroll
        for (int ai = 0; ai < 2; ++ai)
#pragma unroll
            for (int m = 0; m < 4; ++m) { const int row = row0 + ai * HALF + m * 16;
                float r = 1.f; if (MODE == 1 || MODE == 4) r = r8c[ai][m];
                f32x4 o[2];
#pragma unroll
                for (int n = 0; n < 2; ++n) { f32x4 a = acc[ai][0][m][n], g = acc[ai][1][m][n];
                    if (MODE == 0) { a = a * descale + ba[n]; g = g * descale + bg[n];
#pragma unroll
                        for (int e = 0; e < 4; ++e) o[n][e] = a[e] * fast_sigmoid(g[e]); }
                    else if (MODE == 3) {
                        const float c1 = -1.4426950408889634f * descale, c2 = descale * descale * out_scale;
#pragma unroll
                        for (int e = 0; e < 4; ++e) o[n][e] = (a[e] * g[e]) * __builtin_amdgcn_rcpf(1.0f + __builtin_amdgcn_exp2f(a[e] * c1)) * c2; }
                    else { if (MODE == 1) { a = a * (r * descale); g = g * (r * descale); } if (MODE == 4) { a = a * (r * descale); g = g * (r * descale * out_scale); }
#pragma unroll
                        for (int e = 0; e < 4; ++e) o[n][e] = a[e] * fast_sigmoid(a[e]) * g[e]; } }
                if (MODE == 3 || MODE == 4) { u32x2 w; w.x = pk_fp8x4(o[0][0], o[0][1], o[0][2], o[0][3]); w.y = pk_fp8x4(o[1][0], o[1][1], o[1][2], o[1][3]);
                    *(PG8_LAS u32x2*)(W + ((m & 1) * 16 + fr) * 48 + fq * 8) = w;
                    if (m & 1) { __builtin_amdgcn_wave_barrier();
                        const int rr = lane >> 1, pp = lane & 1; const u32x4 ov = *(const PG8_LAS u32x4*)(W + rr * 48 + pp * 16);
                        *(u32x4*)((unsigned char*)O + (size_t)(row - fr - 16 + rr) * ldo + colw + pp * 16) = ov;
                        __builtin_amdgcn_wave_barrier(); } }
                else { u32x4 w; w.x = cvt_pk_bf16(o[0][0], o[0][1]); w.y = cvt_pk_bf16(o[0][2], o[0][3]); w.z = cvt_pk_bf16(o[1][0], o[1][1]); w.w = cvt_pk_bf16(o[1][2], o[1][3]);
                    *(PG8_LAS u32x4*)(W + fr * 80 + fq * 16) = w;
                    __builtin_amdgcn_wave_barrier();
                    const int rr = lane >> 2, pp = lane & 3; const u32x4 ov = *(const PG8_LAS u32x4*)(W + rr * 80 + pp * 16);
                    *(u32x4*)(O + (size_t)(row - fr + rr) * ldo + colw + pp * 8) = ov;
                    __builtin_amdgcn_wave_barrier(); }
                }
    }
};
typedef _Float16 h16x4 __attribute__((ext_vector_type(4)));
typedef _Float16 h16x8 __attribute__((ext_vector_type(8)));
typedef float f32x8 __attribute__((ext_vector_type(8)));
template <bool BIAS, bool AUX, int XB8 = 0, int RIN = 0, int ROUT = 0> struct EpiResid {
    static constexpr bool PERM = true, AFTER_DRAIN = false;
    static_assert(ROUT == 1 && (!AUX || XB8 != 0), "the staged epilogue writes fp16 rows and 1-byte copies");
    const float* resid; float* out; const float* bias; unsigned char* xb; float* part; float descale, xb_scale; PG8_LAS float* red; PG8_LAS unsigned char* stg;
    __device__ __forceinline__ void operator()(const f32x4 (&acc)[2][2][4][2], const Unit& u, int wr, int wc, int fr, int fq) const {
        const int colw = u.pn * BM + wc * 32, col0 = colw + 8 * fq, lane = fq * 16 + fr;
        const int s4 = lane >> 2, p4 = lane & 3, s8 = lane >> 3, p8 = lane & 7;
        PG8_LAS unsigned char* W = stg + (wr * 4 + wc) * 2304;
        f32x4 bv[2][2];
#pragma unroll
        for (int bj = 0; bj < 2; ++bj)
#pragma unroll
            for (int n = 0; n < 2; ++n) bv[bj][n] = BIAS ? *(const f32x4*)(bias + col0 + bj * HALF + n * 4) : (f32x4){0.f, 0.f, 0.f, 0.f};
#pragma unroll
        for (int ai = 0; ai < 2; ++ai) {
            const int rowh = u.pm * BM + wr * 64 + ai * HALF;
            constexpr int MB = RIN ? 4 : 2;
            u32x4 rl[4][RIN ? 2 : 4];
#pragma unroll
            for (int m = 0; m < 4; ++m) {
              if (m % MB == 0) {
#pragma unroll
                for (int mm = m; mm < m + MB; ++mm)
#pragma unroll
                    for (int bj = 0; bj < 2; ++bj) {
                        if (RIN) rl[mm][bj] = *(const u32x4*)((const _Float16*)resid + (size_t)(rowh + mm * 16 + s4) * 1024 + colw + bj * HALF + p4 * 8);
                        else { rl[mm][bj * 2] = *(const u32x4*)(resid + (size_t)(rowh + mm * 16 + s8) * 1024 + colw + bj * HALF + p8 * 4); rl[mm][bj * 2 + 1] = *(const u32x4*)(resid + (size_t)(rowh + mm * 16 + s8 + 8) * 1024 + colw + bj * HALF + p8 * 4); } }
                asm volatile("" ::: "memory");
              }
              { const int rowg = rowh + m * 16; float ss = 0.f;
                f32x4 r[2][2];
                if (RIN) {
                    *(PG8_LAS u32x4*)(W + s4 * 144 + p4 * 16) = rl[m][0]; *(PG8_LAS u32x4*)(W + s4 * 144 + 64 + p4 * 16) = rl[m][1];
                    __builtin_amdgcn_wave_barrier();
#pragma unroll
                    for (int bj = 0; bj < 2; ++bj) { const f32x8 r8 = __builtin_convertvector(*(const PG8_LAS h16x8*)(W + fr * 144 + bj * 64 + fq * 16), f32x8); r[bj][0] = (f32x4){r8[0], r8[1], r8[2], r8[3]}; r[bj][1] = (f32x4){r8[4], r8[5], r8[6], r8[7]}; }
                    __builtin_amdgcn_wave_barrier();
                } else {
#pragma unroll
                    for (int bj = 0; bj < 2; ++bj) {
                        *(PG8_LAS u32x4*)(W + s8 * 144 + p8 * 16) = rl[m][bj * 2]; *(PG8_LAS u32x4*)(W + (s8 + 8) * 144 + p8 * 16) = rl[m][bj * 2 + 1];
                        __builtin_amdgcn_wave_barrier();
                        r[bj][0] = *(const PG8_LAS f32x4*)(W + fr * 144 + fq * 32); r[bj][1] = *(const PG8_LAS f32x4*)(W + fr * 144 + fq * 32 + 16);
                        __builtin_amdgcn_wave_barrier(); }
                }
                f32x4 x[2][2];
#pragma unroll
                for (int bj = 0; bj < 2; ++bj)
#pragma unroll
                    for (int n = 0; n < 2; ++n) { x[bj][n] = r[bj][n] + acc[ai][bj][m][n] * descale + bv[bj][n]; const f32x4 q = x[bj][n]; ss += (q[0] * q[0] + q[1] * q[1]) + (q[2] * q[2] + q[3] * q[3]); }
#pragma unroll
                for (int bj = 0; bj < 2; ++bj) { const f32x8 x8 = {x[bj][0][0], x[bj][0][1], x[bj][0][2], x[bj][0][3], x[bj][1][0], x[bj][1][1], x[bj][1][2], x[bj][1][3]}; *(PG8_LAS h16x8*)(W + fr * 144 + bj * 64 + fq * 16) = __builtin_convertvector(x8, h16x8); }
                __builtin_amdgcn_wave_barrier();
#pragma unroll
                for (int bj = 0; bj < 2; ++bj) *(u32x4*)((_Float16*)out + (size_t)(rowg + s4) * 1024 + colw + bj * HALF + p4 * 8) = *(const PG8_LAS u32x4*)(W + s4 * 144 + bj * 64 + p4 * 16);
                __builtin_amdgcn_wave_barrier();
                if (AUX) {
#pragma unroll
                    for (int bj = 0; bj < 2; ++bj) { u32x2 w;
                        if (XB8 == 1) { w.x = pk_fp8x4(x[bj][0][0] * xb_scale, x[bj][0][1] * xb_scale, x[bj][0][2] * xb_scale, x[bj][0][3] * xb_scale); w.y = pk_fp8x4(x[bj][1][0] * xb_scale, x[bj][1][1] * xb_scale, x[bj][1][2] * xb_scale, x[bj][1][3] * xb_scale); }
                        else { w.x = pk_i8x4(x[bj][0][0] * xb_scale, x[bj][0][1] * xb_scale, x[bj][0][2] * xb_scale, x[bj][0][3] * xb_scale); w.y = pk_i8x4(x[bj][1][0] * xb_scale, x[bj][1][1] * xb_scale, x[bj][1][2] * xb_scale, x[bj][1][3] * xb_scale); }
                        *(PG8_LAS u32x2*)(W + fr * 80 + bj * 32 + fq * 8) = w; }
                    __builtin_amdgcn_wave_barrier();
                    *(u32x4*)(xb + (size_t)(rowg + s4) * 1024 + colw + (p4 >> 1) * HALF + (p4 & 1) * 16) = *(const PG8_LAS u32x4*)(W + s4 * 80 + (p4 >> 1) * 32 + (p4 & 1) * 16);
                    __builtin_amdgcn_wave_barrier();
                    ss += __shfl_xor(ss, 16); ss += __shfl_xor(ss, 32); if (fq == 0) red[(ai * HALF + wr * 64 + m * 16 + fr) * 4 + wc] = ss; }
              }
            }
        }
        if (AUX) {
            __syncthreads();
            const int t = ((wr * 4 + wc) << 6) | (fq * 16 + fr);
            if (t < BM) { const f32x4 q = *(const PG8_LAS f32x4*)(red + t * 4); part[(size_t)(u.pm * BM + t) * 4 + u.pn] = (q[0] + q[1]) + (q[2] + q[3]); }
            __syncthreads();
        }
    }
};
struct EpiQKV {
    static constexpr bool PERM = true, AFTER_DRAIN = false;
    bf16_t* Kb; size_t kvq_stride; const float* part; const float* kgain; const float* qgain; float qscale, descale;
    mutable float r8c[2][4]; mutable int pmc; PG8_LAS unsigned char* stg;
    __device__ __forceinline__ void operator()(const f32x4 (&acc)[2][2][4][2], const Unit& u, int wr, int wc, int fr, int fq) const {
        const int kind = u.pn >> 2, head = (u.pn & 3) * 4 + wc;
        bf16_t* dst = Kb + (size_t)kind * kvq_stride;
        const float* gsrc = kind == 0 ? kgain : qgain; const float gs = kind == 2 ? qscale : 1.f;
        const int row0 = u.pm * BM + wr * 64 + fr, colb = head * 64 + 8 * fq; (void)colb;
        PG8_LAS unsigned char* ws_ = stg + (wr * 4 + wc) * 2304;
        f32x4 gv[2][2];
#pragma unroll
        for (int bj = 0; bj < 2; ++bj)
#pragma unroll
            for (int n = 0; n < 2; ++n) gv[bj][n] = *(const f32x4*)(gsrc + 32 * bj + 8 * fq + 4 * n) * gs;
        if (u.pm != pmc) { row_rstd8(part, row0, r8c); pmc = u.pm; }
#pragma unroll
        for (int ai = 0; ai < 2; ++ai)
#pragma unroll
            for (int m = 0; m < 4; ++m) { const int row = row0 + ai * HALF + m * 16; const float r = r8c[ai][m] * descale;
                f32x4 v[2][2]; float ss = 0.f;
#pragma unroll
                for (int bj = 0; bj < 2; ++bj)
#pragma unroll
                    for (int n = 0; n < 2; ++n) { v[bj][n] = acc[ai][bj][m][n] * r; const f32x4 x = v[bj][n]; ss += (x[0] * x[0] + x[1] * x[1]) + (x[2] * x[2] + x[3] * x[3]); }
                ss += __shfl_xor(ss, 16); ss += __shfl_xor(ss, 32);
                if (kind != 1) { const float inv = __builtin_amdgcn_rsqf(ss * (1.0f / 64.0f) + 1e-6f);
#pragma unroll
                    for (int bj = 0; bj < 2; ++bj)
#pragma unroll
                        for (int n = 0; n < 2; ++n) v[bj][n] = v[bj][n] * gv[bj][n] * inv; }
#pragma unroll
                for (int bj = 0; bj < 2; ++bj) { u32x4 w; w.x = cvt_pk_bf16(v[bj][0][0], v[bj][0][1]); w.y = cvt_pk_bf16(v[bj][0][2], v[bj][0][3]); w.z = cvt_pk_bf16(v[bj][1][0], v[bj][1][1]); w.w = cvt_pk_bf16(v[bj][1][2], v[bj][1][3]);
                    *(PG8_LAS u32x4*)(ws_ + fr * 144 + bj * 64 + fq * 16) = w; }
                { const int l = fq * 16 + fr, rr = l >> 3, cc = l & 7; const int rowb = row - fr;
                  const u32x4 o0 = *(const PG8_LAS u32x4*)(ws_ + rr * 144 + cc * 16), o1 = *(const PG8_LAS u32x4*)(ws_ + (rr + 8) * 144 + cc * 16);
                  *(u32x4*)(dst + (size_t)(rowb + rr) * 1024 + head * 64 + cc * 8) = o0; *(u32x4*)(dst + (size_t)(rowb + rr + 8) * 1024 + head * 64 + cc * 8) = o1; }
                __builtin_amdgcn_sched_barrier(0); }
    }
};
struct EpiMoeDown {
    static constexpr bool PERM = true, AFTER_DRAIN = false;
    unsigned char* Y; const float* rowgate; float descale;
    template <bool ADD> __device__ __forceinline__ void run(const f32x4 (&acc)[2][2][4][2], const Unit& u, int wr, int wc, int fr, int fq, const PG8_GAS u32x2* sl) const {
        const int rt0 = u.pm * BM + wr * 64 + fr, col0 = u.pn * BM + wc * 32 + 8 * fq;
        float gtv[2][4];
#pragma unroll
        for (int ai = 0; ai < 2; ++ai)
#pragma unroll
            for (int m = 0; m < 4; ++m) gtv[ai][m] = rowgate[rt0 + ai * HALF + m * 16] * descale;
#pragma unroll
        for (int ai = 0; ai < 2; ++ai) {
#pragma unroll
            for (int m = 0; m < 4; ++m) { const float gt = gtv[ai][m]; unsigned char* p = Y + (size_t)(rt0 + ai * HALF + m * 16) * 1024 + col0;
#pragma unroll
                for (int bj = 0; bj < 2; ++bj) { f32x4 s0 = acc[ai][bj][m][0], s1 = acc[ai][bj][m][1];
                    if (ADD) { const u32x2 q0 = sl[bj * 2 + 0], q1 = sl[bj * 2 + 1];
                        s0[0] += __uint_as_float(q0.x << 16); s0[1] += __uint_as_float(q0.x & 0xffff0000u); s0[2] += __uint_as_float(q0.y << 16); s0[3] += __uint_as_float(q0.y & 0xffff0000u);
                        s1[0] += __uint_as_float(q1.x << 16); s1[1] += __uint_as_float(q1.x & 0xffff0000u); s1[2] += __uint_as_float(q1.y << 16); s1[3] += __uint_as_float(q1.y & 0xffff0000u); }
                    s0 = s0 * gt; s1 = s1 * gt;
                    u32x2 w; w.x = pk_i8x4(s0[0], s0[1], s0[2], s0[3]); w.y = pk_i8x4(s1[0], s1[1], s1[2], s1[3]);
                    *(u32x2*)(p + bj * HALF) = w; }
                if (ADD) { sl += 512 * 4; asm volatile("" : "+v"(sl)); } }
            asm volatile("" ::: "memory"); }
    }
    __device__ __forceinline__ void operator()(const f32x4 (&acc)[2][2][4][2], const Unit& u, int wr, int wc, int fr, int fq) const { run<false>(acc, u, wr, wc, fr, fq, nullptr); }
};

template <class Epi, class Sched, bool GATHER, int PREC = 0>
__device__ __forceinline__ void gemm_phase(PG8_LAS unsigned char* lds, const Gemm g, const Sched& S, const Epi& E, const int tid) {
    constexpr bool FP8 = (PREC == 1), I8 = (PREC == 2), BYTE1 = (PREC != 0);
    const int wid = __builtin_amdgcn_readfirstlane(tid >> 6), lane = tid & 63, wr = wid >> 2, wc = wid & 3, fr = lane & 15, fq = lane >> 4;
    const int K = g.K;
    const int rowb = BYTE1 ? K : 2 * K;
    unsigned voffB[2]; unsigned vC0[2], vC1[2], vN0[2], vN1[2]; int Rr[2], Cc[2];
#pragma unroll
    for (int i = 0; i < 2; ++i) { int R, C; stage_rc(tid * 16 + i * 8192, R, C); const int Rb = Epi::PERM ? ((R & ~31) + perm32(R & 31)) : R;
        Rr[i] = R; Cc[i] = C; vC0[i] = (unsigned)(R * rowb + C * 2); vC1[i] = vC0[i]; vN0[i] = vC0[i]; vN1[i] = vC0[i]; voffB[i] = (unsigned)(Rb * rowb + C * 2); }
    const size_t kstep = (size_t)(BK * 2);
    const size_t hstep = (size_t)HALF * rowb;
    const size_t hstepA = GATHER ? 0 : hstep;
    const size_t tstep = 2 * hstep;
    const unsigned ldsw = (unsigned)wid * 1024u;
    const int aoff = lds_byte(wr * 64 + fr, fq * 8), boff = lds_byte(wc * 32 + fr, fq * 8);
    const int aoff1 = aoff ^ 64, boff1 = boff ^ 64;
#define PG8_SA(b, h) (((b) * 2 + (h)) * HTB)
#define PG8_SB(b, h) ((4 + (b) * 2 + (h)) * HTB)
#define PG8_STAGE(bufoff, gbase, v0, v1) do { \
        __builtin_amdgcn_global_load_lds((const unsigned*)((const char*)(gbase) + (v0)), (PG8_LAS unsigned*)(lds + (bufoff) + ldsw), 16, 0, 0); \
        __builtin_amdgcn_global_load_lds((const unsigned*)((const char*)(gbase) + (v1)), (PG8_LAS unsigned*)(lds + (bufoff) + ldsw + 8192), 16, 0, 0); } while (0)
#define PG8_LD8(addr, addr1) __builtin_shufflevector(*(const PG8_LAS v4i_t*)(addr), *(const PG8_LAS v4i_t*)(addr1), 0, 1, 2, 3, 4, 5, 6, 7)
#define PG8_LDA(dst, b, h) do { if (FP8) { _Pragma("unroll") for (int m = 0; m < 4; ++m) dst##8[m] = PG8_LD8(lds + PG8_SA(b, h) + aoff + m * 2048, lds + PG8_SA(b, h) + aoff1 + m * 2048); } else { \
        _Pragma("unroll") for (int m = 0; m < 4; ++m) _Pragma("unroll") for (int k = 0; k < 2; ++k) dst[m][k] = *(const PG8_LAS bf16x8*)(lds + PG8_SA(b, h) + (k ? aoff1 : aoff) + m * 2048); } } while (0)
#define PG8_LDB(dst, b, h) do { if (FP8) { _Pragma("unroll") for (int n = 0; n < 2; ++n) dst##8[n] = PG8_LD8(lds + PG8_SB(b, h) + boff + n * 2048, lds + PG8_SB(b, h) + boff1 + n * 2048); } else { \
        _Pragma("unroll") for (int n = 0; n < 2; ++n) _Pragma("unroll") for (int k = 0; k < 2; ++k) dst[n][k] = *(const PG8_LAS bf16x8*)(lds + PG8_SB(b, h) + (k ? boff1 : boff) + n * 2048); } } while (0)
#if defined(PROBE_HALF_MFMA)
#define PG8_SKIP(ai) ((ai) == 1 && cur.part == 3)
#else
#define PG8_SKIP(ai) false
#endif
#define PG8_MMA(ai, bj, At, Bt) do { if (PG8_SKIP(ai)) break; __builtin_amdgcn_s_setprio(1); _Pragma("unroll") for (int m = 0; m < 4; ++m) _Pragma("unroll") for (int n = 0; n < 2; ++n) { \
        if (FP8) asm volatile("v_mfma_scale_f32_16x16x128_f8f6f4 %0, %1, %2, %0, %3, %3 op_sel_hi:[0,0,0]" : "+v"(acc[ai][bj][m][n]) : "v"(Bt##8[n]), "v"(At##8[m]), "v"(sc1)); \
        else if (I8) { _Pragma("unroll") for (int k = 0; k < 2; ++k) acc[ai][bj][m][n] = __builtin_bit_cast(f32x4, __builtin_amdgcn_mfma_i32_16x16x64_i8(__builtin_bit_cast(v4i_t, Bt[n][k]), __builtin_bit_cast(v4i_t, At[m][k]), __builtin_bit_cast(v4i_t, acc[ai][bj][m][n]), 0, 0, 0)); } \
        else { _Pragma("unroll") for (int k = 0; k < 2; ++k) acc[ai][bj][m][n] = __builtin_amdgcn_mfma_f32_16x16x32_bf16(Bt[n][k], At[m][k], acc[ai][bj][m][n], 0, 0, 0); } } __builtin_amdgcn_s_setprio(0); } while (0)
#define PG8_WAIT_V(n) asm volatile("s_waitcnt vmcnt(" #n ")" ::: "memory")
#define PG8_WAIT_L(n) asm volatile("s_waitcnt lgkmcnt(" #n ")" ::: "memory")
#define PG8_BAR __builtin_amdgcn_s_barrier()
#define PG8_SCHED __builtin_amdgcn_sched_barrier(0)
#define PG8_TOKOFF(pm_, h_, i_) ({ int t_ = g.rowtok[(pm_) * BM + (h_) * HALF + Rr[i_]]; t_ = t_ < 0 ? 0 : t_; (unsigned)(t_ * rowb + Cc[i_] * 2); })
    unsigned sc1 = 0u; if (FP8) asm volatile("v_mov_b32 %0, 0x7f7f7f7f" : "=v"(sc1));
    Unit cur, nxt; int ui = 0;
    if (!S.next(0, cur)) return;
    f32x4 acc[2][2][4][2];
#pragma unroll
    for (int a = 0; a < 2; ++a)
#pragma unroll
        for (int b = 0; b < 2; ++b)
#pragma unroll
            for (int m = 0; m < 4; ++m)
#pragma unroll
                for (int n = 0; n < 2; ++n) acc[a][b][m][n] = (f32x4){0.f, 0.f, 0.f, 0.f};
    bf16x8 At[4][2], B0[2][2], B1[2][2]; v8i_t At8[4], B08[2], B18[2];
    if (GATHER) {
#pragma unroll
        for (int i = 0; i < 2; ++i) { vC0[i] = PG8_TOKOFF(cur.pm, 0, i); vC1[i] = PG8_TOKOFF(cur.pm, 1, i); }
    }
    const char* cA = (GATHER ? (const char*)g.A : (const char*)g.A + (size_t)cur.pm * tstep) + (size_t)cur.kt0 * kstep;
    const char* cB = (const char*)g.Bt + (size_t)cur.be * g.bstride + (size_t)cur.pn * tstep + (size_t)cur.kt0 * kstep;
    PG8_STAGE(PG8_SB(0, 0), cB, voffB[0], voffB[1]); PG8_STAGE(PG8_SB(0, 1), cB + hstep, voffB[0], voffB[1]); PG8_STAGE(PG8_SA(0, 0), cA, vC0[0], vC0[1]); PG8_STAGE(PG8_SA(0, 1), cA + hstepA, vC1[0], vC1[1]);
    if (wr == 1) PG8_BAR;
    PG8_WAIT_V(2); PG8_BAR;
    PG8_STAGE(PG8_SB(1, 0), cB + kstep, voffB[0], voffB[1]); PG8_STAGE(PG8_SA(1, 0), cA + kstep, vC0[0], vC0[1]); PG8_STAGE(PG8_SB(1, 1), cB + hstep + kstep, voffB[0], voffB[1]);
    PG8_WAIT_V(6); PG8_BAR;
    for (;;) {
        const bool has_next = S.next(ui + 1, nxt);
        const char* nA = has_next ? (GATHER ? (const char*)g.A : (const char*)g.A + (size_t)nxt.pm * tstep) + (size_t)nxt.kt0 * kstep : cA;
        const char* nB = has_next ? (const char*)g.Bt + (size_t)nxt.be * g.bstride + (size_t)nxt.pn * tstep + (size_t)nxt.kt0 * kstep : cB;
        if (GATHER) {
            if (has_next && nxt.pm != cur.pm) {
#pragma unroll
                for (int i = 0; i < 2; ++i) { vN0[i] = PG8_TOKOFF(nxt.pm, 0, i); vN1[i] = PG8_TOKOFF(nxt.pm, 1, i); }
            } else {
#pragma unroll
                for (int i = 0; i < 2; ++i) { vN0[i] = vC0[i]; vN1[i] = vC1[i]; }
            }
        }
        const int nkt = cur.nkt;
        for (int t = 0; t < nkt; t += 2) {
            const bool last = (t == nkt - 2);
            const char* a1 = cA + (size_t)(t + 1) * kstep;
            const char* a2 = last ? nA : cA + (size_t)(t + 2) * kstep; const char* b2 = last ? nB : cB + (size_t)(t + 2) * kstep;
            const char* a3 = a2 + kstep; const char* b3 = b2 + kstep;
            const unsigned x00 = (GATHER && last) ? vN0[0] : vC0[0], x01 = (GATHER && last) ? vN0[1] : vC0[1], x10 = (GATHER && last) ? vN1[0] : vC1[0], x11 = (GATHER && last) ? vN1[1] : vC1[1];
            PG8_LDB(B0, 0, 0); PG8_LDB(B1, 0, 1); PG8_SCHED; PG8_LDA(At, 0, 0); PG8_STAGE(PG8_SA(1, 1), a1 + hstepA, vC1[0], vC1[1]);
            PG8_WAIT_V(8); PG8_WAIT_L(0); PG8_BAR; PG8_MMA(0, 0, At, B0); PG8_MMA(0, 1, At, B1); PG8_BAR; PG8_SCHED;
            PG8_LDA(At, 0, 1); PG8_STAGE(PG8_SB(0, 0), b2, voffB[0], voffB[1]); PG8_STAGE(PG8_SB(0, 1), b2 + hstep, voffB[0], voffB[1]); PG8_STAGE(PG8_SA(0, 0), a2, x00, x01);
            PG8_WAIT_V(8); PG8_WAIT_L(0); PG8_BAR; PG8_MMA(1, 0, At, B0); PG8_MMA(1, 1, At, B1); PG8_BAR; PG8_SCHED;
            PG8_LDB(B0, 1, 0); PG8_LDB(B1, 1, 1); PG8_SCHED; PG8_LDA(At, 1, 0); PG8_STAGE(PG8_SA(0, 1), a2 + hstepA, x10, x11);
            PG8_WAIT_V(8); PG8_WAIT_L(0); PG8_BAR; PG8_MMA(0, 0, At, B0); PG8_MMA(0, 1, At, B1); PG8_BAR; PG8_SCHED;
            PG8_LDA(At, 1, 1); PG8_STAGE(PG8_SB(1, 0), b3, voffB[0], voffB[1]); PG8_STAGE(PG8_SB(1, 1), b3 + hstep, voffB[0], voffB[1]); PG8_STAGE(PG8_SA(1, 0), a3, x00, x01);
            PG8_WAIT_V(8); PG8_WAIT_L(0); PG8_BAR; PG8_MMA(1, 0, At, B0); PG8_MMA(1, 1, At, B1); PG8_BAR; PG8_SCHED;
        }
        if (wr == 0) PG8_BAR;
        if (FP8) { asm volatile("s_nop 15\n\ts_nop 15" ::: "memory");
#pragma unroll
            for (int a = 0; a < 2; ++a)
#pragma unroll
                for (int b = 0; b < 2; ++b)
#pragma unroll
                    for (int m = 0; m < 4; ++m)
#pragma unroll
                        for (int n = 0; n < 2; ++n) asm volatile("" : "+v"(acc[a][b][m][n])); }
        if (I8) {
#pragma unroll
            for (int a = 0; a < 2; ++a)
#pragma unroll
                for (int b = 0; b < 2; ++b)
#pragma unroll
                    for (int m = 0; m < 4; ++m)
#pragma unroll
                        for (int n = 0; n < 2; ++n) { const v4i_t q = __builtin_bit_cast(v4i_t, acc[a][b][m][n]); acc[a][b][m][n] = (f32x4){(float)q[0], (float)q[1], (float)q[2], (float)q[3]}; } }
        if (g.noepi) {} else
        if constexpr (Sched::STREAMK) {
            if (cur.part == 1) {
                PG8_GAS u32x2* sl = (PG8_GAS u32x2*)g.slab + (size_t)S.wg() * (32 * 512) + tid * 4;
#pragma unroll
                for (int a = 0; a < 2; ++a)
#pragma unroll
                    for (int m = 0; m < 4; ++m) {
#pragma unroll
                        for (int b = 0; b < 2; ++b)
#pragma unroll
                            for (int n = 0; n < 2; ++n) { u32x2 w; w.x = cvt_pk_bf16(acc[a][b][m][n][0], acc[a][b][m][n][1]); w.y = cvt_pk_bf16(acc[a][b][m][n][2], acc[a][b][m][n][3]); sl[b * 2 + n] = w; }
                        sl += 512 * 4; asm volatile("" : "+v"(sl)); }
                asm volatile("s_waitcnt vmcnt(0)" ::: "memory");
                __syncthreads();
                if (tid == 0) { __builtin_amdgcn_fence(__ATOMIC_RELEASE, "agent"); asm volatile("s_waitcnt vmcnt(0)" ::: "memory");
                    __hip_atomic_store(g.skflag + 16 * S.wg(), 1u, __ATOMIC_RELAXED, __HIP_MEMORY_SCOPE_AGENT); }
            } else if (cur.part == 2) {
                if (wid == 0) { unsigned sp = 0;
                    while (__hip_atomic_load(g.skflag + 16 * (S.wg() + 1), __ATOMIC_RELAXED, __HIP_MEMORY_SCOPE_AGENT) == 0u) { __builtin_amdgcn_s_sleep(2);
                        if (++sp > (1u << 22)) { if (lane == 0) __hip_atomic_store(g.tmo, 1u, __ATOMIC_RELAXED, __HIP_MEMORY_SCOPE_AGENT); break; } }
                    __builtin_amdgcn_fence(__ATOMIC_ACQUIRE, "agent"); }
                asm volatile("s_waitcnt vmcnt(0)" ::: "memory");
                __syncthreads();
                E.template run<true>(acc, cur, wr, wc, fr, fq, (const PG8_GAS u32x2*)g.slab + (size_t)(S.wg() + 1) * (32 * 512) + tid * 4);
            } else { if (cur.part != 3) E(acc, cur, wr, wc, fr, fq); }
        } else { if (cur.part != 3) E(acc, cur, wr, wc, fr, fq); }
        if (!has_next) break;
#pragma unroll
        for (int a = 0; a < 2; ++a)
#pragma unroll
            for (int b = 0; b < 2; ++b)
#pragma unroll
                for (int m = 0; m < 4; ++m)
#pragma unroll
                    for (int n = 0; n < 2; ++n) acc[a][b][m][n] = (f32x4){0.f, 0.f, 0.f, 0.f};
        cur = nxt; cA = nA; cB = nB; ++ui;
        if (GATHER) {
#pragma unroll
            for (int i = 0; i < 2; ++i) { vC0[i] = vN0[i]; vC1[i] = vN1[i]; }
        }
        if (wr == 1) PG8_BAR;
    }
    PG8_WAIT_V(0);
    PG8_BAR;
#undef PG8_SA
#undef PG8_SB
#undef PG8_STAGE
#undef PG8_LDA
#undef PG8_LDB
#undef PG8_MMA
#undef PG8_LD8
#undef PG8_WAIT_V
#undef PG8_WAIT_L
#undef PG8_BAR
#undef PG8_SCHED
#undef PG8_TOKOFF
}
}
#define GAS __attribute__((address_space(1)))
#define LAS __attribute__((address_space(3)))
typedef unsigned short bf16;
typedef unsigned v4u __attribute__((ext_vector_type(4)));
typedef float f32x4 __attribute__((ext_vector_type(4)));
typedef short bf16x8 __attribute__((ext_vector_type(8)));
typedef GAS unsigned gu32;
typedef GAS unsigned long long gu64;
#define RLX_AGENT __ATOMIC_RELAXED, __HIP_MEMORY_SCOPE_AGENT
#define LDS_WAIT() asm volatile("s_waitcnt lgkmcnt(0)" ::: "memory")
#define VM_WAIT() asm volatile("s_waitcnt vmcnt(0)" ::: "memory")
__device__ __forceinline__ unsigned long long rt() { return __builtin_amdgcn_s_memrealtime(); }
__device__ __forceinline__ unsigned f2bf(float f) { unsigned u = __builtin_bit_cast(unsigned, f); return (u + 0x7fffu + ((u >> 16) & 1u)) >> 16; }
__device__ __forceinline__ unsigned pk2(float lo, float hi) { return f2bf(lo) | (f2bf(hi) << 16); }

#define XB_TMO      128
#define XB_XCNT(j)  (256  + 64 * (j))
#define XB_XSUB(j)  (1280 + 64 * (j))
#define XB_XGEN(j)  (2304 + 64 * (j))
#define XB_TOP      3328
#define XB_TOPGEN   3392
#define XCD_BAR_WORDS 3456
#define XB_SPIN_CAP (1u << 18)

__device__ __forceinline__ unsigned xb_ld(unsigned* p)              { return __hip_atomic_load(p, __ATOMIC_RELAXED, __HIP_MEMORY_SCOPE_AGENT); }
__device__ __forceinline__ unsigned xb_add(unsigned* p, unsigned v) { return __hip_atomic_fetch_add(p, v, __ATOMIC_RELAXED, __HIP_MEMORY_SCOPE_AGENT); }
__device__ __forceinline__ unsigned xb_xcc_id() { return (unsigned)__builtin_amdgcn_s_getreg((3 << 11) | 20) & 0xFu; }
#define XB_SPIN(cond, bar) do { unsigned _sp = 0; while (cond) { __builtin_amdgcn_s_sleep(1); \
    if ((++_sp & 255u) == 0u) { if (xb_ld(&(bar)[XB_TMO])) break; if (_sp > XB_SPIN_CAP) { atomicAdd(&(bar)[XB_TMO], 1u); break; } } } } while (0)

struct XcdBarrier {
    unsigned* bar; unsigned x;
    volatile LAS unsigned* st;
};

__device__ __forceinline__ XcdBarrier xcd_barrier_post(unsigned* bar, volatile LAS unsigned* st) {
    XcdBarrier b; b.bar = bar; b.x = xb_xcc_id(); b.st = st;
    if (threadIdx.x == 0) (void)xb_add(&bar[XB_XCNT(b.x)], 1u);
    return b;
}
__device__ __forceinline__ void xcd_barrier_complete(unsigned* bar, unsigned x, unsigned& nloc, unsigned& nx) {
    const unsigned G = gridDim.x * gridDim.y * gridDim.z;
    unsigned sum, cnt, mine, sp = 0u;
    for (;;) {
        sum = 0u; cnt = 0u; mine = 0u;
#pragma unroll
        for (unsigned j = 0; j < 16; ++j) { const unsigned c = xb_ld(&bar[XB_XCNT(j)]); sum += c; cnt += (c > 0u) ? 1u : 0u; mine = (j == x) ? c : mine; }
        if (sum == G) break;
        __builtin_amdgcn_s_sleep(1);
        if ((++sp & 255u) == 0u) { if (xb_ld(&bar[XB_TMO])) break; if (sp > XB_SPIN_CAP) { atomicAdd(&bar[XB_TMO], 1u); break; } }
    }
    nloc = mine > 0u ? mine : 1u; nx = cnt > 0u ? cnt : 1u;
}

__device__ __forceinline__ void xcd_barrier(const XcdBarrier& b) {
    asm volatile("s_waitcnt vmcnt(0)" ::: "memory");
    __syncthreads();
    if (threadIdx.x == 0) {
        unsigned* bar = b.bar;
        __builtin_amdgcn_s_waitcnt(0);
        unsigned nloc = b.st[0], nx = b.st[1];
        if (nloc == 0u) { xcd_barrier_complete(bar, b.x, nloc, nx); b.st[0] = nloc; b.st[1] = nx; }
        const unsigned old = xb_add(&bar[XB_XSUB(b.x)], 1u);
        const unsigned gen = old / nloc;
        if (old + 1u == (gen + 1u) * nloc) {
            __builtin_amdgcn_fence(__ATOMIC_RELEASE, "agent");
            asm volatile("s_waitcnt vmcnt(0)" ::: "memory");
            const unsigned og = xb_add(&bar[XB_TOP], 1u);
            const unsigned tg = og / nx;
            if (og + 1u == (tg + 1u) * nx) xb_add(&bar[XB_TOPGEN], 1u);
            else XB_SPIN(xb_ld(&bar[XB_TOPGEN]) == tg, bar);
            __builtin_amdgcn_fence(__ATOMIC_ACQUIRE, "agent");
            xb_add(&bar[XB_XGEN(b.x)], 1u);
            asm volatile("s_waitcnt vmcnt(0)" ::: "memory");
        } else {
            XB_SPIN(xb_ld(&bar[XB_XGEN(b.x)]) == gen, bar);
            __builtin_amdgcn_fence(__ATOMIC_ACQUIRE, "agent");
            asm volatile("s_waitcnt vmcnt(0)" ::: "memory");
        }
    }
    __syncthreads();
}

constexpr int NWAVES = 8;
constexpr int T = 32768, D = 1024, SEQ = 4096, NBATCH = 8;
constexpr int DFF = 2752, DFFP = 2816, DFFE = 3584, NEXP = 8;
constexpr int ROWCAP = 67584;
constexpr float EPS = 1e-6f;
constexpr float LOG2E = 1.4426950408889634f;
constexpr float SOFTMAX_OFS = 16.f;
constexpr float QSCALE = 0.125f * LOG2E;
#ifndef I8_P1
#define I8_P1 1
#endif
#ifndef I8_P3
#define I8_P3 0
#endif
#ifndef I8_P4
#define I8_P4 1
#endif
constexpr float SA_N = 127.f / 5.f, SA_X = 127.f / 6.f, SW_I8 = 127.f * 32.f / 4.5f;
constexpr float Y_SCALE = 127.f / 2.5f;
constexpr float W8_SCALE = 64.f, H3_SCALE = 16.f, HM_SCALE = 8.f, X8_SCALE = 16.f, HB_SCALE = 8.f, O8_SCALE = 64.f;
constexpr size_t MiB = 1u << 20;
constexpr size_t WS_CTL = 0, CTL_ZERO_BYTES = 1 * MiB;
constexpr size_t WS_PART1 = 1 * MiB, WS_PART2 = 3 * MiB, WS_LSE = 5 * MiB;
constexpr size_t WS_ROUTE = 7 * MiB, WS_GATE1 = WS_ROUTE + 128 * 1024, WS_GATE2 = WS_ROUTE + 256 * 1024, WS_WAVECNT = WS_ROUTE + 384 * 1024, WS_BLOCKCNT = WS_ROUTE + 448 * 1024, WS_GOFS = WS_ROUTE + 480 * 1024;
constexpr size_t WS_ROWTOK = 8 * MiB, WS_ROWGATE = 8 * MiB + 512 * 1024;
constexpr size_t WS_WIN = 12 * MiB, WS_WOUT = 16 * MiB, WS_WF13 = 18 * MiB, WS_WFD = 29 * MiB, WS_WQKV = 35 * MiB, WS_WO = 53 * MiB;
constexpr size_t WS_WM13 = 56 * MiB, WS_WM2 = 112 * MiB;
constexpr size_t WS_XH = 144 * MiB;
constexpr size_t WS_A0 = 224 * MiB;
constexpr size_t WS_H0 = WS_A0, WS_GLU = WS_A0 + 64 * MiB, WS_V = WS_A0 + 128 * MiB;
constexpr size_t WS_X1B = WS_A0, WS_HB = WS_A0 + 64 * MiB;
constexpr size_t WS_X2B = WS_A0, WS_KG = WS_A0 + 64 * MiB, WS_VG = WS_A0 + 128 * MiB, WS_QG = WS_A0 + 192 * MiB, WS_O = WS_A0 + 256 * MiB, WS_O8 = WS_A0 + 32 * MiB;
constexpr size_t WS_H3 = WS_A0, WS_HM = WS_A0 + 66 * MiB;
constexpr size_t WS_END = 548 * MiB;
static_assert(WS_HB + (size_t)T * DFFP * 2 <= WS_END && WS_O + (size_t)T * D * 2 <= WS_END && WS_HM + (size_t)ROWCAP * DFFE <= WS_END, "arena");
static_assert(WS_WFD + (size_t)D * DFFP * 2 <= WS_WQKV && WS_WO + (size_t)D * D * 2 <= WS_WM13 && WS_WM13 + (size_t)NEXP * 7168 * 1024 <= WS_WM2 && WS_WM2 + (size_t)NEXP * D * DFFE <= WS_XH && WS_XH + (size_t)T * D * 2 <= WS_A0, "weights");
constexpr int CW_AQ = 50000;
constexpr int CW_TMO = 0, CW_CODE = 1, CW_BAR = 4096, CW_SKFLAG = 16384;
constexpr size_t WS_SLAB = 12 * MiB;
constexpr size_t WS_POS = 9 * MiB;
constexpr size_t WS_Y = WS_A0;
static_assert(WS_SLAB + (size_t)256 * 131072 <= 56 * MiB && WS_Y + (size_t)ROWCAP * 1024 <= WS_HM, "slab / Y");

constexpr int RING_OFF = 0, RING_BYTES = 131072;
constexpr int LDSCTL_OFF = RING_BYTES, MISC_OFF = LDSCTL_OFF + 320;
constexpr int XTRA_OFF = RING_BYTES + 512;
constexpr int LDS_BYTES = 155648;

constexpr int NPHASE = 18;

__constant__ unsigned char T5_BUCKET[3][132] = {
 {0,1,2,3,4,5,6,7,8,9,10,11,12,13,14,15,16,16,16,16,16,16,17,17,17,17,17,17,17,17,18,18,18,18,18,18,18,18,18,18,19,19,19,19,19,19,19,19,19,19,19,19,19,19,20,20,20,20,20,20,20,20,20,20,20,20,20,20,20,20,20,20,20,21,21,21,21,21,21,21,21,21,21,21,21,21,21,21,21,21,21,21,21,21,21,21,21,21,21,22,22,22,22,22,22,22,22,22,22,22,22,22,22,22,22,22,22,22,22,22,22,22,22,22,22,22,22,22,22,0,0,0},
 {0,4,8,12,16,16,17,17,18,18,19,19,19,19,20,20,20,20,20,21,21,21,21,21,21,22,22,22,22,22,22,22,22,22,23,23,23,23,23,23,23,23,23,23,23,23,24,24,24,24,24,24,24,24,24,24,24,24,24,24,24,24,25,25,25,25,25,25,25,25,25,25,25,25,25,25,25,25,25,25,25,25,25,26,26,26,26,26,26,26,26,26,26,26,26,26,26,26,26,26,26,26,26,26,26,26,26,26,26,26,26,26,26,27,27,27,27,27,27,27,27,27,27,27,27,27,27,27,27,0,0,0},
 {0,16,18,19,20,21,21,22,22,23,23,23,24,24,24,24,25,25,25,25,25,26,26,26,26,26,26,26,26,27,27,27,27,27,27,27,27,27,27,28,28,28,28,28,28,28,28,28,28,28,28,28,29,29,29,29,29,29,29,29,29,29,29,29,29,29,29,29,29,29,30,30,30,30,30,30,30,30,30,30,30,30,30,30,30,30,30,30,30,30,30,30,30,30,30,31,31,31,31,31,31,31,31,31,31,31,31,31,31,31,31,31,31,31,31,31,31,31,31,31,31,31,31,31,31,31,31,31,31,0,0,0}};

typedef float f32x16 __attribute__((ext_vector_type(16)));
typedef float f32x2v __attribute__((ext_vector_type(2)));
typedef __bf16 bf16x2v __attribute__((ext_vector_type(2)));
typedef short v4i16_t __attribute__((ext_vector_type(4)));
__device__ __forceinline__ unsigned pkbf(float lo, float hi) { f32x2v v = {lo, hi}; bf16x2v b = __builtin_convertvector(v, bf16x2v); return __builtin_bit_cast(unsigned, b); }
__device__ __forceinline__ float bflo(unsigned u) { return __uint_as_float(u << 16); }
__device__ __forceinline__ float bfhi(unsigned u) { return __uint_as_float(u & 0xffff0000u); }
template <int N> __device__ __forceinline__ float dpp_row_ror(float v) { return __builtin_bit_cast(float, __builtin_amdgcn_update_dpp(0, __builtin_bit_cast(int, v), 0x120 + N, 0xf, 0xf, true)); }
__device__ __forceinline__ float wave_sum(float v) {
    v += dpp_row_ror<8>(v); v += dpp_row_ror<4>(v); v += dpp_row_ror<2>(v); v += dpp_row_ror<1>(v);
    const int b = __builtin_bit_cast(int, v);
    return (__builtin_bit_cast(float, __builtin_amdgcn_readlane(b, 0)) + __builtin_bit_cast(float, __builtin_amdgcn_readlane(b, 16))) + (__builtin_bit_cast(float, __builtin_amdgcn_readlane(b, 32)) + __builtin_bit_cast(float, __builtin_amdgcn_readlane(b, 48)));
}
__device__ __forceinline__ int crow(int r, int hi) { return (r & 3) + 8 * (r >> 2) + 4 * hi; }

struct TrDesc { const float* W; const float* gsc; unsigned char* WT; int ldw, Kp, drow0, k0, n0src, is8; float scale; };
__device__ __forceinline__ int hmap_row0(int L) { const int lc = L & 255; return (L & ~255) + 128 * ((lc >> 5) & 1) + 32 * (lc >> 6); }

constexpr int IT_MG = NEXP * 16 * 112, IT_MU = IT_MG, IT_MD = NEXP * 56 * 32, IT_WIN = 16 * 64, IT_WOUT = 16 * 32, IT_FG = 16 * 86, IT_FU = IT_FG, IT_FD = 43 * 32, IT_KV = 16 * 192, IT_Q = 16 * 96, IT_WO = 16 * 32;
constexpr int IT_MOE = IT_MG + IT_MU + IT_MD;
static_assert(IT_MOE == 3 * 256 * 56, "expert-weight items per attention phase and workgroup");
constexpr int IT_TOTAL = IT_MG + IT_MU + IT_MD + IT_WIN + IT_WOUT + IT_FG + IT_FU + IT_FD + IT_KV + IT_Q + IT_WO;
typedef const __attribute__((address_space(4))) unsigned char* kargp0_t;
#define P0IN(i) (*(const float* const __attribute__((address_space(4)))*)(kp + 8 * (i)))
__device__ __forceinline__ void tr_desc(int it, kargp0_t kp, unsigned char* ws, TrDesc& d) {
    int r = it; d.gsc = nullptr; d.is8 = 2; d.scale = SW_I8; d.Kp = 1024;
    if (r < IT_MG) { const int e = r / 1792, rr = r % 1792, j = (rr % 112) * 32; d.W = P0IN(23) + (size_t)e * D * DFFE; d.ldw = DFFE; d.WT = ws + WS_WM13 + (size_t)e * 7168 * 1024; d.drow0 = 256 * (j >> 7) + (j & 127); d.k0 = (rr / 112) * 64; d.n0src = j; return; } r -= IT_MG;
    if (r < IT_MU) { const int e = r / 1792, rr = r % 1792, j = (rr % 112) * 32; d.W = P0IN(24) + (size_t)e * D * DFFE; d.ldw = DFFE; d.WT = ws + WS_WM13 + (size_t)e * 7168 * 1024; d.drow0 = 256 * (j >> 7) + 128 + (j & 127); d.k0 = (rr / 112) * 64; d.n0src = j; return; } r -= IT_MU;
    if (r < IT_MD) { const int e = r / 1792, rr = r % 1792, j = (rr % 32) * 32; d.W = P0IN(25) + (size_t)e * DFFE * D; d.ldw = D; d.WT = ws + WS_WM2 + (size_t)e * 1024 * DFFE; d.Kp = DFFE; d.is8 = 1; d.scale = W8_SCALE; d.drow0 = j; d.k0 = (rr / 32) * 64; d.n0src = j; return; } r -= IT_MD;
    if (r < IT_KV) { const int c = (r % 192) * 32, kvsel = c / 3072, cg = c % 3072, g = cg >> 10, hc = cg & 1023, L = kvsel * 1024 + hc; d.W = P0IN(12); d.ldw = 6144; d.gsc = P0IN(11); d.WT = ws + WS_WQKV + (size_t)g * 3072 * 1024; d.drow0 = hmap_row0(L); d.k0 = (r / 192) * 64; d.n0src = c; return; } r -= IT_KV;
    if (r < IT_Q) { const int c = (r % 96) * 32, g = c >> 10, hc = c & 1023, L = 2048 + hc; d.W = P0IN(15); d.ldw = 3072; d.gsc = P0IN(14); d.WT = ws + WS_WQKV + (size_t)g * 3072 * 1024; d.drow0 = hmap_row0(L); d.k0 = (r / 96) * 64; d.n0src = c; return; } r -= IT_Q;
    if (r < IT_WIN) { const int c = (r % 64) * 32, sel = c >> 10, j = c & 1023; d.W = P0IN(3); d.ldw = 2048; d.WT = ws + WS_WIN; if (!I8_P1) { d.is8 = 0; d.scale = 1.f; } d.drow0 = 256 * (j >> 7) + 128 * sel + (j & 127); d.k0 = (r / 64) * 64; d.n0src = c; return; } r -= IT_WIN;
    if (r < IT_WOUT) { const int j = (r % 32) * 32; d.W = P0IN(9); d.ldw = 1024; d.WT = ws + WS_WOUT; if (!I8_P3) { d.is8 = 0; d.scale = 1.f; } d.drow0 = j; d.k0 = (r / 32) * 64; d.n0src = j; return; } r -= IT_WOUT;
    if (r < IT_FG) { const int j = (r % 86) * 32; d.W = P0IN(19); d.ldw = DFF; d.gsc = P0IN(18); d.WT = ws + WS_WF13; if (!I8_P4) { d.is8 = 0; d.scale = 1.f; } d.drow0 = 256 * (j >> 7) + (j & 127); d.k0 = (r / 86) * 64; d.n0src = j; return; } r -= IT_FG;
    if (r < IT_FU) { const int j = (r % 86) * 32; d.W = P0IN(20); d.ldw = DFF; d.gsc = P0IN(18); d.WT = ws + WS_WF13; if (!I8_P4) { d.is8 = 0; d.scale = 1.f; } d.drow0 = 256 * (j >> 7) + 128 + (j & 127); d.k0 = (r / 86) * 64; d.n0src = j; return; } r -= IT_FU;
    if (r < IT_FD) { const int j = (r % 32) * 32; d.W = P0IN(21); d.ldw = 1024; d.WT = ws + WS_WFD; d.Kp = DFFP; d.is8 = 0; d.scale = 1.f; d.drow0 = j; d.k0 = (r / 32) * 64; d.n0src = j; return; } r -= IT_FD;
    { const int j = (r % 32) * 32; d.W = P0IN(17); d.ldw = 1024; d.WT = ws + WS_WO; d.drow0 = j; d.k0 = (r / 32) * 64; d.n0src = j; d.is8 = 1; d.scale = W8_SCALE; }
}
__device__ __forceinline__ void tr_load(const TrDesc& d, f32x4 (&v)[8], f32x4 (&gv)[2], int lane) {
#pragma unroll
    for (int i = 0; i < 8; ++i) v[i] = __builtin_nontemporal_load((const f32x4*)(d.W + (size_t)(d.k0 + 8 * i + (lane >> 3)) * d.ldw + d.n0src + 4 * (lane & 7)));
    const float* gp = d.gsc ? d.gsc + d.k0 + 8 * (lane & 7) : d.W + (size_t)d.k0 * d.ldw + d.n0src;
    gv[0] = *(const f32x4*)gp; gv[1] = *(const f32x4*)(gp + 4);
}
template <bool NT = false>
__device__ __forceinline__ void tr_store(const TrDesc& d, const f32x4 (&v)[8], const f32x4 (&gv)[2], LAS float* scr, int lane) {
#pragma unroll
    for (int i = 0; i < 8; ++i) { LAS float* w = scr + (8 * i + (lane >> 3)) * 33 + 4 * (lane & 7); w[0] = v[i].x; w[1] = v[i].y; w[2] = v[i].z; w[3] = v[i].w; }
    LDS_WAIT(); asm volatile("" ::: "memory");
    const int c = lane & 7; const float sc = d.scale;
    const f32x4 one4 = {1.f, 1.f, 1.f, 1.f}; const f32x4 gv0 = d.gsc ? gv[0] : one4, gv1 = d.gsc ? gv[1] : one4;
#pragma unroll
    for (int j = 0; j < 4; ++j) { const int n = (lane >> 3) + 8 * j; const LAS float* s = scr + (8 * c) * 33 + n;
        const float x0 = s[0 * 33] * gv0.x * sc, x1 = s[1 * 33] * gv0.y * sc, x2 = s[2 * 33] * gv0.z * sc, x3 = s[3 * 33] * gv0.w * sc, x4 = s[4 * 33] * gv1.x * sc, x5 = s[5 * 33] * gv1.y * sc, x6 = s[6 * 33] * gv1.z * sc, x7 = s[7 * 33] * gv1.w * sc;
        if (d.is8 == 2) { pg8::u32x2 o; o.x = pg8::pk_i8x4(x0, x1, x2, x3); o.y = pg8::pk_i8x4(x4, x5, x6, x7); GAS pg8::u32x2* op = (GAS pg8::u32x2*)(d.WT + (size_t)(d.drow0 + n) * d.Kp + d.k0 + 8 * c); if (NT) __builtin_nontemporal_store(o, op); else *op = o; }
        else if (d.is8) { pg8::u32x2 o; o.x = pg8::pk_fp8x4(x0, x1, x2, x3); o.y = pg8::pk_fp8x4(x4, x5, x6, x7); GAS pg8::u32x2* op = (GAS pg8::u32x2*)(d.WT + (size_t)(d.drow0 + n) * d.Kp + d.k0 + 8 * c); if (NT) __builtin_nontemporal_store(o, op); else *op = o; }
        else { v4u o; o.x = pkbf(x0, x1); o.y = pkbf(x2, x3); o.z = pkbf(x4, x5); o.w = pkbf(x6, x7); *(GAS v4u*)((bf16*)d.WT + (size_t)(d.drow0 + n) * d.Kp + d.k0 + 8 * c) = o; } }
    LDS_WAIT(); asm volatile("" ::: "memory");
}

__device__ __forceinline__ void p0_items(kargp0_t kp, unsigned char* ws, LAS float* scr, int first, int stride, int lo, int hi, int lane) {
    TrDesc da, db, dc; f32x4 va[8], vb[8], vc[8]; f32x4 ga[2], gb[2], gc[2];
    int it = lo + first; const int NGW = stride;
    if (it < hi) { tr_desc(it, kp, ws, da); tr_load(da, va, ga, lane); }
    if (it + NGW < hi) { tr_desc(it + NGW, kp, ws, db); tr_load(db, vb, gb, lane); }
    while (it < hi) {
        if (it + 2 * NGW < hi) { tr_desc(it + 2 * NGW, kp, ws, dc); tr_load(dc, vc, gc, lane); }
        tr_store(da, va, ga, scr, lane);
        if (it + NGW >= hi) break;
        if (it + 3 * NGW < hi) { tr_desc(it + 3 * NGW, kp, ws, da); tr_load(da, va, ga, lane); }
        tr_store(db, vb, gb, scr, lane);
        if (it + 2 * NGW >= hi) break;
        if (it + 4 * NGW < hi) { tr_desc(it + 4 * NGW, kp, ws, db); tr_load(db, vb, gb, lane); }
        tr_store(dc, vc, gc, scr, lane);
        it += 3 * NGW;
    }
}
__device__ __forceinline__ void p0_items2(kargp0_t kp, unsigned char* ws, LAS float* scr, int first, int stride, int lo, int hi, int lane) {
    if (first >= hi - lo) return;
    const int n = (hi - lo - first + stride - 1) / stride, base = lo + first, last = n - 1;
    TrDesc da, db; f32x4 va[8], vb[8]; f32x4 ga[2], gb[2];
#define P0_ITEM(k) (base + ((k) < last ? (k) : last) * stride)
    tr_desc(base, kp, ws, da); tr_load(da, va, ga, lane);
    for (int k = 0; k + 1 < n; k += 2) {
        tr_desc(P0_ITEM(k + 1), kp, ws, db); tr_load(db, vb, gb, lane);
        tr_store<true>(da, va, ga, scr, lane);
        tr_desc(P0_ITEM(k + 2), kp, ws, da); tr_load(da, va, ga, lane);
        tr_store<true>(db, vb, gb, scr, lane);
    }
    if (n & 1) tr_store<true>(da, va, ga, scr, lane);
#undef P0_ITEM
}
__device__ __forceinline__ void p0_prologue(kargp0_t kp, unsigned char* ws, LAS unsigned char* lds, int G, int vcu, int tid, int lane, int wave) {
    LAS float* scr = (LAS float*)(lds + RING_OFF + wave * 16384);
    const int gw = vcu * NWAVES + wave, NGW = G * NWAVES;
    bf16* WF13 = (bf16*)(ws + WS_WF13); bf16* WFD = (bf16*)(ws + WS_WFD);
    p0_items(kp, ws, scr, gw, NGW, (G == 256) ? IT_MOE : 0, IT_TOTAL, lane);
#ifdef PROBE_CONV_NC
    if ((vcu & 31) < PROBE_CONV_NC) p0_items(kp, ws, scr, ((vcu >> 5) * PROBE_CONV_NC + (vcu & 31)) * NWAVES + wave, 8 * PROBE_CONV_NC * NWAVES, 0, IT_MOE, lane);
#endif
    const int gt = vcu * (NWAVES * 64) + tid, NGT = G * NWAVES * 64; const v4u z = {0u, 0u, 0u, 0u};
    { constexpr int RB = I8_P4 ? 1024 : 2048, CH = RB / 16;
      for (int i = gt; i < 2 * 64 * CH; i += NGT) { const int sel = i / (64 * CH), rr = (i / CH) & 63, ch = i % CH; *(GAS v4u*)((unsigned char*)WF13 + (size_t)(256 * 21 + 128 * sel + 64 + rr) * RB + ch * 16) = z; } }
    for (int i = gt; i < 1024 * 8; i += NGT) { const int row = i >> 3, ch = i & 7; *(GAS v4u*)(WFD + (size_t)row * DFFP + DFF + ch * 8) = z; }
    const float* x = P0IN(0); const float* gn = P0IN(2); bf16* H0 = (bf16*)(ws + WS_H0);
    f32x4 gv[4];
#pragma unroll
    for (int j = 0; j < 4; ++j) gv[j] = *(const f32x4*)(gn + 4 * lane + 256 * j);
    for (int m0 = gw * 4; m0 < T; m0 += NGW * 4) {
        f32x4 v[4][4];
#pragma unroll
        for (int q = 0; q < 4; ++q) { const GAS f32x4* xr = (const GAS f32x4*)(x + (size_t)(m0 + q) * D) + lane;
#pragma unroll
            for (int j = 0; j < 4; ++j) v[q][j] = __builtin_nontemporal_load(xr + 64 * j); }
#pragma unroll
        for (int q = 0; q < 4; ++q) { float s = 0.f;
#pragma unroll
            for (int j = 0; j < 4; ++j) s += (v[q][j].x * v[q][j].x + v[q][j].y * v[q][j].y) + (v[q][j].z * v[q][j].z + v[q][j].w * v[q][j].w);
            const float rstd = 1.f / sqrtf(wave_sum(s) * (1.f / D) + EPS);
            if (I8_P1) { GAS unsigned* o4 = (GAS unsigned*)((unsigned char*)H0 + (size_t)(m0 + q) * D) + lane;
#pragma unroll
                for (int j = 0; j < 4; ++j) { const f32x4 y = v[q][j] * (rstd * SA_N) * gv[j]; o4[64 * j] = pg8::pk_i8x4(y.x, y.y, y.z, y.w); } }
            else { GAS unsigned long long* o8 = (GAS unsigned long long*)(H0 + (size_t)(m0 + q) * D) + lane;
#pragma unroll
                for (int j = 0; j < 4; ++j) { const f32x4 y = v[q][j] * rstd * gv[j]; o8[64 * j] = (unsigned long long)pkbf(y.x, y.y) | ((unsigned long long)pkbf(y.z, y.w) << 32); } } }
    }
}

__device__ __forceinline__ void conv_phase(const bf16* glu, const float* dw_w, const float* dw_b, const float* ln_g, const float* ln_b, bf16* vout, LAS unsigned char* lds, int G, int vcu, int tid, int lane, int wave) {
    LAS float* ybuf = (LAS float*)(lds + RING_OFF);
    const int c0 = 2 * tid;
    float w0[31], w1[31];
#pragma unroll
    for (int k = 0; k < 31; ++k) { const f32x2v w = *(const f32x2v*)(dw_w + k * 1024 + c0); w0[k] = w.x; w1[k] = w.y; }
    const f32x2v dbv = *(const f32x2v*)(dw_b + c0);
    LAS float* lnp = (LAS float*)(lds + XTRA_OFF);
    for (int i = tid; i < 1024; i += NWAVES * 64) { lnp[i] = ln_g[i]; lnp[1024 + i] = ln_b[i]; }
    __syncthreads();
    for (int item = vcu; item < T / 128; item += G) {
        const int b = item >> 5, s0 = (item & 31) * 128;
        const bf16* ub = glu + (size_t)b * SEQ * D + c0;
        float r0[32], r1[32];
        r0[0] = 0.f; r1[0] = 0.f; r0[1] = 0.f; r1[1] = 0.f;
#pragma unroll
        for (int i = 0; i < 30; ++i) { const int s = s0 - 30 + i; unsigned v = 0u; if (s >= 0) v = *(const unsigned*)(ub + (size_t)s * D); r0[i + 2] = bflo(v); r1[i + 2] = bfhi(v); }
        for (int base = 0; base < 128; base += 32) {
            unsigned nu[32];
#pragma unroll
            for (int j = 0; j < 32; ++j) nu[j] = *(const unsigned*)(ub + (size_t)(s0 + base + j) * D);
#pragma unroll
            for (int j = 0; j < 32; ++j) {
                r0[j] = bflo(nu[j]); r1[j] = bfhi(nu[j]);
                float y0 = dbv.x, y1 = dbv.y;
#pragma unroll
                for (int k = 0; k < 31; ++k) { const int idx = (j + 2 + k) & 31; y0 += r0[idx] * w0[k]; y1 += r1[idx] * w1[k]; }
                *(LAS f32x2v*)(ybuf + j * 1024 + c0) = (f32x2v){y0, y1};
            }
            __syncthreads();
            const int ntok = 32;
            for (int j = wave; j < ntok; j += NWAVES) {
                f32x4 y[4]; float s = 0.f;
#pragma unroll
                for (int i = 0; i < 4; ++i) { y[i] = *(const LAS f32x4*)(ybuf + j * 1024 + 4 * lane + 256 * i); s += (y[i].x + y[i].y) + (y[i].z + y[i].w); }
                const float mean = wave_sum(s) * (1.f / D); float q = 0.f;
#pragma unroll
                for (int i = 0; i < 4; ++i) { y[i] = y[i] - mean; q += (y[i].x * y[i].x + y[i].y * y[i].y) + (y[i].z * y[i].z + y[i].w * y[i].w); }
                const float rstd = 1.f / sqrtf(wave_sum(q) * (1.f / D) + EPS);
                GAS unsigned* o4 = (GAS unsigned*)((unsigned char*)vout + ((size_t)b * SEQ + s0 + base + j) * D) + lane;
                GAS unsigned long long* o8 = (GAS unsigned long long*)(vout + ((size_t)b * SEQ + s0 + base + j) * D) + lane;
#pragma unroll
                for (int i = 0; i < 4; ++i) { const f32x4 lgv = *(const LAS f32x4*)(lnp + 4 * lane + 256 * i), lbv = *(const LAS f32x4*)(lnp + 1024 + 4 * lane + 256 * i); f32x4 z = y[i] * rstd * lgv + lbv;
                    z.x *= pg8::fast_sigmoid(z.x); z.y *= pg8::fast_sigmoid(z.y); z.z *= pg8::fast_sigmoid(z.z); z.w *= pg8::fast_sigmoid(z.w);
                    if (I8_P3) o4[64 * i] = pg8::pk_i8x4(z.x * SA_N, z.y * SA_N, z.z * SA_N, z.w * SA_N);
                    else o8[64 * i] = (unsigned long long)pkbf(z.x, z.y) | ((unsigned long long)pkbf(z.z, z.w) << 32); }
            }
            __syncthreads();
        }
    }
}

__device__ __forceinline__ void attn_phase(LAS unsigned char* lds, int grp, const bf16* Kb, const bf16* Vb, const bf16* Qb, bf16* Ob, unsigned char* O8, float* lse, const float* rel_bias, unsigned* qheads, int G, int vcu, int tid, int lane, int wave) {
    const int dsh = 2 * grp, dil = 1 << dsh;
    LAS unsigned char* Kl = lds + RING_OFF;
    LAS unsigned char* Vl = lds + RING_OFF + 55296;
    LAS float* btab_all = (LAS float*)(lds + XTRA_OFF);
    for (int i = tid; i < 16 * 192; i += NWAVES * 64) { const int hh = i / 192, j = i % 192, dist = 159 - j;
        btab_all[i] = (dist >= 0 && dist <= 128) ? rel_bias[(int)T5_BUCKET[grp][dist] * 48 + grp * 16 + hh] * LOG2E - SOFTMAX_OFS : -1.0e30f; }
    const int lq = lane & 31, hi = lane >> 5;
    v4u kvp[6], vvp[6];
#define ATT_DECODE(IDX, b_, h_, res_, n0_) const int bh_##b_ = (IDX) >> 4, w16_##b_ = (IDX) & 15, b_ = bh_##b_ >> 4, h_ = bh_##b_ & 15, res_ = w16_##b_ & (dil - 1), n0_ = (w16_##b_ >> dsh) * 256
#define ATT_LOAD(IDX) do { ATT_DECODE(IDX, pb, ph, pres, pn0); \
        _Pragma("unroll") for (int i = 0; i < 6; ++i) { const int cidx = tid + 512 * i, j = cidx >> 3, c16 = cidx & 7, sub = pn0 - 128 + j; \
            kvp[i] = (v4u){0u, 0u, 0u, 0u}; vvp[i] = kvp[i]; \
            if (sub >= 0) { const size_t off = ((size_t)pb * SEQ + ((size_t)sub << dsh) + pres) * D + ph * 64 + c16 * 8; kvp[i] = *(const GAS v4u*)(Kb + off); vvp[i] = *(const GAS v4u*)(Vb + off); } } } while (0)
    pg8::bf16x8 qnext[4];
#define ATT_LOADQ(IDX) do { ATT_DECODE(IDX, qb_, qh_, qres_, qn0_); const size_t qrow_ = (size_t)qb_ * SEQ + ((size_t)(qn0_ + 32 * wave + lq) << dsh) + qres_; \
        _Pragma("unroll") for (int c = 0; c < 4; ++c) qnext[c] = *(const pg8::bf16x8*)(Qb + qrow_ * D + qh_ * 64 + 16 * c + 8 * hi); } while (0)
    const bool dyn = (G == 256);
    const int xq = vcu >> 5;
    LAS int* qL = (LAS int*)(lds + XTRA_OFF + 12288 + 64);
    int idx = vcu;
    if (idx < 2048) { ATT_LOAD(idx); ATT_LOADQ(idx); }
    __syncthreads();
    while (idx < 2048) {
        int claimed = 0;
        if (dyn && tid == 0) claimed = (int)__hip_atomic_fetch_add(qheads + 16 * xq, 1u, __ATOMIC_RELAXED, __HIP_MEMORY_SCOPE_AGENT);
        ATT_DECODE(idx, b, h, res, n0);
        const int ql = 32 * wave + lq;
        const size_t qrow = (size_t)b * SEQ + ((size_t)(n0 + ql) << dsh) + res;
        pg8::bf16x8 qr[4];
#pragma unroll
        for (int c = 0; c < 4; ++c) qr[c] = qnext[c];
        __syncthreads();
#pragma unroll
        for (int i = 0; i < 6; ++i) { const int cidx = tid + 512 * i, j = cidx >> 3, c16 = cidx & 7;
            *(LAS v4u*)(Kl + j * 144 + c16 * 16) = kvp[i]; *(LAS v4u*)(Vl + (c16 >> 2) * 24576 + j * 64 + (c16 & 3) * 16) = vvp[i]; }
        if (dyn && tid == 0) qL[0] = 32 + claimed;
        __syncthreads();
        int nidx = idx + G;
        if (dyn) { const int jn = qL[0]; nidx = jn < 256 ? ((jn >> 5) << 8) + (xq << 5) + (jn & 31) : 2048; }
        if (nidx < 2048) ATT_LOAD(nidx);
        float sv[5][16]; float m = -3.0e38f;
        const int kofs = n0 - 128 + 32 * wave;
        const LAS float* brow = btab_all + h * 192 + (31 - lq + 4 * hi);
#pragma unroll
        for (int kt = 0; kt < 5; ++kt) {
            f32x16 S = (f32x16){0.f, 0.f, 0.f, 0.f, 0.f, 0.f, 0.f, 0.f, 0.f, 0.f, 0.f, 0.f, 0.f, 0.f, 0.f, 0.f};
#pragma unroll
            for (int c = 0; c < 4; ++c) { const pg8::bf16x8 a = *(const LAS pg8::bf16x8*)(Kl + (32 * wave + 32 * kt + lq) * 144 + (16 * c + 8 * hi) * 2);
                S = __builtin_amdgcn_mfma_f32_32x32x16_bf16(a, qr[c], S, 0, 0, 0); }
#pragma unroll
            for (int r = 0; r < 16; ++r) { const float s = S[r] + brow[32 * kt + (r & 3) + 8 * (r >> 2)]; sv[kt][r] = s; }
            __builtin_amdgcn_sched_barrier(0);
        }
        if (kofs < 0) {
#pragma unroll
            for (int kt = 0; kt < 5; ++kt)
#pragma unroll
                for (int r = 0; r < 16; ++r) { const int kk = 32 * kt + crow(r, hi); if (kofs + kk < 0) sv[kt][r] = -1.0e30f; }
        }
        m = SOFTMAX_OFS;
        float l = 0.f; unsigned pw[5][8];
#pragma unroll
        for (int kt = 0; kt < 5; ++kt) {
#pragma unroll
            for (int r = 0; r < 16; r += 2) { const float p0 = __builtin_amdgcn_exp2f(sv[kt][r]), p1 = __builtin_amdgcn_exp2f(sv[kt][r + 1]); l += p0 + p1; pw[kt][r >> 1] = pkbf(p0, p1); }
            __builtin_amdgcn_sched_barrier(0);
        }
        l += __shfl_xor(l, 32);
        f32x16 O0 = (f32x16){0.f, 0.f, 0.f, 0.f, 0.f, 0.f, 0.f, 0.f, 0.f, 0.f, 0.f, 0.f, 0.f, 0.f, 0.f, 0.f}, O1 = O0;
        const int vlane = ((lane & 15) >> 2) * 64 + ((lane >> 4) & 1) * 32 + (lane & 3) * 8;
#pragma unroll
        for (int kt = 0; kt < 5; ++kt)
#pragma unroll
            for (int s2 = 0; s2 < 2; ++s2) {
                v4u pq; pq.x = pw[kt][4 * s2 + 0]; pq.y = pw[kt][4 * s2 + 1]; pq.z = pw[kt][4 * s2 + 2]; pq.w = pw[kt][4 * s2 + 3];
                const pg8::bf16x8 pf = __builtin_bit_cast(pg8::bf16x8, pq);
                const int vrow = 32 * wave + 32 * kt + 16 * s2 + 4 * hi;
                LAS unsigned char* vp = Vl + vrow * 64 + vlane;
                const v4i16_t a0 = __builtin_amdgcn_ds_read_tr16_b64_v4i16((LAS v4i16_t*)(vp)), a1 = __builtin_amdgcn_ds_read_tr16_b64_v4i16((LAS v4i16_t*)(vp + 512));
                const v4i16_t b0 = __builtin_amdgcn_ds_read_tr16_b64_v4i16((LAS v4i16_t*)(vp + 24576)), b1 = __builtin_amdgcn_ds_read_tr16_b64_v4i16((LAS v4i16_t*)(vp + 24576 + 512));
                const pg8::bf16x8 vf0 = (pg8::bf16x8){a0[0], a0[1], a0[2], a0[3], a1[0], a1[1], a1[2], a1[3]};
                const pg8::bf16x8 vf1 = (pg8::bf16x8){b0[0], b0[1], b0[2], b0[3], b1[0], b1[1], b1[2], b1[3]};
                O0 = __builtin_amdgcn_mfma_f32_32x32x16_bf16(vf0, pf, O0, 0, 0, 0);
                O1 = __builtin_amdgcn_mfma_f32_32x32x16_bf16(vf1, pf, O1, 0, 0, 0);
                __builtin_amdgcn_sched_barrier(0);
            }
        if (nidx < 2048) ATT_LOADQ(nidx);
        const float inv_l = 1.f / l, lse2 = m + __builtin_amdgcn_logf(l);
        const size_t orow = qrow;
        v4u oldv[4];
        if (grp != 0) {
#pragma unroll
            for (int i = 0; i < 4; ++i) { const int ch = lane + 64 * i, qq = ch >> 3, c8 = ch & 7; oldv[i] = *(const GAS v4u*)(Ob + ((size_t)b * SEQ + ((size_t)(n0 + 32 * wave + qq) << dsh) + res) * D + h * 64 + c8 * 8); } }
        float co = 0.f, cg = inv_l, lnew = lse2;
        if (grp != 0) { const float lo_ = lse[orow * 16 + h]; const float M = fmaxf(lo_, lse2); const float wo = __builtin_amdgcn_exp2f(lo_ - M), wg = __builtin_amdgcn_exp2f(lse2 - M), den = wo + wg;
            co = wo / den; cg = wg / den * inv_l; lnew = M + __builtin_amdgcn_logf(den); }
        __syncthreads();
        LAS unsigned char* stg = Kl + wave * 4608;
        LAS float* cot = (LAS float*)(Kl + 8 * 4608) + wave * 32;
#pragma unroll
        for (int rg = 0; rg < 4; ++rg) {
            pg8::u32x2 wa, wb; wa.x = pkbf(O0[4 * rg] * cg, O0[4 * rg + 1] * cg); wa.y = pkbf(O0[4 * rg + 2] * cg, O0[4 * rg + 3] * cg);
            wb.x = pkbf(O1[4 * rg] * cg, O1[4 * rg + 1] * cg); wb.y = pkbf(O1[4 * rg + 2] * cg, O1[4 * rg + 3] * cg);
            *(LAS pg8::u32x2*)(stg + lq * 144 + (8 * rg + 4 * hi) * 2) = wa; *(LAS pg8::u32x2*)(stg + lq * 144 + (32 + 8 * rg + 4 * hi) * 2) = wb; }
        if (hi == 0) cot[lq] = co;
        if (hi == 0) lse[orow * 16 + h] = lnew;
#pragma unroll
        for (int i = 0; i < 4; ++i) { const int ch = lane + 64 * i, qq = ch >> 3, c8 = ch & 7;
            const v4u sv4 = *(const LAS v4u*)(stg + qq * 144 + c8 * 16);
            bf16* op = Ob + ((size_t)b * SEQ + ((size_t)(n0 + 32 * wave + qq) << dsh) + res) * D + h * 64 + c8 * 8;
            v4u ov = sv4;
            if (grp != 0) { const float cq = cot[qq]; const v4u old = oldv[i];
                ov.x = pkbf(bflo(sv4.x) + cq * bflo(old.x), bfhi(sv4.x) + cq * bfhi(old.x)); ov.y = pkbf(bflo(sv4.y) + cq * bflo(old.y), bfhi(sv4.y) + cq * bfhi(old.y));
                ov.z = pkbf(bflo(sv4.z) + cq * bflo(old.z), bfhi(sv4.z) + cq * bfhi(old.z)); ov.w = pkbf(bflo(sv4.w) + cq * bflo(old.w), bfhi(sv4.w) + cq * bfhi(old.w)); }
            if (grp == 2) { unsigned char* o8 = O8 + ((size_t)b * SEQ + ((size_t)(n0 + 32 * wave + qq) << dsh) + res) * D + h * 64 + c8 * 8;
                pg8::u32x2 w8; w8.x = pg8::pk_fp8x4(bflo(ov.x) * O8_SCALE, bfhi(ov.x) * O8_SCALE, bflo(ov.y) * O8_SCALE, bfhi(ov.y) * O8_SCALE); w8.y = pg8::pk_fp8x4(bflo(ov.z) * O8_SCALE, bfhi(ov.z) * O8_SCALE, bflo(ov.w) * O8_SCALE, bfhi(ov.w) * O8_SCALE);
                *(GAS pg8::u32x2*)o8 = w8; }
            else *(GAS v4u*)op = ov; }
        idx = nidx;
    }
    __syncthreads();
#undef ATT_DECODE
#undef ATT_LOAD
#undef ATT_LOADQ
}

__device__ __forceinline__ void route_phase(const _Float16* x3, const float* gnorm, const float* wr, unsigned char* ws, LAS unsigned char* lds, int G, int vcu, int tid, int lane, int wave) {
    LAS float* WrT = (LAS float*)(lds + RING_OFF);
    LAS unsigned* wcL = (LAS unsigned*)(lds + RING_OFF + 32768);
    for (int i = tid; i < 8192; i += NWAVES * 64) { const int e = i >> 10, k = i & 1023; WrT[i] = wr[k * 8 + e] * gnorm[k]; }
    __syncthreads();
    unsigned* route = (unsigned*)(ws + WS_ROUTE); float* gate1 = (float*)(ws + WS_GATE1); float* gate2 = (float*)(ws + WS_GATE2);
    unsigned* wavecnt = (unsigned*)(ws + WS_WAVECNT); int* blockcnt = (int*)(ws + WS_BLOCKCNT); unsigned char* H3 = ws + WS_H3;
    const int gw = vcu * NWAVES + wave, NGW = G * NWAVES, tpw = (T + NGW - 1) / NGW;
    const int t0 = gw * tpw, t1 = (t0 + tpw) < T ? (t0 + tpw) : T;
    f32x4 gv[4];
#pragma unroll
    for (int j = 0; j < 4; ++j) gv[j] = *(const f32x4*)(gnorm + 4 * lane + 256 * j);
    unsigned long long cnt0 = 0ull, cnt1 = 0ull;
    f32x4 vn[4];
    if (t0 < t1) { const GAS pg8::h16x4* xr = (const GAS pg8::h16x4*)(x3 + (size_t)t0 * D) + lane;
#pragma unroll
        for (int j = 0; j < 4; ++j) vn[j] = __builtin_convertvector(xr[64 * j], f32x4); }
    for (int t = t0; t < t1; ++t) {
        f32x4 v[4]; float ss = 0.f;
#pragma unroll
        for (int j = 0; j < 4; ++j) { v[j] = vn[j]; ss += (v[j].x * v[j].x + v[j].y * v[j].y) + (v[j].z * v[j].z + v[j].w * v[j].w); }
        if (t + 1 < t1) { const GAS pg8::h16x4* xr = (const GAS pg8::h16x4*)(x3 + (size_t)(t + 1) * D) + lane;
#pragma unroll
            for (int j = 0; j < 4; ++j) vn[j] = __builtin_convertvector(xr[64 * j], f32x4); }
        float dt[8];
#pragma unroll
        for (int e = 0; e < 8; ++e) { float a = 0.f;
#pragma unroll
            for (int j = 0; j < 4; ++j) { const f32x4 w = *(const LAS f32x4*)(WrT + e * 1024 + 4 * lane + 256 * j); a += (v[j].x * w.x + v[j].y * w.y) + (v[j].z * w.z + v[j].w * w.w); }
            dt[e] = a; }
        ss = wave_sum(ss);
#pragma unroll
        for (int e = 0; e < 8; ++e) dt[e] = wave_sum(dt[e]);
        const float rstd = 1.f / sqrtf(ss * (1.f / D) + EPS);
        GAS unsigned* o4 = (GAS unsigned*)(H3 + (size_t)t * D) + lane;
#pragma unroll
        for (int j = 0; j < 4; ++j) { const f32x4 y = v[j] * (rstd * SA_N) * gv[j]; o4[64 * j] = pg8::pk_i8x4(y.x, y.y, y.z, y.w); }
        int e1 = 0; float v1 = dt[0] * rstd;
#pragma unroll
        for (int e = 1; e < 8; ++e) { const float x = dt[e] * rstd; if (x > v1) { v1 = x; e1 = e; } }
        int e2 = -1; float v2 = -3.0e38f;
#pragma unroll
        for (int e = 0; e < 8; ++e) { const float x = dt[e] * rstd; if (e != e1 && x > v2) { v2 = x; e2 = e; } }
        const float g2 = 1.f / (1.f + __expf(v1 - v2)), g1 = 1.f - g2;
        cnt0 += 1ull << (8 * e1); cnt1 += 1ull << (8 * e2);
        if (lane == 0) { route[t] = (unsigned)e1 | ((unsigned)e2 << 8); gate1[t] = g1; gate2[t] = g2; }
    }
    if (lane == 0) { v4u c; c.x = (unsigned)cnt0; c.y = (unsigned)(cnt0 >> 32); c.z = (unsigned)cnt1; c.w = (unsigned)(cnt1 >> 32);
        *(GAS v4u*)(wavecnt + (size_t)gw * 4) = c; wcL[wave * 4 + 0] = c.x; wcL[wave * 4 + 1] = c.y; wcL[wave * 4 + 2] = c.z; wcL[wave * 4 + 3] = c.w; }
    __syncthreads();
    if (tid < 16) { const int slot = tid >> 3, e = tid & 7; int s = 0;
#pragma unroll
        for (int w = 0; w < NWAVES; ++w) s += (int)((wcL[w * 4 + slot * 2 + (e >> 2)] >> (8 * (e & 3))) & 255u);
        blockcnt[vcu * 16 + tid] = s; }
    __syncthreads();
}

__device__ __forceinline__ void pos_phase(unsigned char* ws, LAS unsigned char* lds, int G, int vcu, int tid, int lane, int wave) {
    LAS int* cntL = (LAS int*)(lds + RING_OFF);
    LAS int* pAll = (LAS int*)(lds + RING_OFF + 65536);
    LAS int* pBef = pAll + 512;
    LAS int* totL = pBef + 512;
    const int* blockcnt = (const int*)(ws + WS_BLOCKCNT); const unsigned* wavecnt = (const unsigned*)(ws + WS_WAVECNT);
    const unsigned* route = (const unsigned*)(ws + WS_ROUTE); const float* gate1 = (const float*)(ws + WS_GATE1); const float* gate2 = (const float*)(ws + WS_GATE2);
    int* gofs = (int*)(ws + WS_GOFS);
    for (int i = tid; i < G * 16; i += NWAVES * 64) cntL[i] = blockcnt[i];
    __syncthreads();
    { const int c = tid & 15, part = tid >> 4, bpp = (G + 31) / 32; int sa = 0, sb = 0;
      for (int bb = part * bpp; bb < (part + 1) * bpp && bb < G; ++bb) { const int v = cntL[bb * 16 + c]; sa += v; if (bb < vcu) sb += v; }
      pAll[part * 16 + c] = sa; pBef[part * 16 + c] = sb; }
    __syncthreads();
    if (tid < 16) { int sa = 0, sb = 0;
        for (int p = 0; p < 32; ++p) { sa += pAll[p * 16 + tid]; sb += pBef[p * 16 + tid]; }
        totL[tid] = sa; totL[16 + tid] = sb; }
    __syncthreads();
    if (tid == 0) { int off = 0;
        for (int e = 0; e < 8; ++e) { totL[32 + e] = off; totL[32 + 8 + e] = off + totL[e]; if (vcu == 0) { gofs[e] = off; gofs[8 + e] = off + totL[e]; gofs[32 + e] = off >> 8; } off += ((totL[e] + totL[8 + e] + 255) >> 8) << 8; }
        if (vcu == 0) gofs[16] = off >> 8; }
    __syncthreads();
    const int gw = vcu * NWAVES + wave, NGW = G * NWAVES, tpw = (T + NGW - 1) / NGW;
    const int t0 = gw * tpw, t1 = (t0 + tpw) < T ? (t0 + tpw) : T;
    int mypos = 0;
    if (lane < 16) { mypos = totL[32 + lane] + totL[16 + lane];
        for (int w = 0; w < wave; ++w) mypos += (int)((wavecnt[(size_t)(vcu * NWAVES + w) * 4 + (lane >> 3) * 2 + ((lane & 7) >> 2)] >> (8 * (lane & 3))) & 255u); }
    int* pos01 = (int*)(ws + WS_POS);
    int* rowtok0 = (int*)(ws + WS_ROWTOK); int* rowtok1 = rowtok0; float* rowgate0 = (float*)(ws + WS_ROWGATE); float* rowgate1 = rowgate0;
    for (int t = t0; t < t1; ++t) {
        const unsigned rt = route[t]; const int e1 = (int)(rt & 255u), e2 = (int)((rt >> 8) & 255u);
        const int p1 = __shfl(mypos, e1), p2 = __shfl(mypos, 8 + e2);
        if (lane == e1 || lane == 8 + e2) mypos += 1;
        if (lane == 0) { rowtok0[p1] = t; rowgate0[p1] = gate1[t]; rowtok1[p2] = t; rowgate1[p2] = gate2[t]; pos01[t] = p1; pos01[T + t] = p2; }
    }
    if (vcu < 8) { int* rtk = (int*)(ws + WS_ROWTOK); float* rgt = (float*)(ws + WS_ROWGATE);
        const int beg = totL[32 + vcu] + totL[vcu] + totL[8 + vcu], end = totL[32 + vcu] + (((totL[vcu] + totL[8 + vcu] + 255) >> 8) << 8);
        for (int i = beg + tid; i < end; i += NWAVES * 64) { rtk[i] = -1; rgt[i] = 0.f; } }
    __syncthreads();
}

__device__ __forceinline__ void combine_phase(float* out, unsigned char* ws, int G, int vcu, int tid, int lane, int wave) {
    const int* pos01 = (const int*)(ws + WS_POS); const unsigned char* Y = ws + WS_Y; const _Float16* XH = (const _Float16*)(ws + WS_XH);
    const int gw = vcu * NWAVES + wave, NGW = G * NWAVES; const float ys = 1.f / Y_SCALE;
    for (int t0 = gw * 4; t0 < T; t0 += NGW * 4) {
        v4u ya[4], yb[4]; f32x4 o[4][4];
#pragma unroll
        for (int q = 0; q < 4; ++q) { const int t = t0 + q; const int p0 = pos01[t], p1 = pos01[T + t];
            ya[q] = *(const GAS v4u*)(Y + (size_t)p0 * 1024 + 16 * lane); yb[q] = *(const GAS v4u*)(Y + (size_t)p1 * 1024 + 16 * lane);
#pragma unroll
            for (int j = 0; j < 4; ++j) o[q][j] = __builtin_convertvector(*(const GAS pg8::h16x4*)(XH + (size_t)t * 1024 + 16 * lane + 4 * j), f32x4); }
#pragma unroll
        for (int q = 0; q < 4; ++q)
#pragma unroll
            for (int j = 0; j < 4; ++j) { const unsigned a = ya[q][j], c = yb[q][j]; f32x4 x = o[q][j];
                x.x += (float)(((int)(a << 24) >> 24) + ((int)(c << 24) >> 24)) * ys; x.y += (float)(((int)(a << 16) >> 24) + ((int)(c << 16) >> 24)) * ys;
                x.z += (float)(((int)(a << 8) >> 24) + ((int)(c << 8) >> 24)) * ys; x.w += (float)(((int)a >> 24) + ((int)c >> 24)) * ys;
                __builtin_nontemporal_store(x, (GAS f32x4*)(out + (size_t)(t0 + q) * 1024 + 16 * lane + 4 * j)); }
    }
}

constexpr int N_LAUNCHES = MK_N_LAUNCHES;
struct Args { const float* in[26]; float* out; unsigned char* ws; int ph_lo, ph_hi; };
typedef const __attribute__((address_space(4))) unsigned char* kargp_t;
#ifdef PROBE_CLK_PHASE
#define CLK_BEGIN(k) unsigned long long ck0_ = 0, rt0_ = 0; if ((k) == PROBE_CLK_PHASE) { ck0_ = __builtin_amdgcn_s_memtime(); rt0_ = __builtin_amdgcn_s_memrealtime(); }
#define CLK_END(k) if ((k) == PROBE_CLK_PHASE && bx == 0 && tid == 0) { const unsigned long long ck1_ = __builtin_amdgcn_s_memtime(), rt1_ = __builtin_amdgcn_s_memrealtime(); const float qv_ = floorf((float)(ck1_ - ck0_) / (float)(rt1_ - rt0_) + 0.5f); ((float*)(ws + WS_GOFS))[100] = 100.f * qv_ * qv_; }
#else
#define CLK_BEGIN(k)
#define CLK_END(k)
#endif
#define PH_ENTER() kargp_t kp_ = kp0; asm volatile("" : "+s"(kp_)); int tid = tid0; asm volatile("" : "+v"(tid)); const int lane = tid & 63, wave = __builtin_amdgcn_readfirstlane(tid >> 6); \
    unsigned char* ws = *(unsigned char* const __attribute__((address_space(4)))*)(kp_ + 216); float* out = *(float* const __attribute__((address_space(4)))*)(kp_ + 208); (void)lane; (void)wave; (void)out
#define INP(i) (*(const float* const __attribute__((address_space(4)))*)(kp_ + 8 * (i)))
__global__ void __launch_bounds__(NWAVES * 64, 2) mk_fwd(Args args) {
    extern __shared__ __attribute__((aligned(16))) unsigned char lds_raw[];
    LAS unsigned char* lds = (LAS unsigned char*)lds_raw;
    static_assert(sizeof(Args) == 232 && __builtin_offsetof(Args, out) == 208 && __builtin_offsetof(Args, ws) == 216, "Args layout");
    const kargp_t kp0 = (kargp_t)__builtin_amdgcn_kernarg_segment_ptr();
    const int tid0 = threadIdx.x;
    const int G = gridDim.x, bx = blockIdx.x, vcu = (G % 8 == 0) ? (bx % 8) * (G / 8) + bx / 8 : bx;
    for (int u = tid0; u < (XTRA_OFF - LDSCTL_OFF) / 4; u += NWAVES * 64) ((LAS unsigned*)(lds + LDSCTL_OFF))[u] = 0u;
    __syncthreads();
    XcdBarrier bar; bar.bar = (unsigned*)(args.ws + WS_CTL) + CW_BAR; bar.x = 0; bar.st = (volatile LAS unsigned*)(lds + MISC_OFF) + 8;
    if (N_LAUNCHES == 1) bar = xcd_barrier_post((unsigned*)(args.ws + WS_CTL) + CW_BAR, (volatile LAS unsigned*)(lds + MISC_OFF) + 8);
#define GRID_BAR() do { if (N_LAUNCHES == 1) xcd_barrier(bar); } while (0)
    const int lo = args.ph_lo, hi = args.ph_hi;
#ifndef PH_MASK
#define PH_MASK 0xFFFFFFFFu
#endif
#define IN(k) (((PH_MASK >> (k)) & 1u) && lo <= (k) && (k) < hi)
#define BOTH(k) (IN(k) && IN((k) + 1))
#ifndef PROBE_NOEPI
#define PROBE_NOEPI 0
#endif
#ifndef PROBE_REP_MASK
#define PROBE_REP_MASK 0u
#define PROBE_REP_N 1
#endif
#define REPS(k) (((PROBE_REP_MASK >> (k)) & 1u) ? PROBE_REP_N : 1)

    _Pragma("nounroll") for (int rep_ = 0; rep_ < REPS(0); ++rep_) if (IN(0)) { PH_ENTER(); CLK_BEGIN(0); p0_prologue(kp_, ws, lds, G, vcu, tid, lane, wave); __syncthreads(); CLK_END(0); if (BOTH(0)) GRID_BAR(); }
    _Pragma("nounroll") for (int rep_ = 0; rep_ < REPS(1); ++rep_) if (IN(1)) { PH_ENTER(); CLK_BEGIN(1);
        pg8::Gemm g{(const bf16*)(ws + WS_H0), (const bf16*)(ws + WS_WIN), T, 2048, 1024, 0, nullptr, nullptr, nullptr, nullptr, 0}; pg8::StaticOrder S; S.init(T, 2048, G, bx, I8_P1 ? 1024 / 128 : 1024 / 64);
        pg8::EpiGated<0> E{(bf16*)(ws + WS_GLU), 1024, INP(4), 1024, nullptr, I8_P1 ? 1.f / (SA_N * SW_I8) : 1.f, 1.f, {}, -1, lds + XTRA_OFF};
        pg8::gemm_phase<pg8::EpiGated<0>, pg8::StaticOrder, false, I8_P1 ? 2 : 0>(lds + RING_OFF, g, S, E, tid);
        CLK_END(1); if (BOTH(1)) GRID_BAR();
    }
    _Pragma("nounroll") for (int rep_ = 0; rep_ < REPS(2); ++rep_) if (IN(2)) { PH_ENTER(); CLK_BEGIN(2); conv_phase((const bf16*)(ws + WS_GLU), INP(5), INP(6), INP(7), INP(8), (bf16*)(ws + WS_V), lds, G, vcu, tid, lane, wave); CLK_END(2); if (BOTH(2)) GRID_BAR(); }
    _Pragma("nounroll") for (int rep_ = 0; rep_ < REPS(3); ++rep_) if (IN(3)) { PH_ENTER(); CLK_BEGIN(3);
        pg8::Gemm g{(const bf16*)(ws + WS_V), (const bf16*)(ws + WS_WOUT), T, 1024, 1024, 0, nullptr, nullptr, nullptr, nullptr, 0}; pg8::StaticOrder S; S.init(T, 1024, G, bx, I8_P3 ? 1024 / 128 : 1024 / 64);
        pg8::EpiResid<true, true, I8_P4 ? 2 : 0, 0, 1> E{INP(0), (float*)(ws + WS_XH), INP(10), ws + WS_X1B, (float*)(ws + WS_PART1), I8_P3 ? 1.f / (SA_N * SW_I8) : 1.f, I8_P4 ? SA_X : 1.f, (LAS float*)(lds + XTRA_OFF), lds + XTRA_OFF + 4096};
        pg8::gemm_phase<pg8::EpiResid<true, true, I8_P4 ? 2 : 0, 0, 1>, pg8::StaticOrder, false, I8_P3 ? 2 : 0>(lds + RING_OFF, g, S, E, tid);
        CLK_END(3); if (BOTH(3)) GRID_BAR();
    }
    _Pragma("nounroll") for (int rep_ = 0; rep_ < REPS(4); ++rep_) if (IN(4)) { PH_ENTER(); CLK_BEGIN(4);
        pg8::Gemm g{(const bf16*)(ws + WS_X1B), (const bf16*)(ws + WS_WF13), T, 5632, 1024, 0, nullptr, nullptr, nullptr, nullptr, 0}; pg8::StaticOrder S; S.init(T, 5632, G, bx, I8_P4 ? 1024 / 128 : 1024 / 64);
        pg8::EpiGated<1> E{(bf16*)(ws + WS_HB), DFFP, nullptr, 0, (const float*)(ws + WS_PART1), I8_P4 ? 1.f / (SA_X * SW_I8) : 1.f, 1.f, {}, -1, lds + XTRA_OFF};
        if (G == 256) {
            const int slot = vcu % 11;
            S.i1 = slot;
            pg8::gemm_phase<pg8::EpiGated<1>, pg8::StaticOrder, false, I8_P4 ? 2 : 0>(lds + RING_OFF, g, S, E, tid);
            __syncthreads();
            p0_items2(kp_, ws, (LAS float*)(lds + RING_OFF + wave * 16384), wave, NWAVES, vcu * (IT_MOE / 256), (vcu + 1) * (IT_MOE / 256), lane);
            __syncthreads();
            S.i0 = slot; S.i1 = 0x7fffffff;
        }
        pg8::gemm_phase<pg8::EpiGated<1>, pg8::StaticOrder, false, I8_P4 ? 2 : 0>(lds + RING_OFF, g, S, E, tid);
        CLK_END(4); if (BOTH(4)) GRID_BAR();
    }
    _Pragma("nounroll") for (int rep_ = 0; rep_ < REPS(5); ++rep_) if (IN(5)) { PH_ENTER(); CLK_BEGIN(5);
        pg8::Gemm g{(const bf16*)(ws + WS_HB), (const bf16*)(ws + WS_WFD), T, 1024, DFFP, 0, nullptr, nullptr, nullptr, nullptr, 0}; pg8::StaticOrder S; S.init(T, 1024, G, bx, DFFP / 64);
        pg8::EpiResid<false, true, 2, 1, 1> E{(const float*)(ws + WS_XH), (float*)(ws + WS_XH), nullptr, ws + WS_X2B, (float*)(ws + WS_PART2), 1.f, SA_X, (LAS float*)(lds + XTRA_OFF), lds + XTRA_OFF + 4096};
        pg8::gemm_phase<pg8::EpiResid<false, true, 2, 1, 1>, pg8::StaticOrder, false>(lds + RING_OFF, g, S, E, tid);
        CLK_END(5); if (BOTH(5)) GRID_BAR();
    }
    for (int grp = 0; grp < 3; ++grp) {
        _Pragma("nounroll") for (int rep_ = 0; rep_ < REPS(6 + 2 * grp); ++rep_) if (IN(6 + 2 * grp)) { PH_ENTER(); CLK_BEGIN(6 + 2 * grp);
            pg8::Gemm g{(const bf16*)(ws + WS_X2B), (const bf16*)(ws + WS_WQKV + (size_t)grp * 3072 * 1024), T, 3072, 1024, 0, nullptr, nullptr, nullptr, nullptr, 0}; pg8::StaticOrder S; S.init(T, 3072, G, bx, 1024 / 128);
            pg8::EpiQKV E{(bf16*)(ws + WS_KG), (size_t)T * D, (const float*)(ws + WS_PART2), INP(13) + grp * 64, INP(16) + grp * 64, QSCALE, 1.f / (SA_X * SW_I8), {}, -1, lds + XTRA_OFF};
            pg8::gemm_phase<pg8::EpiQKV, pg8::StaticOrder, false, 2>(lds + RING_OFF, g, S, E, tid);
            CLK_END(6 + 2 * grp); if (BOTH(6 + 2 * grp)) GRID_BAR();
        }
        _Pragma("nounroll") for (int rep_ = 0; rep_ < REPS(7 + 2 * grp); ++rep_) if (IN(7 + 2 * grp)) { PH_ENTER(); CLK_BEGIN(7 + 2 * grp);
            attn_phase(lds, grp, (const bf16*)(ws + WS_KG), (const bf16*)(ws + WS_VG), (const bf16*)(ws + WS_QG), (bf16*)(ws + WS_O), ws + WS_O8, (float*)(ws + WS_LSE), INP(1), (unsigned*)(ws + WS_CTL) + CW_AQ + grp * 128, G, vcu, tid, lane, wave);
            CLK_END(7 + 2 * grp); if (BOTH(7 + 2 * grp)) GRID_BAR();
        }
    }
    _Pragma("nounroll") for (int rep_ = 0; rep_ < REPS(12); ++rep_) if (IN(12)) { PH_ENTER(); CLK_BEGIN(12);
        pg8::Gemm g{(const bf16*)(ws + WS_O8), (const bf16*)(ws + WS_WO), T, 1024, 1024, 0, nullptr, nullptr, nullptr, nullptr, 0}; pg8::StaticOrder S; S.init(T, 1024, G, bx, 1024 / 128);
        pg8::EpiResid<false, false, 0, 1, 1> E{(const float*)(ws + WS_XH), (float*)(ws + WS_XH), nullptr, nullptr, nullptr, 1.f / (W8_SCALE * O8_SCALE), 1.f, nullptr, lds + XTRA_OFF + 4096};
        pg8::gemm_phase<pg8::EpiResid<false, false, 0, 1, 1>, pg8::StaticOrder, false, 1>(lds + RING_OFF, g, S, E, tid);
        CLK_END(12); if (BOTH(12)) GRID_BAR();
    }
    _Pragma("nounroll") for (int rep_ = 0; rep_ < REPS(13); ++rep_) if (IN(13)) { PH_ENTER(); CLK_BEGIN(13); route_phase((const _Float16*)(ws + WS_XH), INP(18) + 1024, INP(22), ws, lds, G, vcu, tid, lane, wave); CLK_END(13); if (BOTH(13)) GRID_BAR(); }
    _Pragma("nounroll") for (int rep_ = 0; rep_ < REPS(14); ++rep_) if (IN(14)) { PH_ENTER(); CLK_BEGIN(14); pos_phase(ws, lds, G, vcu, tid, lane, wave); CLK_END(14); if (BOTH(14)) GRID_BAR(); }
    _Pragma("nounroll") for (int rep_ = 0; rep_ < REPS(15); ++rep_) if (IN(15)) { PH_ENTER(); CLK_BEGIN(15);
        const int* gofs = (const int*)(ws + WS_GOFS); const int* rowtok = (const int*)(ws + WS_ROWTOK);
        const int ntile = gofs[16];
        pg8::MoeOrder S; S.so.init(ntile * 256, 7168, G, bx, 1024 / 128); S.p0 = 0; S.p1 = 0; S.ppu = 0;
        S.t1 = gofs[32 + 1]; S.t2 = gofs[32 + 2]; S.t3 = gofs[32 + 3]; S.t4 = gofs[32 + 4]; S.t5 = gofs[32 + 5]; S.t6 = gofs[32 + 6]; S.t7 = gofs[32 + 7];
        pg8::Gemm g{(const bf16*)(ws + WS_H3), (const bf16*)(ws + WS_WM13), ntile * 256, 7168, 1024, (size_t)7168 * 1024, rowtok, nullptr, nullptr, nullptr, 0};
        pg8::EpiGated<3> E{(bf16*)(ws + WS_HM), DFFE, nullptr, 0, nullptr, 1.f / (SA_N * SW_I8), HM_SCALE, {}, -1, lds + XTRA_OFF};
        pg8::gemm_phase<pg8::EpiGated<3>, pg8::MoeOrder, true, 2>(lds + RING_OFF, g, S, E, tid);
        CLK_END(15); if (BOTH(15)) GRID_BAR();
    }
    _Pragma("nounroll") for (int rep_ = 0; rep_ < REPS(16); ++rep_) if (IN(16)) { PH_ENTER(); CLK_BEGIN(16);
        const int* gofs = (const int*)(ws + WS_GOFS); const float* rowgate = (const float*)(ws + WS_ROWGATE);
        const int ntile = gofs[16];
        pg8::MoeOrderSK S; S.so.init(ntile * 256, 1024, G, vcu, DFFE / 128); S.plan();
        S.t1 = gofs[32 + 1]; S.t2 = gofs[32 + 2]; S.t3 = gofs[32 + 3]; S.t4 = gofs[32 + 4]; S.t5 = gofs[32 + 5]; S.t6 = gofs[32 + 6]; S.t7 = gofs[32 + 7];
        pg8::Gemm g{(const bf16*)(ws + WS_HM), (const bf16*)(ws + WS_WM2), ntile * 256, 1024, DFFE, (size_t)1024 * DFFE, nullptr, ws + WS_SLAB, (unsigned*)(ws + WS_CTL) + CW_SKFLAG + (rep_ & 1) * 8192, (unsigned*)(ws + WS_CTL) + CW_TMO, 0};
        pg8::EpiMoeDown E{ws + WS_Y, rowgate, Y_SCALE / (W8_SCALE * HM_SCALE)};
        pg8::gemm_phase<pg8::EpiMoeDown, pg8::MoeOrderSK, false, 1>(lds + RING_OFF, g, S, E, tid);
        CLK_END(16); if (BOTH(16)) GRID_BAR();
    }
    _Pragma("nounroll") for (int rep_ = 0; rep_ < REPS(17); ++rep_) if (IN(17)) { PH_ENTER(); CLK_BEGIN(17); combine_phase(out, ws, G, vcu, tid, lane, wave); }
#ifdef PROBE_CLK_PHASE
    if (bx == 0 && tid0 == 0) { asm volatile("s_waitcnt vmcnt(0)" ::: "memory"); args.out[(size_t)T * D - 1] = ((float*)(args.ws + WS_GOFS))[100]; }
#endif
#ifdef PROBE_TCH
    {
        GRID_BAR();
        if (bx == 0 && tid0 == 0) { const unsigned tot = __hip_atomic_load((unsigned*)(args.ws + WS_CTL) + 60000, __ATOMIC_RELAXED, __HIP_MEMORY_SCOPE_AGENT); const unsigned long long wait_ticks = (unsigned long long)(tot / (unsigned)G) * PROBE_TCH;
            const unsigned long long t0_ = __builtin_amdgcn_s_memrealtime(); while (__builtin_amdgcn_s_memrealtime() - t0_ < wait_ticks) __builtin_amdgcn_s_sleep(8); } }
#endif
#undef IN
#undef BOTH
#undef GRID_BAR
}

extern "C" void kernel_launch(void* const* d_in, const int* in_sizes, int n_in, void* d_out, int out_size, void* d_ws, size_t ws_size, hipStream_t stream) {
    static int grid = 0;
    if (grid == 0) {
        if (n_in != 26 || in_sizes[0] != T * D || out_size != T * D || ws_size < WS_END) { fprintf(stderr, "kernel_launch: unexpected shapes: n_in %d in0 %d out %d ws %zu (need >= %zu); nothing launched\n", n_in, n_in > 0 ? in_sizes[0] : -1, out_size, ws_size, (size_t)WS_END); grid = -1; return; }
        int dev = 0, cus = 0;
        if (hipGetDevice(&dev) != hipSuccess || hipDeviceGetAttribute(&cus, hipDeviceAttributeMultiprocessorCount, dev) != hipSuccess) { fprintf(stderr, "kernel_launch: device query failed\n"); grid = -1; return; }
        if (hipFuncSetAttribute((const void*)mk_fwd, hipFuncAttributeMaxDynamicSharedMemorySize, LDS_BYTES) != hipSuccess) { fprintf(stderr, "kernel_launch: hipFuncSetAttribute failed\n"); grid = -1; return; }
        int per_cu = 0;
        if (hipOccupancyMaxActiveBlocksPerMultiprocessor(&per_cu, (const void*)mk_fwd, NWAVES * 64, LDS_BYTES) != hipSuccess || per_cu < 1) fprintf(stderr, "kernel_launch: note: occupancy query reports %d workgroups per CU\n", per_cu);
        (void)hipGetLastError();
        grid = cus;
    }
    if (grid < 0) return;
    if (hipMemsetAsync((char*)d_ws + WS_CTL, 0, CTL_ZERO_BYTES, stream) != hipSuccess) { fprintf(stderr, "kernel_launch: hipMemsetAsync failed\n"); return; }
    Args a{};
    for (int i = 0; i < 26; ++i) a.in[i] = (const float*)d_in[i];
    a.out = (float*)d_out; a.ws = (unsigned char*)d_ws;
    for (int li = 0; li < N_LAUNCHES; ++li) {
        a.ph_lo = (N_LAUNCHES == 1) ? 0 : li; a.ph_hi = (N_LAUNCHES == 1) ? NPHASE : li + 1;
        hipLaunchKernelGGL(mk_fwd, dim3(grid), dim3(NWAVES * 64), LDS_BYTES, stream, a);
        const hipError_t le = hipPeekAtLastError();
        if (le != hipSuccess) { fprintf(stderr, "kernel_launch: launch %d failed: %s\n", li, hipGetErrorName(le)); break; }
    }
}
```

```cpp
#include <hip/hip_runtime.h>
#include <cstdio>
#include <cstdint>
#ifndef MK_N_LAUNCHES
#define MK_N_LAUNCHES 1
#endif
namespace pg8 {
#define PG8_LAS __attribute__((address_space(3)))
#define PG8_GAS __attribute__((address_space(1)))
typedef unsigned short bf16_t;
typedef short bf16x8 __attribute__((ext_vector_type(8)));
typedef float f32x4 __attribute__((ext_vector_type(4)));
typedef float f32x2 __attribute__((ext_vector_type(2)));
typedef unsigned u32x4 __attribute__((ext_vector_type(4)));
typedef unsigned u32x2 __attribute__((ext_vector_type(2)));
typedef int v4i_t __attribute__((ext_vector_type(4)));
typedef int v8i_t __attribute__((ext_vector_type(8)));
constexpr int BM = 256, BK = 64, HALF = 128, HTB = HALF * BK * 2  , STAGE_BYTES = 8 * HTB, NXCD = 8, WGM = 8;

__host__ __device__ __forceinline__ int lds_byte(int r, int c) { return r * 128 + ((((c >> 3) ^ r) & 7) << 4) + (c & 7) * 2; }
__host__ __device__ __forceinline__ void stage_rc(int b, int& R, int& C) { R = b >> 7; C = ((((b >> 4) ^ R) & 7) << 3) + ((b & 15) >> 1); }
__host__ __device__ __forceinline__ int perm32(int rho) { const int n = rho >> 4, i = rho & 15; return 8 * (i >> 2) + 4 * n + (i & 3); }

struct Unit { int pm, pn, be, kt0, nkt, part; };
struct Gemm { const bf16_t* A; const bf16_t* Bt; int M, N, K; size_t bstride; const int* rowtok; unsigned char* slab; unsigned* skflag; unsigned* tmo; int noepi; };

struct StaticOrder {
    static constexpr bool STREAMK = false;
    int nM, nN, nwg, G, c, nt, i0, i1;
    __host__ __device__ __forceinline__ void init(int M, int N, int G_, int c_, int nt_) { nM = M / BM; nN = N / BM; nwg = nM * nN; G = G_; c = c_; nt = nt_; i0 = 0; i1 = 0x7fffffff; }
    __host__ __device__ __forceinline__ int wg() const { return c; }
    __host__ __device__ __forceinline__ bool next(int i, Unit& u) const { const int ii = i + i0; if (ii >= i1) return false; const long L = (long)ii * G + c; if (L >= nwg) return false; map((int)L, u); return true; }
    __host__ __device__ __forceinline__ void map_linear(int wgid, Unit& u) const {
        const int nig = WGM * nN, gid = wgid / nig, fm = gid * WGM, gsz = (nM - fm) < WGM ? (nM - fm) : WGM;
        u.pm = fm + ((wgid % nig) % gsz); u.pn = (wgid % nig) / gsz; u.be = 0; u.kt0 = 0; u.nkt = nt; u.part = 0;
    }
    __host__ __device__ __forceinline__ void map(int L, Unit& u) const {
        int wgid = L; { const int q = nwg / NXCD, r = nwg % NXCD, xcd = wgid % NXCD, off = wgid / NXCD; wgid = (xcd < r ? xcd * (q + 1) : r * (q + 1) + (xcd - r) * q) + off; }
        const int nig = WGM * nN, gid = wgid / nig, fm = gid * WGM, gsz = (nM - fm) < WGM ? (nM - fm) : WGM;
        u.pm = fm + ((wgid % nig) % gsz); u.pn = (wgid % nig) / gsz; u.be = 0; u.kt0 = 0; u.nkt = nt; u.part = 0;
    }
};
template <bool STREAMK_> struct MoeOrderT {
    static constexpr bool STREAMK = STREAMK_;
    StaticOrder so; int t1, t2, t3, t4, t5, t6, t7; int p0, p1, ppu;
    __device__ __forceinline__ int wg() const { return so.c; }
    __device__ __forceinline__ void plan() { ppu = so.nt / 2; const long tot = (long)so.nwg * ppu; p0 = (int)(tot * so.c / so.G); p1 = (int)(tot * (so.c + 1) / so.G); }
    __device__ __forceinline__ bool next(int i, Unit& u) const {
#if defined(PROBE_DOUBLE_KLOOP)
        if (!STREAMK) { if (!so.next(i >> 1, u)) return false; if (!(i & 1)) u.part = 3; }
#else
        if (!STREAMK) { if (!so.next(i, u)) return false; }
#endif
        else { const int first = p0 / ppu, uidx = first + i; const int s = (i == 0) ? (p0 - first * ppu) : 0; const int rem = p1 - uidx * ppu;
            if (rem <= s) return false;
            const int e = rem < ppu ? rem : ppu;
            so.map_linear(uidx, u); u.kt0 = 2 * s; u.nkt = 2 * (e - s); u.part = (s > 0) ? 1 : ((e < ppu) ? 2 : 0); }
        const int q = u.pm; u.be = (q >= t1) + (q >= t2) + (q >= t3) + (q >= t4) + (q >= t5) + (q >= t6) + (q >= t7); return true;
    }
};
typedef MoeOrderT<false> MoeOrder;
typedef MoeOrderT<true> MoeOrderSK;

__device__ __forceinline__ float xsum4(float v) {
    const unsigned u = __builtin_bit_cast(unsigned, v);
    const auto r1 = __builtin_amdgcn_permlane16_swap(u, u, false, false);
    const float s2 = __builtin_bit_cast(float, (unsigned)r1[0]) + __builtin_bit_cast(float, (unsigned)r1[1]);
    const unsigned u2 = __builtin_bit_cast(unsigned, s2);
    const auto r2 = __builtin_amdgcn_permlane32_swap(u2, u2, false, false);
    return __builtin_bit_cast(float, (unsigned)r2[0]) + __builtin_bit_cast(float, (unsigned)r2[1]);
}
__device__ __forceinline__ unsigned cvt_pk_bf16(float lo, float hi) { unsigned r; asm volatile("v_cvt_pk_bf16_f32 %0, %1, %2" : "=v"(r) : "v"(lo), "v"(hi)); return r; }
__device__ __forceinline__ float fast_sigmoid(float x) { return __builtin_amdgcn_rcpf(1.0f + __builtin_amdgcn_exp2f(-1.4426950408889634f * x)); }
__device__ __forceinline__ float row_rstd(const float* part, int row) {
    const f32x4 a = *(const f32x4*)(part + (size_t)row * 4);
    return __builtin_amdgcn_rsqf(((a[0] + a[1]) + (a[2] + a[3])) * (1.0f / 1024.0f) + 1e-6f);
}
__device__ __forceinline__ void row_rstd8(const float* part, int row0, float (&r)[2][4]) {
#pragma unroll
    for (int ai = 0; ai < 2; ++ai)
#pragma unroll
        for (int m = 0; m < 4; ++m) r[ai][m] = row_rstd(part, row0 + ai * HALF + m * 16);
}
__device__ __forceinline__ unsigned pk_fp8x4(float a, float b, float c, float d) {
    a = __builtin_amdgcn_fmed3f(a, -448.f, 448.f); b = __builtin_amdgcn_fmed3f(b, -448.f, 448.f); c = __builtin_amdgcn_fmed3f(c, -448.f, 448.f); d = __builtin_amdgcn_fmed3f(d, -448.f, 448.f);
    unsigned w = 0u; w = __builtin_amdgcn_cvt_pk_fp8_f32(a, b, w, false); w = __builtin_amdgcn_cvt_pk_fp8_f32(c, d, w, true); return w;
}
__device__ __forceinline__ unsigned pk_i8x4(float a, float b, float c, float d) {
    const int ia = (int)__builtin_rintf(__builtin_amdgcn_fmed3f(a, -127.f, 127.f)), ib = (int)__builtin_rintf(__builtin_amdgcn_fmed3f(b, -127.f, 127.f));
    const int ic = (int)__builtin_rintf(__builtin_amdgcn_fmed3f(c, -127.f, 127.f)), id = (int)__builtin_rintf(__builtin_amdgcn_fmed3f(d, -127.f, 127.f));
    return ((unsigned)ia & 255u) | (((unsigned)ib & 255u) << 8) | (((unsigned)ic & 255u) << 16) | ((unsigned)id << 24);
}

template <int MODE> struct EpiGated {
    static constexpr bool PERM = true, AFTER_DRAIN = false;
    bf16_t* O; int ldo; const float* bias; int bias_half; const float* part; float descale, out_scale;
    mutable float r8c[2][4]; mutable int pmc; PG8_LAS unsigned char* stg;
    __device__ __forceinline__ void operator()(const f32x4 (&acc)[2][2][4][2], const Unit& u, int wr, int wc, int fr, int fq) const {
        const int row0 = u.pm * BM + wr * 64 + fr, col0 = u.pn * 128 + wc * 32 + 8 * fq;
        const int lane = fq * 16 + fr, colw = u.pn * 128 + wc * 32; PG8_LAS unsigned char* W = stg + (wr * 4 + wc) * 1536;
        f32x4 ba[2], bg[2];
#pragma unroll
        for (int n = 0; n < 2; ++n) { if (MODE == 0) { ba[n] = *(const f32x4*)(bias + col0 + 4 * n); bg[n] = *(const f32x4*)(bias + bias_half + col0 + 4 * n); } else { ba[n] = (f32x4){0.f, 0.f, 0.f, 0.f}; bg[n] = ba[n]; } }
        if ((MODE == 1 || MODE == 4) && u.pm != pmc) { row_rstd8(part, row0, r8c); pmc = u.pm; }
#pragma unroll
        for (int ai = 0; ai < 2; ++ai)
#pragma unroll
            for (int m = 0; m < 4; ++m) { const int row = row0 + ai * HALF + m * 16;
                float r = 1.f; if (MODE == 1 || MODE == 4) r = r8c[ai][m];
                f32x4 o[2];
#pragma unroll
                for (int n = 0; n < 2; ++n) { f32x4 a = acc[ai][0][m][n], g = acc[ai][1][m][n];
                    if (MODE == 0) { a = a * descale + ba[n]; g = g * descale + bg[n];
#pragma unroll
                        for (int e = 0; e < 4; ++e) o[n][e] = a[e] * fast_sigmoid(g[e]); }
                    else if (MODE == 3) {
                        const float c1 = -1.4426950408889634f * descale, c2 = descale * descale * out_scale;
#pragma unroll
                        for (int e = 0; e < 4; ++e) o[n][e] = (a[e] * g[e]) * __builtin_amdgcn_rcpf(1.0f + __builtin_amdgcn_exp2f(a[e] * c1)) * c2; }
                    else { if (MODE == 1) { a = a * (r * descale); g = g * (r * descale); } if (MODE == 4) { a = a * (r * descale); g = g * (r * descale * out_scale); }
#pragma unroll
                        for (int e = 0; e < 4; ++e) o[n][e] = a[e] * fast_sigmoid(a[e]) * g[e]; } }
                if (MODE == 3 || MODE == 4) { u32x2 w; w.x = pk_fp8x4(o[0][0], o[0][1], o[0][2], o[0][3]); w.y = pk_fp8x4(o[1][0], o[1][1], o[1][2], o[1][3]);
                    *(PG8_LAS u32x2*)(W + ((m & 1) * 16 + fr) * 48 + fq * 8) = w;
                    if (m & 1) { __builtin_amdgcn_wave_barrier();
                        const int rr = lane >> 1, pp = lane & 1; const u32x4 ov = *(const PG8_LAS u32x4*)(W + rr * 48 + pp * 16);
                        *(u32x4*)((unsigned char*)O + (size_t)(row - fr - 16 + rr) * ldo + colw + pp * 16) = ov;
                        __builtin_amdgcn_wave_barrier(); } }
                else { u32x4 w; w.x = cvt_pk_bf16(o[0][0], o[0][1]); w.y = cvt_pk_bf16(o[0][2], o[0][3]); w.z = cvt_pk_bf16(o[1][0], o[1][1]); w.w = cvt_pk_bf16(o[1][2], o[1][3]);
                    *(PG8_LAS u32x4*)(W + fr * 80 + fq * 16) = w;
                    __builtin_amdgcn_wave_barrier();
                    const int rr = lane >> 2, pp = lane & 3; const u32x4 ov = *(const PG8_LAS u32x4*)(W + rr * 80 + pp * 16);
                    *(u32x4*)(O + (size_t)(row - fr + rr) * ldo + colw + pp * 8) = ov;
                    __builtin_amdgcn_wave_barrier(); }
                }
    }
};
typedef _Float16 h16x4 __attribute__((ext_vector_type(4)));
typedef _Float16 h16x8 __attribute__((ext_vector_type(8)));
typedef float f32x8 __attribute__((ext_vector_type(8)));
template <bool BIAS, bool AUX, int XB8 = 0, int RIN = 0, int ROUT = 0> struct EpiResid {
    static constexpr bool PERM = true, AFTER_DRAIN = false;
    static_assert(ROUT == 1 && (!AUX || XB8 != 0), "the staged epilogue writes fp16 rows and 1-byte copies");
    const float* resid; float* out; const float* bias; unsigned char* xb; float* part; float descale, xb_scale; PG8_LAS float* red; PG8_LAS unsigned char* stg;
    __device__ __forceinline__ void operator()(const f32x4 (&acc)[2][2][4][2], const Unit& u, int wr, int wc, int fr, int fq) const {
        const int colw = u.pn * BM + wc * 32, col0 = colw + 8 * fq, lane = fq * 16 + fr;
        const int s4 = lane >> 2, p4 = lane & 3, s8 = lane >> 3, p8 = lane & 7;
        PG8_LAS unsigned char* W = stg + (wr * 4 + wc) * 2304;
        f32x4 bv[2][2];
#pragma unroll
        for (int bj = 0; bj < 2; ++bj)
#pragma unroll
            for (int n = 0; n < 2; ++n) bv[bj][n] = BIAS ? *(const f32x4*)(bias + col0 + bj * HALF + n * 4) : (f32x4){0.f, 0.f, 0.f, 0.f};
#pragma unroll
        for (int ai = 0; ai < 2; ++ai) {
            const int rowh = u.pm * BM + wr * 64 + ai * HALF;
            constexpr int MB = RIN ? 4 : 2;
            u32x4 rl[4][RIN ? 2 : 4];
#pragma unroll
            for (int m = 0; m < 4; ++m) {
              if (m % MB == 0) {
#pragma unroll
                for (int mm = m; mm < m + MB; ++mm)
#pragma unroll
                    for (int bj = 0; bj < 2; ++bj) {
                        if (RIN) rl[mm][bj] = *(const u32x4*)((const _Float16*)resid + (size_t)(rowh + mm * 16 + s4) * 1024 + colw + bj * HALF + p4 * 8);
                        else { rl[mm][bj * 2] = *(const u32x4*)(resid + (size_t)(rowh + mm * 16 + s8) * 1024 + colw + bj * HALF + p8 * 4); rl[mm][bj * 2 + 1] = *(const u32x4*)(resid + (size_t)(rowh + mm * 16 + s8 + 8) * 1024 + colw + bj * HALF + p8 * 4); } }
                asm volatile("" ::: "memory");
              }
              { const int rowg = rowh + m * 16; float ss = 0.f;
                f32x4 r[2][2];
                if (RIN) {
                    *(PG8_LAS u32x4*)(W + s4 * 144 + p4 * 16) = rl[m][0]; *(PG8_LAS u32x4*)(W + s4 * 144 + 64 + p4 * 16) = rl[m][1];
                    __builtin_amdgcn_wave_barrier();
#pragma unroll
                    for (int bj = 0; bj < 2; ++bj) { const f32x8 r8 = __builtin_convertvector(*(const PG8_LAS h16x8*)(W + fr * 144 + bj * 64 + fq * 16), f32x8); r[bj][0] = (f32x4){r8[0], r8[1], r8[2], r8[3]}; r[bj][1] = (f32x4){r8[4], r8[5], r8[6], r8[7]}; }
                    __builtin_amdgcn_wave_barrier();
                } else {
#pragma unroll
                    for (int bj = 0; bj < 2; ++bj) {
                        *(PG8_LAS u32x4*)(W + s8 * 144 + p8 * 16) = rl[m][bj * 2]; *(PG8_LAS u32x4*)(W + (s8 + 8) * 144 + p8 * 16) = rl[m][bj * 2 + 1];
                        __builtin_amdgcn_wave_barrier();
                        r[bj][0] = *(const PG8_LAS f32x4*)(W + fr * 144 + fq * 32); r[bj][1] = *(const PG8_LAS f32x4*)(W + fr * 144 + fq * 32 + 16);
                        __builtin_amdgcn_wave_barrier(); }
                }
                f32x4 x[2][2];
#pragma unroll
                for (int bj = 0; bj < 2; ++bj)
#pragma unroll
                    for (int n = 0; n < 2; ++n) { x[bj][n] = r[bj][n] + acc[ai][bj][m][n] * descale + bv[bj][n]; const f32x4 q = x[bj][n]; ss += (q[0] * q[0] + q[1] * q[1]) + (q[2] * q[2] + q[3] * q[3]); }
#pragma unroll
                for (int bj = 0; bj < 2; ++bj) { const f32x8 x8 = {x[bj][0][0], x[bj][0][1], x[bj][0][2], x[bj][0][3], x[bj][1][0], x[bj][1][1], x[bj][1][2], x[bj][1][3]}; *(PG8_LAS h16x8*)(W + fr * 144 + bj * 64 + fq * 16) = __builtin_convertvector(x8, h16x8); }
                __builtin_amdgcn_wave_barrier();
#pragma unroll
                for (int bj = 0; bj < 2; ++bj) *(u32x4*)((_Float16*)out + (size_t)(rowg + s4) * 1024 + colw + bj * HALF + p4 * 8) = *(const PG8_LAS u32x4*)(W + s4 * 144 + bj * 64 + p4 * 16);
                __builtin_amdgcn_wave_barrier();
                if (AUX) {
#pragma unroll
                    for (int bj = 0; bj < 2; ++bj) { u32x2 w;
                        if (XB8 == 1) { w.x = pk_fp8x4(x[bj][0][0] * xb_scale, x[bj][0][1] * xb_scale, x[bj][0][2] * xb_scale, x[bj][0][3] * xb_scale); w.y = pk_fp8x4(x[bj][1][0] * xb_scale, x[bj][1][1] * xb_scale, x[bj][1][2] * xb_scale, x[bj][1][3] * xb_scale); }
                        else { w.x = pk_i8x4(x[bj][0][0] * xb_scale, x[bj][0][1] * xb_scale, x[bj][0][2] * xb_scale, x[bj][0][3] * xb_scale); w.y = pk_i8x4(x[bj][1][0] * xb_scale, x[bj][1][1] * xb_scale, x[bj][1][2] * xb_scale, x[bj][1][3] * xb_scale); }
                        *(PG8_LAS u32x2*)(W + fr * 80 + bj * 32 + fq * 8) = w; }
                    __builtin_amdgcn_wave_barrier();
                    *(u32x4*)(xb + (size_t)(rowg + s4) * 1024 + colw + (p4 >> 1) * HALF + (p4 & 1) * 16) = *(const PG8_LAS u32x4*)(W + s4 * 80 + (p4 >> 1) * 32 + (p4 & 1) * 16);
                    __builtin_amdgcn_wave_barrier();
                    ss += __shfl_xor(ss, 16); ss += __shfl_xor(ss, 32); if (fq == 0) red[(ai * HALF + wr * 64 + m * 16 + fr) * 4 + wc] = ss; }
              }
            }
        }
        if (AUX) {
            __syncthreads();
            const int t = ((wr * 4 + wc) << 6) | (fq * 16 + fr);
            if (t < BM) { const f32x4 q = *(const PG8_LAS f32x4*)(red + t * 4); part[(size_t)(u.pm * BM + t) * 4 + u.pn] = (q[0] + q[1]) + (q[2] + q[3]); }
            __syncthreads();
        }
    }
};
struct EpiQKV {
    static constexpr bool PERM = true, AFTER_DRAIN = false;
    bf16_t* Kb; size_t kvq_stride; const float* part; const float* kgain; const float* qgain; float qscale, descale;
    mutable float r8c[2][4]; mutable int pmc; PG8_LAS unsigned char* stg;
    __device__ __forceinline__ void operator()(const f32x4 (&acc)[2][2][4][2], const Unit& u, int wr, int wc, int fr, int fq) const {
        const int kind = u.pn >> 2, head = (u.pn & 3) * 4 + wc;
        bf16_t* dst = Kb + (size_t)kind * kvq_stride;
        const float* gsrc = kind == 0 ? kgain : qgain; const float gs = kind == 2 ? qscale : 1.f;
        const int row0 = u.pm * BM + wr * 64 + fr, colb = head * 64 + 8 * fq; (void)colb;
        PG8_LAS unsigned char* ws_ = stg + (wr * 4 + wc) * 2304;
        f32x4 gv[2][2];
#pragma unroll
        for (int bj = 0; bj < 2; ++bj)
#pragma unroll
            for (int n = 0; n < 2; ++n) gv[bj][n] = *(const f32x4*)(gsrc + 32 * bj + 8 * fq + 4 * n) * gs;
        float r8[2][4]; row_rstd8(part, row0, r8);
#pragma unroll
        for (int ai = 0; ai < 2; ++ai)
#pragma unroll
            for (int m = 0; m < 4; ++m) { const int row = row0 + ai * HALF + m * 16; const float r = r8[ai][m] * descale;
                f32x4 v[2][2]; float ss = 0.f;
#pragma unroll
                for (int bj = 0; bj < 2; ++bj)
#pragma unroll
                    for (int n = 0; n < 2; ++n) { v[bj][n] = acc[ai][bj][m][n] * r; const f32x4 x = v[bj][n]; ss += (x[0] * x[0] + x[1] * x[1]) + (x[2] * x[2] + x[3] * x[3]); }
                ss = xsum4(ss);
                if (kind != 1) { const float inv = __builtin_amdgcn_rsqf(ss * (1.0f / 64.0f) + 1e-6f);
#pragma unroll
                    for (int bj = 0; bj < 2; ++bj)
#pragma unroll
                        for (int n = 0; n < 2; ++n) v[bj][n] = v[bj][n] * gv[bj][n] * inv; }
#pragma unroll
                for (int bj = 0; bj < 2; ++bj) { u32x4 w; w.x = cvt_pk_bf16(v[bj][0][0], v[bj][0][1]); w.y = cvt_pk_bf16(v[bj][0][2], v[bj][0][3]); w.z = cvt_pk_bf16(v[bj][1][0], v[bj][1][1]); w.w = cvt_pk_bf16(v[bj][1][2], v[bj][1][3]);
                    *(PG8_LAS u32x4*)(ws_ + fr * 144 + bj * 64 + fq * 16) = w; }
                { const int l = fq * 16 + fr, rr = l >> 3, cc = l & 7; const int rowb = row - fr;
                  const u32x4 o0 = *(const PG8_LAS u32x4*)(ws_ + rr * 144 + cc * 16), o1 = *(const PG8_LAS u32x4*)(ws_ + (rr + 8) * 144 + cc * 16);
                  *(u32x4*)(dst + (size_t)(rowb + rr) * 1024 + head * 64 + cc * 8) = o0; *(u32x4*)(dst + (size_t)(rowb + rr + 8) * 1024 + head * 64 + cc * 8) = o1; }
                __builtin_amdgcn_sched_barrier(0); }
    }
};
struct EpiMoeDown {
    static constexpr bool PERM = true, AFTER_DRAIN = false;
    unsigned char* Y; const float* rowgate; float descale;
    template <bool ADD> __device__ __forceinline__ void run(const f32x4 (&acc)[2][2][4][2], const Unit& u, int wr, int wc, int fr, int fq, const PG8_GAS u32x2* sl) const {
        const int rt0 = u.pm * BM + wr * 64 + fr, col0 = u.pn * BM + wc * 32 + 8 * fq;
        float gtv[2][4];
#pragma unroll
        for (int ai = 0; ai < 2; ++ai)
#pragma unroll
            for (int m = 0; m < 4; ++m) gtv[ai][m] = rowgate[rt0 + ai * HALF + m * 16] * descale;
#pragma unroll
        for (int ai = 0; ai < 2; ++ai) {
#pragma unroll
            for (int m = 0; m < 4; ++m) { const float gt = gtv[ai][m]; unsigned char* p = Y + (size_t)(rt0 + ai * HALF + m * 16) * 1024 + col0;
#pragma unroll
                for (int bj = 0; bj < 2; ++bj) { f32x4 s0 = acc[ai][bj][m][0], s1 = acc[ai][bj][m][1];
                    if (ADD) { const u32x2 q0 = sl[bj * 2 + 0], q1 = sl[bj * 2 + 1];
                        s0[0] += __uint_as_float(q0.x << 16); s0[1] += __uint_as_float(q0.x & 0xffff0000u); s0[2] += __uint_as_float(q0.y << 16); s0[3] += __uint_as_float(q0.y & 0xffff0000u);
                        s1[0] += __uint_as_float(q1.x << 16); s1[1] += __uint_as_float(q1.x & 0xffff0000u); s1[2] += __uint_as_float(q1.y << 16); s1[3] += __uint_as_float(q1.y & 0xffff0000u); }
                    s0 = s0 * gt; s1 = s1 * gt;
                    u32x2 w; w.x = pk_i8x4(s0[0], s0[1], s0[2], s0[3]); w.y = pk_i8x4(s1[0], s1[1], s1[2], s1[3]);
                    *(u32x2*)(p + bj * HALF) = w; }
                if (ADD) { sl += 512 * 4; asm volatile("" : "+v"(sl)); } }
            asm volatile("" ::: "memory"); }
    }
    __device__ __forceinline__ void operator()(const f32x4 (&acc)[2][2][4][2], const Unit& u, int wr, int wc, int fr, int fq) const { run<false>(acc, u, wr, wc, fr, fq, nullptr); }
};

template <class Epi, class Sched, bool GATHER, int PREC = 0>
__device__ __forceinline__ void gemm_phase(PG8_LAS unsigned char* lds, const Gemm g, const Sched& S, const Epi& E, const int tid) {
    constexpr bool FP8 = (PREC == 1), I8 = (PREC == 2), BYTE1 = (PREC != 0);
    const int wid = __builtin_amdgcn_readfirstlane(tid >> 6), lane = tid & 63, wr = wid >> 2, wc = wid & 3, fr = lane & 15, fq = lane >> 4;
    const int K = g.K;
    const int rowb = BYTE1 ? K : 2 * K;
    unsigned voffB[2]; unsigned vC0[2], vC1[2], vN0[2], vN1[2]; int Rr[2], Cc[2];
#pragma unroll
    for (int i = 0; i < 2; ++i) { int R, C; stage_rc(tid * 16 + i * 8192, R, C); const int Rb = Epi::PERM ? ((R & ~31) + perm32(R & 31)) : R;
        Rr[i] = R; Cc[i] = C; vC0[i] = (unsigned)(R * rowb + C * 2); vC1[i] = vC0[i]; vN0[i] = vC0[i]; vN1[i] = vC0[i]; voffB[i] = (unsigned)(Rb * rowb + C * 2); }
    const size_t kstep = (size_t)(BK * 2);
    const size_t hstep = (size_t)HALF * rowb;
    const size_t hstepA = GATHER ? 0 : hstep;
    const size_t tstep = 2 * hstep;
    const unsigned ldsw = (unsigned)wid * 1024u;
    const int aoff = lds_byte(wr * 64 + fr, fq * 8), boff = lds_byte(wc * 32 + fr, fq * 8);
    const int aoff1 = aoff ^ 64, boff1 = boff ^ 64;
#define PG8_SA(b, h) (((b) * 2 + (h)) * HTB)
#define PG8_SB(b, h) ((4 + (b) * 2 + (h)) * HTB)
#define PG8_STAGE(bufoff, gbase, v0, v1) do { \
        __builtin_amdgcn_global_load_lds((const unsigned*)((const char*)(gbase) + (v0)), (PG8_LAS unsigned*)(lds + (bufoff) + ldsw), 16, 0, 0); \
        __builtin_amdgcn_global_load_lds((const unsigned*)((const char*)(gbase) + (v1)), (PG8_LAS unsigned*)(lds + (bufoff) + ldsw + 8192), 16, 0, 0); } while (0)
#define PG8_LD8(addr, addr1) __builtin_shufflevector(*(const PG8_LAS v4i_t*)(addr), *(const PG8_LAS v4i_t*)(addr1), 0, 1, 2, 3, 4, 5, 6, 7)
#define PG8_LDA(dst, b, h) do { if (FP8) { _Pragma("unroll") for (int m = 0; m < 4; ++m) dst##8[m] = PG8_LD8(lds + PG8_SA(b, h) + aoff + m * 2048, lds + PG8_SA(b, h) + aoff1 + m * 2048); } else { \
        _Pragma("unroll") for (int m = 0; m < 4; ++m) _Pragma("unroll") for (int k = 0; k < 2; ++k) dst[m][k] = *(const PG8_LAS bf16x8*)(lds + PG8_SA(b, h) + (k ? aoff1 : aoff) + m * 2048); } } while (0)
#define PG8_LDB(dst, b, h) do { if (FP8) { _Pragma("unroll") for (int n = 0; n < 2; ++n) dst##8[n] = PG8_LD8(lds + PG8_SB(b, h) + boff + n * 2048, lds + PG8_SB(b, h) + boff1 + n * 2048); } else { \
        _Pragma("unroll") for (int n = 0; n < 2; ++n) _Pragma("unroll") for (int k = 0; k < 2; ++k) dst[n][k] = *(const PG8_LAS bf16x8*)(lds + PG8_SB(b, h) + (k ? boff1 : boff) + n * 2048); } } while (0)
#if defined(PROBE_HALF_MFMA)
#define PG8_SKIP(ai) ((ai) == 1 && cur.part == 3)
#else
#define PG8_SKIP(ai) false
#endif
#define PG8_MMA(ai, bj, At, Bt) do { if (PG8_SKIP(ai)) break; __builtin_amdgcn_s_setprio(1); _Pragma("unroll") for (int m = 0; m < 4; ++m) _Pragma("unroll") for (int n = 0; n < 2; ++n) { \
        if (FP8) asm volatile("v_mfma_scale_f32_16x16x128_f8f6f4 %0, %1, %2, %0, %3, %3 op_sel_hi:[0,0,0]" : "+v"(acc[ai][bj][m][n]) : "v"(Bt##8[n]), "v"(At##8[m]), "v"(sc1)); \
        else if (I8) { _Pragma("unroll") for (int k = 0; k < 2; ++k) acc[ai][bj][m][n] = __builtin_bit_cast(f32x4, __builtin_amdgcn_mfma_i32_16x16x64_i8(__builtin_bit_cast(v4i_t, Bt[n][k]), __builtin_bit_cast(v4i_t, At[m][k]), __builtin_bit_cast(v4i_t, acc[ai][bj][m][n]), 0, 0, 0)); } \
        else { _Pragma("unroll") for (int k = 0; k < 2; ++k) acc[ai][bj][m][n] = __builtin_amdgcn_mfma_f32_16x16x32_bf16(Bt[n][k], At[m][k], acc[ai][bj][m][n], 0, 0, 0); } } __builtin_amdgcn_s_setprio(0); } while (0)
#define PG8_WAIT_V(n) asm volatile("s_waitcnt vmcnt(" #n ")" ::: "memory")
#define PG8_WAIT_L(n) asm volatile("s_waitcnt lgkmcnt(" #n ")" ::: "memory")
#define PG8_BAR __builtin_amdgcn_s_barrier()
#define PG8_SCHED __builtin_amdgcn_sched_barrier(0)
#define PG8_TOKOFF(pm_, h_, i_) ({ int t_ = g.rowtok[(pm_) * BM + (h_) * HALF + Rr[i_]]; t_ = t_ < 0 ? 0 : t_; (unsigned)(t_ * rowb + Cc[i_] * 2); })
    unsigned sc1 = 0u; if (FP8) asm volatile("v_mov_b32 %0, 0x7f7f7f7f" : "=v"(sc1));
    Unit cur, nxt; int ui = 0;
    if (!S.next(0, cur)) return;
    f32x4 acc[2][2][4][2];
#pragma unroll
    for (int a = 0; a < 2; ++a)
#pragma unroll
        for (int b = 0; b < 2; ++b)
#pragma unroll
            for (int m = 0; m < 4; ++m)
#pragma unroll
                for (int n = 0; n < 2; ++n) acc[a][b][m][n] = (f32x4){0.f, 0.f, 0.f, 0.f};
    bf16x8 At[4][2], B0[2][2], B1[2][2]; v8i_t At8[4], B08[2], B18[2];
    if (GATHER) {
#pragma unroll
        for (int i = 0; i < 2; ++i) { vC0[i] = PG8_TOKOFF(cur.pm, 0, i); vC1[i] = PG8_TOKOFF(cur.pm, 1, i); }
    }
    const char* cA = (GATHER ? (const char*)g.A : (const char*)g.A + (size_t)cur.pm * tstep) + (size_t)cur.kt0 * kstep;
    const char* cB = (const char*)g.Bt + (size_t)cur.be * g.bstride + (size_t)cur.pn * tstep + (size_t)cur.kt0 * kstep;
    PG8_STAGE(PG8_SB(0, 0), cB, voffB[0], voffB[1]); PG8_STAGE(PG8_SB(0, 1), cB + hstep, voffB[0], voffB[1]); PG8_STAGE(PG8_SA(0, 0), cA, vC0[0], vC0[1]); PG8_STAGE(PG8_SA(0, 1), cA + hstepA, vC1[0], vC1[1]);
    if (wr == 1) PG8_BAR;
    PG8_WAIT_V(2); PG8_BAR;
    PG8_STAGE(PG8_SB(1, 0), cB + kstep, voffB[0], voffB[1]); PG8_STAGE(PG8_SA(1, 0), cA + kstep, vC0[0], vC0[1]); PG8_STAGE(PG8_SB(1, 1), cB + hstep + kstep, voffB[0], voffB[1]);
    PG8_WAIT_V(6); PG8_BAR;
    for (;;) {
        const bool has_next = S.next(ui + 1, nxt);
        const char* nA = has_next ? (GATHER ? (const char*)g.A : (const char*)g.A + (size_t)nxt.pm * tstep) + (size_t)nxt.kt0 * kstep : cA;
        const char* nB = has_next ? (const char*)g.Bt + (size_t)nxt.be * g.bstride + (size_t)nxt.pn * tstep + (size_t)nxt.kt0 * kstep : cB;
        if (GATHER) {
            if (has_next && nxt.pm != cur.pm) {
#pragma unroll
                for (int i = 0; i < 2; ++i) { vN0[i] = PG8_TOKOFF(nxt.pm, 0, i); vN1[i] = PG8_TOKOFF(nxt.pm, 1, i); }
            } else {
#pragma unroll
                for (int i = 0; i < 2; ++i) { vN0[i] = vC0[i]; vN1[i] = vC1[i]; }
            }
        }
        const int nkt = cur.nkt;
        for (int t = 0; t < nkt; t += 2) {
            const bool last = (t == nkt - 2);
            const char* a1 = cA + (size_t)(t + 1) * kstep;
            const char* a2 = last ? nA : cA + (size_t)(t + 2) * kstep; const char* b2 = last ? nB : cB + (size_t)(t + 2) * kstep;
            const char* a3 = a2 + kstep; const char* b3 = b2 + kstep;
            const unsigned x00 = (GATHER && last) ? vN0[0] : vC0[0], x01 = (GATHER && last) ? vN0[1] : vC0[1], x10 = (GATHER && last) ? vN1[0] : vC1[0], x11 = (GATHER && last) ? vN1[1] : vC1[1];
            PG8_LDB(B0, 0, 0); PG8_LDB(B1, 0, 1); PG8_SCHED; PG8_LDA(At, 0, 0); PG8_STAGE(PG8_SA(1, 1), a1 + hstepA, vC1[0], vC1[1]);
            PG8_WAIT_V(8); PG8_WAIT_L(0); PG8_BAR; PG8_MMA(0, 0, At, B0); PG8_MMA(0, 1, At, B1); PG8_BAR; PG8_SCHED;
            PG8_LDA(At, 0, 1); PG8_STAGE(PG8_SB(0, 0), b2, voffB[0], voffB[1]); PG8_STAGE(PG8_SB(0, 1), b2 + hstep, voffB[0], voffB[1]); PG8_STAGE(PG8_SA(0, 0), a2, x00, x01);
            PG8_WAIT_V(8); PG8_WAIT_L(0); PG8_BAR; PG8_MMA(1, 0, At, B0); PG8_MMA(1, 1, At, B1); PG8_BAR; PG8_SCHED;
            PG8_LDB(B0, 1, 0); PG8_LDB(B1, 1, 1); PG8_SCHED; PG8_LDA(At, 1, 0); PG8_STAGE(PG8_SA(0, 1), a2 + hstepA, x10, x11);
            PG8_WAIT_V(8); PG8_WAIT_L(0); PG8_BAR; PG8_MMA(0, 0, At, B0); PG8_MMA(0, 1, At, B1); PG8_BAR; PG8_SCHED;
            PG8_LDA(At, 1, 1); PG8_STAGE(PG8_SB(1, 0), b3, voffB[0], voffB[1]); PG8_STAGE(PG8_SB(1, 1), b3 + hstep, voffB[0], voffB[1]); PG8_STAGE(PG8_SA(1, 0), a3, x00, x01);
            PG8_WAIT_V(8); PG8_WAIT_L(0); PG8_BAR; PG8_MMA(1, 0, At, B0); PG8_MMA(1, 1, At, B1); PG8_BAR; PG8_SCHED;
        }
        if (wr == 0) PG8_BAR;
        if (FP8) { asm volatile("s_nop 15\n\ts_nop 15" ::: "memory");
#pragma unroll
            for (int a = 0; a < 2; ++a)
#pragma unroll
                for (int b = 0; b < 2; ++b)
#pragma unroll
                    for (int m = 0; m < 4; ++m)
#pragma unroll
                        for (int n = 0; n < 2; ++n) asm volatile("" : "+v"(acc[a][b][m][n])); }
        if (I8) {
#pragma unroll
            for (int a = 0; a < 2; ++a)
#pragma unroll
                for (int b = 0; b < 2; ++b)
#pragma unroll
                    for (int m = 0; m < 4; ++m)
#pragma unroll
                        for (int n = 0; n < 2; ++n) { const v4i_t q = __builtin_bit_cast(v4i_t, acc[a][b][m][n]); acc[a][b][m][n] = (f32x4){(float)q[0], (float)q[1], (float)q[2], (float)q[3]}; } }
        if (g.noepi) {} else
        if constexpr (Sched::STREAMK) {
            if (cur.part == 1) {
                PG8_GAS u32x2* sl = (PG8_GAS u32x2*)g.slab + (size_t)S.wg() * (32 * 512) + tid * 4;
#pragma unroll
                for (int a = 0; a < 2; ++a)
#pragma unroll
                    for (int m = 0; m < 4; ++m) {
#pragma unroll
                        for (int b = 0; b < 2; ++b)
#pragma unroll
                            for (int n = 0; n < 2; ++n) { u32x2 w; w.x = cvt_pk_bf16(acc[a][b][m][n][0], acc[a][b][m][n][1]); w.y = cvt_pk_bf16(acc[a][b][m][n][2], acc[a][b][m][n][3]); sl[b * 2 + n] = w; }
                        sl += 512 * 4; asm volatile("" : "+v"(sl)); }
                asm volatile("s_waitcnt vmcnt(0)" ::: "memory");
                __syncthreads();
                if (tid == 0) { __builtin_amdgcn_fence(__ATOMIC_RELEASE, "agent"); asm volatile("s_waitcnt vmcnt(0)" ::: "memory");
                    __hip_atomic_store(g.skflag + 16 * S.wg(), 1u, __ATOMIC_RELAXED, __HIP_MEMORY_SCOPE_AGENT); }
            } else if (cur.part == 2) {
                if (wid == 0) { unsigned sp = 0;
                    while (__hip_atomic_load(g.skflag + 16 * (S.wg() + 1), __ATOMIC_RELAXED, __HIP_MEMORY_SCOPE_AGENT) == 0u) { __builtin_amdgcn_s_sleep(2);
                        if (++sp > (1u << 22)) { if (lane == 0) __hip_atomic_store(g.tmo, 1u, __ATOMIC_RELAXED, __HIP_MEMORY_SCOPE_AGENT); break; } }
                    __builtin_amdgcn_fence(__ATOMIC_ACQUIRE, "agent"); }
                asm volatile("s_waitcnt vmcnt(0)" ::: "memory");
                __syncthreads();
                E.template run<true>(acc, cur, wr, wc, fr, fq, (const PG8_GAS u32x2*)g.slab + (size_t)(S.wg() + 1) * (32 * 512) + tid * 4);
            } else { if (cur.part != 3) E(acc, cur, wr, wc, fr, fq); }
        } else { if (cur.part != 3) E(acc, cur, wr, wc, fr, fq); }
        if (!has_next) break;
#pragma unroll
        for (int a = 0; a < 2; ++a)
#pragma unroll
            for (int b = 0; b < 2; ++b)
#pragma unroll
                for (int m = 0; m < 4; ++m)
#pragma unroll
                    for (int n = 0; n < 2; ++n) acc[a][b][m][n] = (f32x4){0.f, 0.f, 0.f, 0.f};
        cur = nxt; cA = nA; cB = nB; ++ui;
        if (GATHER) {
#pragma unroll
            for (int i = 0; i < 2; ++i) { vC0[i] = vN0[i]; vC1[i] = vN1[i]; }
        }
        if (wr == 1) PG8_BAR;
    }
    PG8_WAIT_V(0);
    PG8_BAR;
#undef PG8_SA
#undef PG8_SB
#undef PG8_STAGE
#undef PG8_LDA
#undef PG8_LDB
#undef PG8_MMA
#undef PG8_LD8
#undef PG8_WAIT_V
#undef PG8_WAIT_L
#undef PG8_BAR
#undef PG8_SCHED
#undef PG8_TOKOFF
}
}
#define GAS __attribute__((address_space(1)))
#define LAS __attribute__((address_space(3)))
typedef unsigned short bf16;
typedef unsigned v4u __attribute__((ext_vector_type(4)));
typedef float f32x4 __attribute__((ext_vector_type(4)));
typedef short bf16x8 __attribute__((ext_vector_type(8)));
typedef GAS unsigned gu32;
typedef GAS unsigned long long gu64;
#define RLX_AGENT __ATOMIC_RELAXED, __HIP_MEMORY_SCOPE_AGENT
#define LDS_WAIT() asm volatile("s_waitcnt lgkmcnt(0)" ::: "memory")
#define VM_WAIT() asm volatile("s_waitcnt vmcnt(0)" ::: "memory")
__device__ __forceinline__ unsigned long long rt() { return __builtin_amdgcn_s_memrealtime(); }
__device__ __forceinline__ unsigned f2bf(float f) { unsigned u = __builtin_bit_cast(unsigned, f); return (u + 0x7fffu + ((u >> 16) & 1u)) >> 16; }
__device__ __forceinline__ unsigned pk2(float lo, float hi) { return f2bf(lo) | (f2bf(hi) << 16); }

#define XB_TMO      128
#define XB_XCNT(j)  (256  + 64 * (j))
#define XB_XSUB(j)  (1280 + 64 * (j))
#define XB_XGEN(j)  (2304 + 64 * (j))
#define XB_TOP      3328
#define XB_TOPGEN   3392
#define XCD_BAR_WORDS 3456
#define XB_SPIN_CAP (1u << 18)

__device__ __forceinline__ unsigned xb_ld(unsigned* p)              { return __hip_atomic_load(p, __ATOMIC_RELAXED, __HIP_MEMORY_SCOPE_AGENT); }
__device__ __forceinline__ unsigned xb_add(unsigned* p, unsigned v) { return __hip_atomic_fetch_add(p, v, __ATOMIC_RELAXED, __HIP_MEMORY_SCOPE_AGENT); }
__device__ __forceinline__ unsigned xb_xcc_id() { return (unsigned)__builtin_amdgcn_s_getreg((3 << 11) | 20) & 0xFu; }
#define XB_SPIN(cond, bar) do { unsigned _sp = 0; while (cond) { __builtin_amdgcn_s_sleep(1); \
    if ((++_sp & 255u) == 0u) { if (xb_ld(&(bar)[XB_TMO])) break; if (_sp > XB_SPIN_CAP) { atomicAdd(&(bar)[XB_TMO], 1u); break; } } } } while (0)

struct XcdBarrier {
    unsigned* bar; unsigned x;
    volatile LAS unsigned* st;
};

__device__ __forceinline__ XcdBarrier xcd_barrier_post(unsigned* bar, volatile LAS unsigned* st) {
    XcdBarrier b; b.bar = bar; b.x = xb_xcc_id(); b.st = st;
    if (threadIdx.x == 0) (void)xb_add(&bar[XB_XCNT(b.x)], 1u);
    return b;
}
__device__ __forceinline__ void xcd_barrier_complete(unsigned* bar, unsigned x, unsigned& nloc, unsigned& nx) {
    const unsigned G = gridDim.x * gridDim.y * gridDim.z;
    unsigned sum, cnt, mine, sp = 0u;
    for (;;) {
        sum = 0u; cnt = 0u; mine = 0u;
#pragma unroll
        for (unsigned j = 0; j < 16; ++j) { const unsigned c = xb_ld(&bar[XB_XCNT(j)]); sum += c; cnt += (c > 0u) ? 1u : 0u; mine = (j == x) ? c : mine; }
        if (sum == G) break;
        __builtin_amdgcn_s_sleep(1);
        if ((++sp & 255u) == 0u) { if (xb_ld(&bar[XB_TMO])) break; if (sp > XB_SPIN_CAP) { atomicAdd(&bar[XB_TMO], 1u); break; } }
    }
    nloc = mine > 0u ? mine : 1u; nx = cnt > 0u ? cnt : 1u;
}

__device__ __forceinline__ void xcd_barrier(const XcdBarrier& b) {
    asm volatile("s_waitcnt vmcnt(0)" ::: "memory");
    __syncthreads();
    if (threadIdx.x == 0) {
        unsigned* bar = b.bar;
        __builtin_amdgcn_s_waitcnt(0);
        unsigned nloc = b.st[0], nx = b.st[1];
        if (nloc == 0u) { xcd_barrier_complete(bar, b.x, nloc, nx); b.st[0] = nloc; b.st[1] = nx; }
        const unsigned old = xb_add(&bar[XB_XSUB(b.x)], 1u);
        const unsigned gen = old / nloc;
        if (old + 1u == (gen + 1u) * nloc) {
            __builtin_amdgcn_fence(__ATOMIC_RELEASE, "agent");
            asm volatile("s_waitcnt vmcnt(0)" ::: "memory");
            const unsigned og = xb_add(&bar[XB_TOP], 1u);
            const unsigned tg = og / nx;
            if (og + 1u == (tg + 1u) * nx) xb_add(&bar[XB_TOPGEN], 1u);
            else XB_SPIN(xb_ld(&bar[XB_TOPGEN]) == tg, bar);
            __builtin_amdgcn_fence(__ATOMIC_ACQUIRE, "agent");
            xb_add(&bar[XB_XGEN(b.x)], 1u);
            asm volatile("s_waitcnt vmcnt(0)" ::: "memory");
        } else {
            XB_SPIN(xb_ld(&bar[XB_XGEN(b.x)]) == gen, bar);
            __builtin_amdgcn_fence(__ATOMIC_ACQUIRE, "agent");
            asm volatile("s_waitcnt vmcnt(0)" ::: "memory");
        }
    }
    __syncthreads();
}

constexpr int NWAVES = 8;
constexpr int T = 32768, D = 1024, SEQ = 4096, NBATCH = 8;
constexpr int DFF = 2752, DFFP = 2816, DFFE = 3584, NEXP = 8;
constexpr int ROWCAP = 67584;
constexpr float EPS = 1e-6f;
constexpr float LOG2E = 1.4426950408889634f;
constexpr float SOFTMAX_OFS = 16.f;
constexpr float QSCALE = 0.125f * LOG2E;
#ifndef I8_P1
#define I8_P1 1
#endif
#ifndef I8_P3
#define I8_P3 0
#endif
#ifndef I8_P4
#define I8_P4 1
#endif
constexpr float SA_N = 127.f / 5.f, SA_X = 127.f / 6.f, SW_I8 = 127.f * 32.f / 4.5f;
constexpr float Y_SCALE = 127.f / 2.5f;
constexpr float W8_SCALE = 64.f, H3_SCALE = 16.f, HM_SCALE = 8.f, X8_SCALE = 16.f, HB_SCALE = 8.f, O8_SCALE = 64.f;
constexpr size_t MiB = 1u << 20;
constexpr size_t WS_CTL = 0, CTL_ZERO_BYTES = 1 * MiB;
constexpr size_t WS_PART1 = 1 * MiB, WS_PART2 = 3 * MiB, WS_LSE = 5 * MiB;
constexpr size_t WS_ROUTE = 7 * MiB, WS_GATE1 = WS_ROUTE + 128 * 1024, WS_GATE2 = WS_ROUTE + 256 * 1024, WS_WAVECNT = WS_ROUTE + 384 * 1024, WS_BLOCKCNT = WS_ROUTE + 448 * 1024, WS_GOFS = WS_ROUTE + 480 * 1024;
constexpr size_t WS_ROWTOK = 8 * MiB, WS_ROWGATE = 8 * MiB + 512 * 1024;
constexpr size_t WS_WIN = 12 * MiB, WS_WOUT = 16 * MiB, WS_WF13 = 18 * MiB, WS_WFD = 29 * MiB, WS_WQKV = 35 * MiB, WS_WO = 53 * MiB;
constexpr size_t WS_WM13 = 56 * MiB, WS_WM2 = 112 * MiB;
constexpr size_t WS_XH = 144 * MiB;
constexpr size_t WS_A0 = 224 * MiB;
constexpr size_t WS_H0 = WS_A0, WS_GLU = WS_A0 + 64 * MiB, WS_V = WS_A0 + 128 * MiB;
constexpr size_t WS_X1B = WS_A0, WS_HB = WS_A0 + 64 * MiB;
constexpr size_t WS_X2B = WS_A0, WS_KG = WS_A0 + 64 * MiB, WS_VG = WS_A0 + 128 * MiB, WS_QG = WS_A0 + 192 * MiB, WS_O = WS_A0 + 256 * MiB, WS_O8 = WS_A0 + 32 * MiB;
constexpr size_t WS_H3 = WS_A0, WS_HM = WS_A0 + 66 * MiB;
constexpr size_t WS_END = 548 * MiB;
static_assert(WS_HB + (size_t)T * DFFP * 2 <= WS_END && WS_O + (size_t)T * D * 2 <= WS_END && WS_HM + (size_t)ROWCAP * DFFE <= WS_END, "arena");
static_assert(WS_WFD + (size_t)D * DFFP * 2 <= WS_WQKV && WS_WO + (size_t)D * D * 2 <= WS_WM13 && WS_WM13 + (size_t)NEXP * 7168 * 1024 <= WS_WM2 && WS_WM2 + (size_t)NEXP * D * DFFE <= WS_XH && WS_XH + (size_t)T * D * 2 <= WS_A0, "weights");
constexpr int CW_AQ = 50000;
constexpr int CW_TMO = 0, CW_CODE = 1, CW_BAR = 4096, CW_SKFLAG = 16384;
constexpr size_t WS_SLAB = 12 * MiB;
constexpr size_t WS_POS = 9 * MiB;
constexpr size_t WS_Y = WS_A0;
static_assert(WS_SLAB + (size_t)256 * 131072 <= 56 * MiB && WS_Y + (size_t)ROWCAP * 1024 <= WS_HM, "slab / Y");

constexpr int RING_OFF = 0, RING_BYTES = 131072;
constexpr int LDSCTL_OFF = RING_BYTES, MISC_OFF = LDSCTL_OFF + 320;
constexpr int XTRA_OFF = RING_BYTES + 512;
constexpr int LDS_BYTES = 163840;

constexpr int NPHASE = 18;

__constant__ unsigned char T5_BUCKET[3][132] = {
 {0,1,2,3,4,5,6,7,8,9,10,11,12,13,14,15,16,16,16,16,16,16,17,17,17,17,17,17,17,17,18,18,18,18,18,18,18,18,18,18,19,19,19,19,19,19,19,19,19,19,19,19,19,19,20,20,20,20,20,20,20,20,20,20,20,20,20,20,20,20,20,20,20,21,21,21,21,21,21,21,21,21,21,21,21,21,21,21,21,21,21,21,21,21,21,21,21,21,21,22,22,22,22,22,22,22,22,22,22,22,22,22,22,22,22,22,22,22,22,22,22,22,22,22,22,22,22,22,22,0,0,0},
 {0,4,8,12,16,16,17,17,18,18,19,19,19,19,20,20,20,20,20,21,21,21,21,21,21,22,22,22,22,22,22,22,22,22,23,23,23,23,23,23,23,23,23,23,23,23,24,24,24,24,24,24,24,24,24,24,24,24,24,24,24,24,25,25,25,25,25,25,25,25,25,25,25,25,25,25,25,25,25,25,25,25,25,26,26,26,26,26,26,26,26,26,26,26,26,26,26,26,26,26,26,26,26,26,26,26,26,26,26,26,26,26,26,27,27,27,27,27,27,27,27,27,27,27,27,27,27,27,27,0,0,0},
 {0,16,18,19,20,21,21,22,22,23,23,23,24,24,24,24,25,25,25,25,25,26,26,26,26,26,26,26,26,27,27,27,27,27,27,27,27,27,27,28,28,28,28,28,28,28,28,28,28,28,28,28,29,29,29,29,29,29,29,29,29,29,29,29,29,29,29,29,29,29,30,30,30,30,30,30,30,30,30,30,30,30,30,30,30,30,30,30,30,30,30,30,30,30,30,31,31,31,31,31,31,31,31,31,31,31,31,31,31,31,31,31,31,31,31,31,31,31,31,31,31,31,31,31,31,31,31,31,31,0,0,0}};

typedef float f32x16 __attribute__((ext_vector_type(16)));
typedef float f32x2v __attribute__((ext_vector_type(2)));
typedef __bf16 bf16x2v __attribute__((ext_vector_type(2)));
typedef short v4i16_t __attribute__((ext_vector_type(4)));
__device__ __forceinline__ unsigned pkbf(float lo, float hi) { f32x2v v = {lo, hi}; bf16x2v b = __builtin_convertvector(v, bf16x2v); return __builtin_bit_cast(unsigned, b); }
__device__ __forceinline__ float bflo(unsigned u) { return __uint_as_float(u << 16); }
__device__ __forceinline__ float bfhi(unsigned u) { return __uint_as_float(u & 0xffff0000u); }
template <int N> __device__ __forceinline__ float dpp_row_ror(float v) { return __builtin_bit_cast(float, __builtin_amdgcn_update_dpp(0, __builtin_bit_cast(int, v), 0x120 + N, 0xf, 0xf, true)); }
__device__ __forceinline__ float wave_sum(float v) {
    v += dpp_row_ror<8>(v); v += dpp_row_ror<4>(v); v += dpp_row_ror<2>(v); v += dpp_row_ror<1>(v);
    const int b = __builtin_bit_cast(int, v);
    return (__builtin_bit_cast(float, __builtin_amdgcn_readlane(b, 0)) + __builtin_bit_cast(float, __builtin_amdgcn_readlane(b, 16))) + (__builtin_bit_cast(float, __builtin_amdgcn_readlane(b, 32)) + __builtin_bit_cast(float, __builtin_amdgcn_readlane(b, 48)));
}
__device__ __forceinline__ int crow(int r, int hi) { return (r & 3) + 8 * (r >> 2) + 4 * hi; }

struct TrDesc { const float* W; const float* gsc; unsigned char* WT; int ldw, Kp, drow0, k0, n0src, is8; float scale; };
__device__ __forceinline__ int hmap_row0(int L) { const int lc = L & 255; return (L & ~255) + 128 * ((lc >> 5) & 1) + 32 * (lc >> 6); }

constexpr int IT_MG = NEXP * 16 * 112, IT_MU = IT_MG, IT_MD = NEXP * 56 * 32, IT_WIN = 16 * 64, IT_WOUT = 16 * 32, IT_FG = 16 * 86, IT_FU = IT_FG, IT_FD = 43 * 32, IT_KV = 16 * 192, IT_Q = 16 * 96, IT_WO = 16 * 32;
constexpr int IT_MOE = IT_MG + IT_MU + IT_MD;
static_assert(IT_MOE == 3 * 256 * 56, "expert-weight items per attention phase and workgroup");
constexpr int CONV_RT = 16;
constexpr int IT_TOTAL = IT_MG + IT_MU + IT_MD + IT_WIN + IT_WOUT + IT_FG + IT_FU + IT_FD + IT_KV + IT_Q + IT_WO;
typedef const __attribute__((address_space(4))) unsigned char* kargp0_t;
#define P0IN(i) (*(const float* const __attribute__((address_space(4)))*)(kp + 8 * (i)))
template <bool MOE = false>
__device__ __forceinline__ void tr_desc(int it, kargp0_t kp, unsigned char* ws, TrDesc& d) {
    int r = it; d.gsc = nullptr; d.is8 = 2; d.scale = SW_I8; d.Kp = 1024;
    if (r < IT_MG) { const int e = r / 1792, rr = r % 1792, j = (rr % 112) * 32; d.W = P0IN(23) + (size_t)e * D * DFFE; d.ldw = DFFE; d.WT = ws + WS_WM13 + (size_t)e * 7168 * 1024; d.drow0 = 256 * (j >> 7) + (j & 127); d.k0 = (rr / 112) * 64; d.n0src = j; return; } r -= IT_MG;
    if (r < IT_MU) { const int e = r / 1792, rr = r % 1792, j = (rr % 112) * 32; d.W = P0IN(24) + (size_t)e * D * DFFE; d.ldw = DFFE; d.WT = ws + WS_WM13 + (size_t)e * 7168 * 1024; d.drow0 = 256 * (j >> 7) + 128 + (j & 127); d.k0 = (rr / 112) * 64; d.n0src = j; return; } r -= IT_MU;
    if (MOE || r < IT_MD) { const int e = r / 1792, rr = r % 1792, j = (rr % 32) * 32; d.W = P0IN(25) + (size_t)e * DFFE * D; d.ldw = D; d.WT = ws + WS_WM2 + (size_t)e * 1024 * DFFE; d.Kp = DFFE; d.is8 = 1; d.scale = W8_SCALE; d.drow0 = j; d.k0 = (rr / 32) * 64; d.n0src = j; return; } r -= IT_MD;
    if (r < IT_KV) { const int c = (r % 192) * 32, kvsel = c / 3072, cg = c % 3072, g = cg >> 10, hc = cg & 1023, L = kvsel * 1024 + hc; d.W = P0IN(12); d.ldw = 6144; d.gsc = P0IN(11); d.WT = ws + WS_WQKV + (size_t)g * 3072 * 1024; d.drow0 = hmap_row0(L); d.k0 = (r / 192) * 64; d.n0src = c; return; } r -= IT_KV;
    if (r < IT_Q) { const int c = (r % 96) * 32, g = c >> 10, hc = c & 1023, L = 2048 + hc; d.W = P0IN(15); d.ldw = 3072; d.gsc = P0IN(14); d.WT = ws + WS_WQKV + (size_t)g * 3072 * 1024; d.drow0 = hmap_row0(L); d.k0 = (r / 96) * 64; d.n0src = c; return; } r -= IT_Q;
    if (r < IT_WIN) { const int c = (r % 64) * 32, sel = c >> 10, j = c & 1023; d.W = P0IN(3); d.ldw = 2048; d.WT = ws + WS_WIN; if (!I8_P1) { d.is8 = 0; d.scale = 1.f; } d.drow0 = 256 * (j >> 7) + 128 * sel + (j & 127); d.k0 = (r / 64) * 64; d.n0src = c; return; } r -= IT_WIN;
    if (r < IT_WOUT) { const int j = (r % 32) * 32; d.W = P0IN(9); d.ldw = 1024; d.WT = ws + WS_WOUT; if (!I8_P3) { d.is8 = 0; d.scale = 1.f; } d.drow0 = j; d.k0 = (r / 32) * 64; d.n0src = j; return; } r -= IT_WOUT;
    if (r < IT_FG) { const int j = (r % 86) * 32; d.W = P0IN(19); d.ldw = DFF; d.gsc = P0IN(18); d.WT = ws + WS_WF13; if (!I8_P4) { d.is8 = 0; d.scale = 1.f; } d.drow0 = 256 * (j >> 7) + (j & 127); d.k0 = (r / 86) * 64; d.n0src = j; return; } r -= IT_FG;
    if (r < IT_FU) { const int j = (r % 86) * 32; d.W = P0IN(20); d.ldw = DFF; d.gsc = P0IN(18); d.WT = ws + WS_WF13; if (!I8_P4) { d.is8 = 0; d.scale = 1.f; } d.drow0 = 256 * (j >> 7) + 128 + (j & 127); d.k0 = (r / 86) * 64; d.n0src = j; return; } r -= IT_FU;
    if (r < IT_FD) { const int j = (r % 32) * 32; d.W = P0IN(21); d.ldw = 1024; d.WT = ws + WS_WFD; d.Kp = DFFP; d.is8 = 0; d.scale = 1.f; d.drow0 = j; d.k0 = (r / 32) * 64; d.n0src = j; return; } r -= IT_FD;
    { const int j = (r % 32) * 32; d.W = P0IN(17); d.ldw = 1024; d.WT = ws + WS_WO; d.drow0 = j; d.k0 = (r / 32) * 64; d.n0src = j; d.is8 = 1; d.scale = W8_SCALE; }
}
__device__ __forceinline__ void tr_load(const TrDesc& d, f32x4 (&v)[8], f32x4 (&gv)[2], int lane) {
#pragma unroll
    for (int i = 0; i < 8; ++i) v[i] = __builtin_nontemporal_load((const f32x4*)(d.W + (size_t)(d.k0 + 8 * i + (lane >> 3)) * d.ldw + d.n0src + 4 * (lane & 7)));
    const float* gp = d.gsc ? d.gsc + d.k0 + 8 * (lane & 7) : d.W + (size_t)d.k0 * d.ldw + d.n0src;
    gv[0] = *(const f32x4*)gp; gv[1] = *(const f32x4*)(gp + 4);
}
template <bool NT = false>
__device__ __forceinline__ void tr_store(const TrDesc& d, const f32x4 (&v)[8], const f32x4 (&gv)[2], LAS float* scr, int lane) {
#pragma unroll
    for (int i = 0; i < 8; ++i) { LAS float* w = scr + (8 * i + (lane >> 3)) * 33 + 4 * (lane & 7); w[0] = v[i].x; w[1] = v[i].y; w[2] = v[i].z; w[3] = v[i].w; }
    LDS_WAIT(); asm volatile("" ::: "memory");
    const int c = lane & 7; const float sc = d.scale;
    const f32x4 one4 = {1.f, 1.f, 1.f, 1.f}; const f32x4 gv0 = d.gsc ? gv[0] : one4, gv1 = d.gsc ? gv[1] : one4;
#pragma unroll
    for (int j = 0; j < 4; ++j) { const int n = (lane >> 3) + 8 * j; const LAS float* s = scr + (8 * c) * 33 + n;
        const float x0 = s[0 * 33] * gv0.x * sc, x1 = s[1 * 33] * gv0.y * sc, x2 = s[2 * 33] * gv0.z * sc, x3 = s[3 * 33] * gv0.w * sc, x4 = s[4 * 33] * gv1.x * sc, x5 = s[5 * 33] * gv1.y * sc, x6 = s[6 * 33] * gv1.z * sc, x7 = s[7 * 33] * gv1.w * sc;
        if (d.is8 == 2) { pg8::u32x2 o; o.x = pg8::pk_i8x4(x0, x1, x2, x3); o.y = pg8::pk_i8x4(x4, x5, x6, x7); GAS pg8::u32x2* op = (GAS pg8::u32x2*)(d.WT + (size_t)(d.drow0 + n) * d.Kp + d.k0 + 8 * c); if (NT) __builtin_nontemporal_store(o, op); else *op = o; }
        else if (d.is8) { pg8::u32x2 o; o.x = pg8::pk_fp8x4(x0, x1, x2, x3); o.y = pg8::pk_fp8x4(x4, x5, x6, x7); GAS pg8::u32x2* op = (GAS pg8::u32x2*)(d.WT + (size_t)(d.drow0 + n) * d.Kp + d.k0 + 8 * c); if (NT) __builtin_nontemporal_store(o, op); else *op = o; }
        else { v4u o; o.x = pkbf(x0, x1); o.y = pkbf(x2, x3); o.z = pkbf(x4, x5); o.w = pkbf(x6, x7); *(GAS v4u*)((bf16*)d.WT + (size_t)(d.drow0 + n) * d.Kp + d.k0 + 8 * c) = o; } }
    LDS_WAIT(); asm volatile("" ::: "memory");
}

__device__ __forceinline__ void tr_loadr(const TrDesc& d, float (&v)[32], int lane) {
    const float* p = d.W + (size_t)d.k0 * d.ldw + d.n0src;
    const unsigned voff = (unsigned)((lane >> 5) * d.ldw + (lane & 31));
#pragma unroll
    for (int i = 0; i < 32; ++i) v[i] = __builtin_nontemporal_load(p + (size_t)(2 * i) * d.ldw + voff);
}
__device__ __forceinline__ unsigned pk_i8x4_fast(float a, float b, float c, float d) {
    unsigned w = 0u; w = __builtin_amdgcn_cvt_pk_u8_f32(a, 0u, w); w = __builtin_amdgcn_cvt_pk_u8_f32(b, 1u, w); w = __builtin_amdgcn_cvt_pk_u8_f32(c, 2u, w); w = __builtin_amdgcn_cvt_pk_u8_f32(d, 3u, w);
    return w ^ 0x80808080u;
}
__device__ __forceinline__ void tr_storer(const TrDesc& d, float (&v)[32], int lane) {
#pragma unroll
    for (int i = 0; i < 16; ++i) { const auto r = __builtin_amdgcn_permlane32_swap(__builtin_bit_cast(unsigned, v[i]), __builtin_bit_cast(unsigned, v[i + 16]), false, false);
        v[i] = __builtin_bit_cast(float, (unsigned)r[0]); v[i + 16] = __builtin_bit_cast(float, (unsigned)r[1]); }
    const int n = lane & 31, kh = 32 * (lane >> 5); const float sc = d.scale;
#define TRK(j) v[((j) >> 1) + 16 * ((j) & 1)]
    if (d.gsc) {
        const float* gp = d.gsc + d.k0 + kh;
#pragma unroll
        for (int q = 0; q < 8; ++q) { const f32x4 g4 = *(const f32x4*)(gp + 4 * q); TRK(4 * q) *= g4.x; TRK(4 * q + 1) *= g4.y; TRK(4 * q + 2) *= g4.z; TRK(4 * q + 3) *= g4.w; }
    }
    if (d.is8) { unsigned w[8];
        if (d.is8 == 2) {
#pragma unroll
            for (int q = 0; q < 8; ++q) w[q] = pk_i8x4_fast(TRK(4 * q) * sc + 128.f, TRK(4 * q + 1) * sc + 128.f, TRK(4 * q + 2) * sc + 128.f, TRK(4 * q + 3) * sc + 128.f);
        } else {
#pragma unroll
            for (int q = 0; q < 8; ++q) w[q] = pg8::pk_fp8x4(TRK(4 * q) * sc, TRK(4 * q + 1) * sc, TRK(4 * q + 2) * sc, TRK(4 * q + 3) * sc);
        }
        GAS v4u* o = (GAS v4u*)(d.WT + (size_t)(d.drow0 + n) * d.Kp + d.k0 + kh);
        o[0] = (v4u){w[0], w[1], w[2], w[3]}; o[1] = (v4u){w[4], w[5], w[6], w[7]};
    } else {
        GAS v4u* o = (GAS v4u*)((bf16*)d.WT + (size_t)(d.drow0 + n) * d.Kp + d.k0 + kh);
#pragma unroll
        for (int q = 0; q < 4; ++q) o[q] = (v4u){pkbf(TRK(8 * q) * sc, TRK(8 * q + 1) * sc), pkbf(TRK(8 * q + 2) * sc, TRK(8 * q + 3) * sc), pkbf(TRK(8 * q + 4) * sc, TRK(8 * q + 5) * sc), pkbf(TRK(8 * q + 6) * sc, TRK(8 * q + 7) * sc)};
    }
#undef TRK
}

__device__ __forceinline__ void p0_items(kargp0_t kp, unsigned char* ws, LAS float* scr, int first, int stride, int lo, int hi, int lane) {
    TrDesc da, db, dc; f32x4 va[8], vb[8], vc[8]; f32x4 ga[2], gb[2], gc[2];
    int it = lo + first; const int NGW = stride;
    if (it < hi) { tr_desc(it, kp, ws, da); tr_load(da, va, ga, lane); }
    if (it + NGW < hi) { tr_desc(it + NGW, kp, ws, db); tr_load(db, vb, gb, lane); }
    while (it < hi) {
        if (it + 2 * NGW < hi) { tr_desc(it + 2 * NGW, kp, ws, dc); tr_load(dc, vc, gc, lane); }
        tr_store(da, va, ga, scr, lane);
        if (it + NGW >= hi) break;
        if (it + 3 * NGW < hi) { tr_desc(it + 3 * NGW, kp, ws, da); tr_load(da, va, ga, lane); }
        tr_store(db, vb, gb, scr, lane);
        if (it + 2 * NGW >= hi) break;
        if (it + 4 * NGW < hi) { tr_desc(it + 4 * NGW, kp, ws, db); tr_load(db, vb, gb, lane); }
        tr_store(dc, vc, gc, scr, lane);
        it += 3 * NGW;
    }
}
__device__ __forceinline__ void p0_items2(kargp0_t kp, unsigned char* ws, LAS float* scr, int first, int stride, int lo, int hi, int lane) {
    if (first >= hi - lo) return;
    const int n = (hi - lo - first + stride - 1) / stride, base = lo + first, last = n - 1;
    TrDesc da, db; f32x4 va[8], vb[8]; f32x4 ga[2], gb[2];
#define P0_ITEM(k) (base + ((k) < last ? (k) : last) * stride)
    tr_desc(base, kp, ws, da); tr_load(da, va, ga, lane);
    for (int k = 0; k + 1 < n; k += 2) {
        tr_desc(P0_ITEM(k + 1), kp, ws, db); tr_load(db, vb, gb, lane);
        tr_store<true>(da, va, ga, scr, lane);
        tr_desc(P0_ITEM(k + 2), kp, ws, da); tr_load(da, va, ga, lane);
        tr_store<true>(db, vb, gb, scr, lane);
    }
    if (n & 1) tr_store<true>(da, va, ga, scr, lane);
#undef P0_ITEM
}
__device__ __forceinline__ void p0_prologue(kargp0_t kp, unsigned char* ws, LAS unsigned char* lds, int G, int vcu, int tid, int lane, int wave) {
    LAS float* scr = (LAS float*)(lds + RING_OFF + wave * 16384);
    const int gw = vcu * NWAVES + wave, NGW = G * NWAVES;
    bf16* WF13 = (bf16*)(ws + WS_WF13); bf16* WFD = (bf16*)(ws + WS_WFD);
    p0_items(kp, ws, scr, gw, NGW, (G == 256) ? IT_MOE : 0, IT_TOTAL, lane);
#ifdef PROBE_CONV_NC
    if ((vcu & 31) < PROBE_CONV_NC) p0_items(kp, ws, scr, ((vcu >> 5) * PROBE_CONV_NC + (vcu & 31)) * NWAVES + wave, 8 * PROBE_CONV_NC * NWAVES, 0, IT_MOE, lane);
#endif
    const int gt = vcu * (NWAVES * 64) + tid, NGT = G * NWAVES * 64; const v4u z = {0u, 0u, 0u, 0u};
    { constexpr int RB = I8_P4 ? 1024 : 2048, CH = RB / 16;
      for (int i = gt; i < 2 * 64 * CH; i += NGT) { const int sel = i / (64 * CH), rr = (i / CH) & 63, ch = i % CH; *(GAS v4u*)((unsigned char*)WF13 + (size_t)(256 * 21 + 128 * sel + 64 + rr) * RB + ch * 16) = z; } }
    for (int i = gt; i < 1024 * 8; i += NGT) { const int row = i >> 3, ch = i & 7; *(GAS v4u*)(WFD + (size_t)row * DFFP + DFF + ch * 8) = z; }
    const float* x = P0IN(0); const float* gn = P0IN(2); bf16* H0 = (bf16*)(ws + WS_H0);
    f32x4 gv[4];
#pragma unroll
    for (int j = 0; j < 4; ++j) gv[j] = *(const f32x4*)(gn + 4 * lane + 256 * j);
    for (int m0 = gw * 4; m0 < T; m0 += NGW * 4) {
        f32x4 v[4][4];
#pragma unroll
        for (int q = 0; q < 4; ++q) { const GAS f32x4* xr = (const GAS f32x4*)(x + (size_t)(m0 + q) * D) + lane;
#pragma unroll
            for (int j = 0; j < 4; ++j) v[q][j] = __builtin_nontemporal_load(xr + 64 * j); }
#pragma unroll
        for (int q = 0; q < 4; ++q) { float s = 0.f;
#pragma unroll
            for (int j = 0; j < 4; ++j) s += (v[q][j].x * v[q][j].x + v[q][j].y * v[q][j].y) + (v[q][j].z * v[q][j].z + v[q][j].w * v[q][j].w);
            const float rstd = 1.f / sqrtf(wave_sum(s) * (1.f / D) + EPS);
            if (I8_P1) { GAS unsigned* o4 = (GAS unsigned*)((unsigned char*)H0 + (size_t)(m0 + q) * D) + lane;
#pragma unroll
                for (int j = 0; j < 4; ++j) { const f32x4 y = v[q][j] * (rstd * SA_N) * gv[j]; o4[64 * j] = pg8::pk_i8x4(y.x, y.y, y.z, y.w); } }
            else { GAS unsigned long long* o8 = (GAS unsigned long long*)(H0 + (size_t)(m0 + q) * D) + lane;
#pragma unroll
                for (int j = 0; j < 4; ++j) { const f32x4 y = v[q][j] * rstd * gv[j]; o8[64 * j] = (unsigned long long)pkbf(y.x, y.y) | ((unsigned long long)pkbf(y.z, y.w) << 32); } } }
    }
}

__device__ __forceinline__ void conv_phase(const bf16* glu, const float* dw_w, const float* dw_b, const float* ln_g, const float* ln_b, bf16* vout, LAS unsigned char* lds, int G, int vcu, int tid, int lane, int wave) {
    LAS float* ybuf = (LAS float*)(lds + RING_OFF);
    const int c0 = 2 * tid;
    float w0[31], w1[31];
#pragma unroll
    for (int k = 0; k < 31; ++k) { const f32x2v w = *(const f32x2v*)(dw_w + k * 1024 + c0); w0[k] = w.x; w1[k] = w.y; }
    const f32x2v dbv = *(const f32x2v*)(dw_b + c0);
    LAS float* lnp = (LAS float*)(lds + XTRA_OFF);
    for (int i = tid; i < 1024; i += NWAVES * 64) { lnp[i] = ln_g[i]; lnp[1024 + i] = ln_b[i]; }
    __syncthreads();
    for (int item = vcu; item < T / 128; item += G) {
        const int b = item >> 5, s0 = (item & 31) * 128;
        const bf16* ub = glu + (size_t)b * SEQ * D + c0;
        float r0[32], r1[32];
        r0[0] = 0.f; r1[0] = 0.f; r0[1] = 0.f; r1[1] = 0.f;
#pragma unroll
        for (int i = 0; i < 30; ++i) { const int s = s0 - 30 + i; unsigned v = 0u; if (s >= 0) v = *(const unsigned*)(ub + (size_t)s * D); r0[i + 2] = bflo(v); r1[i + 2] = bfhi(v); }
        for (int base = 0; base < 128; base += 32) {
            unsigned nu[32];
#pragma unroll
            for (int j = 0; j < 32; ++j) nu[j] = *(const unsigned*)(ub + (size_t)(s0 + base + j) * D);
#pragma unroll
            for (int j = 0; j < 32; ++j) {
                r0[j] = bflo(nu[j]); r1[j] = bfhi(nu[j]);
                float y0 = dbv.x, y1 = dbv.y;
#pragma unroll
                for (int k = 0; k < 31; ++k) { const int idx = (j + 2 + k) & 31; y0 += r0[idx] * w0[k]; y1 += r1[idx] * w1[k]; }
                *(LAS f32x2v*)(ybuf + j * 1024 + c0) = (f32x2v){y0, y1};
            }
            __syncthreads();
            const int ntok = 32;
            for (int j = wave; j < ntok; j += NWAVES) {
                f32x4 y[4]; float s = 0.f;
#pragma unroll
                for (int i = 0; i < 4; ++i) { y[i] = *(const LAS f32x4*)(ybuf + j * 1024 + 4 * lane + 256 * i); s += (y[i].x + y[i].y) + (y[i].z + y[i].w); }
                const float mean = wave_sum(s) * (1.f / D); float q = 0.f;
#pragma unroll
                for (int i = 0; i < 4; ++i) { y[i] = y[i] - mean; q += (y[i].x * y[i].x + y[i].y * y[i].y) + (y[i].z * y[i].z + y[i].w * y[i].w); }
                const float rstd = 1.f / sqrtf(wave_sum(q) * (1.f / D) + EPS);
                GAS unsigned* o4 = (GAS unsigned*)((unsigned char*)vout + ((size_t)b * SEQ + s0 + base + j) * D) + lane;
                GAS unsigned long long* o8 = (GAS unsigned long long*)(vout + ((size_t)b * SEQ + s0 + base + j) * D) + lane;
#pragma unroll
                for (int i = 0; i < 4; ++i) { const f32x4 lgv = *(const LAS f32x4*)(lnp + 4 * lane + 256 * i), lbv = *(const LAS f32x4*)(lnp + 1024 + 4 * lane + 256 * i); f32x4 z = y[i] * rstd * lgv + lbv;
                    z.x *= pg8::fast_sigmoid(z.x); z.y *= pg8::fast_sigmoid(z.y); z.z *= pg8::fast_sigmoid(z.z); z.w *= pg8::fast_sigmoid(z.w);
                    if (I8_P3) o4[64 * i] = pg8::pk_i8x4(z.x * SA_N, z.y * SA_N, z.z * SA_N, z.w * SA_N);
                    else o8[64 * i] = (unsigned long long)pkbf(z.x, z.y) | ((unsigned long long)pkbf(z.z, z.w) << 32); }
            }
            __syncthreads();
        }
    }
}

__device__ __forceinline__ void attn_phase(LAS unsigned char* lds, int grp, const bf16* Kb, const bf16* Vb, const bf16* Qb, bf16* Ob, unsigned char* O8, float* lse, const float* rel_bias, unsigned* qheads, int G, int vcu, int tid, int lane, int wave) {
    const int dsh = 2 * grp, dil = 1 << dsh;
    LAS unsigned char* Kl = lds + RING_OFF;
    LAS unsigned char* Vl = lds + RING_OFF + 55296;
    LAS float* btab_all = (LAS float*)(lds + XTRA_OFF);
    for (int i = tid; i < 16 * 192; i += NWAVES * 64) { const int hh = i / 192, j = i % 192, dist = 159 - j;
        btab_all[i] = (dist >= 0 && dist <= 128) ? rel_bias[(int)T5_BUCKET[grp][dist] * 48 + grp * 16 + hh] * LOG2E - SOFTMAX_OFS : -1.0e30f; }
    const int lq = lane & 31, hi = lane >> 5;
    v4u kvp[6], vvp[6];
#define ATT_DECODE(IDX, b_, h_, res_, n0_) const int bh_##b_ = (IDX) >> 4, w16_##b_ = (IDX) & 15, b_ = bh_##b_ >> 4, h_ = bh_##b_ & 15, res_ = w16_##b_ & (dil - 1), n0_ = (w16_##b_ >> dsh) * 256
#define ATT_LOAD(IDX) do { ATT_DECODE(IDX, pb, ph, pres, pn0); \
        _Pragma("unroll") for (int i = 0; i < 6; ++i) { const int cidx = tid + 512 * i, j = cidx >> 3, c16 = cidx & 7, sub = pn0 - 128 + j; \
            kvp[i] = (v4u){0u, 0u, 0u, 0u}; vvp[i] = kvp[i]; \
            if (sub >= 0) { const size_t off = ((size_t)pb * SEQ + ((size_t)sub << dsh) + pres) * D + ph * 64 + c16 * 8; kvp[i] = *(const GAS v4u*)(Kb + off); vvp[i] = *(const GAS v4u*)(Vb + off); } } } while (0)
    pg8::bf16x8 qnext[4];
#define ATT_LOADQ(IDX) do { ATT_DECODE(IDX, qb_, qh_, qres_, qn0_); \
        _Pragma("unroll") for (int c = 0; c < 4; ++c) { const size_t qrow_ = (size_t)qb_ * SEQ + ((size_t)(qn0_ + 32 * wave + 8 * c + (lane >> 3)) << dsh) + qres_; \
            qnext[c] = *(const pg8::bf16x8*)(Qb + qrow_ * D + qh_ * 64 + (lane & 7) * 8); } } while (0)
    const bool dyn = (G == 256);
    const int xq = vcu >> 5;
    LAS int* qL = (LAS int*)(lds + XTRA_OFF + 12288 + 64);
    int idx = vcu;
    if (idx < 2048) { ATT_LOAD(idx); ATT_LOADQ(idx); }
    __syncthreads();
    while (idx < 2048) {
        int claimed = 0;
        if (dyn && tid == 0) claimed = (int)__hip_atomic_fetch_add(qheads + 16 * xq, 1u, __ATOMIC_RELAXED, __HIP_MEMORY_SCOPE_AGENT);
        ATT_DECODE(idx, b, h, res, n0);
        const int ql = 32 * wave + lq;
        const size_t qrow = (size_t)b * SEQ + ((size_t)(n0 + ql) << dsh) + res;
        pg8::bf16x8 qr[4];
        { LAS unsigned char* QI = lds + XTRA_OFF + 13312 + wave * 2304;
          pg8::bf16x8 ta[4], tb[4];
          *(LAS pg8::bf16x8*)(QI + (lane >> 3) * 144 + (lane & 7) * 16) = qnext[0]; *(LAS pg8::bf16x8*)(QI + (8 + (lane >> 3)) * 144 + (lane & 7) * 16) = qnext[1];
          __builtin_amdgcn_wave_barrier();
#pragma unroll
          for (int c = 0; c < 4; ++c) ta[c] = *(const LAS pg8::bf16x8*)(QI + (lq & 15) * 144 + (2 * c + hi) * 16);
          __builtin_amdgcn_wave_barrier();
          *(LAS pg8::bf16x8*)(QI + (lane >> 3) * 144 + (lane & 7) * 16) = qnext[2]; *(LAS pg8::bf16x8*)(QI + (8 + (lane >> 3)) * 144 + (lane & 7) * 16) = qnext[3];
          __builtin_amdgcn_wave_barrier();
#pragma unroll
          for (int c = 0; c < 4; ++c) tb[c] = *(const LAS pg8::bf16x8*)(QI + (lq & 15) * 144 + (2 * c + hi) * 16);
          __builtin_amdgcn_wave_barrier();
#pragma unroll
          for (int c = 0; c < 4; ++c) qr[c] = (lq < 16) ? ta[c] : tb[c]; }
        __syncthreads();
#pragma unroll
        for (int i = 0; i < 6; ++i) { const int cidx = tid + 512 * i, j = cidx >> 3, c16 = cidx & 7;
            *(LAS v4u*)(Kl + j * 144 + c16 * 16) = kvp[i]; *(LAS v4u*)(Vl + (c16 >> 2) * 24576 + j * 64 + (c16 & 3) * 16) = vvp[i]; }
        if (dyn && tid == 0) qL[0] = 32 + claimed;
        __syncthreads();
        int nidx = idx + G;
        if (dyn) { const int jn = qL[0]; nidx = jn < 256 ? ((jn >> 5) << 8) + (xq << 5) + (jn & 31) : 2048; }
        if (nidx < 2048) ATT_LOAD(nidx);
        float sv[5][16]; float m = -3.0e38f;
        const int kofs = n0 - 128 + 32 * wave;
        const LAS float* brow = btab_all + h * 192 + (31 - lq + 4 * hi);
#pragma unroll
        for (int kt = 0; kt < 5; ++kt) {
            f32x16 S;
#pragma unroll
            for (int r = 0; r < 16; ++r) S[r] = brow[32 * kt + (r & 3) + 8 * (r >> 2)];
#pragma unroll
            for (int c = 0; c < 4; ++c) { const pg8::bf16x8 a = *(const LAS pg8::bf16x8*)(Kl + (32 * wave + 32 * kt + lq) * 144 + (16 * c + 8 * hi) * 2);
                S = __builtin_amdgcn_mfma_f32_32x32x16_bf16(a, qr[c], S, 0, 0, 0); }
#pragma unroll
            for (int r = 0; r < 16; ++r) sv[kt][r] = S[r];
            __builtin_amdgcn_sched_barrier(0);
        }
        if (kofs < 0) {
#pragma unroll
            for (int kt = 0; kt < 5; ++kt)
#pragma unroll
                for (int r = 0; r < 16; ++r) { const int kk = 32 * kt + crow(r, hi); if (kofs + kk < 0) sv[kt][r] = -1.0e30f; }
        }
        m = SOFTMAX_OFS;
        float l = 0.f; unsigned pw[5][8];
#pragma unroll
        for (int kt = 0; kt < 5; ++kt) {
#pragma unroll
            for (int r = 0; r < 16; r += 2) { const float p0 = __builtin_amdgcn_exp2f(sv[kt][r]), p1 = __builtin_amdgcn_exp2f(sv[kt][r + 1]); l += p0 + p1; pw[kt][r >> 1] = pkbf(p0, p1); }
            __builtin_amdgcn_sched_barrier(0);
        }
        l += __shfl_xor(l, 32);
        f32x16 O0 = (f32x16){0.f, 0.f, 0.f, 0.f, 0.f, 0.f, 0.f, 0.f, 0.f, 0.f, 0.f, 0.f, 0.f, 0.f, 0.f, 0.f}, O1 = O0;
        const int vlane = ((lane & 15) >> 2) * 64 + ((lane >> 4) & 1) * 32 + (lane & 3) * 8;
#pragma unroll
        for (int kt = 0; kt < 5; ++kt)
#pragma unroll
            for (int s2 = 0; s2 < 2; ++s2) {
                v4u pq; pq.x = pw[kt][4 * s2 + 0]; pq.y = pw[kt][4 * s2 + 1]; pq.z = pw[kt][4 * s2 + 2]; pq.w = pw[kt][4 * s2 + 3];
                const pg8::bf16x8 pf = __builtin_bit_cast(pg8::bf16x8, pq);
                const int vrow = 32 * wave + 32 * kt + 16 * s2 + 4 * hi;
                LAS unsigned char* vp = Vl + vrow * 64 + vlane;
                const v4i16_t a0 = __builtin_amdgcn_ds_read_tr16_b64_v4i16((LAS v4i16_t*)(vp)), a1 = __builtin_amdgcn_ds_read_tr16_b64_v4i16((LAS v4i16_t*)(vp + 512));
                const v4i16_t b0 = __builtin_amdgcn_ds_read_tr16_b64_v4i16((LAS v4i16_t*)(vp + 24576)), b1 = __builtin_amdgcn_ds_read_tr16_b64_v4i16((LAS v4i16_t*)(vp + 24576 + 512));
                const pg8::bf16x8 vf0 = (pg8::bf16x8){a0[0], a0[1], a0[2], a0[3], a1[0], a1[1], a1[2], a1[3]};
                const pg8::bf16x8 vf1 = (pg8::bf16x8){b0[0], b0[1], b0[2], b0[3], b1[0], b1[1], b1[2], b1[3]};
                O0 = __builtin_amdgcn_mfma_f32_32x32x16_bf16(vf0, pf, O0, 0, 0, 0);
                O1 = __builtin_amdgcn_mfma_f32_32x32x16_bf16(vf1, pf, O1, 0, 0, 0);
                __builtin_amdgcn_sched_barrier(0);
            }
        if (nidx < 2048) ATT_LOADQ(nidx);
        const float inv_l = 1.f / l, lse2 = m + __builtin_amdgcn_logf(l);
        const size_t orow = qrow;
        v4u oldv[4];
        if (grp != 0) {
#pragma unroll
            for (int i = 0; i < 4; ++i) { const int ch = lane + 64 * i, qq = ch >> 3, c8 = ch & 7; oldv[i] = *(const GAS v4u*)(Ob + ((size_t)b * SEQ + ((size_t)(n0 + 32 * wave + qq) << dsh) + res) * D + h * 64 + c8 * 8); } }
        float co = 0.f, cg = inv_l, lnew = lse2;
        const size_t lidx = (size_t)(b * 16 + h) * SEQ + (orow - (size_t)b * SEQ);
        if (grp != 0) { const float lo_ = lse[lidx]; const float M = fmaxf(lo_, lse2); const float wo = __builtin_amdgcn_exp2f(lo_ - M), wg = __builtin_amdgcn_exp2f(lse2 - M), den = wo + wg;
            co = wo / den; cg = wg / den * inv_l; lnew = M + __builtin_amdgcn_logf(den); }
        __syncthreads();
        LAS unsigned char* stg = Kl + wave * 4608;
        LAS float* cot = (LAS float*)(Kl + 8 * 4608) + wave * 32;
#pragma unroll
        for (int rg = 0; rg < 4; ++rg) {
            pg8::u32x2 wa, wb; wa.x = pkbf(O0[4 * rg] * cg, O0[4 * rg + 1] * cg); wa.y = pkbf(O0[4 * rg + 2] * cg, O0[4 * rg + 3] * cg);
            wb.x = pkbf(O1[4 * rg] * cg, O1[4 * rg + 1] * cg); wb.y = pkbf(O1[4 * rg + 2] * cg, O1[4 * rg + 3] * cg);
            *(LAS pg8::u32x2*)(stg + lq * 144 + (8 * rg + 4 * hi) * 2) = wa; *(LAS pg8::u32x2*)(stg + lq * 144 + (32 + 8 * rg + 4 * hi) * 2) = wb; }
        if (hi == 0) cot[lq] = co;
        if (hi == 0) lse[lidx] = lnew;
#pragma unroll
        for (int i = 0; i < 4; ++i) { const int ch = lane + 64 * i, qq = ch >> 3, c8 = ch & 7;
            const v4u sv4 = *(const LAS v4u*)(stg + qq * 144 + c8 * 16);
            bf16* op = Ob + ((size_t)b * SEQ + ((size_t)(n0 + 32 * wave + qq) << dsh) + res) * D + h * 64 + c8 * 8;
            v4u ov = sv4;
            if (grp != 0) { const float cq = cot[qq]; const v4u old = oldv[i];
                ov.x = pkbf(bflo(sv4.x) + cq * bflo(old.x), bfhi(sv4.x) + cq * bfhi(old.x)); ov.y = pkbf(bflo(sv4.y) + cq * bflo(old.y), bfhi(sv4.y) + cq * bfhi(old.y));
                ov.z = pkbf(bflo(sv4.z) + cq * bflo(old.z), bfhi(sv4.z) + cq * bfhi(old.z)); ov.w = pkbf(bflo(sv4.w) + cq * bflo(old.w), bfhi(sv4.w) + cq * bfhi(old.w)); }
            if (grp == 2) { unsigned char* o8 = O8 + ((size_t)b * SEQ + ((size_t)(n0 + 32 * wave + qq) << dsh) + res) * D + h * 64 + c8 * 8;
                pg8::u32x2 w8; w8.x = pg8::pk_fp8x4(bflo(ov.x) * O8_SCALE, bfhi(ov.x) * O8_SCALE, bflo(ov.y) * O8_SCALE, bfhi(ov.y) * O8_SCALE); w8.y = pg8::pk_fp8x4(bflo(ov.z) * O8_SCALE, bfhi(ov.z) * O8_SCALE, bflo(ov.w) * O8_SCALE, bfhi(ov.w) * O8_SCALE);
                *(GAS pg8::u32x2*)o8 = w8; }
            else *(GAS v4u*)op = ov; }
        idx = nidx;
    }
    __syncthreads();
#undef ATT_DECODE
#undef ATT_LOAD
#undef ATT_LOADQ
}

__device__ __forceinline__ void route_phase(const _Float16* x3, const float* gnorm, const float* wr, kargp0_t kp, unsigned char* ws, LAS unsigned char* lds, int G, int vcu, int tid, int lane, int wave) {
    LAS float* WrT = (LAS float*)(lds + RING_OFF);
    LAS unsigned* wcL = (LAS unsigned*)(lds + RING_OFF + 32768);
    for (int i = tid; i < 8192; i += NWAVES * 64) { const int e = i >> 10, k = i & 1023; WrT[i] = wr[k * 8 + e] * gnorm[k]; }
    __syncthreads();
    unsigned* route = (unsigned*)(ws + WS_ROUTE); float* gate1 = (float*)(ws + WS_GATE1); float* gate2 = (float*)(ws + WS_GATE2);
    unsigned* wavecnt = (unsigned*)(ws + WS_WAVECNT); int* blockcnt = (int*)(ws + WS_BLOCKCNT); unsigned char* H3 = ws + WS_H3;
    const int gw = vcu * NWAVES + wave, NGW = G * NWAVES, tpw = (T + NGW - 1) / NGW;
    const int t0 = gw * tpw, t1 = (t0 + tpw) < T ? (t0 + tpw) : T;
    f32x4 gv[4];
#pragma unroll
    for (int j = 0; j < 4; ++j) gv[j] = *(const f32x4*)(gnorm + 4 * lane + 256 * j);
    unsigned long long cnt0 = 0ull, cnt1 = 0ull;
    pg8::h16x4 cur[4][4], nxt[4][4];
#define RT_LOAD4(tt) do { _Pragma("unroll") for (int q = 0; q < 4; ++q) { const int tc_ = ((tt) + q) < t1 ? ((tt) + q) : t1 - 1; const GAS pg8::h16x4* xr_ = (const GAS pg8::h16x4*)(x3 + (size_t)tc_ * D) + lane; \
        _Pragma("unroll") for (int j = 0; j < 4; ++j) nxt[q][j] = xr_[64 * j]; } } while (0)
    auto process2 = [&](const pg8::h16x4 (&rawA)[4], const pg8::h16x4 (&rawB)[4], const int tA, const bool hasB) {
        f32x4 va[4], vb[4]; float ssA = 0.f, ssB = 0.f;
#pragma unroll
        for (int j = 0; j < 4; ++j) { va[j] = __builtin_convertvector(rawA[j], f32x4); vb[j] = __builtin_convertvector(rawB[j], f32x4);
            ssA += (va[j].x * va[j].x + va[j].y * va[j].y) + (va[j].z * va[j].z + va[j].w * va[j].w); ssB += (vb[j].x * vb[j].x + vb[j].y * vb[j].y) + (vb[j].z * vb[j].z + vb[j].w * vb[j].w); }
        float da[8], db[8];
        LAS float* wl = WrT + 4 * lane; asm volatile("" : "+v"(wl));
#pragma unroll
        for (int e = 0; e < 8; ++e) { float a = 0.f, b = 0.f;
#pragma unroll
            for (int j = 0; j < 4; ++j) { const f32x4 w = *(const LAS f32x4*)(wl + e * 1024 + 256 * j);
                a += (va[j].x * w.x + va[j].y * w.y) + (va[j].z * w.z + va[j].w * w.w); b += (vb[j].x * w.x + vb[j].y * w.y) + (vb[j].z * w.z + vb[j].w * w.w); }
            da[e] = a; db[e] = b; }
        ssA = wave_sum(ssA); ssB = wave_sum(ssB);
#pragma unroll
        for (int e = 0; e < 8; ++e) { da[e] = wave_sum(da[e]); db[e] = wave_sum(db[e]); }
        auto finish = [&](const f32x4 (&v)[4], const float (&d)[8], const float ss, const int t) {
            const float rstd = 1.f / sqrtf(ss * (1.f / D) + EPS);
            GAS unsigned* o4 = (GAS unsigned*)(H3 + (size_t)t * D) + lane;
#pragma unroll
            for (int j = 0; j < 4; ++j) { const f32x4 y = v[j] * (rstd * SA_N) * gv[j] + 128.f;
                unsigned w = 0u; w = __builtin_amdgcn_cvt_pk_u8_f32(y.x, 0u, w); w = __builtin_amdgcn_cvt_pk_u8_f32(y.y, 1u, w); w = __builtin_amdgcn_cvt_pk_u8_f32(y.z, 2u, w); w = __builtin_amdgcn_cvt_pk_u8_f32(y.w, 3u, w);
                o4[64 * j] = w ^ 0x80808080u; }
            int e1 = 0; float v1 = d[0] * rstd;
#pragma unroll
            for (int e = 1; e < 8; ++e) { const float x = d[e] * rstd; if (x > v1) { v1 = x; e1 = e; } }
            int e2 = -1; float v2 = -3.0e38f;
#pragma unroll
            for (int e = 0; e < 8; ++e) { const float x = d[e] * rstd; if (e != e1 && x > v2) { v2 = x; e2 = e; } }
            const float g2 = 1.f / (1.f + __expf(v1 - v2)), g1 = 1.f - g2;
            cnt0 += 1ull << (8 * e1); cnt1 += 1ull << (8 * e2);
            if (lane == 0) { route[t] = (unsigned)e1 | ((unsigned)e2 << 8); gate1[t] = g1; gate2[t] = g2; }
        };
        finish(va, da, ssA, tA);
        if (hasB) finish(vb, db, ssB, tA + 1);
    };
    int ck = 0;
    if (t0 < t1) RT_LOAD4(t0);
    for (int t = t0; t < t1; t += 4) {
#pragma unroll
        for (int q = 0; q < 4; ++q)
#pragma unroll
            for (int j = 0; j < 4; ++j) cur[q][j] = nxt[q][j];
        RT_LOAD4(t + 4);
#pragma unroll
        for (int q = 0; q < 4; q += 2) if (t + q < t1) {
            const bool cv = (G == 256) && ck + 1 < CONV_RT; TrDesc cd, ce; float cvv[32], cvw[32];
            if (cv) { tr_desc<true>(vcu * (IT_MOE / 256) + ck * NWAVES + wave, kp, ws, cd); tr_loadr(cd, cvv, lane); tr_desc<true>(vcu * (IT_MOE / 256) + (ck + 1) * NWAVES + wave, kp, ws, ce); tr_loadr(ce, cvw, lane); }
            process2(cur[q], cur[q + 1], t + q, t + q + 1 < t1);
            if (cv) { tr_storer(cd, cvv, lane); tr_storer(ce, cvw, lane); ck += 2; } }
    }
#undef RT_LOAD4
    if (G == 256) for (; ck < CONV_RT; ++ck) { TrDesc cd; float cvv[32]; tr_desc<true>(vcu * (IT_MOE / 256) + ck * NWAVES + wave, kp, ws, cd); tr_loadr(cd, cvv, lane); tr_storer(cd, cvv, lane); }
    if (lane == 0) { v4u c; c.x = (unsigned)cnt0; c.y = (unsigned)(cnt0 >> 32); c.z = (unsigned)cnt1; c.w = (unsigned)(cnt1 >> 32);
        *(GAS v4u*)(wavecnt + (size_t)gw * 4) = c; wcL[wave * 4 + 0] = c.x; wcL[wave * 4 + 1] = c.y; wcL[wave * 4 + 2] = c.z; wcL[wave * 4 + 3] = c.w; }
    __syncthreads();
    if (tid < 16) { const int slot = tid >> 3, e = tid & 7; int s = 0;
#pragma unroll
        for (int w = 0; w < NWAVES; ++w) s += (int)((wcL[w * 4 + slot * 2 + (e >> 2)] >> (8 * (e & 3))) & 255u);
        blockcnt[vcu * 16 + tid] = s; }
    __syncthreads();
}

__device__ __forceinline__ void pos_phase(unsigned char* ws, LAS unsigned char* lds, int G, int vcu, int tid, int lane, int wave) {
    LAS int* cntL = (LAS int*)(lds + RING_OFF);
    LAS int* pAll = (LAS int*)(lds + RING_OFF + 65536);
    LAS int* pBef = pAll + 512;
    LAS int* totL = pBef + 512;
    const int* blockcnt = (const int*)(ws + WS_BLOCKCNT); const unsigned* wavecnt = (const unsigned*)(ws + WS_WAVECNT);
    const unsigned* route = (const unsigned*)(ws + WS_ROUTE); const float* gate1 = (const float*)(ws + WS_GATE1); const float* gate2 = (const float*)(ws + WS_GATE2);
    int* gofs = (int*)(ws + WS_GOFS);
    for (int i = tid; i < G * 16; i += NWAVES * 64) cntL[i] = blockcnt[i];
    __syncthreads();
    { const int c = tid & 15, part = tid >> 4, bpp = (G + 31) / 32; int sa = 0, sb = 0;
      for (int bb = part * bpp; bb < (part + 1) * bpp && bb < G; ++bb) { const int v = cntL[bb * 16 + c]; sa += v; if (bb < vcu) sb += v; }
      pAll[part * 16 + c] = sa; pBef[part * 16 + c] = sb; }
    __syncthreads();
    if (tid < 16) { int sa = 0, sb = 0;
        for (int p = 0; p < 32; ++p) { sa += pAll[p * 16 + tid]; sb += pBef[p * 16 + tid]; }
        totL[tid] = sa; totL[16 + tid] = sb; }
    __syncthreads();
    if (tid == 0) { int off = 0;
        for (int e = 0; e < 8; ++e) { totL[32 + e] = off; totL[32 + 8 + e] = off + totL[e]; if (vcu == 0) { gofs[e] = off; gofs[8 + e] = off + totL[e]; gofs[32 + e] = off >> 8; } off += ((totL[e] + totL[8 + e] + 255) >> 8) << 8; }
        if (vcu == 0) gofs[16] = off >> 8; }
    __syncthreads();
    const int gw = vcu * NWAVES + wave, NGW = G * NWAVES, tpw = (T + NGW - 1) / NGW;
    const int t0 = gw * tpw, t1 = (t0 + tpw) < T ? (t0 + tpw) : T;
    int mypos = 0;
    if (lane < 16) { mypos = totL[32 + lane] + totL[16 + lane];
        for (int w = 0; w < wave; ++w) mypos += (int)((wavecnt[(size_t)(vcu * NWAVES + w) * 4 + (lane >> 3) * 2 + ((lane & 7) >> 2)] >> (8 * (lane & 3))) & 255u); }
    int* pos01 = (int*)(ws + WS_POS);
    int* rowtok0 = (int*)(ws + WS_ROWTOK); int* rowtok1 = rowtok0; float* rowgate0 = (float*)(ws + WS_ROWGATE); float* rowgate1 = rowgate0;
    for (int tb = t0; tb < t1; tb += 64) {
        const int nt = (t1 - tb) < 64 ? (t1 - tb) : 64, tk = tb + lane;
        unsigned rt = 0u; float g1 = 0.f, g2 = 0.f;
        if (lane < nt) { rt = route[tk]; g1 = gate1[tk]; g2 = gate2[tk]; }
        int myp1 = 0, myp2 = 0;
        for (int i = 0; i < nt; ++i) {
            const unsigned rti = (unsigned)__builtin_amdgcn_readlane((int)rt, i); const int e1 = (int)(rti & 255u), e2 = (int)((rti >> 8) & 255u);
            const int p1 = __builtin_amdgcn_readlane(mypos, e1), p2 = __builtin_amdgcn_readlane(mypos, 8 + e2);
            if (lane == e1 || lane == 8 + e2) mypos += 1;
            if (lane == i) { myp1 = p1; myp2 = p2; }
        }
        if (lane < nt) { rowtok0[myp1] = tk; rowgate0[myp1] = g1; rowtok1[myp2] = tk; rowgate1[myp2] = g2; pos01[tk] = myp1; pos01[T + tk] = myp2; }
    }
    if (vcu < 8) { int* rtk = (int*)(ws + WS_ROWTOK); float* rgt = (float*)(ws + WS_ROWGATE);
        const int beg = totL[32 + vcu] + totL[vcu] + totL[8 + vcu], end = totL[32 + vcu] + (((totL[vcu] + totL[8 + vcu] + 255) >> 8) << 8);
        for (int i = beg + tid; i < end; i += NWAVES * 64) { rtk[i] = -1; rgt[i] = 0.f; } }
    __syncthreads();
}

__device__ __forceinline__ void combine_phase(float* out, unsigned char* ws, int G, int vcu, int tid, int lane, int wave) {
    const int* pos01 = (const int*)(ws + WS_POS); const unsigned char* Y = ws + WS_Y; const _Float16* XH = (const _Float16*)(ws + WS_XH);
    const int gw = vcu * NWAVES + wave, NGW = G * NWAVES; const float ys = 1.f / Y_SCALE;
    for (int t0 = gw * 4; t0 < T; t0 += NGW * 4) {
        unsigned ya[4][4], yb[4][4]; pg8::h16x4 xh[4][4];
#pragma unroll
        for (int q = 0; q < 4; ++q) { const int t = t0 + q; const int p0 = pos01[t], p1 = pos01[T + t];
#pragma unroll
            for (int j = 0; j < 4; ++j) { ya[q][j] = *(const GAS unsigned*)(Y + (size_t)p0 * 1024 + 4 * lane + 256 * j); yb[q][j] = *(const GAS unsigned*)(Y + (size_t)p1 * 1024 + 4 * lane + 256 * j);
                xh[q][j] = *(const GAS pg8::h16x4*)(XH + (size_t)t * 1024 + 4 * lane + 256 * j); } }
#pragma unroll
        for (int q = 0; q < 4; ++q)
#pragma unroll
            for (int j = 0; j < 4; ++j) { const unsigned a = ya[q][j], c = yb[q][j]; f32x4 x = __builtin_convertvector(xh[q][j], f32x4);
                x.x += (float)(((int)(a << 24) >> 24) + ((int)(c << 24) >> 24)) * ys; x.y += (float)(((int)(a << 16) >> 24) + ((int)(c << 16) >> 24)) * ys;
                x.z += (float)(((int)(a << 8) >> 24) + ((int)(c << 8) >> 24)) * ys; x.w += (float)(((int)a >> 24) + ((int)c >> 24)) * ys;
                __builtin_nontemporal_store(x, (GAS f32x4*)(out + (size_t)(t0 + q) * 1024 + 4 * lane + 256 * j)); }
    }
}

constexpr int N_LAUNCHES = MK_N_LAUNCHES;
struct Args { const float* in[26]; float* out; unsigned char* ws; int ph_lo, ph_hi; };
typedef const __attribute__((address_space(4))) unsigned char* kargp_t;
#ifdef PROBE_CLK_PHASE
#define CLK_BEGIN(k) unsigned long long ck0_ = 0, rt0_ = 0; if ((k) == PROBE_CLK_PHASE) { ck0_ = __builtin_amdgcn_s_memtime(); rt0_ = __builtin_amdgcn_s_memrealtime(); }
#define CLK_END(k) if ((k) == PROBE_CLK_PHASE && bx == 0 && tid == 0) { const unsigned long long ck1_ = __builtin_amdgcn_s_memtime(), rt1_ = __builtin_amdgcn_s_memrealtime(); const float qv_ = floorf((float)(ck1_ - ck0_) / (float)(rt1_ - rt0_) + 0.5f); ((float*)(ws + WS_GOFS))[100] = 100.f * qv_ * qv_; }
#else
#define CLK_BEGIN(k)
#define CLK_END(k)
#endif
#define PH_ENTER() kargp_t kp_ = kp0; asm volatile("" : "+s"(kp_)); int tid = tid0; asm volatile("" : "+v"(tid)); const int lane = tid & 63, wave = __builtin_amdgcn_readfirstlane(tid >> 6); \
    unsigned char* ws = *(unsigned char* const __attribute__((address_space(4)))*)(kp_ + 216); float* out = *(float* const __attribute__((address_space(4)))*)(kp_ + 208); (void)lane; (void)wave; (void)out
#define INP(i) (*(const float* const __attribute__((address_space(4)))*)(kp_ + 8 * (i)))
__global__ void __launch_bounds__(NWAVES * 64, 2) mk_fwd(Args args) {
    extern __shared__ __attribute__((aligned(16))) unsigned char lds_raw[];
    LAS unsigned char* lds = (LAS unsigned char*)lds_raw;
    static_assert(sizeof(Args) == 232 && __builtin_offsetof(Args, out) == 208 && __builtin_offsetof(Args, ws) == 216, "Args layout");
    const kargp_t kp0 = (kargp_t)__builtin_amdgcn_kernarg_segment_ptr();
    const int tid0 = threadIdx.x;
    const int G = gridDim.x, bx = blockIdx.x, vcu = (G % 8 == 0) ? (bx % 8) * (G / 8) + bx / 8 : bx;
    for (int u = tid0; u < (XTRA_OFF - LDSCTL_OFF) / 4; u += NWAVES * 64) ((LAS unsigned*)(lds + LDSCTL_OFF))[u] = 0u;
    __syncthreads();
    XcdBarrier bar; bar.bar = (unsigned*)(args.ws + WS_CTL) + CW_BAR; bar.x = 0; bar.st = (volatile LAS unsigned*)(lds + MISC_OFF) + 8;
    if (N_LAUNCHES == 1) bar = xcd_barrier_post((unsigned*)(args.ws + WS_CTL) + CW_BAR, (volatile LAS unsigned*)(lds + MISC_OFF) + 8);
#define GRID_BAR() do { if (N_LAUNCHES == 1) xcd_barrier(bar); } while (0)
    const int lo = args.ph_lo, hi = args.ph_hi;
#ifndef PH_MASK
#define PH_MASK 0xFFFFFFFFu
#endif
#define IN(k) (((PH_MASK >> (k)) & 1u) && lo <= (k) && (k) < hi)
#define BOTH(k) (IN(k) && IN((k) + 1))
#ifndef PROBE_NOEPI
#define PROBE_NOEPI 0
#endif
#ifndef PROBE_REP_MASK
#define PROBE_REP_MASK 0u
#define PROBE_REP_N 1
#endif
#define REPS(k) (((PROBE_REP_MASK >> (k)) & 1u) ? PROBE_REP_N : 1)

    _Pragma("nounroll") for (int rep_ = 0; rep_ < REPS(0); ++rep_) if (IN(0)) { PH_ENTER(); CLK_BEGIN(0); p0_prologue(kp_, ws, lds, G, vcu, tid, lane, wave); __syncthreads(); CLK_END(0); if (BOTH(0)) GRID_BAR(); }
    _Pragma("nounroll") for (int rep_ = 0; rep_ < REPS(1); ++rep_) if (IN(1)) { PH_ENTER(); CLK_BEGIN(1);
        pg8::Gemm g{(const bf16*)(ws + WS_H0), (const bf16*)(ws + WS_WIN), T, 2048, 1024, 0, nullptr, nullptr, nullptr, nullptr, 0}; pg8::StaticOrder S; S.init(T, 2048, G, bx, I8_P1 ? 1024 / 128 : 1024 / 64);
        pg8::EpiGated<0> E{(bf16*)(ws + WS_GLU), 1024, INP(4), 1024, nullptr, I8_P1 ? 1.f / (SA_N * SW_I8) : 1.f, 1.f, {}, -1, lds + XTRA_OFF};
        pg8::gemm_phase<pg8::EpiGated<0>, pg8::StaticOrder, false, I8_P1 ? 2 : 0>(lds + RING_OFF, g, S, E, tid);
        CLK_END(1); if (BOTH(1)) GRID_BAR();
    }
    _Pragma("nounroll") for (int rep_ = 0; rep_ < REPS(2); ++rep_) if (IN(2)) { PH_ENTER(); CLK_BEGIN(2); conv_phase((const bf16*)(ws + WS_GLU), INP(5), INP(6), INP(7), INP(8), (bf16*)(ws + WS_V), lds, G, vcu, tid, lane, wave); CLK_END(2); if (BOTH(2)) GRID_BAR(); }
    _Pragma("nounroll") for (int rep_ = 0; rep_ < REPS(3); ++rep_) if (IN(3)) { PH_ENTER(); CLK_BEGIN(3);
        pg8::Gemm g{(const bf16*)(ws + WS_V), (const bf16*)(ws + WS_WOUT), T, 1024, 1024, 0, nullptr, nullptr, nullptr, nullptr, 0}; pg8::StaticOrder S; S.init(T, 1024, G, bx, I8_P3 ? 1024 / 128 : 1024 / 64);
        pg8::EpiResid<true, true, I8_P4 ? 2 : 0, 0, 1> E{INP(0), (float*)(ws + WS_XH), INP(10), ws + WS_X1B, (float*)(ws + WS_PART1), I8_P3 ? 1.f / (SA_N * SW_I8) : 1.f, I8_P4 ? SA_X : 1.f, (LAS float*)(lds + XTRA_OFF), lds + XTRA_OFF + 4096};
        pg8::gemm_phase<pg8::EpiResid<true, true, I8_P4 ? 2 : 0, 0, 1>, pg8::StaticOrder, false, I8_P3 ? 2 : 0>(lds + RING_OFF, g, S, E, tid);
        CLK_END(3); if (BOTH(3)) GRID_BAR();
    }
    _Pragma("nounroll") for (int rep_ = 0; rep_ < REPS(4); ++rep_) if (IN(4)) { PH_ENTER(); CLK_BEGIN(4);
        pg8::Gemm g{(const bf16*)(ws + WS_X1B), (const bf16*)(ws + WS_WF13), T, 5632, 1024, 0, nullptr, nullptr, nullptr, nullptr, 0}; pg8::StaticOrder S; S.init(T, 5632, G, bx, I8_P4 ? 1024 / 128 : 1024 / 64);
        pg8::EpiGated<1> E{(bf16*)(ws + WS_HB), DFFP, nullptr, 0, (const float*)(ws + WS_PART1), I8_P4 ? 1.f / (SA_X * SW_I8) : 1.f, 1.f, {}, -1, lds + XTRA_OFF};
        if (G == 256) {
            const int slot = vcu % 11;
            S.i1 = slot;
            pg8::gemm_phase<pg8::EpiGated<1>, pg8::StaticOrder, false, I8_P4 ? 2 : 0>(lds + RING_OFF, g, S, E, tid);
            __syncthreads();
            p0_items2(kp_, ws, (LAS float*)(lds + RING_OFF + wave * 16384), wave, NWAVES, vcu * (IT_MOE / 256) + CONV_RT * NWAVES, (vcu + 1) * (IT_MOE / 256), lane);
            __syncthreads();
            S.i0 = slot; S.i1 = 0x7fffffff;
        }
        pg8::gemm_phase<pg8::EpiGated<1>, pg8::StaticOrder, false, I8_P4 ? 2 : 0>(lds + RING_OFF, g, S, E, tid);
        CLK_END(4); if (BOTH(4)) GRID_BAR();
    }
    _Pragma("nounroll") for (int rep_ = 0; rep_ < REPS(5); ++rep_) if (IN(5)) { PH_ENTER(); CLK_BEGIN(5);
        pg8::Gemm g{(const bf16*)(ws + WS_HB), (const bf16*)(ws + WS_WFD), T, 1024, DFFP, 0, nullptr, nullptr, nullptr, nullptr, 0}; pg8::StaticOrder S; S.init(T, 1024, G, bx, DFFP / 64);
        pg8::EpiResid<false, true, 2, 1, 1> E{(const float*)(ws + WS_XH), (float*)(ws + WS_XH), nullptr, ws + WS_X2B, (float*)(ws + WS_PART2), 1.f, SA_X, (LAS float*)(lds + XTRA_OFF), lds + XTRA_OFF + 4096};
        pg8::gemm_phase<pg8::EpiResid<false, true, 2, 1, 1>, pg8::StaticOrder, false>(lds + RING_OFF, g, S, E, tid);
        CLK_END(5); if (BOTH(5)) GRID_BAR();
    }
    for (int grp = 0; grp < 3; ++grp) {
        _Pragma("nounroll") for (int rep_ = 0; rep_ < REPS(6 + 2 * grp); ++rep_) if (IN(6 + 2 * grp)) { PH_ENTER(); CLK_BEGIN(6 + 2 * grp);
            pg8::Gemm g{(const bf16*)(ws + WS_X2B), (const bf16*)(ws + WS_WQKV + (size_t)grp * 3072 * 1024), T, 3072, 1024, 0, nullptr, nullptr, nullptr, nullptr, 0}; pg8::StaticOrder S; S.init(T, 3072, G, bx, 1024 / 128);
            pg8::EpiQKV E{(bf16*)(ws + WS_KG), (size_t)T * D, (const float*)(ws + WS_PART2), INP(13) + grp * 64, INP(16) + grp * 64, QSCALE, 1.f / (SA_X * SW_I8), {}, -1, lds + XTRA_OFF};
            pg8::gemm_phase<pg8::EpiQKV, pg8::StaticOrder, false, 2>(lds + RING_OFF, g, S, E, tid);
            CLK_END(6 + 2 * grp); if (BOTH(6 + 2 * grp)) GRID_BAR();
        }
        _Pragma("nounroll") for (int rep_ = 0; rep_ < REPS(7 + 2 * grp); ++rep_) if (IN(7 + 2 * grp)) { PH_ENTER(); CLK_BEGIN(7 + 2 * grp);
            attn_phase(lds, grp, (const bf16*)(ws + WS_KG), (const bf16*)(ws + WS_VG), (const bf16*)(ws + WS_QG), (bf16*)(ws + WS_O), ws + WS_O8, (float*)(ws + WS_LSE), INP(1), (unsigned*)(ws + WS_CTL) + CW_AQ + grp * 128, G, vcu, tid, lane, wave);
            CLK_END(7 + 2 * grp); if (BOTH(7 + 2 * grp)) GRID_BAR();
        }
    }
    _Pragma("nounroll") for (int rep_ = 0; rep_ < REPS(12); ++rep_) if (IN(12)) { PH_ENTER(); CLK_BEGIN(12);
        pg8::Gemm g{(const bf16*)(ws + WS_O8), (const bf16*)(ws + WS_WO), T, 1024, 1024, 0, nullptr, nullptr, nullptr, nullptr, 0}; pg8::StaticOrder S; S.init(T, 1024, G, bx, 1024 / 128);
        pg8::EpiResid<false, false, 0, 1, 1> E{(const float*)(ws + WS_XH), (float*)(ws + WS_XH), nullptr, nullptr, nullptr, 1.f / (W8_SCALE * O8_SCALE), 1.f, nullptr, lds + XTRA_OFF + 4096};
        pg8::gemm_phase<pg8::EpiResid<false, false, 0, 1, 1>, pg8::StaticOrder, false, 1>(lds + RING_OFF, g, S, E, tid);
        CLK_END(12); if (BOTH(12)) GRID_BAR();
    }
    _Pragma("nounroll") for (int rep_ = 0; rep_ < REPS(13); ++rep_) if (IN(13)) { PH_ENTER(); CLK_BEGIN(13); route_phase((const _Float16*)(ws + WS_XH), INP(18) + 1024, INP(22), kp_, ws, lds, G, vcu, tid, lane, wave); CLK_END(13); if (BOTH(13)) GRID_BAR(); }
    _Pragma("nounroll") for (int rep_ = 0; rep_ < REPS(14); ++rep_) if (IN(14)) { PH_ENTER(); CLK_BEGIN(14); pos_phase(ws, lds, G, vcu, tid, lane, wave); CLK_END(14); if (BOTH(14)) GRID_BAR(); }
    _Pragma("nounroll") for (int rep_ = 0; rep_ < REPS(15); ++rep_) if (IN(15)) { PH_ENTER(); CLK_BEGIN(15);
        const int* gofs = (const int*)(ws + WS_GOFS); const int* rowtok = (const int*)(ws + WS_ROWTOK);
        const int ntile = gofs[16];
        pg8::MoeOrder S; S.so.init(ntile * 256, 7168, G, bx, 1024 / 128); S.p0 = 0; S.p1 = 0; S.ppu = 0;
        S.t1 = gofs[32 + 1]; S.t2 = gofs[32 + 2]; S.t3 = gofs[32 + 3]; S.t4 = gofs[32 + 4]; S.t5 = gofs[32 + 5]; S.t6 = gofs[32 + 6]; S.t7 = gofs[32 + 7];
        pg8::Gemm g{(const bf16*)(ws + WS_H3), (const bf16*)(ws + WS_WM13), ntile * 256, 7168, 1024, (size_t)7168 * 1024, rowtok, nullptr, nullptr, nullptr, 0};
        pg8::EpiGated<3> E{(bf16*)(ws + WS_HM), DFFE, nullptr, 0, nullptr, 1.f / (SA_N * SW_I8), HM_SCALE, {}, -1, lds + XTRA_OFF};
        pg8::gemm_phase<pg8::EpiGated<3>, pg8::MoeOrder, true, 2>(lds + RING_OFF, g, S, E, tid);
        CLK_END(15); if (BOTH(15)) GRID_BAR();
    }
    _Pragma("nounroll") for (int rep_ = 0; rep_ < REPS(16); ++rep_) if (IN(16)) { PH_ENTER(); CLK_BEGIN(16);
        const int* gofs = (const int*)(ws + WS_GOFS); const float* rowgate = (const float*)(ws + WS_ROWGATE);
        const int ntile = gofs[16];
        pg8::MoeOrderSK S; S.so.init(ntile * 256, 1024, G, vcu, DFFE / 128); S.plan();
        S.t1 = gofs[32 + 1]; S.t2 = gofs[32 + 2]; S.t3 = gofs[32 + 3]; S.t4 = gofs[32 + 4]; S.t5 = gofs[32 + 5]; S.t6 = gofs[32 + 6]; S.t7 = gofs[32 + 7];
        pg8::Gemm g{(const bf16*)(ws + WS_HM), (const bf16*)(ws + WS_WM2), ntile * 256, 1024, DFFE, (size_t)1024 * DFFE, nullptr, ws + WS_SLAB, (unsigned*)(ws + WS_CTL) + CW_SKFLAG + (rep_ & 1) * 8192, (unsigned*)(ws + WS_CTL) + CW_TMO, 0};
        pg8::EpiMoeDown E{ws + WS_Y, rowgate, Y_SCALE / (W8_SCALE * HM_SCALE)};
        pg8::gemm_phase<pg8::EpiMoeDown, pg8::MoeOrderSK, false, 1>(lds + RING_OFF, g, S, E, tid);
        CLK_END(16); if (BOTH(16)) GRID_BAR();
    }
    _Pragma("nounroll") for (int rep_ = 0; rep_ < REPS(17); ++rep_) if (IN(17)) { PH_ENTER(); CLK_BEGIN(17); combine_phase(out, ws, G, vcu, tid, lane, wave); }
#ifdef PROBE_CLK_PHASE
    if (bx == 0 && tid0 == 0) { asm volatile("s_waitcnt vmcnt(0)" ::: "memory"); args.out[(size_t)T * D - 1] = ((float*)(args.ws + WS_GOFS))[100]; }
#endif
#ifdef PROBE_TCH
    {
        GRID_BAR();
        if (bx == 0 && tid0 == 0) { const unsigned tot = __hip_atomic_load((unsigned*)(args.ws + WS_CTL) + 60000, __ATOMIC_RELAXED, __HIP_MEMORY_SCOPE_AGENT); const unsigned long long wait_ticks = (unsigned long long)(tot / (unsigned)G) * PROBE_TCH;
            const unsigned long long t0_ = __builtin_amdgcn_s_memrealtime(); while (__builtin_amdgcn_s_memrealtime() - t0_ < wait_ticks) __builtin_amdgcn_s_sleep(8); } }
#endif
#undef IN
#undef BOTH
#undef GRID_BAR
}

extern "C" void kernel_launch(void* const* d_in, const int* in_sizes, int n_in, void* d_out, int out_size, void* d_ws, size_t ws_size, hipStream_t stream) {
    static int grid = 0;
    if (grid == 0) {
        if (n_in != 26 || in_sizes[0] != T * D || out_size != T * D || ws_size < WS_END) { fprintf(stderr, "kernel_launch: unexpected shapes: n_in %d in0 %d out %d ws %zu (need >= %zu); nothing launched\n", n_in, n_in > 0 ? in_sizes[0] : -1, out_size, ws_size, (size_t)WS_END); grid = -1; return; }
        int dev = 0, cus = 0;
        if (hipGetDevice(&dev) != hipSuccess || hipDeviceGetAttribute(&cus, hipDeviceAttributeMultiprocessorCount, dev) != hipSuccess) { fprintf(stderr, "kernel_launch: device query failed\n"); grid = -1; return; }
        if (hipFuncSetAttribute((const void*)mk_fwd, hipFuncAttributeMaxDynamicSharedMemorySize, LDS_BYTES) != hipSuccess) { fprintf(stderr, "kernel_launch: hipFuncSetAttribute failed\n"); grid = -1; return; }
        int per_cu = 0;
        if (hipOccupancyMaxActiveBlocksPerMultiprocessor(&per_cu, (const void*)mk_fwd, NWAVES * 64, LDS_BYTES) != hipSuccess || per_cu < 1) fprintf(stderr, "kernel_launch: note: occupancy query reports %d workgroups per CU\n", per_cu);
        (void)hipGetLastError();
        grid = cus;
    }
    if (grid < 0) return;
    if (hipMemsetAsync((char*)d_ws + WS_CTL, 0, CTL_ZERO_BYTES, stream) != hipSuccess) { fprintf(stderr, "kernel_launch: hipMemsetAsync failed\n"); return; }
    Args a{};
    for (int i = 0; i < 26; ++i) a.in[i] = (const float*)d_in[i];
    a.out = (float*)d_out; a.ws = (unsigned char*)d_ws;
    for (int li = 0; li < N_LAUNCHES; ++li) {
        a.ph_lo = (N_LAUNCHES == 1) ? 0 : li; a.ph_hi = (N_LAUNCHES == 1) ? NPHASE : li + 1;
        hipLaunchKernelGGL(mk_fwd, dim3(grid), dim3(NWAVES * 64), LDS_BYTES, stream, a);
        const hipError_t le = hipPeekAtLastError();
        if (le != hipSuccess) { fprintf(stderr, "kernel_launch: launch %d failed: %s\n", li, hipGetErrorName(le)); break; }
    }
}
```
